# Optimizing an MI355X kernel written in HIP

```python
import jax, jax.numpy as jnp
from jax import lax
import numpy as np

D_MODEL = 1024
BATCH = 8
SEQ = 4096
DEPTH = 2

CTX_LEN = 256
GRID_W = 64

ATT_HEADS = 8
ATT_KV_HEADS = 2
ATT_GROUP = ATT_HEADS // ATT_KV_HEADS
ATT_HEAD_DIM = 64
WINDOW = 128
ATT_BLOCK = 128
BAND_SIDE = WINDOW // ATT_BLOCK
ROPE_BASE = 10000.0

ML_HEADS = 4
ML_DK = 64
ML_DV = 128
ML_CONV_W = 3

HG_HEADS = 4
HG_DK = 64
HG_DV = 128

CHUNK = 64
D_FF = ((8 * D_MODEL // 3 + 127) // 128) * 128
N_BRANCH = 3
N_SUB = 3
N_MOD = 3 * N_SUB
EPS = 1e-6

ATT_Q = ATT_HEADS * ATT_HEAD_DIM
ATT_KV = ATT_KV_HEADS * ATT_HEAD_DIM
ML_QK = ML_HEADS * ML_DK
ML_V = ML_HEADS * ML_DV
HG_K = HG_HEADS * HG_DK
HG_V = HG_HEADS * HG_DV
COLUMN_SIZES = (ATT_Q, ATT_KV, ATT_KV,
                ML_QK, ML_QK, ML_V, ML_V, 2 * ML_HEADS, 2 * ML_HEADS,
                HG_K, HG_K, HG_K, HG_V, HG_V,
                N_BRANCH * D_MODEL)
D_IN = sum(COLUMN_SIZES)

kernel_name = "hybrid_swa_mlstm_hgrn2_diffusion_block"


def rms_norm(x, g):
    x32 = x.astype(jnp.float32)
    y = x32 * lax.rsqrt(jnp.mean(x32 * x32, axis=-1, keepdims=True) + EPS)
    return (y * g.astype(jnp.float32)).astype(x.dtype)


def ada_pre(x, mod, j, g):
    return rms_norm(x, g) * (1.0 + mod[..., 3 * j + 1, :]) + mod[..., 3 * j, :]


def ada_post(x, y, mod, j, g, w):
    return x + w * mod[..., 3 * j + 2, :] * rms_norm(y, g)


def macaron_ffn(x, mod, j, g_pre, g_post, w1, w3, w2):
    h = ada_pre(x, mod, j, g_pre)
    y = (jax.nn.silu(h @ w1) * (h @ w3)) @ w2
    return ada_post(x, y, mod, j, g_post, 0.5)


def split_columns(p):
    idx = np.cumsum(COLUMN_SIZES)[:-1].tolist()
    return jnp.split(p, idx, axis=-1)


def short_conv(x, w):
    K = w.shape[0]
    L = x.shape[1]
    r = K // 2
    xp = jnp.pad(x, ((0, 0), (r, r), (0, 0)))
    out = xp[:, 0:L] * w[0]
    for j in range(1, K):
        out = out + xp[:, j:j + L] * w[j]
    return out


def axial_angles(L):
    rows = L // GRID_W
    row = jnp.repeat(jnp.arange(rows, dtype=jnp.float32), GRID_W)
    col = jnp.tile(jnp.arange(GRID_W, dtype=jnp.float32), rows)
    n_freq = ATT_HEAD_DIM // 4
    inv = ROPE_BASE ** (-jnp.arange(n_freq, dtype=jnp.float32) / n_freq)
    return row[:, None] * inv, col[:, None] * inv


def rope_axis(x, ang):
    F = ang.shape[-1]
    shape = (ang.shape[0],) + (1,) * (x.ndim - 3) + (F,)
    cos = jnp.cos(ang).reshape(shape).astype(x.dtype)
    sin = jnp.sin(ang).reshape(shape).astype(x.dtype)
    x1, x2 = x[..., :F], x[..., F:]
    return jnp.concatenate([x1 * cos - x2 * sin, x2 * cos + x1 * sin], axis=-1)


def rope_2d(x, ang_row, ang_col):
    half = ATT_HEAD_DIM // 2
    return jnp.concatenate([rope_axis(x[..., :half], ang_row), rope_axis(x[..., half:], ang_col)], axis=-1)


def sink_softmax(s, sink):
    sk = sink.astype(jnp.float32)[:, :, None, None]
    m = jnp.maximum(jnp.max(s, axis=-1, keepdims=True), sk)
    p = jnp.exp(s - m)
    return p / (jnp.sum(p, axis=-1, keepdims=True) + jnp.exp(sk - m))


def context_attention(q, k, v, sink):
    B, Lc = q.shape[:2]
    s = jnp.einsum('bqgrd,bkgd->bgrqk', q, k).astype(jnp.float32)
    p = sink_softmax(s, sink.reshape(ATT_KV_HEADS, ATT_GROUP)).astype(v.dtype)
    return jnp.einsum('bgrqk,bkgd->bqgrd', p, v).reshape(B, Lc, ATT_Q)


def banded_attention(q, k, v, k_ctx, v_ctx, sink):
    B, L, G, R, d = q.shape
    nb = L // ATT_BLOCK
    pad = BAND_SIDE * ATT_BLOCK
    n_band = (2 * BAND_SIDE + 1) * ATT_BLOCK

    def band(a):
        ap = jnp.pad(a, ((0, 0), (pad, pad), (0, 0), (0, 0)))
        pieces = [ap[:, s * ATT_BLOCK: s * ATT_BLOCK + L].reshape(B, nb, ATT_BLOCK, G, d)
                  for s in range(2 * BAND_SIDE + 1)]
        return jnp.moveaxis(jnp.concatenate(pieces, axis=2), 1, 0)

    qb = jnp.moveaxis(q.reshape(B, nb, ATT_BLOCK, G, R, d), 1, 0)
    kb, vb = band(k), band(v)
    rel = (jnp.arange(n_band) - pad)[None, :] - jnp.arange(ATT_BLOCK)[:, None]
    in_window = jnp.abs(rel) <= WINDOW
    sink_gr = sink.reshape(G, R)

    def block(inp):
        i, qi, ki, vi = inp
        kpos = i * ATT_BLOCK - pad + jnp.arange(n_band)
        valid = in_window & ((kpos >= 0) & (kpos < L))[None, :]
        s_lat = jnp.einsum('bqgrd,bkgd->bgrqk', qi, ki).astype(jnp.float32)
        s_lat = jnp.where(valid, s_lat, -jnp.inf)
        s_ctx = jnp.einsum('bqgrd,bkgd->bgrqk', qi, k_ctx).astype(jnp.float32)
        p = sink_softmax(jnp.concatenate([s_lat, s_ctx], axis=-1), sink_gr).astype(vi.dtype)
        return jnp.einsum('bgrqk,bkgd->bqgrd', p, jnp.concatenate([vi, v_ctx], axis=1))

    out = lax.map(block, (jnp.arange(nb), qb, kb, vb))
    return jnp.moveaxis(out, 0, 1).reshape(B, L, G * R * d)


def mlstm_scan(q, k, v, log_i, log_f, state):
    B, H, L, _ = q.shape
    nc = L // CHUNK
    tri = jnp.tril(jnp.ones((CHUNK, CHUNK), bool))

    def chunks(a):
        return jnp.moveaxis(a.reshape((B, H, nc, CHUNK) + a.shape[3:]), 2, 0)

    def step(carry, inp):
        C, n, m = carry
        qc, kc, vc, ic, fc = inp
        b = jnp.cumsum(fc, axis=-1)
        logw = jnp.where(tri, b[..., :, None] - b[..., None, :] + ic[..., None, :], -jnp.inf)
        inter = b + m[..., None]
        m_t = jnp.maximum(inter, jnp.max(logw, axis=-1))
        w_prev = jnp.exp(inter - m_t)
        scores = jnp.einsum('bhtd,bhsd->bhts', qc, kc) * jnp.exp(logw - m_t[..., None])
        num = (w_prev[..., None] * jnp.einsum('bhtd,bhde->bhte', qc, C)
               + jnp.einsum('bhts,bhse->bhte', scores, vc))
        den = w_prev * jnp.einsum('bhtd,bhd->bht', qc, n) + jnp.sum(scores, axis=-1)
        h = num / jnp.maximum(jnp.abs(den), jnp.exp(-m_t))[..., None]
        bl = b[..., -1]
        logu = bl[..., None] - b + ic
        m_new = jnp.maximum(bl + m, jnp.max(logu, axis=-1))
        a_prev = jnp.exp(bl + m - m_new)
        u = jnp.exp(logu - m_new[..., None])
        C = a_prev[..., None, None] * C + jnp.einsum('bhs,bhsd,bhse->bhde', u, kc, vc)
        n = a_prev[..., None] * n + jnp.einsum('bhs,bhsd->bhd', u, kc)
        return (C, n, m_new), h

    state, hs = lax.scan(step, state, (chunks(q), chunks(k), chunks(v), chunks(log_i), chunks(log_f)))
    return jnp.moveaxis(hs, 0, 2).reshape(B, H, L, -1), state


def hgrn2_scan(q, k, v, log_f, S0):
    B, H, L, _ = q.shape
    nc = L // CHUNK
    tri = jnp.tril(jnp.ones((CHUNK, CHUNK), bool))

    def chunks(a):
        return jnp.moveaxis(a.reshape(B, H, nc, CHUNK, a.shape[-1]), 2, 0)

    def step(S, inp):
        qc, kc, vc, fc = inp
        b = jnp.cumsum(fc, axis=2)
        o = jnp.einsum('bhtd,bhde->bhte', qc * jnp.exp(b), S)
        diff = b[:, :, :, None, :] - b[:, :, None, :, :]
        decay = jnp.exp(jnp.where(tri[:, :, None], diff, -jnp.inf))
        A = jnp.einsum('bhtd,bhsd,bhtsd->bhts', qc, kc, decay)
        o = o + jnp.einsum('bhts,bhse->bhte', A, vc)
        bl = b[:, :, -1:, :]
        S = (jnp.exp(bl[:, :, 0, :, None]) * S
             + jnp.einsum('bhsd,bhse->bhde', kc * jnp.exp(bl - b), vc))
        return S, o

    S, o = lax.scan(step, S0, (chunks(q), chunks(k), chunks(v), chunks(log_f)))
    return jnp.moveaxis(o, 0, 2).reshape(B, H, L, -1), S


def _identity(a):
    return a


def _reverse(a):
    return jnp.flip(a, axis=2)


def project_stream(p, ml_conv, ml_f_bias, lb, ang):
    B, L, _ = p.shape
    f32 = jnp.float32
    (a_q, a_k, a_v, m_q, m_k, m_v, m_o, m_i, m_f,
     h_q, h_f_fwd, h_f_bwd, h_i, h_g, br_g) = split_columns(p)

    def heads(a, h):
        return jnp.swapaxes(a.reshape(B, L, h, -1), 1, 2).astype(f32)

    q = a_q.reshape(B, L, ATT_KV_HEADS, ATT_GROUP, ATT_HEAD_DIM)
    k = a_k.reshape(B, L, ATT_KV_HEADS, ATT_HEAD_DIM)
    v = a_v.reshape(B, L, ATT_KV_HEADS, ATT_HEAD_DIM)
    if ang is not None:
        q = rope_2d(q, ang[0], ang[1])
        k = rope_2d(k, ang[0], ang[1])
    q = q * ATT_HEAD_DIM ** -0.5

    mq = jax.nn.silu(short_conv(m_q, ml_conv[:, :ML_QK]))
    mk = jax.nn.silu(short_conv(m_k, ml_conv[:, ML_QK:])) * ML_DK ** -0.5
    ml_i = jnp.transpose(m_i.reshape(B, L, 2, ML_HEADS).astype(f32), (2, 0, 3, 1))
    ml_f = jnp.transpose(jax.nn.log_sigmoid(m_f.reshape(B, L, 2, ML_HEADS).astype(f32) + ml_f_bias),
                         (2, 0, 3, 1))

    lb_h = lb.reshape(HG_HEADS, HG_DK)
    hq = jax.nn.silu(h_q) * HG_DK ** -0.5
    hg_k, hg_f = [], []
    for z in (h_f_fwd, h_f_bwd):
        z = z.reshape(B, L, HG_HEADS, HG_DK).astype(f32)
        log_f = jnp.logaddexp(jnp.log(lb_h), jnp.log1p(-lb_h) + jax.nn.log_sigmoid(z))
        hg_f.append(jnp.swapaxes(log_f, 1, 2))
        hg_k.append(jnp.swapaxes((1.0 - lb_h) * jax.nn.sigmoid(-z), 1, 2))

    return dict(att_q=q, att_k=k, att_v=v,
                ml_q=heads(mq, ML_HEADS), ml_k=heads(mk, ML_HEADS), ml_v=heads(m_v, ML_HEADS),
                ml_o=m_o, ml_i=ml_i, ml_f=ml_f,
                hg_q=heads(hq, HG_HEADS), hg_k=hg_k, hg_f=hg_f, hg_v=heads(h_i, HG_HEADS), hg_g=h_g,
                br_g=br_g)


def mlstm_bidir(sx, sc):
    B = sc['ml_q'].shape[0]
    f32 = jnp.float32
    init = (jnp.zeros((B, ML_HEADS, ML_DK, ML_DV), f32), jnp.zeros((B, ML_HEADS, ML_DK), f32),
            jnp.zeros((B, ML_HEADS), f32))
    out_x, out_c = [], []
    for d in range(2):
        fl = _reverse if d == 1 else _identity
        hc, st = mlstm_scan(fl(sc['ml_q']), fl(sc['ml_k']), fl(sc['ml_v']),
                            fl(sc['ml_i'][d]), fl(sc['ml_f'][d]), init)
        hx, _ = mlstm_scan(fl(sx['ml_q']), fl(sx['ml_k']), fl(sx['ml_v']),
                           fl(sx['ml_i'][d]), fl(sx['ml_f'][d]), st)
        out_x.append(fl(hx))
        out_c.append(fl(hc))
    return out_x[0] + out_x[1], out_c[0] + out_c[1]


def hgrn2_bidir(sx, sc):
    B = sc['hg_q'].shape[0]
    init = jnp.zeros((B, HG_HEADS, HG_DK, HG_DV), jnp.float32)
    out_x, out_c = [], []
    for d in range(2):
        fl = _reverse if d == 1 else _identity
        oc, st = hgrn2_scan(fl(sc['hg_q']), fl(sc['hg_k'][d]), fl(sc['hg_v']), fl(sc['hg_f'][d]), init)
        ox, _ = hgrn2_scan(fl(sx['hg_q']), fl(sx['hg_k'][d]), fl(sx['hg_v']), fl(sx['hg_f'][d]), st)
        out_x.append(fl(ox))
        out_c.append(fl(oc))
    return out_x[0] + out_x[1], out_c[0] + out_c[1]


def mlstm_readout(h, o_gate, g):
    B, _, L, _ = h.shape
    y = rms_norm(jnp.swapaxes(h, 1, 2), g.reshape(ML_HEADS, ML_DV)).reshape(B, L, ML_V)
    return (y * jax.nn.sigmoid(o_gate.astype(jnp.float32))).astype(o_gate.dtype)


def hgrn2_readout(o, gate, g):
    B, _, L, _ = o.shape
    y = rms_norm(jnp.swapaxes(o, 1, 2), g.reshape(HG_HEADS, HG_DV)).reshape(B, L, HG_V)
    return (y * jax.nn.silu(gate.astype(jnp.float32))).astype(gate.dtype)


def merge_branches(br_g, att, ml, hg, wb_att, wb_ml, wb_hg, w_out):
    B, L, _ = att.shape
    g = jax.nn.sigmoid(br_g).reshape(B, L, N_BRANCH, D_MODEL)
    y = (g[..., 0, :] * (att @ wb_att) + g[..., 1, :] * (ml @ wb_ml) + g[..., 2, :] * (hg @ wb_hg))
    return y @ w_out


def token_mix(hx, hc, ang, w_in, sink, ml_conv, ml_f_bias, ml_norm, lb, hg_norm,
              wb_att, wb_ml, wb_hg, w_out, need_ctx_out):
    sx = project_stream(hx @ w_in, ml_conv, ml_f_bias, lb, ang)
    sc = project_stream(hc @ w_in, ml_conv, ml_f_bias, lb, None)
    att_x = banded_attention(sx['att_q'], sx['att_k'], sx['att_v'], sc['att_k'], sc['att_v'], sink)
    ml_x, ml_c = mlstm_bidir(sx, sc)
    hg_x, hg_c = hgrn2_bidir(sx, sc)
    yx = merge_branches(sx['br_g'], att_x.astype(hx.dtype),
                        mlstm_readout(ml_x, sx['ml_o'], ml_norm),
                        hgrn2_readout(hg_x, sx['hg_g'], hg_norm), wb_att, wb_ml, wb_hg, w_out)
    yc = None
    if need_ctx_out:
        att_c = context_attention(sc['att_q'], sc['att_k'], sc['att_v'], sink)
        yc = merge_branches(sc['br_g'], att_c.astype(hc.dtype),
                            mlstm_readout(ml_c, sc['ml_o'], ml_norm),
                            hgrn2_readout(hg_c, sc['hg_g'], hg_norm), wb_att, wb_ml, wb_hg, w_out)
    return yx, yc


def setup_inputs(seed: int = 0) -> dict:
    key = jax.random.key(seed)
    ks = jax.random.split(key, 24)
    f32 = jnp.float32

    def nrm(k, shape, scale):
        return jax.random.normal(k, shape, f32) * scale

    return {
        "x": nrm(ks[0], (BATCH, SEQ, D_MODEL), 1.0),
        "c": nrm(ks[1], (BATCH, D_MODEL), 1.0),
        "ctx": nrm(ks[2], (BATCH, CTX_LEN, D_MODEL), 1.0),
        "c_ctx": nrm(ks[3], (D_MODEL,), 1.0),
        "w_ada": nrm(ks[4], (DEPTH, D_MODEL, N_MOD * D_MODEL), 0.5 * D_MODEL ** -0.5),
        "b_ada": nrm(ks[5], (DEPTH, N_MOD * D_MODEL), 0.02),
        "norm_pre": 1.0 + nrm(ks[6], (DEPTH, N_SUB, D_MODEL), 0.02),
        "norm_post": 1.0 + nrm(ks[7], (DEPTH, N_SUB, D_MODEL), 0.02),
        "ffn_w1": nrm(ks[8], (DEPTH, 2, D_MODEL, D_FF), D_MODEL ** -0.5),
        "ffn_w3": nrm(ks[9], (DEPTH, 2, D_MODEL, D_FF), D_MODEL ** -0.5),
        "ffn_w2": nrm(ks[10], (DEPTH, 2, D_FF, D_MODEL), D_FF ** -0.5),
        "w_in": nrm(ks[11], (DEPTH, D_MODEL, D_IN), D_MODEL ** -0.5),
        "att_sink": nrm(ks[12], (DEPTH, ATT_HEADS), 0.5),
        "ml_conv": nrm(ks[13], (DEPTH, ML_CONV_W, 2 * ML_QK), ML_CONV_W ** -0.5),
        "ml_f_bias": jnp.linspace(3.0, 6.0, ML_HEADS, dtype=f32) + nrm(ks[14], (DEPTH, 2, ML_HEADS), 0.1),
        "ml_norm": 1.0 + nrm(ks[15], (DEPTH, ML_V), 0.02),
        "hg_lb_logits": nrm(ks[16], (DEPTH, HG_K), 0.1),
        "hg_norm": 1.0 + nrm(ks[17], (DEPTH, HG_V), 0.02),
        "w_branch_att": nrm(ks[18], (DEPTH, ATT_Q, D_MODEL), ATT_Q ** -0.5),
        "w_branch_ml": nrm(ks[19], (DEPTH, ML_V, D_MODEL), ML_V ** -0.5),
        "w_branch_hg": nrm(ks[20], (DEPTH, HG_V, D_MODEL), HG_V ** -0.5),
        "w_out": nrm(ks[21], (DEPTH, D_MODEL, D_MODEL), D_MODEL ** -0.5),
    }


def reference(x, c, ctx, c_ctx, w_ada, b_ada, norm_pre, norm_post, ffn_w1, ffn_w3, ffn_w2,
              w_in, att_sink, ml_conv, ml_f_bias, ml_norm, hg_lb_logits, hg_norm,
              w_branch_att, w_branch_ml, w_branch_hg, w_out):
    B, L, D = x.shape
    ang = axial_angles(L)
    lb_all = jnp.cumsum(jax.nn.softmax(hg_lb_logits.astype(jnp.float32), axis=0), axis=0)
    lb_all = lb_all - lb_all[0:1]
    cx = ctx
    for l in range(DEPTH):
        last = l == DEPTH - 1
        mod_x = (jax.nn.silu(c) @ w_ada[l] + b_ada[l]).reshape(B, 1, N_MOD, D)
        mod_c = (jax.nn.silu(c_ctx) @ w_ada[l] + b_ada[l]).reshape(1, 1, N_MOD, D)
        x = macaron_ffn(x, mod_x, 0, norm_pre[l, 0], norm_post[l, 0], ffn_w1[l, 0], ffn_w3[l, 0], ffn_w2[l, 0])
        cx = macaron_ffn(cx, mod_c, 0, norm_pre[l, 0], norm_post[l, 0], ffn_w1[l, 0], ffn_w3[l, 0], ffn_w2[l, 0])
        hx = ada_pre(x, mod_x, 1, norm_pre[l, 1])
        hc = ada_pre(cx, mod_c, 1, norm_pre[l, 1])
        yx, yc = token_mix(hx, hc, ang, w_in[l], att_sink[l], ml_conv[l], ml_f_bias[l], ml_norm[l],
                           lb_all[l], hg_norm[l], w_branch_att[l], w_branch_ml[l], w_branch_hg[l],
                           w_out[l], not last)
        x = ada_post(x, yx, mod_x, 1, norm_post[l, 1], 1.0)
        x = macaron_ffn(x, mod_x, 2, norm_pre[l, 2], norm_post[l, 2], ffn_w1[l, 1], ffn_w3[l, 1], ffn_w2[l, 1])
        if not last:
            cx = ada_post(cx, yc, mod_c, 1, norm_post[l, 1], 1.0)
            cx = macaron_ffn(cx, mod_c, 2, norm_pre[l, 2], norm_post[l, 2], ffn_w1[l, 1], ffn_w3[l, 1], ffn_w2[l, 1])
    return x
```

```cpp
#include <hip/hip_runtime.h>
#include <hip/hip_cooperative_groups.h>
#include <cstdio>
#include <cstdint>
namespace cg = cooperative_groups;

#define DI __device__ __forceinline__
#define LAS __attribute__((address_space(3)))
typedef unsigned short bf16_t;
typedef short bf16x8 __attribute__((ext_vector_type(8)));
typedef short s16x4 __attribute__((ext_vector_type(4)));
typedef float f32x2 __attribute__((ext_vector_type(2)));
typedef float f32x4 __attribute__((ext_vector_type(4)));
typedef float f32x16 __attribute__((ext_vector_type(16)));
typedef unsigned u32x2 __attribute__((ext_vector_type(2)));
typedef unsigned u32x4 __attribute__((ext_vector_type(4)));

constexpr int DM = 1024, NB = 8, SEQ = 4096, CTXL = 256, DFF = 2816, DIN = 7184, NMOD = 9;
constexpr int MLAT = NB * SEQ, MCTX = NB * CTXL, MTOT = MLAT + MCTX;
constexpr int NPC = 4096;
constexpr int NGC = 3072;
constexpr float EPS = 1e-6f;
constexpr int PC_AQ = 0, PC_AK = 512, PC_AV = 640, PC_MQ = 768, PC_MK = 1024, PC_MV = 1280, PC_MO = 1792, PC_HQ = 2304, PC_HF = 2560, PC_HI = 3072, PC_HG = 3584;

constexpr size_t MiB = 1u << 20;
constexpr size_t WS_MOD = 1 * MiB;
constexpr size_t WS_ROPE = 2 * MiB;
constexpr size_t WS_GATES = 3 * MiB;
constexpr size_t WS_XC = 6 * MiB;
constexpr size_t WS_W = 14 * MiB;
constexpr size_t WS_H = 66 * MiB;
constexpr size_t WS_P = 134 * MiB;
constexpr size_t WS_S = 406 * MiB;
constexpr size_t WS_END = 508 * MiB;
constexpr size_t WO_W13 = 0;
constexpr size_t WO_W2 = WO_W13 + (size_t)2 * 5632 * 1024;
constexpr size_t WO_WIN = WO_W2 + (size_t)2 * 1024 * 2816;
constexpr size_t WO_WG = WO_WIN + (size_t)4096 * 1024;
constexpr size_t WO_WB = WO_WG + (size_t)3072 * 1024;
constexpr size_t WO_WOUT = WO_WB + (size_t)3 * 1024 * 512;
constexpr size_t WO_END = WO_WOUT + (size_t)1024 * 1024;
static_assert(WO_END * 2 <= 52 * MiB, "weights fit");
static_assert((size_t)MTOT * 1024 * 2 <= 68 * MiB && (size_t)MTOT * 4096 * 2 <= 272 * MiB && (size_t)MTOT * 512 * 2 * 3 <= 102 * MiB, "ws map");

constexpr int LDS_BYTES = 131072;

DI unsigned f2bf(float f) { unsigned u = __float_as_uint(f); return (u + 0x7fffu + ((u >> 16) & 1u)) >> 16; }
DI unsigned pk2(float lo, float hi) { return f2bf(lo) | (f2bf(hi) << 16); }
DI float bflo(unsigned w) { return __uint_as_float(w << 16); }
DI float bfhi(unsigned w) { return __uint_as_float(w & 0xffff0000u); }
DI float bf1(short s) { return __uint_as_float(((unsigned)(unsigned short)s) << 16); }
DI float fsigmoid(float x) { return __builtin_amdgcn_rcpf(1.0f + __expf(-x)); }
DI float fsilu(float x) { return x * fsigmoid(x); }
DI float wave_sum(float v) {
#pragma unroll
    for (int o = 1; o < 64; o <<= 1) v += __shfl_xor(v, o);
    return v;
}
DI bf16x8 pack8(float a0, float a1, float a2, float a3, float a4, float a5, float a6, float a7) {
    u32x4 p; p.x = pk2(a0, a1); p.y = pk2(a2, a3); p.z = pk2(a4, a5); p.w = pk2(a6, a7); return __builtin_bit_cast(bf16x8, p);
}
#define MFMA32(a, b, c) __builtin_amdgcn_mfma_f32_32x32x16_bf16((a), (b), (c), 0, 0, 0)
DI int crow(int i, int h) { return (i & 3) + 8 * (i >> 2) + 4 * h; }

namespace pg8 {
#define PG8_LAS __attribute__((address_space(3)))
typedef unsigned short bf16_t;
typedef short bf16x8 __attribute__((ext_vector_type(8)));
typedef float f32x4 __attribute__((ext_vector_type(4)));
typedef unsigned u32x4 __attribute__((ext_vector_type(4)));
constexpr int BM = 256, BK = 64, HALF = 128, HTB = HALF * BK * 2  , STAGE_BYTES = 8 * HTB, NXCD = 8, WGM = 8;

__host__ __device__ __forceinline__ int lds_byte(int r, int c) { const int st = (r >> 4) * 2 + (c >> 5), rr = r & 15, cc = c & 31, ob = rr * 64 + cc * 2; return st * 1024 + (ob ^ (((ob >> 9) & 1) << 5)); }
__host__ __device__ __forceinline__ void stage_rc(int b, int& R, int& C) { const int st = b / 1024, sb = b % 1024, swz = sb ^ (((sb >> 9) & 1) << 5); R = (st >> 1) * 16 + swz / 64; C = (st & 1) * 32 + (swz % 64) / 2; }
__host__ __device__ __forceinline__ int perm32(int rho) { const int n = rho >> 4, i = rho & 15; return 8 * (i >> 2) + 4 * n + (i & 3); }

struct Unit { int pm, pn; };
struct Gemm { const bf16_t* A; const bf16_t* Bt; int M, N, K; };

struct StaticOrder {
    int nM, nN, nwg, G, c;
    __host__ __device__ void init(int M, int N, int G_, int c_) { nM = M / BM; nN = N / BM; nwg = nM * nN; G = G_; c = c_; }
    __host__ __device__ bool next(int i, Unit& u) const {
        const long L = (long)i * G + c; if (L >= nwg) return false;
        int wgid = (int)L; { const int q = nwg / NXCD, r = nwg % NXCD, xcd = wgid % NXCD, off = wgid / NXCD; wgid = (xcd < r ? xcd * (q + 1) : r * (q + 1) + (xcd - r) * q) + off; }
        const int nig = WGM * nN, gid = wgid / nig, fm = gid * WGM, gsz = (nM - fm) < WGM ? (nM - fm) : WGM;
        u.pm = fm + ((wgid % nig) % gsz); u.pn = (wgid % nig) / gsz; return true;
    }
    __device__ __forceinline__ void a_ready(const Unit&) const {}
    __device__ __forceinline__ void done(const Unit&) const {}
};

template <int ACT  > struct EpiBf16 {
    static constexpr bool PERM = true, AFTER_DRAIN = false;
    bf16_t* O; int ldc;
    __device__ __forceinline__ void operator()(const f32x4 (&acc)[2][2][4][2], const Unit& u, int wr, int wc, int fr, int fq) const {
        const int row0 = u.pm * BM + wr * 64 + fr, col0 = u.pn * BM + wc * 32 + 8 * fq;
#pragma unroll
        for (int ai = 0; ai < 2; ++ai)
#pragma unroll
            for (int m = 0; m < 4; ++m) { bf16_t* rowp = O + (size_t)(row0 + ai * HALF + m * 16) * ldc + col0;
#pragma unroll
                for (int bj = 0; bj < 2; ++bj) { f32x4 v0 = acc[ai][bj][m][0], v1 = acc[ai][bj][m][1];
                    if (ACT == 1) {
#pragma unroll
                        for (int k = 0; k < 4; ++k) { v0[k] = fsigmoid(v0[k]); v1[k] = fsigmoid(v1[k]); } }
                    u32x4 w; w.x = pk2(v0[0], v0[1]); w.y = pk2(v0[2], v0[3]); w.z = pk2(v1[0], v1[1]); w.w = pk2(v1[2], v1[3]);
                    *(u32x4*)(rowp + bj * HALF) = w; } }
    }
};
struct EpiSwiGLU {
    static constexpr bool PERM = false, AFTER_DRAIN = false;
    bf16_t* O; int ldc;
    __device__ __forceinline__ void operator()(const f32x4 (&acc)[2][2][4][2], const Unit& u, int wr, int wc, int fr, int fq) const {
        const int row0 = u.pm * BM + wr * 64 + fr, f0 = u.pn * 128 + wc * 16 + 4 * fq;
#pragma unroll
        for (int ai = 0; ai < 2; ++ai)
#pragma unroll
            for (int m = 0; m < 4; ++m) { bf16_t* rowp = O + (size_t)(row0 + ai * HALF + m * 16) * ldc + f0;
#pragma unroll
                for (int bj = 0; bj < 2; ++bj) { const f32x4 a = acc[ai][bj][m][0], b = acc[ai][bj][m][1];
                    u32x2 w; w.x = pk2(fsilu(a[0]) * b[0], fsilu(a[1]) * b[1]); w.y = pk2(fsilu(a[2]) * b[2], fsilu(a[3]) * b[3]);
                    *(u32x2*)(rowp + bj * 64) = w; } }
    }
};
struct EpiMerge {
    static constexpr bool PERM = true, AFTER_DRAIN = false;
    bf16_t* O; const bf16_t* G; int gi;
    __device__ __forceinline__ void operator()(const f32x4 (&acc)[2][2][4][2], const Unit& u, int wr, int wc, int fr, int fq) const {
        const int row0 = u.pm * BM + wr * 64 + fr, col0 = u.pn * BM + wc * 32 + 8 * fq;
#pragma unroll
        for (int ai = 0; ai < 2; ++ai)
#pragma unroll
            for (int m = 0; m < 4; ++m) { const size_t r = (size_t)(row0 + ai * HALF + m * 16);
#pragma unroll
                for (int bj = 0; bj < 2; ++bj) { const int c = col0 + bj * HALF;
                    const u32x4 g = *(const u32x4*)(G + r * 3072 + gi * 1024 + c);
                    const f32x4 v0 = acc[ai][bj][m][0], v1 = acc[ai][bj][m][1];
                    float o0 = bflo(g.x) * v0[0], o1 = bfhi(g.x) * v0[1], o2 = bflo(g.y) * v0[2], o3 = bfhi(g.y) * v0[3];
                    float o4 = bflo(g.z) * v1[0], o5 = bfhi(g.z) * v1[1], o6 = bflo(g.w) * v1[2], o7 = bfhi(g.w) * v1[3];
                    bf16_t* op = O + r * 1024 + c;
                    if (gi > 0) {
                        const unsigned long long p0 = __hip_atomic_load((const unsigned long long*)op, __ATOMIC_RELAXED, __HIP_MEMORY_SCOPE_AGENT);
                        const unsigned long long p1 = __hip_atomic_load((const unsigned long long*)op + 1, __ATOMIC_RELAXED, __HIP_MEMORY_SCOPE_AGENT);
                        const unsigned a0 = (unsigned)p0, a1 = (unsigned)(p0 >> 32), a2 = (unsigned)p1, a3 = (unsigned)(p1 >> 32);
                        o0 += bflo(a0); o1 += bfhi(a0); o2 += bflo(a1); o3 += bfhi(a1); o4 += bflo(a2); o5 += bfhi(a2); o6 += bflo(a3); o7 += bfhi(a3);
                    }
                    u32x4 w; w.x = pk2(o0, o1); w.y = pk2(o2, o3); w.z = pk2(o4, o5); w.w = pk2(o6, o7);
                    *(u32x4*)op = w; } }
    }
};

template <class Epi, class Sched, bool ALIGN_EPI = false, bool SP2 = false>
__device__ __forceinline__ void gemm_phase(PG8_LAS unsigned char* lds, const Gemm g, const Sched& S, const Epi& E) {
    int tid_ = threadIdx.x; asm volatile("" : "+v"(tid_));
    const int tid = tid_, wid = __builtin_amdgcn_readfirstlane(tid >> 6), lane = tid & 63, wr = wid >> 2, wc = wid & 3, fr = lane & 15, fq = lane >> 4;
    const int K = g.K, nt = K / BK;
    unsigned voffA[2], voffB[2];
#pragma unroll
    for (int i = 0; i < 2; ++i) { int R, C; stage_rc(tid * 16 + i * 8192, R, C); const int Rb = Epi::PERM ? ((R & ~31) + perm32(R & 31)) : R;
        voffA[i] = (unsigned)(R * K + C) * 2u; voffB[i] = (unsigned)(Rb * K + C) * 2u; }
    const size_t kstep = (size_t)(BK * 2);
    const size_t hstep = (size_t)HALF * K * 2;
    const size_t tstep = 2 * hstep;
    const unsigned ldsw = (unsigned)wid * 1024u;
    const int aoff = lds_byte(wr * 64 + fr, fq * 8), boff = lds_byte(wc * 32 + fr, fq * 8);
#define PG8_SA(b, h) (((b) * 2 + (h)) * HTB)
#define PG8_SB(b, h) ((4 + (b) * 2 + (h)) * HTB)
#define PG8_STAGE(bufoff, gbase, voff) do { _Pragma("unroll") for (int _i = 0; _i < 2; ++_i) \
        __builtin_amdgcn_global_load_lds((const unsigned*)((const char*)(gbase) + (voff)[_i]), (PG8_LAS unsigned*)(lds + (bufoff) + ldsw + _i * 8192), 16, 0, 0); } while (0)
#define PG8_LDA(dst, b, h) do { _Pragma("unroll") for (int m = 0; m < 4; ++m) _Pragma("unroll") for (int k = 0; k < 2; ++k) dst[m][k] = *(const PG8_LAS bf16x8*)(lds + PG8_SA(b, h) + aoff + m * 2048 + k * 1024); } while (0)
#define PG8_LDB(dst, b, h) do { _Pragma("unroll") for (int n = 0; n < 2; ++n) _Pragma("unroll") for (int k = 0; k < 2; ++k) dst[n][k] = *(const PG8_LAS bf16x8*)(lds + PG8_SB(b, h) + boff + n * 2048 + k * 1024); } while (0)
#define PG8_MMA(ai, bj, At, Bt) do { __builtin_amdgcn_s_setprio(1); _Pragma("unroll") for (int m = 0; m < 4; ++m) _Pragma("unroll") for (int n = 0; n < 2; ++n) _Pragma("unroll") for (int k = 0; k < 2; ++k) \
        acc[ai][bj][m][n] = __builtin_amdgcn_mfma_f32_16x16x32_bf16(Bt[n][k], At[m][k], acc[ai][bj][m][n], 0, 0, 0); __builtin_amdgcn_s_setprio(0); } while (0)
#define PG8_WAIT_V(n) asm volatile("s_waitcnt vmcnt(" #n ")" ::: "memory")
#define PG8_WAIT_L(n) asm volatile("s_waitcnt lgkmcnt(" #n ")" ::: "memory")
#define PG8_BAR __builtin_amdgcn_s_barrier()
#define PG8_SCHED __builtin_amdgcn_sched_barrier(0)
    Unit cur, nxt; int ui = 0;
    if (!S.next(0, cur)) return;
    f32x4 acc[2][2][4][2];
#pragma unroll
    for (int a = 0; a < 2; ++a)
#pragma unroll
        for (int b = 0; b < 2; ++b)
#pragma unroll
            for (int m = 0; m < 4; ++m)
#pragma unroll
                for (int n = 0; n < 2; ++n) acc[a][b][m][n] = (f32x4){0.f, 0.f, 0.f, 0.f};
    bf16x8 At[4][2], B0[2][2], B1[2][2];
    const char* cA = (const char*)g.A + (size_t)cur.pm * tstep; const char* cB = (const char*)g.Bt + (size_t)cur.pn * tstep;
    S.a_ready(cur);
    if constexpr (SP2) {
        PG8_STAGE(PG8_SB(0, 0), cB, voffB); PG8_STAGE(PG8_SB(0, 1), cB + hstep, voffB); PG8_STAGE(PG8_SA(0, 0), cA, voffA); PG8_STAGE(PG8_SA(0, 1), cA + hstep, voffA);
        if (wr == 1) PG8_BAR;
        PG8_WAIT_V(2); PG8_BAR;
        PG8_STAGE(PG8_SB(1, 0), cB + kstep, voffB); PG8_STAGE(PG8_SA(1, 0), cA + kstep, voffA); PG8_STAGE(PG8_SB(1, 1), cB + hstep + kstep, voffB);
        PG8_WAIT_V(6); PG8_BAR;
    } else {
        PG8_STAGE(PG8_SB(0, 0), cB, voffB); PG8_STAGE(PG8_SA(0, 0), cA, voffA); PG8_STAGE(PG8_SB(0, 1), cB + hstep, voffB); PG8_STAGE(PG8_SA(0, 1), cA + hstep, voffA);
        if (wr == 1) PG8_BAR;
        PG8_WAIT_V(4); PG8_BAR;
        PG8_STAGE(PG8_SB(1, 0), cB + kstep, voffB); PG8_STAGE(PG8_SA(1, 0), cA + kstep, voffA); PG8_STAGE(PG8_SB(1, 1), cB + hstep + kstep, voffB);
        PG8_WAIT_V(6); PG8_BAR;
    }
    for (;;) {
        const bool has_next = S.next(ui + 1, nxt);
        const char* nA = has_next ? (const char*)g.A + (size_t)nxt.pm * tstep : cA; const char* nB = has_next ? (const char*)g.Bt + (size_t)nxt.pn * tstep : cB;
        for (int t = 0; t < nt; t += 2) {
            const bool last = (t == nt - 2);
            const char* a1 = cA + (size_t)(t + 1) * kstep;
            const char* a2 = last ? nA : cA + (size_t)(t + 2) * kstep; const char* b2 = last ? nB : cB + (size_t)(t + 2) * kstep;
            const char* a3 = a2 + kstep; const char* b3 = b2 + kstep;
            if (last && has_next) S.a_ready(nxt);
            if constexpr (SP2) {
            PG8_LDB(B0, 0, 0); PG8_LDB(B1, 0, 1); PG8_SCHED; PG8_LDA(At, 0, 0); PG8_STAGE(PG8_SA(1, 1), a1 + hstep, voffA);
            PG8_WAIT_V(8); PG8_WAIT_L(0); PG8_BAR; PG8_MMA(0, 0, At, B0); PG8_MMA(0, 1, At, B1); PG8_BAR; PG8_SCHED;
            PG8_LDA(At, 0, 1); PG8_STAGE(PG8_SB(0, 0), b2, voffB); PG8_STAGE(PG8_SB(0, 1), b2 + hstep, voffB); PG8_STAGE(PG8_SA(0, 0), a2, voffA);
            PG8_WAIT_V(8); PG8_WAIT_L(0); PG8_BAR; PG8_MMA(1, 0, At, B0); PG8_MMA(1, 1, At, B1); PG8_BAR; PG8_SCHED;
            PG8_LDB(B0, 1, 0); PG8_LDB(B1, 1, 1); PG8_SCHED; PG8_LDA(At, 1, 0); PG8_STAGE(PG8_SA(0, 1), a2 + hstep, voffA);
            PG8_WAIT_V(8); PG8_WAIT_L(0); PG8_BAR; PG8_MMA(0, 0, At, B0); PG8_MMA(0, 1, At, B1); PG8_BAR; PG8_SCHED;
            PG8_LDA(At, 1, 1); PG8_STAGE(PG8_SB(1, 0), b3, voffB); PG8_STAGE(PG8_SB(1, 1), b3 + hstep, voffB); PG8_STAGE(PG8_SA(1, 0), a3, voffA);
            PG8_WAIT_V(8); PG8_WAIT_L(0); PG8_BAR; PG8_MMA(1, 0, At, B0); PG8_MMA(1, 1, At, B1); PG8_BAR; PG8_SCHED;
            } else {
            PG8_LDB(B0, 0, 0); PG8_SCHED; PG8_LDA(At, 0, 0); PG8_STAGE(PG8_SA(1, 1), a1 + hstep, voffA);
            PG8_WAIT_L(8); PG8_BAR; PG8_WAIT_L(0); PG8_MMA(0, 0, At, B0); PG8_BAR; PG8_SCHED;
            PG8_LDB(B1, 0, 1); PG8_STAGE(PG8_SB(0, 0), b2, voffB);
            PG8_BAR; PG8_WAIT_L(0); PG8_MMA(0, 1, At, B1); PG8_BAR;
            PG8_LDA(At, 0, 1); PG8_STAGE(PG8_SA(0, 0), a2, voffA);
            PG8_BAR; PG8_WAIT_L(0); PG8_MMA(1, 0, At, B0); PG8_BAR; PG8_SCHED;
            PG8_STAGE(PG8_SB(0, 1), b2 + hstep, voffB);
            PG8_WAIT_V(6); PG8_BAR; PG8_MMA(1, 1, At, B1); PG8_BAR;
            PG8_LDB(B0, 1, 0); PG8_SCHED; PG8_LDA(At, 1, 0); PG8_STAGE(PG8_SA(0, 1), a2 + hstep, voffA);
            PG8_WAIT_L(8); PG8_BAR; PG8_WAIT_L(0); PG8_MMA(0, 0, At, B0); PG8_BAR; PG8_SCHED;
            PG8_LDB(B1, 1, 1); PG8_STAGE(PG8_SB(1, 0), b3, voffB);
            PG8_BAR; PG8_WAIT_L(0); PG8_MMA(0, 1, At, B1); PG8_BAR;
            PG8_LDA(At, 1, 1); PG8_STAGE(PG8_SA(1, 0), a3, voffA);
            PG8_BAR; PG8_WAIT_L(0); PG8_MMA(1, 0, At, B0); PG8_BAR; PG8_SCHED;
            PG8_STAGE(PG8_SB(1, 1), b3 + hstep, voffB);
            PG8_WAIT_V(6); PG8_BAR; PG8_MMA(1, 1, At, B1); PG8_BAR;
            }
        }
        if constexpr (ALIGN_EPI) { if (wr == 0) PG8_BAR; }
        if constexpr (!Epi::AFTER_DRAIN) { E(acc, cur, wr, wc, fr, fq); S.done(cur); }
        if (!has_next) break;
#pragma unroll
        for (int a = 0; a < 2; ++a)
#pragma unroll
            for (int b = 0; b < 2; ++b)
#pragma unroll
                for (int m = 0; m < 4; ++m)
#pragma unroll
                    for (int n = 0; n < 2; ++n) acc[a][b][m][n] = (f32x4){0.f, 0.f, 0.f, 0.f};
        cur = nxt; cA = nA; cB = nB; ++ui;
        if constexpr (ALIGN_EPI) { if (wr == 1) PG8_BAR; }
    }
    PG8_WAIT_V(0);
    if constexpr (!ALIGN_EPI) { if (wr == 0) PG8_BAR; }
    PG8_BAR;
    if constexpr (Epi::AFTER_DRAIN) { E.fused(acc, cur, wr, wc, fr, fq, lds, wid, lane); S.done(cur); }
#undef PG8_SA
#undef PG8_SB
#undef PG8_STAGE
#undef PG8_LDA
#undef PG8_LDB
#undef PG8_MMA
#undef PG8_WAIT_V
#undef PG8_WAIT_L
#undef PG8_BAR
#undef PG8_SCHED
}
}

struct Params { const float* in[22]; float* out; unsigned char* ws; };
typedef const __attribute__((address_space(4))) Params* KP;
DI KP kparams() { KP kp = (KP)__builtin_amdgcn_kernarg_segment_ptr(); asm volatile("" : "+s"(kp)); return kp; }
enum { I_X = 0, I_C, I_CTX, I_CCTX, I_WADA, I_BADA, I_NPRE, I_NPOST, I_W1, I_W3, I_W2, I_WIN, I_SINK, I_MLCONV, I_MLFB, I_MLNORM, I_HGLB, I_HGNORM, I_WBA, I_WBM, I_WBH, I_WOUT };

DI void transpose_item(const float* Wa, const float* Wb, int ldw, int K, bf16_t* dst, int k0, LAS float* scr, int lane) {
    const float* src = (((lane & 31) < 16) ? Wa : Wb) + (lane & 15);
#pragma unroll 8
    for (int i = 0; i < 32; ++i) { const int kk = 2 * i + (lane >> 5); scr[kk * 33 + (lane & 31)] = src[(size_t)(k0 + kk) * ldw]; }
    asm volatile("s_waitcnt lgkmcnt(0)" ::: "memory");
    const int c = lane & 7;
#pragma unroll
    for (int j = 0; j < 4; ++j) { const int n = (lane >> 3) + 8 * j; const LAS float* s = scr + (8 * c) * 33 + n;
        u32x4 o; o.x = pk2(s[0 * 33], s[1 * 33]); o.y = pk2(s[2 * 33], s[3 * 33]); o.z = pk2(s[4 * 33], s[5 * 33]); o.w = pk2(s[6 * 33], s[7 * 33]);
        *(u32x4*)(dst + (size_t)n * K + k0 + 8 * c) = o; }
    asm volatile("s_waitcnt lgkmcnt(0)" ::: "memory");
}
struct Seg { const float* Wa; const float* Wb; int ldw, K, ngroups, colA0, colB0, cstep; bf16_t* dst; };
DI bool seg_run(const Seg& s, int& it, LAS float* scr, int lane) {
    const int nk = s.K / 64, n = s.ngroups * nk;
    if (it >= n) { it -= n; return false; }
    const int gi = it / nk, kb = it % nk;
    transpose_item(s.Wa + s.colA0 + gi * s.cstep, s.Wb + s.colB0 + gi * s.cstep, s.ldw, s.K, s.dst + (size_t)gi * 32 * s.K, kb * 64, scr, lane);
    return true;
}
DI void convert_weights(KP p, int l, LAS unsigned char* lds) {
    int tid_ = threadIdx.x; asm volatile("" : "+v"(tid_));
    const int wave = tid_ >> 6, lane = tid_ & 63;
    LAS float* scr = (LAS float*)(lds + wave * 8704);
    bf16_t* W = (bf16_t*)(p->ws + WS_W);
    const int gw = blockIdx.x * 8 + wave, NGW = gridDim.x * 8;
    constexpr int NITEMS = 2 * 176 * 16 + 2 * 32 * 44 + 128 * 16 + 96 * 16 + 3 * 32 * 8 + 32 * 16;
    for (int item = gw; item < NITEMS; item += NGW) {
        int it = item;
        bool done = false;
#pragma unroll
        for (int f = 0; f < 2 && !done; ++f) {
            const float* w1 = p->in[I_W1] + (size_t)(l * 2 + f) * DM * DFF; const float* w3 = p->in[I_W3] + (size_t)(l * 2 + f) * DM * DFF;
            Seg s{w1, w3, DFF, DM, 176, 0, 0, 16, W + WO_W13 + (size_t)f * 5632 * 1024};
            done = seg_run(s, it, scr, lane);
        }
#pragma unroll
        for (int f = 0; f < 2 && !done; ++f) {
            const float* w2 = p->in[I_W2] + (size_t)(l * 2 + f) * DFF * DM;
            Seg s{w2, w2, DM, DFF, 32, 0, 16, 32, W + WO_W2 + (size_t)f * 1024 * 2816};
            done = seg_run(s, it, scr, lane);
        }
        const float* win = p->in[I_WIN] + (size_t)l * DM * DIN;
        if (!done) { Seg s{win, win, DIN, DM, 72, 0, 16, 32, W + WO_WIN}; done = seg_run(s, it, scr, lane); }
        if (!done) { Seg s{win, win, DIN, DM, 56, 2320, 2336, 32, W + WO_WIN + (size_t)2304 * 1024}; done = seg_run(s, it, scr, lane); }
        if (!done) { Seg s{win, win, DIN, DM, 96, 4112, 4128, 32, W + WO_WG}; done = seg_run(s, it, scr, lane); }
#pragma unroll
        for (int f = 0; f < 3 && !done; ++f) {
            const float* wb = p->in[I_WBA + f] + (size_t)l * 512 * DM;
            Seg s{wb, wb, DM, 512, 32, 0, 16, 32, W + WO_WB + (size_t)f * 1024 * 512};
            done = seg_run(s, it, scr, lane);
        }
        if (!done) { const float* wo = p->in[I_WOUT] + (size_t)l * DM * DM; Seg s{wo, wo, DM, DM, 32, 0, 16, 32, W + WO_WOUT}; done = seg_run(s, it, scr, lane); }
    }
}

DI void mods_phase(KP p, LAS unsigned char* lds, int tid) {
    asm volatile("" : "+v"(tid));
    const int wave = tid >> 6, lane = tid & 63;
    LAS float* sc = (LAS float*)lds;
    LAS float* red = (LAS float*)(lds + 36864);
    for (int i = tid; i < 9 * 1024; i += 512) { const float v = (i < 8192) ? p->in[I_C][i] : p->in[I_CCTX][i - 8192]; sc[i] = v / (1.0f + expf(-v)); }
    __syncthreads();
    float* mod = (float*)(p->ws + WS_MOD);
    for (int it = blockIdx.x; it < 288; it += gridDim.x) {
        const int l = it / 144, cb = it % 144, col = cb * 64 + lane;
        const float* wp = p->in[I_WADA] + ((size_t)l * 1024 + wave * 128) * 9216 + col;
        float acc[9];
#pragma unroll
        for (int i = 0; i < 9; ++i) acc[i] = 0.f;
#pragma unroll 8
        for (int k = 0; k < 128; ++k) { const float wv = wp[(size_t)k * 9216];
#pragma unroll
            for (int i = 0; i < 9; ++i) acc[i] += sc[i * 1024 + wave * 128 + k] * wv; }
#pragma unroll
        for (int i = 0; i < 9; ++i) red[(wave * 9 + i) * 64 + lane] = acc[i];
        __syncthreads();
        for (int o = tid; o < 576; o += 512) { const int i = o >> 6, ln = o & 63; float s = 0.f;
#pragma unroll
            for (int w = 0; w < 8; ++w) s += red[(w * 9 + i) * 64 + ln];
            mod[((size_t)l * 9 + i) * 9216 + cb * 64 + ln] = s + p->in[I_BADA][(size_t)l * 9216 + cb * 64 + ln]; }
        __syncthreads();
    }
    if (blockIdx.x == gridDim.x - 1) {
        f32x2* tab = (f32x2*)(p->ws + WS_ROPE);
        for (int e = tid; e < 1024; e += 512) { const int pos = e >> 4, i = e & 15;
            const float inv = exp2f(-(float)i * (13.287712379549449f / 16.0f));
            const float a = (float)pos * inv; float rev = a * 0.15915494309189535f; rev -= floorf(rev);
            f32x2 cs; cs.x = __builtin_amdgcn_cosf(rev); cs.y = __builtin_amdgcn_sinf(rev); tab[e] = cs; }
    }
}

struct RowArgs {
    const float* xs_lat; const float* xs_ctx; float* xd_lat; float* xd_ctx;
    const bf16_t* Y; bf16_t* H; const float* mod; const float* modpre; const float* gpost; const float* gpre; const float* wgates; float* gates;
    int jpost, jpre, nrows; float wpost;
};
template <bool POST, bool PRE, bool GATES>
DI void row_phase(const RowArgs& a, LAS unsigned char* lds, int tid) {
    asm volatile("" : "+v"(tid));
    const int wave = tid >> 6, lane = tid & 63;
    LAS f32x4* wl = (LAS f32x4*)lds;
    if (GATES) {
        for (int idx = tid; idx < 1024 * 4; idx += 512) { const int k = idx >> 2, c4 = idx & 3; const int ln = (k & 255) >> 2, j = k >> 8, e = k & 3;
            wl[((j * 4 + e) * 4 + c4) * 64 + ln] = *(const f32x4*)(a.wgates + (size_t)k * DIN + 4 * c4); }
        __syncthreads();
    }
    for (int row = blockIdx.x * 8 + wave; row < a.nrows; row += gridDim.x * 8) {
        const int mi = row < MLAT ? (row >> 12) : 8;
        const float* md = a.mod + (size_t)mi * 9216;
        const float* mdp = a.modpre + (size_t)mi * 9216;
        const float* src = row < MLAT ? a.xs_lat + (size_t)row * DM : a.xs_ctx + (size_t)(row - MLAT) * DM;
        f32x4 x[4];
#pragma unroll
        for (int j = 0; j < 4; ++j) x[j] = *(const f32x4*)(src + 4 * lane + 256 * j);
        if (POST) {
            f32x4 y[4]; float s = 0.f;
#pragma unroll
            for (int j = 0; j < 4; ++j) { const u32x2 w = *(const u32x2*)(a.Y + (size_t)row * DM + 4 * lane + 256 * j);
                y[j] = (f32x4){bflo(w.x), bfhi(w.x), bflo(w.y), bfhi(w.y)}; s += (y[j][0] * y[j][0] + y[j][1] * y[j][1]) + (y[j][2] * y[j][2] + y[j][3] * y[j][3]); }
            const float rstd = 1.0f / sqrtf(wave_sum(s) * (1.0f / DM) + EPS);
            float* dst = row < MLAT ? a.xd_lat + (size_t)row * DM : a.xd_ctx + (size_t)(row - MLAT) * DM;
#pragma unroll
            for (int j = 0; j < 4; ++j) { const int c = 4 * lane + 256 * j;
                const f32x4 gt = *(const f32x4*)(md + (3 * a.jpost + 2) * DM + c), gp = *(const f32x4*)(a.gpost + c);
                x[j] = x[j] + a.wpost * gt * (y[j] * rstd * gp);
                *(f32x4*)(dst + c) = x[j]; }
        }
        if (PRE) {
            float s = 0.f;
#pragma unroll
            for (int j = 0; j < 4; ++j) s += (x[j][0] * x[j][0] + x[j][1] * x[j][1]) + (x[j][2] * x[j][2] + x[j][3] * x[j][3]);
            const float rstd = 1.0f / sqrtf(wave_sum(s) * (1.0f / DM) + EPS);
            f32x4 hv[4]; f32x4 g4[4];
#pragma unroll
            for (int c4 = 0; c4 < 4; ++c4) g4[c4] = (f32x4){0.f, 0.f, 0.f, 0.f};
#pragma unroll
            for (int j = 0; j < 4; ++j) { const int c = 4 * lane + 256 * j;
                const f32x4 sh = *(const f32x4*)(mdp + (3 * a.jpre) * DM + c), scl = *(const f32x4*)(mdp + (3 * a.jpre + 1) * DM + c), g = *(const f32x4*)(a.gpre + c);
                hv[j] = (x[j] * rstd * g) * (1.0f + scl) + sh;
                u32x2 w; w.x = pk2(hv[j][0], hv[j][1]); w.y = pk2(hv[j][2], hv[j][3]);
                *(u32x2*)(a.H + (size_t)row * DM + c) = w;
                if (GATES) {
#pragma unroll
                    for (int e = 0; e < 4; ++e)
#pragma unroll
                        for (int c4 = 0; c4 < 4; ++c4) g4[c4] += hv[j][e] * wl[((j * 4 + e) * 4 + c4) * 64 + lane];
                    asm volatile("" ::: "memory");
                } }
            if (GATES) {
#pragma unroll
                for (int c4 = 0; c4 < 4; ++c4)
#pragma unroll
                    for (int k = 0; k < 4; ++k) g4[c4][k] = wave_sum(g4[c4][k]);
                if (lane == 0) {
#pragma unroll
                    for (int c4 = 0; c4 < 4; ++c4) *(f32x4*)(a.gates + (size_t)row * 16 + 4 * c4) = g4[c4]; }
            }
        }
    }
    if (GATES) __syncthreads();
}

constexpr int RS = 144;
constexpr int AT_K = 0, AT_V = 9216, AT_TAB = 18432;
struct AttnArgs { const bf16_t* P; bf16_t* ATT; const float* sink; const f32x2* rope; };

DI void attn_item(const AttnArgs& A, int item, LAS unsigned char* lds, int tid) {
    asm volatile("" : "+v"(tid));
    const int w = tid >> 6, lane = tid & 63, r = lane & 31, hh = lane >> 5;
    const LAS f32x2* tab = (const LAS f32x2*)(lds + AT_TAB);
    int b, g, qb = 0, qrow0; bool lat;
    if (item < 512) { b = item >> 6; g = (item >> 5) & 1; qb = item & 31; lat = true; qrow0 = b * SEQ + qb * 128; }
    else { const int it = item - 512; b = it >> 2; g = (it >> 1) & 1; lat = false; qrow0 = MLAT + b * CTXL + (it & 1) * 128; }
    const int head = g * 4 + (w >> 1), qoff = (w & 1) * 64;
    bf16x8 qf[2][4];
#pragma unroll
    for (int qt = 0; qt < 2; ++qt) {
        const int ql = qoff + 32 * qt + r;
        const bf16_t* qp = A.P + (size_t)(qrow0 + ql) * NPC + PC_AQ + head * 64 + 8 * hh;
        float x[4][8];
#pragma unroll
        for (int ks = 0; ks < 4; ++ks) { const u32x4 raw = *(const u32x4*)(qp + 16 * ks);
            x[ks][0] = bflo(raw.x); x[ks][1] = bfhi(raw.x); x[ks][2] = bflo(raw.y); x[ks][3] = bfhi(raw.y); x[ks][4] = bflo(raw.z); x[ks][5] = bfhi(raw.z); x[ks][6] = bflo(raw.w); x[ks][7] = bfhi(raw.w); }
        if (lat) {
            const int t = qb * 128 + ql;
#pragma unroll
            for (int pr = 0; pr < 2; ++pr) { const int pos = pr ? (t & 63) : (t >> 6);
#pragma unroll
                for (int j = 0; j < 8; ++j) { const f32x2 cs = tab[pos * 16 + 8 * hh + j]; const float x1 = x[2 * pr][j], x2 = x[2 * pr + 1][j];
                    x[2 * pr][j] = x1 * cs.x - x2 * cs.y; x[2 * pr + 1][j] = x2 * cs.x + x1 * cs.y; } }
        }
#pragma unroll
        for (int ks = 0; ks < 4; ++ks) qf[qt][ks] = pack8(x[ks][0] * 0.125f, x[ks][1] * 0.125f, x[ks][2] * 0.125f, x[ks][3] * 0.125f, x[ks][4] * 0.125f, x[ks][5] * 0.125f, x[ks][6] * 0.125f, x[ks][7] * 0.125f);
    }
    f32x16 O[2][2];
#pragma unroll
    for (int qt = 0; qt < 2; ++qt)
#pragma unroll
        for (int dt = 0; dt < 2; ++dt)
#pragma unroll
            for (int i = 0; i < 16; ++i) O[qt][dt][i] = 0.f;
    const float sk = A.sink[head];
    float m_run[2] = {sk, sk}, l_run[2];
    l_run[0] = l_run[1] = (hh == 0) ? 1.0f : 0.0f;
    const int ti_hi = (lat && qb == 31) ? 4 : 6;
    int ti = lat ? (qb == 0 ? 2 : 0) : 6;
    const int ss = tid >> 3, sc8 = tid & 7, half = sc8 >> 2, i0 = (sc8 & 3) * 4;
    u32x2 k1, k2; u32x4 vr;
#define ATT_LOAD(tix) do { const int krow_ = ((tix) < 6 ? b * SEQ + 128 * (qb - 1) + 64 * (tix) : MLAT + b * CTXL + 64 * ((tix) - 6)) + ss; \
        const bf16_t* kp_ = A.P + (size_t)krow_ * NPC; \
        k1 = *(const u32x2*)(kp_ + PC_AK + g * 64 + 32 * half + i0); k2 = *(const u32x2*)(kp_ + PC_AK + g * 64 + 32 * half + 16 + i0); \
        vr = *(const u32x4*)(kp_ + PC_AV + g * 64 + 8 * sc8); } while (0)
    ATT_LOAD(ti);
    for (;;) {
        {
            float a[4] = {bflo(k1.x), bfhi(k1.x), bflo(k1.y), bfhi(k1.y)}, c[4] = {bflo(k2.x), bfhi(k2.x), bflo(k2.y), bfhi(k2.y)};
            if (ti < 6) { const int kpos = 128 * (qb - 1) + 64 * ti + ss; const int pos = half ? (kpos & 63) : (kpos >> 6);
#pragma unroll
                for (int e = 0; e < 4; ++e) { const f32x2 cs = tab[pos * 16 + i0 + e]; const float x1 = a[e], x2 = c[e]; a[e] = x1 * cs.x - x2 * cs.y; c[e] = x2 * cs.x + x1 * cs.y; } }
            u32x2 o1, o2; o1.x = pk2(a[0], a[1]); o1.y = pk2(a[2], a[3]); o2.x = pk2(c[0], c[1]); o2.y = pk2(c[2], c[3]);
            *(LAS u32x2*)(lds + AT_K + ss * RS + (32 * half + i0) * 2) = o1;
            *(LAS u32x2*)(lds + AT_K + ss * RS + (32 * half + 16 + i0) * 2) = o2;
            const unsigned vv[4] = {vr.x, vr.y, vr.z, vr.w};
#pragma unroll
            for (int e = 0; e < 4; ++e) { *(LAS unsigned short*)(lds + AT_V + (8 * sc8 + 2 * e) * RS + ss * 2) = (unsigned short)(vv[e] & 0xffffu);
                *(LAS unsigned short*)(lds + AT_V + (8 * sc8 + 2 * e + 1) * RS + ss * 2) = (unsigned short)(vv[e] >> 16); }
        }
        __syncthreads();
        const int tn = (ti < 6 && ti + 1 == ti_hi) ? 6 : ti + 1;
        if (tn < 10) ATT_LOAD(tn);
        f32x16 S[2][2];
#pragma unroll
        for (int st = 0; st < 2; ++st) {
            bf16x8 kf[4];
#pragma unroll
            for (int ks = 0; ks < 4; ++ks) kf[ks] = *(const LAS bf16x8*)(lds + AT_K + (32 * st + r) * RS + (16 * ks + 8 * hh) * 2);
#pragma unroll
            for (int qt = 0; qt < 2; ++qt) { f32x16 acc;
#pragma unroll
                for (int i = 0; i < 16; ++i) acc[i] = 0.f;
#pragma unroll
                for (int ks = 0; ks < 4; ++ks) acc = MFMA32(kf[ks], qf[qt][ks], acc);
                S[qt][st] = acc; }
        }
        if (ti < 2 || (ti >= 4 && ti < 6)) {
            const int kp0 = 128 * (qb - 1) + 64 * ti;
#pragma unroll
            for (int qt = 0; qt < 2; ++qt) { const int qpos = qb * 128 + qoff + 32 * qt + r;
#pragma unroll
                for (int st = 0; st < 2; ++st)
#pragma unroll
                    for (int i = 0; i < 16; ++i) { const int df = qpos - (kp0 + 32 * st + crow(i, hh)); if (df > 128 || df < -128) S[qt][st][i] = -INFINITY; } }
        }
#pragma unroll
        for (int qt = 0; qt < 2; ++qt) {
            float mx = S[qt][0][0];
#pragma unroll
            for (int st = 0; st < 2; ++st)
#pragma unroll
                for (int i = 0; i < 16; ++i) mx = fmaxf(mx, S[qt][st][i]);
            mx = fmaxf(mx, __shfl_xor(mx, 32));
            const float mn = fmaxf(m_run[qt], mx), scale = __expf(m_run[qt] - mn);
            m_run[qt] = mn; float ls = 0.f;
#pragma unroll
            for (int st = 0; st < 2; ++st)
#pragma unroll
                for (int i = 0; i < 16; ++i) { const float pv = __expf(S[qt][st][i] - mn); S[qt][st][i] = pv; ls += pv; }
            l_run[qt] = l_run[qt] * scale + ls;
#pragma unroll
            for (int dt = 0; dt < 2; ++dt)
#pragma unroll
                for (int i = 0; i < 16; ++i) O[qt][dt][i] *= scale;
        }
#pragma unroll
        for (int kk = 0; kk < 4; ++kk) { const int st = kk >> 1, s2 = kk & 1;
            bf16x8 pb[2];
#pragma unroll
            for (int qt = 0; qt < 2; ++qt) pb[qt] = pack8(S[qt][st][8 * s2 + 0], S[qt][st][8 * s2 + 1], S[qt][st][8 * s2 + 2], S[qt][st][8 * s2 + 3], S[qt][st][8 * s2 + 4], S[qt][st][8 * s2 + 5], S[qt][st][8 * s2 + 6], S[qt][st][8 * s2 + 7]);
#pragma unroll
            for (int dt = 0; dt < 2; ++dt) {
                const LAS unsigned char* vp = lds + AT_V + (32 * dt + r) * RS + (32 * st + 16 * s2 + 4 * hh) * 2;
                const s16x4 lo = *(const LAS s16x4*)vp, hi = *(const LAS s16x4*)(vp + 16);
                const bf16x8 va = __builtin_shufflevector(lo, hi, 0, 1, 2, 3, 4, 5, 6, 7);
#pragma unroll
                for (int qt = 0; qt < 2; ++qt) O[qt][dt] = MFMA32(va, pb[qt], O[qt][dt]);
            }
        }
        __syncthreads();
        if (tn >= 10) break;
        ti = tn;
    }
#undef ATT_LOAD
#pragma unroll
    for (int qt = 0; qt < 2; ++qt) {
        const float l = l_run[qt] + __shfl_xor(l_run[qt], 32), inv = 1.0f / l;
        bf16_t* op = A.ATT + (size_t)(qrow0 + qoff + 32 * qt + r) * 512 + head * 64;
#pragma unroll
        for (int dt = 0; dt < 2; ++dt)
#pragma unroll
            for (int ig = 0; ig < 4; ++ig) { u32x2 wv; wv.x = pk2(O[qt][dt][4 * ig] * inv, O[qt][dt][4 * ig + 1] * inv); wv.y = pk2(O[qt][dt][4 * ig + 2] * inv, O[qt][dt][4 * ig + 3] * inv);
                *(u32x2*)(op + 32 * dt + 8 * ig + 4 * hh) = wv; }
    }
}

constexpr int SC_QS = 0, SC_KS = 9216, SC_QE = 18432, SC_UKT = 27648, SC_VT = 36864, SC_CBT = 55296, SC_F = 73728;
constexpr int SF_BETA = 0, SF_TOT = 256, SF_SSQ = 2304, SF_N = 3328, SF_DEC = 3840, SF_CONV = 4096;
struct ScanArgs { const bf16_t* P; bf16_t* OUT; const float* gates; const float* convw; const float* fbias; const float* gnorm; const float* lbl; int layer; };

template <bool IS_ML>
DI void scan_item(const ScanArgs& A, int b, int hd, LAS unsigned char* lds, int tid) {
    asm volatile("" : "+v"(tid));
    const int w = tid >> 6, lane = tid & 63, r = lane & 31, hh = lane >> 5;
    const int etile = w & 3, ttile = w >> 2, dtile = w >> 2;
    const int p = tid >> 3, dg = tid & 7;
    LAS float* F = (LAS float*)(lds + SC_F);
    LAS float* beta_s = F + SF_BETA / 4; LAS float* tot_s = F + SF_TOT / 4; LAS float* ssq_s = F + SF_SSQ / 4; LAS float* n_s = F + SF_N / 4; LAS float* dec_s = F + SF_DEC / 4; LAS float* conv_s = F + SF_CONV / 4;
    const int vcol = (IS_ML ? PC_MV : PC_HI) + hd * 128, gcol = (IS_ML ? PC_MO : PC_HG) + hd * 128;
    float lbv[8];
    if (IS_ML) {
        if (tid < 384) { const int j = tid >> 6, d = tid & 63; conv_s[tid] = A.convw[(j % 3) * 512 + (j / 3) * 256 + hd * 64 + d]; }
    } else {
#pragma unroll
        for (int e = 0; e < 8; ++e) { const int c = hd * 64 + 8 * dg + e; lbv[e] = (A.layer == 0) ? 0.f : 1.0f / (1.0f + expf(A.lbl[c] - A.lbl[256 + c])); }
    }
    for (int dir = 0; dir < 2; ++dir) {
        f32x16 Cst;
#pragma unroll
        for (int i = 0; i < 16; ++i) Cst[i] = 0.f;
        float m_run = 0.f;
        __syncthreads();
        if (tid < 128) n_s[tid] = 0.f;
#pragma unroll
        for (int ig = 0; ig < 4; ++ig) *(LAS u32x2*)(lds + SC_CBT + (32 * etile + r) * RS + (32 * dtile + 8 * ig + 4 * hh) * 2) = (u32x2){0u, 0u};
        const float fb = IS_ML ? A.fbias[dir * 4 + hd] : 0.f;
        u32x4 rq[3], rk[3], rv[2]; float rgi = 0.f, rgf = 0.f;
#define SC_ROWS(c_) const int cc_ = (c_) < 4 ? (dir ? 3 - (c_) : (c_)) : (dir ? 67 - (c_) : (c_) - 4); \
        const int slo_ = (c_) < 4 ? MLAT + b * CTXL : b * SEQ, slen_ = (c_) < 4 ? CTXL : SEQ; const int rb_ = slo_ + 64 * cc_;
#define SC_LOAD(c_) do { SC_ROWS(c_) const int ti_ = 64 * cc_ + (dir ? 63 - p : p); const bf16_t* pr_ = A.P + (size_t)(slo_ + ti_) * NPC; \
        if (IS_ML) { const u32x4 z4_ = (u32x4){0u, 0u, 0u, 0u}; \
            rq[1] = *(const u32x4*)(pr_ + PC_MQ + hd * 64 + 8 * dg); rk[1] = *(const u32x4*)(pr_ + PC_MK + hd * 64 + 8 * dg); \
            rq[0] = ti_ > 0 ? *(const u32x4*)(pr_ - NPC + PC_MQ + hd * 64 + 8 * dg) : z4_; rk[0] = ti_ > 0 ? *(const u32x4*)(pr_ - NPC + PC_MK + hd * 64 + 8 * dg) : z4_; \
            rq[2] = ti_ + 1 < slen_ ? *(const u32x4*)(pr_ + NPC + PC_MQ + hd * 64 + 8 * dg) : z4_; rk[2] = ti_ + 1 < slen_ ? *(const u32x4*)(pr_ + NPC + PC_MK + hd * 64 + 8 * dg) : z4_; \
            const float* gp_ = A.gates + (size_t)(rb_ + (dir ? 63 - lane : lane)) * 16; rgi = gp_[dir * 4 + hd]; rgf = gp_[8 + dir * 4 + hd]; \
        } else { rq[1] = *(const u32x4*)(pr_ + PC_HQ + hd * 64 + 8 * dg); rk[1] = *(const u32x4*)(pr_ + PC_HF + dir * 256 + hd * 64 + 8 * dg); } \
        rv[0] = *(const u32x4*)(pr_ + vcol + 16 * dg); rv[1] = *(const u32x4*)(pr_ + vcol + 16 * dg + 8); } while (0)
        SC_LOAD(0);
        for (int c = 0; c < 68; ++c) {
            float alpha = 0.f, wprev = 0.f, enm = 0.f, a_prev = 0.f;
            {
                const unsigned vv[8] = {rv[0].x, rv[0].y, rv[0].z, rv[0].w, rv[1].x, rv[1].y, rv[1].z, rv[1].w};
#pragma unroll
                for (int e = 0; e < 8; ++e) { *(LAS unsigned short*)(lds + SC_VT + (16 * dg + 2 * e) * RS + p * 2) = (unsigned short)(vv[e] & 0xffffu);
                    *(LAS unsigned short*)(lds + SC_VT + (16 * dg + 2 * e + 1) * RS + p * 2) = (unsigned short)(vv[e] >> 16); }
            }
            if (IS_ML) {
                const float li = rgi, xf = rgf + fb;
                const float lf = fminf(xf, 0.f) - log1pf(__expf(-fabsf(xf)));
                float bc = lf;
#pragma unroll
                for (int off = 1; off < 64; off <<= 1) { const float v = __shfl_up(bc, off); if (lane >= off) bc += v; }
                const float beta = li - bc; float pm = beta;
#pragma unroll
                for (int off = 1; off < 64; off <<= 1) { const float v = __shfl_up(pm, off); if (lane >= off) pm = fmaxf(pm, v); }
                const float bl = __shfl(bc, 63), pmx = __shfl(pm, 63);
                const float mm = fmaxf(m_run, pm), mmx = fmaxf(m_run, pmx);
                alpha = -mm; wprev = __expf(m_run - mm); enm = __expf(-(bc + mm));
                a_prev = __expf(m_run - mmx); const float u = __expf(beta - mmx);
                m_run = bl + mmx;
                if (w == 0) beta_s[lane] = beta;
                const float up = __shfl(u, p);
                float q8[8], k8[8];
                const unsigned q0[4] = {rq[0].x, rq[0].y, rq[0].z, rq[0].w}, q1[4] = {rq[1].x, rq[1].y, rq[1].z, rq[1].w}, q2[4] = {rq[2].x, rq[2].y, rq[2].z, rq[2].w};
                const unsigned k0[4] = {rk[0].x, rk[0].y, rk[0].z, rk[0].w}, k1[4] = {rk[1].x, rk[1].y, rk[1].z, rk[1].w}, k2[4] = {rk[2].x, rk[2].y, rk[2].z, rk[2].w};
#pragma unroll
                for (int e = 0; e < 4; ++e) { const int d0 = 8 * dg + 2 * e;
                    q8[2 * e] = fsilu(bflo(q0[e]) * conv_s[0 * 64 + d0] + bflo(q1[e]) * conv_s[1 * 64 + d0] + bflo(q2[e]) * conv_s[2 * 64 + d0]);
                    q8[2 * e + 1] = fsilu(bfhi(q0[e]) * conv_s[0 * 64 + d0 + 1] + bfhi(q1[e]) * conv_s[1 * 64 + d0 + 1] + bfhi(q2[e]) * conv_s[2 * 64 + d0 + 1]);
                    k8[2 * e] = 0.125f * fsilu(bflo(k0[e]) * conv_s[3 * 64 + d0] + bflo(k1[e]) * conv_s[4 * 64 + d0] + bflo(k2[e]) * conv_s[5 * 64 + d0]);
                    k8[2 * e + 1] = 0.125f * fsilu(bfhi(k0[e]) * conv_s[3 * 64 + d0 + 1] + bfhi(k1[e]) * conv_s[4 * 64 + d0 + 1] + bfhi(k2[e]) * conv_s[5 * 64 + d0 + 1]); }
                *(LAS bf16x8*)(lds + SC_QS + p * RS + 16 * dg) = pack8(q8[0], q8[1], q8[2], q8[3], q8[4], q8[5], q8[6], q8[7]);
                *(LAS bf16x8*)(lds + SC_KS + p * RS + 16 * dg) = pack8(k8[0], k8[1], k8[2], k8[3], k8[4], k8[5], k8[6], k8[7]);
#pragma unroll
                for (int e = 0; e < 8; ++e) *(LAS unsigned short*)(lds + SC_UKT + (8 * dg + e) * RS + p * 2) = (unsigned short)f2bf(up * k8[e]);
            } else {
                float x[8], kk[8], qs[8];
                const unsigned qr[4] = {rq[1].x, rq[1].y, rq[1].z, rq[1].w}, zr[4] = {rk[1].x, rk[1].y, rk[1].z, rk[1].w};
#pragma unroll
                for (int e = 0; e < 8; ++e) { const float z = (e & 1) ? bfhi(zr[e >> 1]) : bflo(zr[e >> 1]), qv = (e & 1) ? bfhi(qr[e >> 1]) : bflo(qr[e >> 1]);
                    const float ez = __expf(-fabsf(z)), sg = (z >= 0.f ? 1.0f : ez) / (1.0f + ez);
                    const float lb = lbv[e], f = lb + (1.0f - lb) * sg;
                    kk[e] = (1.0f - lb) * (1.0f - sg);
                    x[e] = (lb > 0.f) ? __logf(f) : (fminf(z, 0.f) - log1pf(ez));
                    qs[e] = 0.125f * fsilu(qv); }
#pragma unroll
                for (int off = 8; off < 64; off <<= 1)
#pragma unroll
                    for (int e = 0; e < 8; ++e) { const float v = __shfl_up(x[e], off); if (lane >= off) x[e] += v; }
                if ((lane >> 3) == 7) { *(LAS f32x4*)(tot_s + w * 64 + 8 * dg) = (f32x4){x[0], x[1], x[2], x[3]}; *(LAS f32x4*)(tot_s + w * 64 + 8 * dg + 4) = (f32x4){x[4], x[5], x[6], x[7]}; }
                __syncthreads();
                float offs[8], ref[8], blv[8];
#pragma unroll
                for (int e = 0; e < 8; ++e) { offs[e] = 0.f; ref[e] = 0.f; blv[e] = 0.f; }
#pragma unroll
                for (int w2 = 0; w2 < 8; ++w2) { const f32x4 t0 = *(const LAS f32x4*)(tot_s + w2 * 64 + 8 * dg), t1 = *(const LAS f32x4*)(tot_s + w2 * 64 + 8 * dg + 4);
                    const float tv[8] = {t0[0], t0[1], t0[2], t0[3], t1[0], t1[1], t1[2], t1[3]};
#pragma unroll
                    for (int e = 0; e < 8; ++e) { if (w2 < w) offs[e] += tv[e]; if (w2 < 4) ref[e] += tv[e]; blv[e] += tv[e]; } }
                float qe[8], qt[8], kt[8];
#pragma unroll
                for (int e = 0; e < 8; ++e) { const float bb = x[e] + offs[e];
                    qe[e] = qs[e] * __expf(bb); qt[e] = qs[e] * __expf(fminf(bb - ref[e], 60.f)); kt[e] = kk[e] * __expf(fminf(ref[e] - bb, 60.f));
                    *(LAS unsigned short*)(lds + SC_UKT + (8 * dg + e) * RS + p * 2) = (unsigned short)f2bf(kk[e] * __expf(blv[e] - bb)); }
                *(LAS bf16x8*)(lds + SC_QE + p * RS + 16 * dg) = pack8(qe[0], qe[1], qe[2], qe[3], qe[4], qe[5], qe[6], qe[7]);
                *(LAS bf16x8*)(lds + SC_QS + p * RS + 16 * dg) = pack8(qt[0], qt[1], qt[2], qt[3], qt[4], qt[5], qt[6], qt[7]);
                *(LAS bf16x8*)(lds + SC_KS + p * RS + 16 * dg) = pack8(kt[0], kt[1], kt[2], kt[3], kt[4], kt[5], kt[6], kt[7]);
                if (p == 0) {
#pragma unroll
                    for (int e = 0; e < 8; ++e) dec_s[8 * dg + e] = __expf(blv[e]); }
            }
            __syncthreads();
            SC_ROWS(c)
            if (c + 1 < 68) SC_LOAD(c + 1);
            const int t = 32 * ttile + r;
            bf16x8 qf[4];
#pragma unroll
            for (int ks = 0; ks < 4; ++ks) qf[ks] = *(const LAS bf16x8*)(lds + SC_QS + t * RS + (16 * ks + 8 * hh) * 2);
            f32x16 S[2];
#pragma unroll
            for (int st = 0; st < 2; ++st) { f32x16 acc;
#pragma unroll
                for (int i = 0; i < 16; ++i) acc[i] = 0.f;
#pragma unroll
                for (int ks = 0; ks < 4; ++ks) { const bf16x8 kf = *(const LAS bf16x8*)(lds + SC_KS + (32 * st + r) * RS + (16 * ks + 8 * hh) * 2); acc = MFMA32(kf, qf[ks], acc); }
                S[st] = acc; }
            float inv = 1.0f, wprev_t = 1.0f;
            if (IS_ML) {
                const float alpha_t = __shfl(alpha, t), en_t = __shfl(enm, t); wprev_t = __shfl(wprev, t);
                float rs = 0.f;
#pragma unroll
                for (int st = 0; st < 2; ++st)
#pragma unroll
                    for (int ig = 0; ig < 4; ++ig) { const f32x4 bt = *(const LAS f32x4*)(beta_s + 32 * st + 8 * ig + 4 * hh);
#pragma unroll
                        for (int k = 0; k < 4; ++k) { const int s = 32 * st + 8 * ig + 4 * hh + k; const float e = (s <= t) ? __expf(alpha_t + bt[k]) : 0.f; const float v = S[st][4 * ig + k] * e; S[st][4 * ig + k] = v; rs += v; } }
                rs += __shfl_xor(rs, 32);
                const LAS float* nv = n_s + (c & 1) * 64; float qn = 0.f;
#pragma unroll
                for (int ks = 0; ks < 4; ++ks) { const f32x4 n0 = *(const LAS f32x4*)(nv + 16 * ks + 8 * hh), n1 = *(const LAS f32x4*)(nv + 16 * ks + 8 * hh + 4);
                    qn += bf1(qf[ks][0]) * n0[0] + bf1(qf[ks][1]) * n0[1] + bf1(qf[ks][2]) * n0[2] + bf1(qf[ks][3]) * n0[3] + bf1(qf[ks][4]) * n1[0] + bf1(qf[ks][5]) * n1[1] + bf1(qf[ks][6]) * n1[2] + bf1(qf[ks][7]) * n1[3]; }
                qn += __shfl_xor(qn, 32);
                const float den = wprev_t * qn + rs;
                inv = 1.0f / fmaxf(fabsf(den), en_t);
                if (w == 0) {
                    float sacc = 0.f;
#pragma unroll
                    for (int q8i = 0; q8i < 8; ++q8i) { const bf16x8 uk = *(const LAS bf16x8*)(lds + SC_UKT + lane * RS + 16 * q8i);
#pragma unroll
                        for (int j = 0; j < 8; ++j) sacc += bf1(uk[j]); }
                    n_s[((c + 1) & 1) * 64 + lane] = a_prev * nv[lane] + sacc;
                }
            } else {
#pragma unroll
                for (int st = 0; st < 2; ++st)
#pragma unroll
                    for (int i = 0; i < 16; ++i) { const int s = 32 * st + crow(i, hh); if (s > t) S[st][i] = 0.f; }
            }
            f32x16 acc;
#pragma unroll
            for (int i = 0; i < 16; ++i) acc[i] = 0.f;
#pragma unroll
            for (int ks = 0; ks < 4; ++ks) { const bf16x8 ca = *(const LAS bf16x8*)(lds + SC_CBT + (32 * etile + r) * RS + (16 * ks + 8 * hh) * 2);
                const bf16x8 qb = IS_ML ? qf[ks] : *(const LAS bf16x8*)(lds + SC_QE + t * RS + (16 * ks + 8 * hh) * 2);
                acc = MFMA32(ca, qb, acc); }
            if (IS_ML) {
#pragma unroll
                for (int i = 0; i < 16; ++i) acc[i] *= wprev_t; }
#pragma unroll
            for (int kk2 = 0; kk2 < 4; ++kk2) { const int st = kk2 >> 1, s2 = kk2 & 1;
                const LAS unsigned char* vp = lds + SC_VT + (32 * etile + r) * RS + (32 * st + 16 * s2 + 4 * hh) * 2;
                const s16x4 lo = *(const LAS s16x4*)vp, hi = *(const LAS s16x4*)(vp + 16);
                const bf16x8 va = __builtin_shufflevector(lo, hi, 0, 1, 2, 3, 4, 5, 6, 7);
                const bf16x8 pb = pack8(S[st][8 * s2 + 0], S[st][8 * s2 + 1], S[st][8 * s2 + 2], S[st][8 * s2 + 3], S[st][8 * s2 + 4], S[st][8 * s2 + 5], S[st][8 * s2 + 6], S[st][8 * s2 + 7]);
                acc = MFMA32(va, pb, acc); }
            {
                const int orow = rb_ + (dir ? 63 - t : t);
                bf16_t* op = A.OUT + (size_t)orow * 512 + hd * 128 + 32 * etile + 4 * hh;
                if (dir == 0) {
#pragma unroll
                    for (int ig = 0; ig < 4; ++ig) { u32x2 wv; wv.x = pk2(acc[4 * ig] * inv, acc[4 * ig + 1] * inv); wv.y = pk2(acc[4 * ig + 2] * inv, acc[4 * ig + 3] * inv); *(u32x2*)(op + 8 * ig) = wv; }
                } else {
                    float sq = 0.f;
#pragma unroll
                    for (int ig = 0; ig < 4; ++ig) { const unsigned long long pv = __hip_atomic_load((const unsigned long long*)(op + 8 * ig), __ATOMIC_RELAXED, __HIP_MEMORY_SCOPE_AGENT);
                        const unsigned a0 = (unsigned)pv, a1 = (unsigned)(pv >> 32);
                        acc[4 * ig] = acc[4 * ig] * inv + bflo(a0); acc[4 * ig + 1] = acc[4 * ig + 1] * inv + bfhi(a0); acc[4 * ig + 2] = acc[4 * ig + 2] * inv + bflo(a1); acc[4 * ig + 3] = acc[4 * ig + 3] * inv + bfhi(a1);
                        sq += (acc[4 * ig] * acc[4 * ig] + acc[4 * ig + 1] * acc[4 * ig + 1]) + (acc[4 * ig + 2] * acc[4 * ig + 2] + acc[4 * ig + 3] * acc[4 * ig + 3]); }
                    sq += __shfl_xor(sq, 32);
                    if (hh == 0) ssq_s[etile * 64 + t] = sq;
                    __syncthreads();
                    const float tot = (ssq_s[t] + ssq_s[64 + t]) + (ssq_s[128 + t] + ssq_s[192 + t]);
                    const float rstd = 1.0f / sqrtf(tot * (1.0f / 128.0f) + EPS);
                    const bf16_t* gp = A.P + (size_t)orow * NPC + gcol + 32 * etile + 4 * hh;
                    const float* gn = A.gnorm + hd * 128 + 32 * etile + 4 * hh;
#pragma unroll
                    for (int ig = 0; ig < 4; ++ig) { const u32x2 gw = *(const u32x2*)(gp + 8 * ig); const f32x4 g4 = *(const f32x4*)(gn + 8 * ig);
                        const float g0 = bflo(gw.x), g1 = bfhi(gw.x), g2 = bflo(gw.y), g3 = bfhi(gw.y);
                        const float o0 = acc[4 * ig] * rstd * g4[0] * (IS_ML ? fsigmoid(g0) : fsilu(g0)), o1 = acc[4 * ig + 1] * rstd * g4[1] * (IS_ML ? fsigmoid(g1) : fsilu(g1));
                        const float o2 = acc[4 * ig + 2] * rstd * g4[2] * (IS_ML ? fsigmoid(g2) : fsilu(g2)), o3 = acc[4 * ig + 3] * rstd * g4[3] * (IS_ML ? fsigmoid(g3) : fsilu(g3));
                        u32x2 wv; wv.x = pk2(o0, o1); wv.y = pk2(o2, o3); *(u32x2*)(op + 8 * ig) = wv; }
                }
            }
            if (IS_ML) {
#pragma unroll
                for (int i = 0; i < 16; ++i) Cst[i] *= a_prev;
            } else {
#pragma unroll
                for (int ig = 0; ig < 4; ++ig) { const f32x4 dv = *(const LAS f32x4*)(dec_s + 32 * dtile + 8 * ig + 4 * hh);
#pragma unroll
                    for (int k = 0; k < 4; ++k) Cst[4 * ig + k] *= dv[k]; }
            }
#pragma unroll
            for (int ks = 0; ks < 4; ++ks) { const bf16x8 ua = *(const LAS bf16x8*)(lds + SC_UKT + (32 * dtile + r) * RS + (16 * ks + 8 * hh) * 2);
                const bf16x8 vb = *(const LAS bf16x8*)(lds + SC_VT + (32 * etile + r) * RS + (16 * ks + 8 * hh) * 2);
                Cst = MFMA32(ua, vb, Cst); }
            __syncthreads();
#pragma unroll
            for (int ig = 0; ig < 4; ++ig) { u32x2 wv; wv.x = pk2(Cst[4 * ig], Cst[4 * ig + 1]); wv.y = pk2(Cst[4 * ig + 2], Cst[4 * ig + 3]);
                *(LAS u32x2*)(lds + SC_CBT + (32 * etile + r) * RS + (32 * dtile + 8 * ig + 4 * hh) * 2) = wv; }
        }
#undef SC_LOAD
#undef SC_ROWS
    }
    __syncthreads();
}
#ifndef PH
#define PH 0xffff
#endif

DI void mix_phase(KP p, int l, LAS unsigned char* lds, int tid) {
    asm volatile("" : "+v"(tid));
    const int G = gridDim.x, bid = blockIdx.x;
    const bf16_t* P = (const bf16_t*)(p->ws + WS_P);
    bf16_t* ATT = (bf16_t*)(p->ws + WS_S); bf16_t* MLB = ATT + (size_t)MTOT * 512; bf16_t* HGB = MLB + (size_t)MTOT * 512;
    const int nattn = 512 + (l == 0 ? 32 : 0);
    const bool split = G > 64;
    if (!split || bid < 64) {
        for (int it = bid; it < 64; it += (split ? 64 : G)) {
            const int b = (it >> 2) & 7, hd = it & 3;
            if (it < 32) { ScanArgs A{P, MLB, (const float*)(p->ws + WS_GATES), p->in[I_MLCONV] + (size_t)l * 3 * 512, p->in[I_MLFB] + l * 8, p->in[I_MLNORM] + l * 512, p->in[I_HGLB], l};
#ifndef NO_SCANML
                scan_item<true>(A, b, hd, lds, tid);
#endif
 }
            else { ScanArgs A{P, HGB, (const float*)(p->ws + WS_GATES), p->in[I_MLCONV], p->in[I_MLFB], p->in[I_HGNORM] + l * 512, p->in[I_HGLB], l};
#ifndef NO_SCANHG
                scan_item<false>(A, b, hd, lds, tid);
#endif
 }
        }
    }
    if (!split || bid >= 64) {
        __syncthreads();
        const f32x2* rope = (const f32x2*)(p->ws + WS_ROPE);
        for (int i = tid; i < 1024; i += 512) ((LAS f32x2*)(lds + AT_TAB))[i] = rope[i];
        __syncthreads();
        AttnArgs A{P, ATT, p->in[I_SINK] + l * 8, rope};
        for (int it = split ? bid - 64 : bid; it < nattn; it += (split ? G - 64 : G)) {
#ifndef NO_ATTN
 attn_item(A, it, lds, tid);
#endif
 }
    }
}

template <class Epi> DI void run_gemm(LAS unsigned char* lds, const bf16_t* A, const bf16_t* Bt, int M, int N, int K, const Epi& E) {
    pg8::Gemm g{A, Bt, M, N, K}; pg8::StaticOrder S; S.init(M, N, (int)gridDim.x, (int)blockIdx.x);
    pg8::gemm_phase<Epi, pg8::StaticOrder, true, true>(lds, g, S, E);
}

__global__ void __launch_bounds__(512) fwd_kernel(Params p_unused) {
    extern __shared__ __attribute__((aligned(16))) unsigned char lds_raw[];
    LAS unsigned char* lds = (LAS unsigned char*)lds_raw;
    cg::grid_group grid = cg::this_grid();
#define tid ((int)threadIdx.x)
#define ws (kparams()->ws)
#define W ((bf16_t*)(ws + WS_W))
#define H ((bf16_t*)(ws + WS_H))
#define PB ((bf16_t*)(ws + WS_P))
#define SB ((bf16_t*)(ws + WS_S))
#define XC ((float*)(ws + WS_XC))
#define mod ((const float*)(ws + WS_MOD))
#define gates ((float*)(ws + WS_GATES))
    KP p = kparams();

#if PH & 1
    convert_weights(p, 0, lds);
    __syncthreads();
    mods_phase(p, lds, tid);
#endif
    grid.sync();
    {
        RowArgs a{p->in[I_X], p->in[I_CTX], nullptr, nullptr, nullptr, H, mod, mod, nullptr, p->in[I_NPRE], nullptr, nullptr, 0, 0, MTOT, 0.f};
#if PH & 2
        row_phase<false, true, false>(a, lds, tid);
#endif
    }
    grid.sync();

#pragma unroll 1
    for (int l = 0; l < 2; ++l) {
        p = kparams();
        const float* modl = mod + (size_t)l * 9 * 9216;
        const float* npre = p->in[I_NPRE] + (size_t)l * 3 * DM; const float* npost = p->in[I_NPOST] + (size_t)l * 3 * DM;
        const int M2 = (l == 1) ? MLAT : MTOT;
#if PH & 4
        { pg8::EpiSwiGLU E{PB, DFF}; run_gemm(lds, H, W + WO_W13, MTOT, 5632, DM, E); }
#endif
        grid.sync();
#if PH & 8
        { pg8::EpiBf16<0> E{SB, DM}; run_gemm(lds, PB, W + WO_W2, MTOT, DM, DFF, E); }
#endif
        grid.sync();
        {
            RowArgs a{l == 0 ? p->in[I_X] : p->out, l == 0 ? p->in[I_CTX] : XC, p->out, XC, SB, H, modl, modl, npost, npre + DM, p->in[I_WIN] + (size_t)l * DM * DIN + 2304, gates, 0, 1, MTOT, 0.5f};
#if PH & 16
            row_phase<true, true, true>(a, lds, tid);
#endif
        }
        grid.sync();
#if PH & 32
        { pg8::EpiBf16<0> E{PB, NPC}; run_gemm(lds, H, W + WO_WIN, MTOT, NPC, DM, E); }
#endif
        grid.sync();
#if PH & 64
        mix_phase(p, l, lds, tid);
#endif
        grid.sync();
#if PH & 128
        { pg8::EpiBf16<1> E{PB, NGC}; run_gemm(lds, H, W + WO_WG, M2, NGC, DM, E); }
#endif
        grid.sync();
#if PH & 256
#pragma unroll 1
        for (int gi = 0; gi < 3; ++gi) { pg8::EpiMerge E{H, PB, gi}; run_gemm(lds, SB + (size_t)gi * MTOT * 512, W + WO_WB + (size_t)gi * 1024 * 512, M2, DM, 512, E); }
#endif
        grid.sync();
#if PH & 512
        { pg8::EpiBf16<0> E{SB, DM}; run_gemm(lds, H, W + WO_WOUT, M2, DM, DM, E); }
#endif
        grid.sync();
        {
            RowArgs a{p->out, XC, p->out, XC, SB, H, modl, modl, npost + DM, npre + 2 * DM, nullptr, nullptr, 1, 2, M2, 1.0f};
#if PH & 1024
            row_phase<true, true, false>(a, lds, tid);
#endif
        }
        grid.sync();
#if PH & 2048
        { pg8::EpiSwiGLU E{PB, DFF}; run_gemm(lds, H, W + WO_W13 + (size_t)5632 * 1024, M2, 5632, DM, E); }
#endif
        grid.sync();
#if PH & 4096
        { pg8::EpiBf16<0> E{SB, DM}; run_gemm(lds, PB, W + WO_W2 + (size_t)1024 * 2816, M2, DM, DFF, E); }
#endif
        grid.sync();
        if (l == 0) {
            RowArgs a{p->out, XC, p->out, XC, SB, H, modl, mod + (size_t)9 * 9216, npost + 2 * DM, p->in[I_NPRE] + 3 * DM, nullptr, nullptr, 2, 0, MTOT, 0.5f};
#if PH & 8192
            row_phase<true, true, false>(a, lds, tid);
            __syncthreads();
            convert_weights(p, 1, lds);
#endif
            grid.sync();
        } else {
            RowArgs a{p->out, XC, p->out, XC, SB, H, modl, modl, npost + 2 * DM, nullptr, nullptr, nullptr, 2, 0, MLAT, 0.5f};
#if PH & 16384
            row_phase<true, false, false>(a, lds, tid);
#endif
        }
    }
#undef tid
#undef ws
#undef W
#undef H
#undef PB
#undef SB
#undef XC
#undef mod
#undef gates
}

extern "C" void kernel_launch(void* const* d_in, const int* in_sizes, int n_in, void* d_out, int out_size, void* d_ws, size_t ws_size, hipStream_t stream) {
    static int grid = 0;
    if (grid == 0) {
        if (n_in != 22 || out_size != MLAT * DM || ws_size < WS_END) { fprintf(stderr, "kernel_launch: unexpected shapes (n_in %d out %d ws %zu)\n", n_in, out_size, ws_size); grid = -1; return; }
        int dev = 0, cus = 0, per_cu = 0;
        (void)hipGetDevice(&dev);
        (void)hipDeviceGetAttribute(&cus, hipDeviceAttributeMultiprocessorCount, dev);
        (void)hipFuncSetAttribute((const void*)fwd_kernel, hipFuncAttributeMaxDynamicSharedMemorySize, LDS_BYTES);
        (void)hipOccupancyMaxActiveBlocksPerMultiprocessor(&per_cu, (const void*)fwd_kernel, 512, LDS_BYTES);
        if (per_cu < 1) per_cu = 1;
        if (per_cu > 1) per_cu = 1;
        grid = cus * per_cu;
        if (grid <= 0) grid = 256;
    }
    if (grid < 0) return;
    Params p{};
    for (int i = 0; i < 22; ++i) p.in[i] = (const float*)d_in[i];
    p.out = (float*)d_out; p.ws = (unsigned char*)d_ws;
    void* args[] = {&p};
    hipError_t e = hipLaunchCooperativeKernel((const void*)fwd_kernel, dim3(grid), dim3(512), args, LDS_BYTES, stream);
    if (e != hipSuccess) fprintf(stderr, "cooperative launch failed: %s (grid %d)\n", hipGetErrorString(e), grid);
}
```

```cpp
#include <hip/hip_runtime.h>
#include <hip/hip_cooperative_groups.h>
#include <cstdio>
#include <cstdint>
namespace cg = cooperative_groups;

#define DI __device__ __forceinline__
#define LAS __attribute__((address_space(3)))
typedef unsigned short bf16_t;
typedef short bf16x8 __attribute__((ext_vector_type(8)));
typedef short s16x4 __attribute__((ext_vector_type(4)));
typedef float f32x2 __attribute__((ext_vector_type(2)));
typedef float f32x4 __attribute__((ext_vector_type(4)));
typedef float f32x16 __attribute__((ext_vector_type(16)));
typedef unsigned u32x2 __attribute__((ext_vector_type(2)));
typedef unsigned u32x4 __attribute__((ext_vector_type(4)));

constexpr int DM = 1024, NB = 8, SEQ = 4096, CTXL = 256, DFF = 2816, DIN = 7184, NMOD = 9;
constexpr int MLAT = NB * SEQ, MCTX = NB * CTXL, MTOT = MLAT + MCTX;
constexpr int NPC = 4096;
constexpr int NGC = 3072;
constexpr float EPS = 1e-6f;
constexpr int PC_AQ = 0, PC_AK = 512, PC_AV = 640, PC_MQ = 768, PC_MK = 1024, PC_MV = 1280, PC_MO = 1792, PC_HQ = 2304, PC_HF = 2560, PC_HI = 3072, PC_HG = 3584;

constexpr size_t MiB = 1u << 20;
constexpr size_t WS_MOD = 1 * MiB;
constexpr size_t WS_ROPE = 2 * MiB;
constexpr size_t WS_GATES = 3 * MiB;
constexpr size_t WS_XC = 6 * MiB;
constexpr size_t WS_W = 14 * MiB;
constexpr size_t WS_H = 66 * MiB;
constexpr size_t WS_P = 134 * MiB;
constexpr size_t WS_S = 406 * MiB;
constexpr size_t WS_END = 508 * MiB;
constexpr size_t WO_W13 = 0;
constexpr size_t WO_W2 = WO_W13 + (size_t)2 * 5632 * 1024;
constexpr size_t WO_WIN = WO_W2 + (size_t)2 * 1024 * 2816;
constexpr size_t WO_WG = WO_WIN + (size_t)4096 * 1024;
constexpr size_t WO_WB = WO_WG + (size_t)3072 * 1024;
constexpr size_t WO_WOUT = WO_WB + (size_t)3 * 1024 * 512;
constexpr size_t WO_END = WO_WOUT + (size_t)1024 * 1024;
static_assert(WO_END * 2 <= 52 * MiB, "weights fit");
static_assert((size_t)MTOT * 1024 * 2 <= 68 * MiB && (size_t)MTOT * 4096 * 2 <= 272 * MiB && (size_t)MTOT * 512 * 2 * 3 <= 102 * MiB, "ws map");

constexpr int LDS_BYTES = 131072;

DI unsigned f2bf(float f) { unsigned u = __float_as_uint(f); return (u + 0x7fffu + ((u >> 16) & 1u)) >> 16; }
typedef __bf16 bf16v2 __attribute__((ext_vector_type(2)));
DI unsigned pk2(float lo, float hi) { f32x2 v = {lo, hi}; bf16v2 b = __builtin_convertvector(v, bf16v2); return __builtin_bit_cast(unsigned, b); }
DI float bflo(unsigned w) { return __uint_as_float(w << 16); }
DI float bfhi(unsigned w) { return __uint_as_float(w & 0xffff0000u); }
DI float bf1(short s) { return __uint_as_float(((unsigned)(unsigned short)s) << 16); }
DI float fsigmoid(float x) { return __builtin_amdgcn_rcpf(1.0f + __expf(-x)); }
DI float fsilu(float x) { return x * fsigmoid(x); }
DI float wave_sum(float v) {
#pragma unroll
    for (int o = 1; o < 64; o <<= 1) v += __shfl_xor(v, o);
    return v;
}
DI bf16x8 pack8(float a0, float a1, float a2, float a3, float a4, float a5, float a6, float a7) {
    u32x4 p; p.x = pk2(a0, a1); p.y = pk2(a2, a3); p.z = pk2(a4, a5); p.w = pk2(a6, a7); return __builtin_bit_cast(bf16x8, p);
}
#define MFMA32(a, b, c) __builtin_amdgcn_mfma_f32_32x32x16_bf16((a), (b), (c), 0, 0, 0)
DI int crow(int i, int h) { return (i & 3) + 8 * (i >> 2) + 4 * h; }

namespace pg8 {
#define PG8_LAS __attribute__((address_space(3)))
typedef unsigned short bf16_t;
typedef short bf16x8 __attribute__((ext_vector_type(8)));
typedef float f32x4 __attribute__((ext_vector_type(4)));
typedef unsigned u32x4 __attribute__((ext_vector_type(4)));
constexpr int BM = 256, BK = 64, HALF = 128, HTB = HALF * BK * 2  , STAGE_BYTES = 8 * HTB, NXCD = 8, WGM = 8;

__host__ __device__ __forceinline__ int lds_byte(int r, int c) { const int st = (r >> 4) * 2 + (c >> 5), rr = r & 15, cc = c & 31, ob = rr * 64 + cc * 2; return st * 1024 + (ob ^ (((ob >> 9) & 1) << 5)); }
__host__ __device__ __forceinline__ void stage_rc(int b, int& R, int& C) { const int st = b / 1024, sb = b % 1024, swz = sb ^ (((sb >> 9) & 1) << 5); R = (st >> 1) * 16 + swz / 64; C = (st & 1) * 32 + (swz % 64) / 2; }
__host__ __device__ __forceinline__ int perm32(int rho) { const int n = rho >> 4, i = rho & 15; return 8 * (i >> 2) + 4 * n + (i & 3); }

struct Unit { int pm, pn; };
struct Gemm { const bf16_t* A; const bf16_t* Bt; int M, N, K; };

struct StaticOrder {
    int nM, nN, nwg, G, c;
    __host__ __device__ void init(int M, int N, int G_, int c_) { nM = M / BM; nN = N / BM; nwg = nM * nN; G = G_; c = c_; }
    __host__ __device__ bool next(int i, Unit& u) const {
        const long L = (long)i * G + c; if (L >= nwg) return false;
        int wgid = (int)L; { const int q = nwg / NXCD, r = nwg % NXCD, xcd = wgid % NXCD, off = wgid / NXCD; wgid = (xcd < r ? xcd * (q + 1) : r * (q + 1) + (xcd - r) * q) + off; }
        const int nig = WGM * nN, gid = wgid / nig, fm = gid * WGM, gsz = (nM - fm) < WGM ? (nM - fm) : WGM;
        u.pm = fm + ((wgid % nig) % gsz); u.pn = (wgid % nig) / gsz; return true;
    }
    __device__ __forceinline__ void a_ready(const Unit&) const {}
    __device__ __forceinline__ void done(const Unit&) const {}
};

template <int ACT  > struct EpiBf16 {
    static constexpr bool PERM = true, AFTER_DRAIN = false;
    bf16_t* O; int ldc;
    __device__ __forceinline__ void operator()(const f32x4 (&acc)[2][2][4][2], const Unit& u, int wr, int wc, int fr, int fq) const {
        const int row0 = u.pm * BM + wr * 64 + fr, col0 = u.pn * BM + wc * 32 + 8 * fq;
#pragma unroll
        for (int ai = 0; ai < 2; ++ai)
#pragma unroll
            for (int m = 0; m < 4; ++m) { bf16_t* rowp = O + (size_t)(row0 + ai * HALF + m * 16) * ldc + col0;
#pragma unroll
                for (int bj = 0; bj < 2; ++bj) { f32x4 v0 = acc[ai][bj][m][0], v1 = acc[ai][bj][m][1];
                    if (ACT == 1) {
#pragma unroll
                        for (int k = 0; k < 4; ++k) { v0[k] = fsigmoid(v0[k]); v1[k] = fsigmoid(v1[k]); } }
                    u32x4 w; w.x = pk2(v0[0], v0[1]); w.y = pk2(v0[2], v0[3]); w.z = pk2(v1[0], v1[1]); w.w = pk2(v1[2], v1[3]);
                    *(u32x4*)(rowp + bj * HALF) = w; } }
    }
};
struct EpiSwiGLU {
    static constexpr bool PERM = false, AFTER_DRAIN = false;
    bf16_t* O; int ldc;
    __device__ __forceinline__ void operator()(const f32x4 (&acc)[2][2][4][2], const Unit& u, int wr, int wc, int fr, int fq) const {
        const int row0 = u.pm * BM + wr * 64 + fr, f0 = u.pn * 128 + wc * 16 + 4 * fq;
#pragma unroll
        for (int ai = 0; ai < 2; ++ai)
#pragma unroll
            for (int m = 0; m < 4; ++m) { bf16_t* rowp = O + (size_t)(row0 + ai * HALF + m * 16) * ldc + f0;
#pragma unroll
                for (int bj = 0; bj < 2; ++bj) { const f32x4 a = acc[ai][bj][m][0], b = acc[ai][bj][m][1];
                    u32x2 w; w.x = pk2(fsilu(a[0]) * b[0], fsilu(a[1]) * b[1]); w.y = pk2(fsilu(a[2]) * b[2], fsilu(a[3]) * b[3]);
                    *(u32x2*)(rowp + bj * 64) = w; } }
    }
};
struct EpiMerge {
    static constexpr bool PERM = true, AFTER_DRAIN = false;
    bf16_t* O; const bf16_t* G; int gi;
    __device__ __forceinline__ void operator()(const f32x4 (&acc)[2][2][4][2], const Unit& u, int wr, int wc, int fr, int fq) const {
        const int row0 = u.pm * BM + wr * 64 + fr, col0 = u.pn * BM + wc * 32 + 8 * fq;
#pragma unroll
        for (int ai = 0; ai < 2; ++ai)
#pragma unroll
            for (int m = 0; m < 4; ++m) { const size_t r = (size_t)(row0 + ai * HALF + m * 16);
#pragma unroll
                for (int bj = 0; bj < 2; ++bj) { const int c = col0 + bj * HALF;
                    const u32x4 g = *(const u32x4*)(G + r * 3072 + gi * 1024 + c);
                    const f32x4 v0 = acc[ai][bj][m][0], v1 = acc[ai][bj][m][1];
                    float o0 = bflo(g.x) * v0[0], o1 = bfhi(g.x) * v0[1], o2 = bflo(g.y) * v0[2], o3 = bfhi(g.y) * v0[3];
                    float o4 = bflo(g.z) * v1[0], o5 = bfhi(g.z) * v1[1], o6 = bflo(g.w) * v1[2], o7 = bfhi(g.w) * v1[3];
                    bf16_t* op = O + r * 1024 + c;
                    if (gi > 0) {
                        const unsigned long long p0 = __hip_atomic_load((const unsigned long long*)op, __ATOMIC_RELAXED, __HIP_MEMORY_SCOPE_AGENT);
                        const unsigned long long p1 = __hip_atomic_load((const unsigned long long*)op + 1, __ATOMIC_RELAXED, __HIP_MEMORY_SCOPE_AGENT);
                        const unsigned a0 = (unsigned)p0, a1 = (unsigned)(p0 >> 32), a2 = (unsigned)p1, a3 = (unsigned)(p1 >> 32);
                        o0 += bflo(a0); o1 += bfhi(a0); o2 += bflo(a1); o3 += bfhi(a1); o4 += bflo(a2); o5 += bfhi(a2); o6 += bflo(a3); o7 += bfhi(a3);
                    }
                    u32x4 w; w.x = pk2(o0, o1); w.y = pk2(o2, o3); w.z = pk2(o4, o5); w.w = pk2(o6, o7);
                    *(u32x4*)op = w; } }
    }
};

template <class Epi, class Sched, bool ALIGN_EPI = false, bool SP2 = false>
__device__ __forceinline__ void gemm_phase(PG8_LAS unsigned char* lds, const Gemm g, const Sched& S, const Epi& E) {
    int tid_ = threadIdx.x; asm volatile("" : "+v"(tid_));
    const int tid = tid_, wid = __builtin_amdgcn_readfirstlane(tid >> 6), lane = tid & 63, wr = wid >> 2, wc = wid & 3, fr = lane & 15, fq = lane >> 4;
    const int K = g.K, nt = K / BK;
    unsigned voffA[2], voffB[2];
#pragma unroll
    for (int i = 0; i < 2; ++i) { int R, C; stage_rc(tid * 16 + i * 8192, R, C); const int Rb = Epi::PERM ? ((R & ~31) + perm32(R & 31)) : R;
        voffA[i] = (unsigned)(R * K + C) * 2u; voffB[i] = (unsigned)(Rb * K + C) * 2u; }
    const size_t kstep = (size_t)(BK * 2);
    const size_t hstep = (size_t)HALF * K * 2;
    const size_t tstep = 2 * hstep;
    const unsigned ldsw = (unsigned)wid * 1024u;
    const int aoff = lds_byte(wr * 64 + fr, fq * 8), boff = lds_byte(wc * 32 + fr, fq * 8);
#define PG8_SA(b, h) (((b) * 2 + (h)) * HTB)
#define PG8_SB(b, h) ((4 + (b) * 2 + (h)) * HTB)
#define PG8_STAGE(bufoff, gbase, voff) do { _Pragma("unroll") for (int _i = 0; _i < 2; ++_i) \
        __builtin_amdgcn_global_load_lds((const unsigned*)((const char*)(gbase) + (voff)[_i]), (PG8_LAS unsigned*)(lds + (bufoff) + ldsw + _i * 8192), 16, 0, 0); } while (0)
#define PG8_LDA(dst, b, h) do { _Pragma("unroll") for (int m = 0; m < 4; ++m) _Pragma("unroll") for (int k = 0; k < 2; ++k) dst[m][k] = *(const PG8_LAS bf16x8*)(lds + PG8_SA(b, h) + aoff + m * 2048 + k * 1024); } while (0)
#define PG8_LDB(dst, b, h) do { _Pragma("unroll") for (int n = 0; n < 2; ++n) _Pragma("unroll") for (int k = 0; k < 2; ++k) dst[n][k] = *(const PG8_LAS bf16x8*)(lds + PG8_SB(b, h) + boff + n * 2048 + k * 1024); } while (0)
#define PG8_MMA(ai, bj, At, Bt) do { __builtin_amdgcn_s_setprio(1); _Pragma("unroll") for (int m = 0; m < 4; ++m) _Pragma("unroll") for (int n = 0; n < 2; ++n) _Pragma("unroll") for (int k = 0; k < 2; ++k) \
        acc[ai][bj][m][n] = __builtin_amdgcn_mfma_f32_16x16x32_bf16(Bt[n][k], At[m][k], acc[ai][bj][m][n], 0, 0, 0); __builtin_amdgcn_s_setprio(0); } while (0)
#define PG8_WAIT_V(n) asm volatile("s_waitcnt vmcnt(" #n ")" ::: "memory")
#define PG8_WAIT_L(n) asm volatile("s_waitcnt lgkmcnt(" #n ")" ::: "memory")
#define PG8_BAR __builtin_amdgcn_s_barrier()
#define PG8_SCHED __builtin_amdgcn_sched_barrier(0)
    Unit cur, nxt; int ui = 0;
    if (!S.next(0, cur)) return;
    f32x4 acc[2][2][4][2];
#pragma unroll
    for (int a = 0; a < 2; ++a)
#pragma unroll
        for (int b = 0; b < 2; ++b)
#pragma unroll
            for (int m = 0; m < 4; ++m)
#pragma unroll
                for (int n = 0; n < 2; ++n) acc[a][b][m][n] = (f32x4){0.f, 0.f, 0.f, 0.f};
    bf16x8 At[4][2], B0[2][2], B1[2][2];
    const char* cA = (const char*)g.A + (size_t)cur.pm * tstep; const char* cB = (const char*)g.Bt + (size_t)cur.pn * tstep;
    S.a_ready(cur);
    if constexpr (SP2) {
        PG8_STAGE(PG8_SB(0, 0), cB, voffB); PG8_STAGE(PG8_SB(0, 1), cB + hstep, voffB); PG8_STAGE(PG8_SA(0, 0), cA, voffA); PG8_STAGE(PG8_SA(0, 1), cA + hstep, voffA);
        if (wr == 1) PG8_BAR;
        PG8_WAIT_V(2); PG8_BAR;
        PG8_STAGE(PG8_SB(1, 0), cB + kstep, voffB); PG8_STAGE(PG8_SA(1, 0), cA + kstep, voffA); PG8_STAGE(PG8_SB(1, 1), cB + hstep + kstep, voffB);
        PG8_WAIT_V(6); PG8_BAR;
    } else {
        PG8_STAGE(PG8_SB(0, 0), cB, voffB); PG8_STAGE(PG8_SA(0, 0), cA, voffA); PG8_STAGE(PG8_SB(0, 1), cB + hstep, voffB); PG8_STAGE(PG8_SA(0, 1), cA + hstep, voffA);
        if (wr == 1) PG8_BAR;
        PG8_WAIT_V(4); PG8_BAR;
        PG8_STAGE(PG8_SB(1, 0), cB + kstep, voffB); PG8_STAGE(PG8_SA(1, 0), cA + kstep, voffA); PG8_STAGE(PG8_SB(1, 1), cB + hstep + kstep, voffB);
        PG8_WAIT_V(6); PG8_BAR;
    }
    for (;;) {
        const bool has_next = S.next(ui + 1, nxt);
        const char* nA = has_next ? (const char*)g.A + (size_t)nxt.pm * tstep : cA; const char* nB = has_next ? (const char*)g.Bt + (size_t)nxt.pn * tstep : cB;
        for (int t = 0; t < nt; t += 2) {
            const bool last = (t == nt - 2);
            const char* a1 = cA + (size_t)(t + 1) * kstep;
            const char* a2 = last ? nA : cA + (size_t)(t + 2) * kstep; const char* b2 = last ? nB : cB + (size_t)(t + 2) * kstep;
            const char* a3 = a2 + kstep; const char* b3 = b2 + kstep;
            if (last && has_next) S.a_ready(nxt);
            if constexpr (SP2) {
            PG8_LDB(B0, 0, 0); PG8_LDB(B1, 0, 1); PG8_SCHED; PG8_LDA(At, 0, 0); PG8_STAGE(PG8_SA(1, 1), a1 + hstep, voffA);
            PG8_WAIT_V(8); PG8_WAIT_L(0); PG8_BAR; PG8_MMA(0, 0, At, B0); PG8_MMA(0, 1, At, B1); PG8_BAR; PG8_SCHED;
            PG8_LDA(At, 0, 1); PG8_STAGE(PG8_SB(0, 0), b2, voffB); PG8_STAGE(PG8_SB(0, 1), b2 + hstep, voffB); PG8_STAGE(PG8_SA(0, 0), a2, voffA);
            PG8_WAIT_V(8); PG8_WAIT_L(0); PG8_BAR; PG8_MMA(1, 0, At, B0); PG8_MMA(1, 1, At, B1); PG8_BAR; PG8_SCHED;
            PG8_LDB(B0, 1, 0); PG8_LDB(B1, 1, 1); PG8_SCHED; PG8_LDA(At, 1, 0); PG8_STAGE(PG8_SA(0, 1), a2 + hstep, voffA);
            PG8_WAIT_V(8); PG8_WAIT_L(0); PG8_BAR; PG8_MMA(0, 0, At, B0); PG8_MMA(0, 1, At, B1); PG8_BAR; PG8_SCHED;
            PG8_LDA(At, 1, 1); PG8_STAGE(PG8_SB(1, 0), b3, voffB); PG8_STAGE(PG8_SB(1, 1), b3 + hstep, voffB); PG8_STAGE(PG8_SA(1, 0), a3, voffA);
            PG8_WAIT_V(8); PG8_WAIT_L(0); PG8_BAR; PG8_MMA(1, 0, At, B0); PG8_MMA(1, 1, At, B1); PG8_BAR; PG8_SCHED;
            } else {
            PG8_LDB(B0, 0, 0); PG8_SCHED; PG8_LDA(At, 0, 0); PG8_STAGE(PG8_SA(1, 1), a1 + hstep, voffA);
            PG8_WAIT_L(8); PG8_BAR; PG8_WAIT_L(0); PG8_MMA(0, 0, At, B0); PG8_BAR; PG8_SCHED;
            PG8_LDB(B1, 0, 1); PG8_STAGE(PG8_SB(0, 0), b2, voffB);
            PG8_BAR; PG8_WAIT_L(0); PG8_MMA(0, 1, At, B1); PG8_BAR;
            PG8_LDA(At, 0, 1); PG8_STAGE(PG8_SA(0, 0), a2, voffA);
            PG8_BAR; PG8_WAIT_L(0); PG8_MMA(1, 0, At, B0); PG8_BAR; PG8_SCHED;
            PG8_STAGE(PG8_SB(0, 1), b2 + hstep, voffB);
            PG8_WAIT_V(6); PG8_BAR; PG8_MMA(1, 1, At, B1); PG8_BAR;
            PG8_LDB(B0, 1, 0); PG8_SCHED; PG8_LDA(At, 1, 0); PG8_STAGE(PG8_SA(0, 1), a2 + hstep, voffA);
            PG8_WAIT_L(8); PG8_BAR; PG8_WAIT_L(0); PG8_MMA(0, 0, At, B0); PG8_BAR; PG8_SCHED;
            PG8_LDB(B1, 1, 1); PG8_STAGE(PG8_SB(1, 0), b3, voffB);
            PG8_BAR; PG8_WAIT_L(0); PG8_MMA(0, 1, At, B1); PG8_BAR;
            PG8_LDA(At, 1, 1); PG8_STAGE(PG8_SA(1, 0), a3, voffA);
            PG8_BAR; PG8_WAIT_L(0); PG8_MMA(1, 0, At, B0); PG8_BAR; PG8_SCHED;
            PG8_STAGE(PG8_SB(1, 1), b3 + hstep, voffB);
            PG8_WAIT_V(6); PG8_BAR; PG8_MMA(1, 1, At, B1); PG8_BAR;
            }
        }
        if constexpr (ALIGN_EPI) { if (wr == 0) PG8_BAR; }
        if constexpr (!Epi::AFTER_DRAIN) { E(acc, cur, wr, wc, fr, fq); S.done(cur); }
        if (!has_next) break;
#pragma unroll
        for (int a = 0; a < 2; ++a)
#pragma unroll
            for (int b = 0; b < 2; ++b)
#pragma unroll
                for (int m = 0; m < 4; ++m)
#pragma unroll
                    for (int n = 0; n < 2; ++n) acc[a][b][m][n] = (f32x4){0.f, 0.f, 0.f, 0.f};
        cur = nxt; cA = nA; cB = nB; ++ui;
        if constexpr (ALIGN_EPI) { if (wr == 1) PG8_BAR; }
    }
    PG8_WAIT_V(0);
    if constexpr (!ALIGN_EPI) { if (wr == 0) PG8_BAR; }
    PG8_BAR;
    if constexpr (Epi::AFTER_DRAIN) { E.fused(acc, cur, wr, wc, fr, fq, lds, wid, lane); S.done(cur); }
#undef PG8_SA
#undef PG8_SB
#undef PG8_STAGE
#undef PG8_LDA
#undef PG8_LDB
#undef PG8_MMA
#undef PG8_WAIT_V
#undef PG8_WAIT_L
#undef PG8_BAR
#undef PG8_SCHED
}
}

struct Params { const float* in[22]; float* out; unsigned char* ws; };
typedef const __attribute__((address_space(4))) Params* KP;
DI KP kparams() { KP kp = (KP)__builtin_amdgcn_kernarg_segment_ptr(); asm volatile("" : "+s"(kp)); return kp; }
enum { I_X = 0, I_C, I_CTX, I_CCTX, I_WADA, I_BADA, I_NPRE, I_NPOST, I_W1, I_W3, I_W2, I_WIN, I_SINK, I_MLCONV, I_MLFB, I_MLNORM, I_HGLB, I_HGNORM, I_WBA, I_WBM, I_WBH, I_WOUT };

DI void transpose_item(const float* Wa, const float* Wb, int ldw, int K, bf16_t* dst, int k0, LAS float* scr, int lane) {
    const float* src = (((lane & 31) < 16) ? Wa : Wb) + (lane & 15);
#pragma unroll 8
    for (int i = 0; i < 32; ++i) { const int kk = 2 * i + (lane >> 5); scr[kk * 33 + (lane & 31)] = src[(size_t)(k0 + kk) * ldw]; }
    asm volatile("s_waitcnt lgkmcnt(0)" ::: "memory");
    const int c = lane & 7;
#pragma unroll
    for (int j = 0; j < 4; ++j) { const int n = (lane >> 3) + 8 * j; const LAS float* s = scr + (8 * c) * 33 + n;
        u32x4 o; o.x = pk2(s[0 * 33], s[1 * 33]); o.y = pk2(s[2 * 33], s[3 * 33]); o.z = pk2(s[4 * 33], s[5 * 33]); o.w = pk2(s[6 * 33], s[7 * 33]);
        *(u32x4*)(dst + (size_t)n * K + k0 + 8 * c) = o; }
    asm volatile("s_waitcnt lgkmcnt(0)" ::: "memory");
}
struct Seg { const float* Wa; const float* Wb; int ldw, K, ngroups, colA0, colB0, cstep; bf16_t* dst; };
DI bool seg_run(const Seg& s, int& it, LAS float* scr, int lane) {
    const int nk = s.K / 64, n = s.ngroups * nk;
    if (it >= n) { it -= n; return false; }
    const int gi = it / nk, kb = it % nk;
    transpose_item(s.Wa + s.colA0 + gi * s.cstep, s.Wb + s.colB0 + gi * s.cstep, s.ldw, s.K, s.dst + (size_t)gi * 32 * s.K, kb * 64, scr, lane);
    return true;
}
DI void convert_weights(KP p, int l, LAS unsigned char* lds) {
    int tid_ = threadIdx.x; asm volatile("" : "+v"(tid_));
    const int wave = tid_ >> 6, lane = tid_ & 63;
    LAS float* scr = (LAS float*)(lds + wave * 8704);
    bf16_t* W = (bf16_t*)(p->ws + WS_W);
    const int gw = blockIdx.x * 8 + wave, NGW = gridDim.x * 8;
    constexpr int NITEMS = 2 * 176 * 16 + 2 * 32 * 44 + 128 * 16 + 96 * 16 + 3 * 32 * 8 + 32 * 16;
    for (int item = gw; item < NITEMS; item += NGW) {
        int it = item;
        bool done = false;
#pragma unroll
        for (int f = 0; f < 2 && !done; ++f) {
            const float* w1 = p->in[I_W1] + (size_t)(l * 2 + f) * DM * DFF; const float* w3 = p->in[I_W3] + (size_t)(l * 2 + f) * DM * DFF;
            Seg s{w1, w3, DFF, DM, 176, 0, 0, 16, W + WO_W13 + (size_t)f * 5632 * 1024};
            done = seg_run(s, it, scr, lane);
        }
#pragma unroll
        for (int f = 0; f < 2 && !done; ++f) {
            const float* w2 = p->in[I_W2] + (size_t)(l * 2 + f) * DFF * DM;
            Seg s{w2, w2, DM, DFF, 32, 0, 16, 32, W + WO_W2 + (size_t)f * 1024 * 2816};
            done = seg_run(s, it, scr, lane);
        }
        const float* win = p->in[I_WIN] + (size_t)l * DM * DIN;
        if (!done) { Seg s{win, win, DIN, DM, 72, 0, 16, 32, W + WO_WIN}; done = seg_run(s, it, scr, lane); }
        if (!done) { Seg s{win, win, DIN, DM, 56, 2320, 2336, 32, W + WO_WIN + (size_t)2304 * 1024}; done = seg_run(s, it, scr, lane); }
        if (!done) { Seg s{win, win, DIN, DM, 96, 4112, 4128, 32, W + WO_WG}; done = seg_run(s, it, scr, lane); }
#pragma unroll
        for (int f = 0; f < 3 && !done; ++f) {
            const float* wb = p->in[I_WBA + f] + (size_t)l * 512 * DM;
            Seg s{wb, wb, DM, 512, 32, 0, 16, 32, W + WO_WB + (size_t)f * 1024 * 512};
            done = seg_run(s, it, scr, lane);
        }
        if (!done) { const float* wo = p->in[I_WOUT] + (size_t)l * DM * DM; Seg s{wo, wo, DM, DM, 32, 0, 16, 32, W + WO_WOUT}; done = seg_run(s, it, scr, lane); }
    }
}

DI void mods_phase(KP p, LAS unsigned char* lds, int tid) {
    asm volatile("" : "+v"(tid));
    const int wave = tid >> 6, lane = tid & 63;
    LAS float* sc = (LAS float*)lds;
    LAS float* red = (LAS float*)(lds + 36864);
    for (int i = tid; i < 9 * 1024; i += 512) { const float v = (i < 8192) ? p->in[I_C][i] : p->in[I_CCTX][i - 8192]; sc[i] = v / (1.0f + expf(-v)); }
    __syncthreads();
    float* mod = (float*)(p->ws + WS_MOD);
    for (int it = blockIdx.x; it < 288; it += gridDim.x) {
        const int l = it / 144, cb = it % 144, col = cb * 64 + lane;
        const float* wp = p->in[I_WADA] + ((size_t)l * 1024 + wave * 128) * 9216 + col;
        float acc[9];
#pragma unroll
        for (int i = 0; i < 9; ++i) acc[i] = 0.f;
#pragma unroll 8
        for (int k = 0; k < 128; ++k) { const float wv = wp[(size_t)k * 9216];
#pragma unroll
            for (int i = 0; i < 9; ++i) acc[i] += sc[i * 1024 + wave * 128 + k] * wv; }
#pragma unroll
        for (int i = 0; i < 9; ++i) red[(wave * 9 + i) * 64 + lane] = acc[i];
        __syncthreads();
        for (int o = tid; o < 576; o += 512) { const int i = o >> 6, ln = o & 63; float s = 0.f;
#pragma unroll
            for (int w = 0; w < 8; ++w) s += red[(w * 9 + i) * 64 + ln];
            mod[((size_t)l * 9 + i) * 9216 + cb * 64 + ln] = s + p->in[I_BADA][(size_t)l * 9216 + cb * 64 + ln]; }
        __syncthreads();
    }
    if (blockIdx.x == gridDim.x - 1) {
        f32x2* tab = (f32x2*)(p->ws + WS_ROPE);
        for (int e = tid; e < 1024; e += 512) { const int pos = e >> 4, i = e & 15;
            const float inv = exp2f(-(float)i * (13.287712379549449f / 16.0f));
            const float a = (float)pos * inv; float rev = a * 0.15915494309189535f; rev -= floorf(rev);
            f32x2 cs; cs.x = __builtin_amdgcn_cosf(rev); cs.y = __builtin_amdgcn_sinf(rev); tab[e] = cs; }
    }
}

struct RowArgs {
    const float* xs_lat; const float* xs_ctx; float* xd_lat; float* xd_ctx;
    const bf16_t* Y; bf16_t* H; const float* mod; const float* modpre; const float* gpost; const float* gpre; const float* wgates; float* gates;
    int jpost, jpre, nrows; float wpost;
};
template <bool POST, bool PRE, bool GATES>
DI void row_phase(const RowArgs& a, LAS unsigned char* lds, int tid) {
    asm volatile("" : "+v"(tid));
    const int wave = tid >> 6, lane = tid & 63;
    LAS f32x4* wl = (LAS f32x4*)lds;
    if (GATES) {
        for (int idx = tid; idx < 1024 * 4; idx += 512) { const int k = idx >> 2, c4 = idx & 3; const int ln = (k & 255) >> 2, j = k >> 8, e = k & 3;
            wl[((j * 4 + e) * 4 + c4) * 64 + ln] = *(const f32x4*)(a.wgates + (size_t)k * DIN + 4 * c4); }
        __syncthreads();
    }
    for (int row = blockIdx.x * 8 + wave; row < a.nrows; row += gridDim.x * 8) {
        const int mi = row < MLAT ? (row >> 12) : 8;
        const float* md = a.mod + (size_t)mi * 9216;
        const float* mdp = a.modpre + (size_t)mi * 9216;
        const float* src = row < MLAT ? a.xs_lat + (size_t)row * DM : a.xs_ctx + (size_t)(row - MLAT) * DM;
        f32x4 x[4];
#pragma unroll
        for (int j = 0; j < 4; ++j) x[j] = *(const f32x4*)(src + 4 * lane + 256 * j);
        if (POST) {
            f32x4 y[4]; float s = 0.f;
#pragma unroll
            for (int j = 0; j < 4; ++j) { const u32x2 w = *(const u32x2*)(a.Y + (size_t)row * DM + 4 * lane + 256 * j);
                y[j] = (f32x4){bflo(w.x), bfhi(w.x), bflo(w.y), bfhi(w.y)}; s += (y[j][0] * y[j][0] + y[j][1] * y[j][1]) + (y[j][2] * y[j][2] + y[j][3] * y[j][3]); }
            const float rstd = 1.0f / sqrtf(wave_sum(s) * (1.0f / DM) + EPS);
            float* dst = row < MLAT ? a.xd_lat + (size_t)row * DM : a.xd_ctx + (size_t)(row - MLAT) * DM;
#pragma unroll
            for (int j = 0; j < 4; ++j) { const int c = 4 * lane + 256 * j;
                const f32x4 gt = *(const f32x4*)(md + (3 * a.jpost + 2) * DM + c), gp = *(const f32x4*)(a.gpost + c);
                x[j] = x[j] + a.wpost * gt * (y[j] * rstd * gp);
                *(f32x4*)(dst + c) = x[j]; }
        }
        if (PRE) {
            float s = 0.f;
#pragma unroll
            for (int j = 0; j < 4; ++j) s += (x[j][0] * x[j][0] + x[j][1] * x[j][1]) + (x[j][2] * x[j][2] + x[j][3] * x[j][3]);
            const float rstd = 1.0f / sqrtf(wave_sum(s) * (1.0f / DM) + EPS);
            f32x4 hv[4]; f32x4 g4[4];
#pragma unroll
            for (int c4 = 0; c4 < 4; ++c4) g4[c4] = (f32x4){0.f, 0.f, 0.f, 0.f};
#pragma unroll
            for (int j = 0; j < 4; ++j) { const int c = 4 * lane + 256 * j;
                const f32x4 sh = *(const f32x4*)(mdp + (3 * a.jpre) * DM + c), scl = *(const f32x4*)(mdp + (3 * a.jpre + 1) * DM + c), g = *(const f32x4*)(a.gpre + c);
                hv[j] = (x[j] * rstd * g) * (1.0f + scl) + sh;
                u32x2 w; w.x = pk2(hv[j][0], hv[j][1]); w.y = pk2(hv[j][2], hv[j][3]);
                *(u32x2*)(a.H + (size_t)row * DM + c) = w;
                if (GATES) {
#pragma unroll
                    for (int e = 0; e < 4; ++e)
#pragma unroll
                        for (int c4 = 0; c4 < 4; ++c4) g4[c4] += hv[j][e] * wl[((j * 4 + e) * 4 + c4) * 64 + lane];
                    asm volatile("" ::: "memory");
                } }
            if (GATES) {
#pragma unroll
                for (int c4 = 0; c4 < 4; ++c4)
#pragma unroll
                    for (int k = 0; k < 4; ++k) g4[c4][k] = wave_sum(g4[c4][k]);
                if (lane == 0) {
#pragma unroll
                    for (int c4 = 0; c4 < 4; ++c4) *(f32x4*)(a.gates + (size_t)row * 16 + 4 * c4) = g4[c4]; }
            }
        }
    }
    if (GATES) __syncthreads();
}

constexpr int RS = 144;
constexpr int AT_K = 0, AT_V = 9216, AT_TAB = 18432;
struct AttnArgs { const bf16_t* P; bf16_t* ATT; const float* sink; const f32x2* rope; };

DI void attn_item(const AttnArgs& A, int item, LAS unsigned char* lds, int tid) {
    asm volatile("" : "+v"(tid));
    const int w = tid >> 6, lane = tid & 63, r = lane & 31, hh = lane >> 5;
    const LAS f32x2* tab = (const LAS f32x2*)(lds + AT_TAB);
    int b, g, qb = 0, qrow0; bool lat;
    if (item < 512) { b = item >> 6; g = (item >> 5) & 1; qb = item & 31; lat = true; qrow0 = b * SEQ + qb * 128; }
    else { const int it = item - 512; b = it >> 2; g = (it >> 1) & 1; lat = false; qrow0 = MLAT + b * CTXL + (it & 1) * 128; }
    const int head = g * 4 + (w >> 1), qoff = (w & 1) * 64;
    bf16x8 qf[2][4];
#pragma unroll
    for (int qt = 0; qt < 2; ++qt) {
        const int ql = qoff + 32 * qt + r;
        const bf16_t* qp = A.P + (size_t)(qrow0 + ql) * NPC + PC_AQ + head * 64 + 8 * hh;
        float x[4][8];
#pragma unroll
        for (int ks = 0; ks < 4; ++ks) { const u32x4 raw = *(const u32x4*)(qp + 16 * ks);
            x[ks][0] = bflo(raw.x); x[ks][1] = bfhi(raw.x); x[ks][2] = bflo(raw.y); x[ks][3] = bfhi(raw.y); x[ks][4] = bflo(raw.z); x[ks][5] = bfhi(raw.z); x[ks][6] = bflo(raw.w); x[ks][7] = bfhi(raw.w); }
        if (lat) {
            const int t = qb * 128 + ql;
#pragma unroll
            for (int pr = 0; pr < 2; ++pr) { const int pos = pr ? (t & 63) : (t >> 6);
#pragma unroll
                for (int j = 0; j < 8; ++j) { const f32x2 cs = tab[pos * 16 + 8 * hh + j]; const float x1 = x[2 * pr][j], x2 = x[2 * pr + 1][j];
                    x[2 * pr][j] = x1 * cs.x - x2 * cs.y; x[2 * pr + 1][j] = x2 * cs.x + x1 * cs.y; } }
        }
#pragma unroll
        for (int ks = 0; ks < 4; ++ks) qf[qt][ks] = pack8(x[ks][0] * 0.125f, x[ks][1] * 0.125f, x[ks][2] * 0.125f, x[ks][3] * 0.125f, x[ks][4] * 0.125f, x[ks][5] * 0.125f, x[ks][6] * 0.125f, x[ks][7] * 0.125f);
    }
    f32x16 O[2][2];
#pragma unroll
    for (int qt = 0; qt < 2; ++qt)
#pragma unroll
        for (int dt = 0; dt < 2; ++dt)
#pragma unroll
            for (int i = 0; i < 16; ++i) O[qt][dt][i] = 0.f;
    const float sk = A.sink[head];
    float m_run[2] = {sk, sk}, l_run[2];
    l_run[0] = l_run[1] = (hh == 0) ? 1.0f : 0.0f;
    const int ti_hi = (lat && qb == 31) ? 4 : 6;
    int ti = lat ? (qb == 0 ? 2 : 0) : 6;
    const int ss = tid >> 3, sc8 = tid & 7, half = sc8 >> 2, i0 = (sc8 & 3) * 4;
    u32x2 k1, k2; u32x4 vr;
#define ATT_LOAD(tix) do { const int krow_ = ((tix) < 6 ? b * SEQ + 128 * (qb - 1) + 64 * (tix) : MLAT + b * CTXL + 64 * ((tix) - 6)) + ss; \
        const bf16_t* kp_ = A.P + (size_t)krow_ * NPC; \
        k1 = *(const u32x2*)(kp_ + PC_AK + g * 64 + 32 * half + i0); k2 = *(const u32x2*)(kp_ + PC_AK + g * 64 + 32 * half + 16 + i0); \
        vr = *(const u32x4*)(kp_ + PC_AV + g * 64 + 8 * sc8); } while (0)
    ATT_LOAD(ti);
    for (;;) {
        {
            float a[4] = {bflo(k1.x), bfhi(k1.x), bflo(k1.y), bfhi(k1.y)}, c[4] = {bflo(k2.x), bfhi(k2.x), bflo(k2.y), bfhi(k2.y)};
            if (ti < 6) { const int kpos = 128 * (qb - 1) + 64 * ti + ss; const int pos = half ? (kpos & 63) : (kpos >> 6);
#pragma unroll
                for (int e = 0; e < 4; ++e) { const f32x2 cs = tab[pos * 16 + i0 + e]; const float x1 = a[e], x2 = c[e]; a[e] = x1 * cs.x - x2 * cs.y; c[e] = x2 * cs.x + x1 * cs.y; } }
            u32x2 o1, o2; o1.x = pk2(a[0], a[1]); o1.y = pk2(a[2], a[3]); o2.x = pk2(c[0], c[1]); o2.y = pk2(c[2], c[3]);
            *(LAS u32x2*)(lds + AT_K + ss * RS + (32 * half + i0) * 2) = o1;
            *(LAS u32x2*)(lds + AT_K + ss * RS + (32 * half + 16 + i0) * 2) = o2;
            const unsigned vv[4] = {vr.x, vr.y, vr.z, vr.w};
#pragma unroll
            for (int e = 0; e < 4; ++e) { *(LAS unsigned short*)(lds + AT_V + (8 * sc8 + 2 * e) * RS + ss * 2) = (unsigned short)(vv[e] & 0xffffu);
                *(LAS unsigned short*)(lds + AT_V + (8 * sc8 + 2 * e + 1) * RS + ss * 2) = (unsigned short)(vv[e] >> 16); }
        }
        __syncthreads();
        const int tn = (ti < 6 && ti + 1 == ti_hi) ? 6 : ti + 1;
        if (tn < 10) ATT_LOAD(tn);
        f32x16 S[2][2];
#pragma unroll
        for (int st = 0; st < 2; ++st) {
            bf16x8 kf[4];
#pragma unroll
            for (int ks = 0; ks < 4; ++ks) kf[ks] = *(const LAS bf16x8*)(lds + AT_K + (32 * st + r) * RS + (16 * ks + 8 * hh) * 2);
#pragma unroll
            for (int qt = 0; qt < 2; ++qt) { f32x16 acc;
#pragma unroll
                for (int i = 0; i < 16; ++i) acc[i] = 0.f;
#pragma unroll
                for (int ks = 0; ks < 4; ++ks) acc = MFMA32(kf[ks], qf[qt][ks], acc);
                S[qt][st] = acc; }
        }
        if (ti < 2 || (ti >= 4 && ti < 6)) {
            const int kp0 = 128 * (qb - 1) + 64 * ti;
#pragma unroll
            for (int qt = 0; qt < 2; ++qt) { const int qpos = qb * 128 + qoff + 32 * qt + r;
#pragma unroll
                for (int st = 0; st < 2; ++st)
#pragma unroll
                    for (int i = 0; i < 16; ++i) { const int df = qpos - (kp0 + 32 * st + crow(i, hh)); if (df > 128 || df < -128) S[qt][st][i] = -INFINITY; } }
        }
#pragma unroll
        for (int qt = 0; qt < 2; ++qt) {
            float mx = S[qt][0][0];
#pragma unroll
            for (int st = 0; st < 2; ++st)
#pragma unroll
                for (int i = 0; i < 16; ++i) mx = fmaxf(mx, S[qt][st][i]);
            mx = fmaxf(mx, __shfl_xor(mx, 32));
            const float mn = fmaxf(m_run[qt], mx), scale = __expf(m_run[qt] - mn);
            m_run[qt] = mn; float ls = 0.f;
#pragma unroll
            for (int st = 0; st < 2; ++st)
#pragma unroll
                for (int i = 0; i < 16; ++i) { const float pv = __expf(S[qt][st][i] - mn); S[qt][st][i] = pv; ls += pv; }
            l_run[qt] = l_run[qt] * scale + ls;
#pragma unroll
            for (int dt = 0; dt < 2; ++dt)
#pragma unroll
                for (int i = 0; i < 16; ++i) O[qt][dt][i] *= scale;
        }
#pragma unroll
        for (int kk = 0; kk < 4; ++kk) { const int st = kk >> 1, s2 = kk & 1;
            bf16x8 pb[2];
#pragma unroll
            for (int qt = 0; qt < 2; ++qt) pb[qt] = pack8(S[qt][st][8 * s2 + 0], S[qt][st][8 * s2 + 1], S[qt][st][8 * s2 + 2], S[qt][st][8 * s2 + 3], S[qt][st][8 * s2 + 4], S[qt][st][8 * s2 + 5], S[qt][st][8 * s2 + 6], S[qt][st][8 * s2 + 7]);
#pragma unroll
            for (int dt = 0; dt < 2; ++dt) {
                const LAS unsigned char* vp = lds + AT_V + (32 * dt + r) * RS + (32 * st + 16 * s2 + 4 * hh) * 2;
                const s16x4 lo = *(const LAS s16x4*)vp, hi = *(const LAS s16x4*)(vp + 16);
                const bf16x8 va = __builtin_shufflevector(lo, hi, 0, 1, 2, 3, 4, 5, 6, 7);
#pragma unroll
                for (int qt = 0; qt < 2; ++qt) O[qt][dt] = MFMA32(va, pb[qt], O[qt][dt]);
            }
        }
        __syncthreads();
        if (tn >= 10) break;
        ti = tn;
    }
#undef ATT_LOAD
#pragma unroll
    for (int qt = 0; qt < 2; ++qt) {
        const float l = l_run[qt] + __shfl_xor(l_run[qt], 32), inv = 1.0f / l;
        bf16_t* op = A.ATT + (size_t)(qrow0 + qoff + 32 * qt + r) * 512 + head * 64;
#pragma unroll
        for (int dt = 0; dt < 2; ++dt)
#pragma unroll
            for (int ig = 0; ig < 4; ++ig) { u32x2 wv; wv.x = pk2(O[qt][dt][4 * ig] * inv, O[qt][dt][4 * ig + 1] * inv); wv.y = pk2(O[qt][dt][4 * ig + 2] * inv, O[qt][dt][4 * ig + 3] * inv);
                *(u32x2*)(op + 32 * dt + 8 * ig + 4 * hh) = wv; }
    }
}

constexpr int SC_QS = 0, SC_KS = 9216, SC_QE = 18432, SC_UKT = 27648, SC_VT = 36864, SC_CBT = 55296, SC_F = 73728;
constexpr int SF_BETA = 0, SF_TOT = 256, SF_SSQ = 2304, SF_N = 3328, SF_DEC = 3840, SF_CONV = 4096, SF_CACHE = 5632;
struct ScanArgs { const bf16_t* P; bf16_t* OUT; const float* gates; const float* convw; const float* fbias; const float* gnorm; const float* lbl; int layer; };

template <bool IS_ML>
DI void scan_item(const ScanArgs& A, int b, int hd, const int dir, unsigned* prog_mine, unsigned* prog_other, LAS unsigned char* lds, int tid) {
    asm volatile("" : "+v"(tid));
    const int w = tid >> 6, lane = tid & 63, r = lane & 31, hh = lane >> 5;
    const int etile = w & 3, ttile = w >> 2, dtile = w >> 2;
    const int p = tid >> 3, dg = tid & 7;
    LAS float* F = (LAS float*)(lds + SC_F);
    LAS float* beta_s = F + SF_BETA / 4; LAS float* tot_s = F + SF_TOT / 4; LAS float* ssq_s = F + SF_SSQ / 4; LAS float* n_s = F + SF_N / 4; LAS float* dec_s = F + SF_DEC / 4; LAS float* conv_s = F + SF_CONV / 4;
    const int vcol = (IS_ML ? PC_MV : PC_HI) + hd * 128, gcol = (IS_ML ? PC_MO : PC_HG) + hd * 128;
    float lbv[8];
    if (IS_ML) {
        if (tid < 384) { const int j = tid >> 6, d = tid & 63; conv_s[tid] = A.convw[(j % 3) * 512 + (j / 3) * 256 + hd * 64 + d]; }
    } else {
#pragma unroll
        for (int e = 0; e < 8; ++e) { const int c = hd * 64 + 8 * dg + e; lbv[e] = (A.layer == 0) ? 0.f : 1.0f / (1.0f + expf(A.lbl[c] - A.lbl[256 + c])); }
    }
    {
        LAS unsigned* cache_s = (LAS unsigned*)(F + SF_CACHE / 4);
        if (tid == 0) cache_s[0] = 0u;
        f32x16 Cst;
#pragma unroll
        for (int i = 0; i < 16; ++i) Cst[i] = 0.f;
        float m_run = 0.f;
        __syncthreads();
        if (tid < 128) n_s[tid] = 0.f;
#pragma unroll
        for (int ig = 0; ig < 4; ++ig) *(LAS u32x2*)(lds + SC_CBT + (32 * etile + r) * RS + (32 * dtile + 8 * ig + 4 * hh) * 2) = (u32x2){0u, 0u};
        const float fb = IS_ML ? A.fbias[dir * 4 + hd] : 0.f;
        u32x4 rq[3], rk[3], rv[2]; float rgi = 0.f, rgf = 0.f;
#define SC_ROWS(c_) const int cc_ = (c_) < 4 ? (dir ? 3 - (c_) : (c_)) : (dir ? 67 - (c_) : (c_) - 4); \
        const int slo_ = (c_) < 4 ? MLAT + b * CTXL : b * SEQ, slen_ = (c_) < 4 ? CTXL : SEQ; const int rb_ = slo_ + 64 * cc_;
#define SC_LOAD(c_) do { SC_ROWS(c_) const int ti_ = 64 * cc_ + (dir ? 63 - p : p); const bf16_t* pr_ = A.P + (size_t)(slo_ + ti_) * NPC; \
        if (IS_ML) { const u32x4 z4_ = (u32x4){0u, 0u, 0u, 0u}; \
            rq[1] = *(const u32x4*)(pr_ + PC_MQ + hd * 64 + 8 * dg); rk[1] = *(const u32x4*)(pr_ + PC_MK + hd * 64 + 8 * dg); \
            rq[0] = ti_ > 0 ? *(const u32x4*)(pr_ - NPC + PC_MQ + hd * 64 + 8 * dg) : z4_; rk[0] = ti_ > 0 ? *(const u32x4*)(pr_ - NPC + PC_MK + hd * 64 + 8 * dg) : z4_; \
            rq[2] = ti_ + 1 < slen_ ? *(const u32x4*)(pr_ + NPC + PC_MQ + hd * 64 + 8 * dg) : z4_; rk[2] = ti_ + 1 < slen_ ? *(const u32x4*)(pr_ + NPC + PC_MK + hd * 64 + 8 * dg) : z4_; \
            const float* gp_ = A.gates + (size_t)(rb_ + (dir ? 63 - lane : lane)) * 16; rgi = gp_[dir * 4 + hd]; rgf = gp_[8 + dir * 4 + hd]; \
        } else { rq[1] = *(const u32x4*)(pr_ + PC_HQ + hd * 64 + 8 * dg); rk[1] = *(const u32x4*)(pr_ + PC_HF + dir * 256 + hd * 64 + 8 * dg); } \
        rv[0] = *(const u32x4*)(pr_ + vcol + 16 * dg); rv[1] = *(const u32x4*)(pr_ + vcol + 16 * dg + 8); } while (0)
        SC_LOAD(0);
        for (int c = 0; c < 68; ++c) {
            float alpha = 0.f, wprev = 0.f, enm = 0.f, a_prev = 0.f;
            {
                const unsigned vv[8] = {rv[0].x, rv[0].y, rv[0].z, rv[0].w, rv[1].x, rv[1].y, rv[1].z, rv[1].w};
#pragma unroll
                for (int e = 0; e < 8; ++e) { *(LAS unsigned short*)(lds + SC_VT + (16 * dg + 2 * e) * RS + p * 2) = (unsigned short)(vv[e] & 0xffffu);
                    *(LAS unsigned short*)(lds + SC_VT + (16 * dg + 2 * e + 1) * RS + p * 2) = (unsigned short)(vv[e] >> 16); }
            }
            if (IS_ML) {
                const float li = rgi, xf = rgf + fb;
                const float lf = fminf(xf, 0.f) - log1pf(__expf(-fabsf(xf)));
                float bc = lf;
#pragma unroll
                for (int off = 1; off < 64; off <<= 1) { const float v = __shfl_up(bc, off); if (lane >= off) bc += v; }
                const float beta = li - bc; float pm = beta;
#pragma unroll
                for (int off = 1; off < 64; off <<= 1) { const float v = __shfl_up(pm, off); if (lane >= off) pm = fmaxf(pm, v); }
                const float bl = __shfl(bc, 63), pmx = __shfl(pm, 63);
                const float mm = fmaxf(m_run, pm), mmx = fmaxf(m_run, pmx);
                alpha = -mm; wprev = __expf(m_run - mm); enm = __expf(-(bc + mm));
                a_prev = __expf(m_run - mmx); const float u = __expf(beta - mmx);
                m_run = bl + mmx;
                if (w == 0) beta_s[lane] = beta;
                const float up = __shfl(u, p);
                float q8[8], k8[8];
                const unsigned q0[4] = {rq[0].x, rq[0].y, rq[0].z, rq[0].w}, q1[4] = {rq[1].x, rq[1].y, rq[1].z, rq[1].w}, q2[4] = {rq[2].x, rq[2].y, rq[2].z, rq[2].w};
                const unsigned k0[4] = {rk[0].x, rk[0].y, rk[0].z, rk[0].w}, k1[4] = {rk[1].x, rk[1].y, rk[1].z, rk[1].w}, k2[4] = {rk[2].x, rk[2].y, rk[2].z, rk[2].w};
#pragma unroll
                for (int e = 0; e < 4; ++e) { const int d0 = 8 * dg + 2 * e;
                    q8[2 * e] = fsilu(bflo(q0[e]) * conv_s[0 * 64 + d0] + bflo(q1[e]) * conv_s[1 * 64 + d0] + bflo(q2[e]) * conv_s[2 * 64 + d0]);
                    q8[2 * e + 1] = fsilu(bfhi(q0[e]) * conv_s[0 * 64 + d0 + 1] + bfhi(q1[e]) * conv_s[1 * 64 + d0 + 1] + bfhi(q2[e]) * conv_s[2 * 64 + d0 + 1]);
                    k8[2 * e] = 0.125f * fsilu(bflo(k0[e]) * conv_s[3 * 64 + d0] + bflo(k1[e]) * conv_s[4 * 64 + d0] + bflo(k2[e]) * conv_s[5 * 64 + d0]);
                    k8[2 * e + 1] = 0.125f * fsilu(bfhi(k0[e]) * conv_s[3 * 64 + d0 + 1] + bfhi(k1[e]) * conv_s[4 * 64 + d0 + 1] + bfhi(k2[e]) * conv_s[5 * 64 + d0 + 1]); }
                *(LAS bf16x8*)(lds + SC_QS + p * RS + 16 * dg) = pack8(q8[0], q8[1], q8[2], q8[3], q8[4], q8[5], q8[6], q8[7]);
                *(LAS bf16x8*)(lds + SC_KS + p * RS + 16 * dg) = pack8(k8[0], k8[1], k8[2], k8[3], k8[4], k8[5], k8[6], k8[7]);
#pragma unroll
                for (int e = 0; e < 8; ++e) *(LAS unsigned short*)(lds + SC_UKT + (8 * dg + e) * RS + p * 2) = (unsigned short)f2bf(up * k8[e]);
            } else {
                float x[8], kk[8], qs[8];
                const unsigned qr[4] = {rq[1].x, rq[1].y, rq[1].z, rq[1].w}, zr[4] = {rk[1].x, rk[1].y, rk[1].z, rk[1].w};
#pragma unroll
                for (int e = 0; e < 8; ++e) { const float z = (e & 1) ? bfhi(zr[e >> 1]) : bflo(zr[e >> 1]), qv = (e & 1) ? bfhi(qr[e >> 1]) : bflo(qr[e >> 1]);
                    const float ez = __expf(-fabsf(z)), sg = (z >= 0.f ? 1.0f : ez) / (1.0f + ez);
                    const float lb = lbv[e], f = lb + (1.0f - lb) * sg;
                    kk[e] = (1.0f - lb) * (1.0f - sg);
                    x[e] = (lb > 0.f) ? __logf(f) : (fminf(z, 0.f) - log1pf(ez));
                    qs[e] = 0.125f * fsilu(qv); }
#pragma unroll
                for (int off = 8; off < 64; off <<= 1)
#pragma unroll
                    for (int e = 0; e < 8; ++e) { const float v = __shfl_up(x[e], off); if (lane >= off) x[e] += v; }
                if ((lane >> 3) == 7) { *(LAS f32x4*)(tot_s + w * 64 + 8 * dg) = (f32x4){x[0], x[1], x[2], x[3]}; *(LAS f32x4*)(tot_s + w * 64 + 8 * dg + 4) = (f32x4){x[4], x[5], x[6], x[7]}; }
                __syncthreads();
                float offs[8], ref[8], blv[8];
#pragma unroll
                for (int e = 0; e < 8; ++e) { offs[e] = 0.f; ref[e] = 0.f; blv[e] = 0.f; }
#pragma unroll
                for (int w2 = 0; w2 < 8; ++w2) { const f32x4 t0 = *(const LAS f32x4*)(tot_s + w2 * 64 + 8 * dg), t1 = *(const LAS f32x4*)(tot_s + w2 * 64 + 8 * dg + 4);
                    const float tv[8] = {t0[0], t0[1], t0[2], t0[3], t1[0], t1[1], t1[2], t1[3]};
#pragma unroll
                    for (int e = 0; e < 8; ++e) { if (w2 < w) offs[e] += tv[e]; if (w2 < 4) ref[e] += tv[e]; blv[e] += tv[e]; } }
                float qe[8], qt[8], kt[8];
#pragma unroll
                for (int e = 0; e < 8; ++e) { const float bb = x[e] + offs[e];
                    qe[e] = qs[e] * __expf(bb); qt[e] = qs[e] * __expf(fminf(bb - ref[e], 60.f)); kt[e] = kk[e] * __expf(fminf(ref[e] - bb, 60.f));
                    *(LAS unsigned short*)(lds + SC_UKT + (8 * dg + e) * RS + p * 2) = (unsigned short)f2bf(kk[e] * __expf(blv[e] - bb)); }
                *(LAS bf16x8*)(lds + SC_QE + p * RS + 16 * dg) = pack8(qe[0], qe[1], qe[2], qe[3], qe[4], qe[5], qe[6], qe[7]);
                *(LAS bf16x8*)(lds + SC_QS + p * RS + 16 * dg) = pack8(qt[0], qt[1], qt[2], qt[3], qt[4], qt[5], qt[6], qt[7]);
                *(LAS bf16x8*)(lds + SC_KS + p * RS + 16 * dg) = pack8(kt[0], kt[1], kt[2], kt[3], kt[4], kt[5], kt[6], kt[7]);
                if (p == 0) {
#pragma unroll
                    for (int e = 0; e < 8; ++e) dec_s[8 * dg + e] = __expf(blv[e]); }
            }
            const bool first_role = (c < 2) || (c >= 4 && c < 36);
            if (!first_role && tid == 0) {
                const int cp = (c < 4) ? 3 - c : 71 - c; const unsigned need = 8u * (unsigned)((cp < 2 ? cp : cp - 2) + 1);
                if (cache_s[0] < need) {
                    unsigned v; unsigned spins = 0;
                    for (;;) { v = __hip_atomic_load(prog_other, __ATOMIC_RELAXED, __HIP_MEMORY_SCOPE_AGENT); if (v >= need) break; __builtin_amdgcn_s_sleep(2); if (++spins > (1u << 24)) break; }
                    __builtin_amdgcn_fence(__ATOMIC_ACQUIRE, "agent");
                    cache_s[0] = v;
                }
            }
            __syncthreads();
            SC_ROWS(c)
            if (c + 1 < 68) SC_LOAD(c + 1);
            const int t = 32 * ttile + r;
            bf16x8 qf[4];
#pragma unroll
            for (int ks = 0; ks < 4; ++ks) qf[ks] = *(const LAS bf16x8*)(lds + SC_QS + t * RS + (16 * ks + 8 * hh) * 2);
            f32x16 S[2];
#pragma unroll
            for (int st = 0; st < 2; ++st) { f32x16 acc;
#pragma unroll
                for (int i = 0; i < 16; ++i) acc[i] = 0.f;
#pragma unroll
                for (int ks = 0; ks < 4; ++ks) { const bf16x8 kf = *(const LAS bf16x8*)(lds + SC_KS + (32 * st + r) * RS + (16 * ks + 8 * hh) * 2); acc = MFMA32(kf, qf[ks], acc); }
                S[st] = acc; }
            float inv = 1.0f, wprev_t = 1.0f;
            if (IS_ML) {
                const float alpha_t = __shfl(alpha, t), en_t = __shfl(enm, t); wprev_t = __shfl(wprev, t);
                float rs = 0.f;
#pragma unroll
                for (int st = 0; st < 2; ++st)
#pragma unroll
                    for (int ig = 0; ig < 4; ++ig) { const f32x4 bt = *(const LAS f32x4*)(beta_s + 32 * st + 8 * ig + 4 * hh);
#pragma unroll
                        for (int k = 0; k < 4; ++k) { const int s = 32 * st + 8 * ig + 4 * hh + k; const float e = (s <= t) ? __expf(alpha_t + bt[k]) : 0.f; const float v = S[st][4 * ig + k] * e; S[st][4 * ig + k] = v; rs += v; } }
                rs += __shfl_xor(rs, 32);
                const LAS float* nv = n_s + (c & 1) * 64; float qn = 0.f;
#pragma unroll
                for (int ks = 0; ks < 4; ++ks) { const f32x4 n0 = *(const LAS f32x4*)(nv + 16 * ks + 8 * hh), n1 = *(const LAS f32x4*)(nv + 16 * ks + 8 * hh + 4);
                    qn += bf1(qf[ks][0]) * n0[0] + bf1(qf[ks][1]) * n0[1] + bf1(qf[ks][2]) * n0[2] + bf1(qf[ks][3]) * n0[3] + bf1(qf[ks][4]) * n1[0] + bf1(qf[ks][5]) * n1[1] + bf1(qf[ks][6]) * n1[2] + bf1(qf[ks][7]) * n1[3]; }
                qn += __shfl_xor(qn, 32);
                const float den = wprev_t * qn + rs;
                inv = 1.0f / fmaxf(fabsf(den), en_t);
                if (w == 0) {
                    float sacc = 0.f;
#pragma unroll
                    for (int q8i = 0; q8i < 8; ++q8i) { const bf16x8 uk = *(const LAS bf16x8*)(lds + SC_UKT + lane * RS + 16 * q8i);
#pragma unroll
                        for (int j = 0; j < 8; ++j) sacc += bf1(uk[j]); }
                    n_s[((c + 1) & 1) * 64 + lane] = a_prev * nv[lane] + sacc;
                }
            } else {
#pragma unroll
                for (int st = 0; st < 2; ++st)
#pragma unroll
                    for (int i = 0; i < 16; ++i) { const int s = 32 * st + crow(i, hh); if (s > t) S[st][i] = 0.f; }
            }
            f32x16 acc;
#pragma unroll
            for (int i = 0; i < 16; ++i) acc[i] = 0.f;
#pragma unroll
            for (int ks = 0; ks < 4; ++ks) { const bf16x8 ca = *(const LAS bf16x8*)(lds + SC_CBT + (32 * etile + r) * RS + (16 * ks + 8 * hh) * 2);
                const bf16x8 qb = IS_ML ? qf[ks] : *(const LAS bf16x8*)(lds + SC_QE + t * RS + (16 * ks + 8 * hh) * 2);
                acc = MFMA32(ca, qb, acc); }
            if (IS_ML) {
#pragma unroll
                for (int i = 0; i < 16; ++i) acc[i] *= wprev_t; }
#pragma unroll
            for (int kk2 = 0; kk2 < 4; ++kk2) { const int st = kk2 >> 1, s2 = kk2 & 1;
                const LAS unsigned char* vp = lds + SC_VT + (32 * etile + r) * RS + (32 * st + 16 * s2 + 4 * hh) * 2;
                const s16x4 lo = *(const LAS s16x4*)vp, hi = *(const LAS s16x4*)(vp + 16);
                const bf16x8 va = __builtin_shufflevector(lo, hi, 0, 1, 2, 3, 4, 5, 6, 7);
                const bf16x8 pb = pack8(S[st][8 * s2 + 0], S[st][8 * s2 + 1], S[st][8 * s2 + 2], S[st][8 * s2 + 3], S[st][8 * s2 + 4], S[st][8 * s2 + 5], S[st][8 * s2 + 6], S[st][8 * s2 + 7]);
                acc = MFMA32(va, pb, acc); }
            {
                const int orow = rb_ + (dir ? 63 - t : t);
                bf16_t* op = A.OUT + (size_t)orow * 512 + hd * 128 + 32 * etile + 4 * hh;
                if (first_role) {
#pragma unroll
                    for (int ig = 0; ig < 4; ++ig) { const unsigned lo_ = pk2(acc[4 * ig] * inv, acc[4 * ig + 1] * inv), hi_ = pk2(acc[4 * ig + 2] * inv, acc[4 * ig + 3] * inv);
                        __hip_atomic_store((unsigned long long*)(op + 8 * ig), ((unsigned long long)hi_ << 32) | lo_, __ATOMIC_RELAXED, __HIP_MEMORY_SCOPE_AGENT); }
                } else {
                    float sq = 0.f;
#pragma unroll
                    for (int ig = 0; ig < 4; ++ig) { const unsigned long long pv = __hip_atomic_load((const unsigned long long*)(op + 8 * ig), __ATOMIC_RELAXED, __HIP_MEMORY_SCOPE_AGENT);
                        const unsigned a0 = (unsigned)pv, a1 = (unsigned)(pv >> 32);
                        acc[4 * ig] = acc[4 * ig] * inv + bflo(a0); acc[4 * ig + 1] = acc[4 * ig + 1] * inv + bfhi(a0); acc[4 * ig + 2] = acc[4 * ig + 2] * inv + bflo(a1); acc[4 * ig + 3] = acc[4 * ig + 3] * inv + bfhi(a1);
                        sq += (acc[4 * ig] * acc[4 * ig] + acc[4 * ig + 1] * acc[4 * ig + 1]) + (acc[4 * ig + 2] * acc[4 * ig + 2] + acc[4 * ig + 3] * acc[4 * ig + 3]); }
                    sq += __shfl_xor(sq, 32);
                    if (hh == 0) ssq_s[etile * 64 + t] = sq;
                    __syncthreads();
                    const float tot = (ssq_s[t] + ssq_s[64 + t]) + (ssq_s[128 + t] + ssq_s[192 + t]);
                    const float rstd = 1.0f / sqrtf(tot * (1.0f / 128.0f) + EPS);
                    const bf16_t* gp = A.P + (size_t)orow * NPC + gcol + 32 * etile + 4 * hh;
                    const float* gn = A.gnorm + hd * 128 + 32 * etile + 4 * hh;
#pragma unroll
                    for (int ig = 0; ig < 4; ++ig) { const u32x2 gw = *(const u32x2*)(gp + 8 * ig); const f32x4 g4 = *(const f32x4*)(gn + 8 * ig);
                        const float g0 = bflo(gw.x), g1 = bfhi(gw.x), g2 = bflo(gw.y), g3 = bfhi(gw.y);
                        const float o0 = acc[4 * ig] * rstd * g4[0] * (IS_ML ? fsigmoid(g0) : fsilu(g0)), o1 = acc[4 * ig + 1] * rstd * g4[1] * (IS_ML ? fsigmoid(g1) : fsilu(g1));
                        const float o2 = acc[4 * ig + 2] * rstd * g4[2] * (IS_ML ? fsigmoid(g2) : fsilu(g2)), o3 = acc[4 * ig + 3] * rstd * g4[3] * (IS_ML ? fsigmoid(g3) : fsilu(g3));
                        u32x2 wv; wv.x = pk2(o0, o1); wv.y = pk2(o2, o3); *(u32x2*)(op + 8 * ig) = wv; }
                }
            }
            if (IS_ML) {
#pragma unroll
                for (int i = 0; i < 16; ++i) Cst[i] *= a_prev;
            } else {
#pragma unroll
                for (int ig = 0; ig < 4; ++ig) { const f32x4 dv = *(const LAS f32x4*)(dec_s + 32 * dtile + 8 * ig + 4 * hh);
#pragma unroll
                    for (int k = 0; k < 4; ++k) Cst[4 * ig + k] *= dv[k]; }
            }
#pragma unroll
            for (int ks = 0; ks < 4; ++ks) { const bf16x8 ua = *(const LAS bf16x8*)(lds + SC_UKT + (32 * dtile + r) * RS + (16 * ks + 8 * hh) * 2);
                const bf16x8 vb = *(const LAS bf16x8*)(lds + SC_VT + (32 * etile + r) * RS + (16 * ks + 8 * hh) * 2);
                Cst = MFMA32(ua, vb, Cst); }
            if (first_role) { asm volatile("s_waitcnt vmcnt(0)" ::: "memory"); if (lane == 0) __hip_atomic_fetch_add(prog_mine, 1u, __ATOMIC_RELAXED, __HIP_MEMORY_SCOPE_AGENT); }
            __syncthreads();
#pragma unroll
            for (int ig = 0; ig < 4; ++ig) { u32x2 wv; wv.x = pk2(Cst[4 * ig], Cst[4 * ig + 1]); wv.y = pk2(Cst[4 * ig + 2], Cst[4 * ig + 3]);
                *(LAS u32x2*)(lds + SC_CBT + (32 * etile + r) * RS + (32 * dtile + 8 * ig + 4 * hh) * 2) = wv; }
        }
#undef SC_LOAD
#undef SC_ROWS
    }
    __syncthreads();
}
#ifndef PH
#define PH 0xffff
#endif

DI void mix_phase(KP p, int l, LAS unsigned char* lds, int tid) {
    asm volatile("" : "+v"(tid));
    const int G = gridDim.x, bid = blockIdx.x;
    const bf16_t* P = (const bf16_t*)(p->ws + WS_P);
    bf16_t* ATT = (bf16_t*)(p->ws + WS_S); bf16_t* MLB = ATT + (size_t)MTOT * 512; bf16_t* HGB = MLB + (size_t)MTOT * 512;
    const int nattn = 512 + (l == 0 ? 32 : 0);
    if (bid < 128) {
        const int it = bid, dir = it & 1, hd = (it >> 1) & 3, b = (it >> 3) & 7, ty = it >> 6;
        unsigned* prog = (unsigned*)p->ws + (l * 128 + (it & ~1)) * 16;
        if (ty == 0) { ScanArgs A{P, MLB, (const float*)(p->ws + WS_GATES), p->in[I_MLCONV] + (size_t)l * 3 * 512, p->in[I_MLFB] + l * 8, p->in[I_MLNORM] + l * 512, p->in[I_HGLB], l};
#ifndef NO_SCANML
            scan_item<true>(A, b, hd, dir, prog + dir * 16, prog + (dir ^ 1) * 16, lds, tid);
#endif
        } else { ScanArgs A{P, HGB, (const float*)(p->ws + WS_GATES), p->in[I_MLCONV], p->in[I_MLFB], p->in[I_HGNORM] + l * 512, p->in[I_HGLB], l};
#ifndef NO_SCANHG
            scan_item<false>(A, b, hd, dir, prog + dir * 16, prog + (dir ^ 1) * 16, lds, tid);
#endif
        }
    }
    if (bid >= 128) {
        __syncthreads();
        const f32x2* rope = (const f32x2*)(p->ws + WS_ROPE);
        for (int i = tid; i < 1024; i += 512) ((LAS f32x2*)(lds + AT_TAB))[i] = rope[i];
        __syncthreads();
        AttnArgs A{P, ATT, p->in[I_SINK] + l * 8, rope};
        for (int it = bid - 128; it < nattn; it += G - 128) {
#ifndef NO_ATTN
 attn_item(A, it, lds, tid);
#endif
 }
    }
}

template <class Epi> DI void run_gemm(LAS unsigned char* lds, const bf16_t* A, const bf16_t* Bt, int M, int N, int K, const Epi& E) {
    pg8::Gemm g{A, Bt, M, N, K}; pg8::StaticOrder S; S.init(M, N, (int)gridDim.x, (int)blockIdx.x);
    pg8::gemm_phase<Epi, pg8::StaticOrder, true, true>(lds, g, S, E);
}

__global__ void __launch_bounds__(512) fwd_kernel(Params p_unused) {
    extern __shared__ __attribute__((aligned(16))) unsigned char lds_raw[];
    LAS unsigned char* lds = (LAS unsigned char*)lds_raw;
    cg::grid_group grid = cg::this_grid();
#define tid ((int)threadIdx.x)
#define ws (kparams()->ws)
#define W ((bf16_t*)(ws + WS_W))
#define H ((bf16_t*)(ws + WS_H))
#define PB ((bf16_t*)(ws + WS_P))
#define SB ((bf16_t*)(ws + WS_S))
#define XC ((float*)(ws + WS_XC))
#define mod ((const float*)(ws + WS_MOD))
#define gates ((float*)(ws + WS_GATES))
    KP p = kparams();

#if PH & 1
    convert_weights(p, 0, lds);
    __syncthreads();
    mods_phase(p, lds, tid);
#endif
    grid.sync();
    {
        RowArgs a{p->in[I_X], p->in[I_CTX], nullptr, nullptr, nullptr, H, mod, mod, nullptr, p->in[I_NPRE], nullptr, nullptr, 0, 0, MTOT, 0.f};
#if PH & 2
        row_phase<false, true, false>(a, lds, tid);
#endif
    }
    grid.sync();

#pragma unroll 1
    for (int l = 0; l < 2; ++l) {
        p = kparams();
        const float* modl = mod + (size_t)l * 9 * 9216;
        const float* npre = p->in[I_NPRE] + (size_t)l * 3 * DM; const float* npost = p->in[I_NPOST] + (size_t)l * 3 * DM;
        const int M2 = (l == 1) ? MLAT : MTOT;
#if PH & 4
        { pg8::EpiSwiGLU E{PB, DFF}; run_gemm(lds, H, W + WO_W13, MTOT, 5632, DM, E); }
#endif
        grid.sync();
#if PH & 8
        { pg8::EpiBf16<0> E{SB, DM}; run_gemm(lds, PB, W + WO_W2, MTOT, DM, DFF, E); }
#endif
        grid.sync();
        {
            RowArgs a{l == 0 ? p->in[I_X] : p->out, l == 0 ? p->in[I_CTX] : XC, p->out, XC, SB, H, modl, modl, npost, npre + DM, p->in[I_WIN] + (size_t)l * DM * DIN + 2304, gates, 0, 1, MTOT, 0.5f};
#if PH & 16
            row_phase<true, true, true>(a, lds, tid);
#endif
        }
        grid.sync();
#if PH & 32
        { pg8::EpiBf16<0> E{PB, NPC}; run_gemm(lds, H, W + WO_WIN, MTOT, NPC, DM, E); }
#endif
        grid.sync();
#if PH & 64
        mix_phase(p, l, lds, tid);
#endif
        grid.sync();
#if PH & 128
        { pg8::EpiBf16<1> E{PB, NGC}; run_gemm(lds, H, W + WO_WG, M2, NGC, DM, E); }
#endif
        grid.sync();
#if PH & 256
#pragma unroll 1
        for (int gi = 0; gi < 3; ++gi) { pg8::EpiMerge E{H, PB, gi}; run_gemm(lds, SB + (size_t)gi * MTOT * 512, W + WO_WB + (size_t)gi * 1024 * 512, M2, DM, 512, E); }
#endif
        grid.sync();
#if PH & 512
        { pg8::EpiBf16<0> E{SB, DM}; run_gemm(lds, H, W + WO_WOUT, M2, DM, DM, E); }
#endif
        grid.sync();
        {
            RowArgs a{p->out, XC, p->out, XC, SB, H, modl, modl, npost + DM, npre + 2 * DM, nullptr, nullptr, 1, 2, M2, 1.0f};
#if PH & 1024
            row_phase<true, true, false>(a, lds, tid);
#endif
        }
        grid.sync();
#if PH & 2048
        { pg8::EpiSwiGLU E{PB, DFF}; run_gemm(lds, H, W + WO_W13 + (size_t)5632 * 1024, M2, 5632, DM, E); }
#endif
        grid.sync();
#if PH & 4096
        { pg8::EpiBf16<0> E{SB, DM}; run_gemm(lds, PB, W + WO_W2 + (size_t)1024 * 2816, M2, DM, DFF, E); }
#endif
        grid.sync();
        if (l == 0) {
            RowArgs a{p->out, XC, p->out, XC, SB, H, modl, mod + (size_t)9 * 9216, npost + 2 * DM, p->in[I_NPRE] + 3 * DM, nullptr, nullptr, 2, 0, MTOT, 0.5f};
#if PH & 8192
            row_phase<true, true, false>(a, lds, tid);
            __syncthreads();
            convert_weights(p, 1, lds);
#endif
            grid.sync();
        } else {
            RowArgs a{p->out, XC, p->out, XC, SB, H, modl, modl, npost + 2 * DM, nullptr, nullptr, nullptr, 2, 0, MLAT, 0.5f};
#if PH & 16384
            row_phase<true, false, false>(a, lds, tid);
#endif
        }
    }
#undef tid
#undef ws
#undef W
#undef H
#undef PB
#undef SB
#undef XC
#undef mod
#undef gates
}

extern "C" void kernel_launch(void* const* d_in, const int* in_sizes, int n_in, void* d_out, int out_size, void* d_ws, size_t ws_size, hipStream_t stream) {
    static int grid = 0;
    if (grid == 0) {
        if (n_in != 22 || out_size != MLAT * DM || ws_size < WS_END) { fprintf(stderr, "kernel_launch: unexpected shapes (n_in %d out %d ws %zu)\n", n_in, out_size, ws_size); grid = -1; return; }
        int dev = 0, cus = 0, per_cu = 0;
        (void)hipGetDevice(&dev);
        (void)hipDeviceGetAttribute(&cus, hipDeviceAttributeMultiprocessorCount, dev);
        (void)hipFuncSetAttribute((const void*)fwd_kernel, hipFuncAttributeMaxDynamicSharedMemorySize, LDS_BYTES);
        (void)hipOccupancyMaxActiveBlocksPerMultiprocessor(&per_cu, (const void*)fwd_kernel, 512, LDS_BYTES);
        if (per_cu < 1) per_cu = 1;
        if (per_cu > 1) per_cu = 1;
        grid = cus * per_cu;
        if (grid <= 0) grid = 256;
    }
    if (grid < 0) return;
    if (grid < 192) { fprintf(stderr, "kernel_launch: grid %d too small for the paired scans\n", grid); return; }
    (void)hipMemsetAsync(d_ws, 0, 65536, stream);
    Params p{};
    for (int i = 0; i < 22; ++i) p.in[i] = (const float*)d_in[i];
    p.out = (float*)d_out; p.ws = (unsigned char*)d_ws;
    void* args[] = {&p};
    hipError_t e = hipLaunchCooperativeKernel((const void*)fwd_kernel, dim3(grid), dim3(512), args, LDS_BYTES, stream);
    if (e != hipSuccess) fprintf(stderr, "cooperative launch failed: %s (grid %d)\n", hipGetErrorString(e), grid);
}
```

```cpp
#include <hip/hip_runtime.h>
#include <hip/hip_cooperative_groups.h>
#include <cstdio>
#include <cstdint>
namespace cg = cooperative_groups;

#define DI __device__ __forceinline__
#define LAS __attribute__((address_space(3)))
typedef unsigned short bf16_t;
typedef short bf16x8 __attribute__((ext_vector_type(8)));
typedef short s16x4 __attribute__((ext_vector_type(4)));
typedef float f32x2 __attribute__((ext_vector_type(2)));
typedef float f32x4 __attribute__((ext_vector_type(4)));
typedef float f32x16 __attribute__((ext_vector_type(16)));
typedef unsigned u32x2 __attribute__((ext_vector_type(2)));
typedef unsigned u32x4 __attribute__((ext_vector_type(4)));

constexpr int DM = 1024, NB = 8, SEQ = 4096, CTXL = 256, DFF = 2816, DIN = 7184, NMOD = 9;
constexpr int MLAT = NB * SEQ, MCTX = NB * CTXL, MTOT = MLAT + MCTX;
constexpr int NPC = 4096;
constexpr int NGC = 3072;
constexpr float EPS = 1e-6f;
constexpr int PC_AQ = 0, PC_AK = 512, PC_AV = 640, PC_MQ = 768, PC_MK = 1024, PC_MV = 1280, PC_MO = 1792, PC_HQ = 2304, PC_HF = 2560, PC_HI = 3072, PC_HG = 3584;

constexpr size_t MiB = 1u << 20;
constexpr size_t WS_MOD = 1 * MiB;
constexpr size_t WS_ROPE = 2 * MiB;
constexpr size_t WS_GATES = 3 * MiB;
constexpr size_t WS_XC = 6 * MiB;
constexpr size_t WS_W = 14 * MiB;
constexpr size_t WS_H = 66 * MiB;
constexpr size_t WS_P = 134 * MiB;
constexpr size_t WS_S = 406 * MiB;
constexpr size_t WS_END = 508 * MiB;
constexpr size_t WO_W13 = 0;
constexpr size_t WO_W2 = WO_W13 + (size_t)2 * 5632 * 1024;
constexpr size_t WO_WIN = WO_W2 + (size_t)2 * 1024 * 2816;
constexpr size_t WO_WG = WO_WIN + (size_t)4096 * 1024;
constexpr size_t WO_WB = WO_WG + (size_t)3072 * 1024;
constexpr size_t WO_WOUT = WO_WB + (size_t)3 * 1024 * 512;
constexpr size_t WO_END = WO_WOUT + (size_t)1024 * 1024;
static_assert(WO_END * 2 <= 52 * MiB, "weights fit");
static_assert((size_t)MTOT * 1024 * 2 <= 68 * MiB && (size_t)MTOT * 4096 * 2 <= 272 * MiB && (size_t)MTOT * 512 * 2 * 3 <= 102 * MiB, "ws map");

constexpr int LDS_BYTES = 131072;
constexpr size_t PTS = (size_t)MTOT * 256;
__device__ __forceinline__ size_t pidx(int row, int col) { return (size_t)(col >> 8) * PTS + (size_t)row * 256 + (col & 255); }

DI unsigned f2bf(float f) { unsigned u = __float_as_uint(f); return (u + 0x7fffu + ((u >> 16) & 1u)) >> 16; }
typedef __bf16 bf16v2 __attribute__((ext_vector_type(2)));
DI unsigned pk2(float lo, float hi) { f32x2 v = {lo, hi}; bf16v2 b = __builtin_convertvector(v, bf16v2); return __builtin_bit_cast(unsigned, b); }
DI float bflo(unsigned w) { return __uint_as_float(w << 16); }
DI float bfhi(unsigned w) { return __uint_as_float(w & 0xffff0000u); }
DI float bf1(short s) { return __uint_as_float(((unsigned)(unsigned short)s) << 16); }
DI float fexp(float x) { return __builtin_amdgcn_exp2f(x * 1.4426950408889634f); }
DI float flog(float x) { return __builtin_amdgcn_logf(x) * 0.6931471805599453f; }
DI float flog1p(float e) { const float u = 1.0f + e, d = u - 1.0f; return d == 0.f ? e : flog(u) * e * __builtin_amdgcn_rcpf(d); }
DI float fsigmoid(float x) { return __builtin_amdgcn_rcpf(1.0f + fexp(-x)); }
DI float fsilu(float x) { return x * fsigmoid(x); }
DI float wave_sum(float v) {
#pragma unroll
    for (int o = 1; o < 64; o <<= 1) v += __shfl_xor(v, o);
    return v;
}
DI bf16x8 pack8(float a0, float a1, float a2, float a3, float a4, float a5, float a6, float a7) {
    u32x4 p; p.x = pk2(a0, a1); p.y = pk2(a2, a3); p.z = pk2(a4, a5); p.w = pk2(a6, a7); return __builtin_bit_cast(bf16x8, p);
}
#define MFMA32(a, b, c) __builtin_amdgcn_mfma_f32_32x32x16_bf16((a), (b), (c), 0, 0, 0)
DI int crow(int i, int h) { return (i & 3) + 8 * (i >> 2) + 4 * h; }

#define LDS_BARRIER() do { asm volatile("s_waitcnt lgkmcnt(0)" ::: "memory"); __builtin_amdgcn_s_barrier(); asm volatile("" ::: "memory"); } while (0)
namespace pg8 {
#define PG8_LAS __attribute__((address_space(3)))
typedef unsigned short bf16_t;
typedef short bf16x8 __attribute__((ext_vector_type(8)));
typedef float f32x4 __attribute__((ext_vector_type(4)));
typedef unsigned u32x4 __attribute__((ext_vector_type(4)));
constexpr int BM = 256, BK = 64, HALF = 128, HTB = HALF * BK * 2  , STAGE_BYTES = 8 * HTB, NXCD = 8, WGM = 8;

__host__ __device__ __forceinline__ int lds_byte(int r, int c) { const int st = (r >> 4) * 2 + (c >> 5), rr = r & 15, cc = c & 31, ob = rr * 64 + cc * 2; return st * 1024 + (ob ^ (((ob >> 9) & 1) << 5)); }
__host__ __device__ __forceinline__ void stage_rc(int b, int& R, int& C) { const int st = b / 1024, sb = b % 1024, swz = sb ^ (((sb >> 9) & 1) << 5); R = (st >> 1) * 16 + swz / 64; C = (st & 1) * 32 + (swz % 64) / 2; }
__host__ __device__ __forceinline__ int perm32(int rho) { const int n = rho >> 4, i = rho & 15; return 8 * (i >> 2) + 4 * n + (i & 3); }

struct Unit { int pm, pn; };
struct Gemm { const bf16_t* A; const bf16_t* Bt; int M, N, K; };

struct StaticOrder {
    int nM, nN, nwg, G, c;
    __host__ __device__ void init(int M, int N, int G_, int c_) { nM = M / BM; nN = N / BM; nwg = nM * nN; G = G_; c = c_; }
    __host__ __device__ bool next(int i, Unit& u) const {
        const long L = (long)i * G + c; if (L >= nwg) return false;
        int wgid = (int)L; { const int q = nwg / NXCD, r = nwg % NXCD, xcd = wgid % NXCD, off = wgid / NXCD; wgid = (xcd < r ? xcd * (q + 1) : r * (q + 1) + (xcd - r) * q) + off; }
        const int nig = WGM * nN, gid = wgid / nig, fm = gid * WGM, gsz = (nM - fm) < WGM ? (nM - fm) : WGM;
        u.pm = fm + ((wgid % nig) % gsz); u.pn = (wgid % nig) / gsz; return true;
    }
    __device__ __forceinline__ void a_ready(const Unit&) const {}
    __device__ __forceinline__ void done(const Unit&) const {}
};

template <int ACT  > struct EpiBf16 {
    static constexpr bool PERM = true, AFTER_DRAIN = false;
    bf16_t* O; int ldc; size_t tstride;
    __device__ __forceinline__ void operator()(const f32x4 (&acc)[2][2][4][2], const Unit& u, int wr, int wc, int fr, int fq) const {
        const int row0 = u.pm * BM + wr * 64 + fr, col0 = (tstride ? 0 : u.pn * BM) + wc * 32 + 8 * fq;
        bf16_t* Ob = O + (size_t)u.pn * tstride;
#pragma unroll
        for (int ai = 0; ai < 2; ++ai)
#pragma unroll
            for (int m = 0; m < 4; ++m) { bf16_t* rowp = Ob + (size_t)(row0 + ai * HALF + m * 16) * ldc + col0;
#pragma unroll
                for (int bj = 0; bj < 2; ++bj) { f32x4 v0 = acc[ai][bj][m][0], v1 = acc[ai][bj][m][1];
                    if (ACT == 1) {
#pragma unroll
                        for (int k = 0; k < 4; ++k) { v0[k] = fsigmoid(v0[k]); v1[k] = fsigmoid(v1[k]); } }
                    u32x4 w; w.x = pk2(v0[0], v0[1]); w.y = pk2(v0[2], v0[3]); w.z = pk2(v1[0], v1[1]); w.w = pk2(v1[2], v1[3]);
                    *(u32x4*)(rowp + bj * HALF) = w; } }
    }
};
struct EpiSwiGLU {
    static constexpr bool PERM = false, AFTER_DRAIN = false;
    bf16_t* O; int ldc;
    __device__ __forceinline__ void operator()(const f32x4 (&acc)[2][2][4][2], const Unit& u, int wr, int wc, int fr, int fq) const {
        const int row0 = u.pm * BM + wr * 64 + fr, f0 = u.pn * 128 + wc * 16 + 4 * fq;
#pragma unroll
        for (int ai = 0; ai < 2; ++ai)
#pragma unroll
            for (int m = 0; m < 4; ++m) { bf16_t* rowp = O + (size_t)(row0 + ai * HALF + m * 16) * ldc + f0;
#pragma unroll
                for (int bj = 0; bj < 2; ++bj) { const f32x4 a = acc[ai][bj][m][0], b = acc[ai][bj][m][1];
                    u32x2 w; w.x = pk2(fsilu(a[0]) * b[0], fsilu(a[1]) * b[1]); w.y = pk2(fsilu(a[2]) * b[2], fsilu(a[3]) * b[3]);
                    *(u32x2*)(rowp + bj * 64) = w; } }
    }
};
struct EpiMerge {
    static constexpr bool PERM = true, AFTER_DRAIN = false;
    bf16_t* O; const bf16_t* G; int gi;
    __device__ __forceinline__ void operator()(const f32x4 (&acc)[2][2][4][2], const Unit& u, int wr, int wc, int fr, int fq) const {
        const int row0 = u.pm * BM + wr * 64 + fr, col0 = u.pn * BM + wc * 32 + 8 * fq;
#pragma unroll
        for (int ai = 0; ai < 2; ++ai)
#pragma unroll
            for (int m = 0; m < 4; ++m) { const size_t r = (size_t)(row0 + ai * HALF + m * 16);
#pragma unroll
                for (int bj = 0; bj < 2; ++bj) { const int c = col0 + bj * HALF;
                    const u32x4 g = *(const u32x4*)(G + r * 3072 + gi * 1024 + c);
                    const f32x4 v0 = acc[ai][bj][m][0], v1 = acc[ai][bj][m][1];
                    float o0 = bflo(g.x) * v0[0], o1 = bfhi(g.x) * v0[1], o2 = bflo(g.y) * v0[2], o3 = bfhi(g.y) * v0[3];
                    float o4 = bflo(g.z) * v1[0], o5 = bfhi(g.z) * v1[1], o6 = bflo(g.w) * v1[2], o7 = bfhi(g.w) * v1[3];
                    bf16_t* op = O + r * 1024 + c;
                    if (gi > 0) {
                        const unsigned long long p0 = __hip_atomic_load((const unsigned long long*)op, __ATOMIC_RELAXED, __HIP_MEMORY_SCOPE_AGENT);
                        const unsigned long long p1 = __hip_atomic_load((const unsigned long long*)op + 1, __ATOMIC_RELAXED, __HIP_MEMORY_SCOPE_AGENT);
                        const unsigned a0 = (unsigned)p0, a1 = (unsigned)(p0 >> 32), a2 = (unsigned)p1, a3 = (unsigned)(p1 >> 32);
                        o0 += bflo(a0); o1 += bfhi(a0); o2 += bflo(a1); o3 += bfhi(a1); o4 += bflo(a2); o5 += bfhi(a2); o6 += bflo(a3); o7 += bfhi(a3);
                    }
                    u32x4 w; w.x = pk2(o0, o1); w.y = pk2(o2, o3); w.z = pk2(o4, o5); w.w = pk2(o6, o7);
                    *(u32x4*)op = w; } }
    }
};

template <class Epi, class Sched, bool ALIGN_EPI = false, bool SP2 = false>
__device__ __forceinline__ void gemm_phase(PG8_LAS unsigned char* lds, const Gemm g, const Sched& S, const Epi& E) {
    int tid_ = threadIdx.x; asm volatile("" : "+v"(tid_));
    const int tid = tid_, wid = __builtin_amdgcn_readfirstlane(tid >> 6), lane = tid & 63, wr = wid >> 2, wc = wid & 3, fr = lane & 15, fq = lane >> 4;
    const int K = g.K, nt = K / BK;
    unsigned voffA[2], voffB[2];
#pragma unroll
    for (int i = 0; i < 2; ++i) { int R, C; stage_rc(tid * 16 + i * 8192, R, C); const int Rb = Epi::PERM ? ((R & ~31) + perm32(R & 31)) : R;
        voffA[i] = (unsigned)(R * K + C) * 2u; voffB[i] = (unsigned)(Rb * K + C) * 2u; }
    const size_t kstep = (size_t)(BK * 2);
    const size_t hstep = (size_t)HALF * K * 2;
    const size_t tstep = 2 * hstep;
    const unsigned ldsw = (unsigned)wid * 1024u;
    const int aoff = lds_byte(wr * 64 + fr, fq * 8), boff = lds_byte(wc * 32 + fr, fq * 8);
#define PG8_SA(b, h) (((b) * 2 + (h)) * HTB)
#define PG8_SB(b, h) ((4 + (b) * 2 + (h)) * HTB)
#define PG8_STAGE(bufoff, gbase, voff) do { _Pragma("unroll") for (int _i = 0; _i < 2; ++_i) \
        __builtin_amdgcn_global_load_lds((const unsigned*)((const char*)(gbase) + (voff)[_i]), (PG8_LAS unsigned*)(lds + (bufoff) + ldsw + _i * 8192), 16, 0, 0); } while (0)
#define PG8_LDA(dst, b, h) do { _Pragma("unroll") for (int m = 0; m < 4; ++m) _Pragma("unroll") for (int k = 0; k < 2; ++k) dst[m][k] = *(const PG8_LAS bf16x8*)(lds + PG8_SA(b, h) + aoff + m * 2048 + k * 1024); } while (0)
#define PG8_LDB(dst, b, h) do { _Pragma("unroll") for (int n = 0; n < 2; ++n) _Pragma("unroll") for (int k = 0; k < 2; ++k) dst[n][k] = *(const PG8_LAS bf16x8*)(lds + PG8_SB(b, h) + boff + n * 2048 + k * 1024); } while (0)
#define PG8_MMA(ai, bj, At, Bt) do { __builtin_amdgcn_s_setprio(1); _Pragma("unroll") for (int m = 0; m < 4; ++m) _Pragma("unroll") for (int n = 0; n < 2; ++n) _Pragma("unroll") for (int k = 0; k < 2; ++k) \
        acc[ai][bj][m][n] = __builtin_amdgcn_mfma_f32_16x16x32_bf16(Bt[n][k], At[m][k], acc[ai][bj][m][n], 0, 0, 0); __builtin_amdgcn_s_setprio(0); } while (0)
#define PG8_WAIT_V(n) asm volatile("s_waitcnt vmcnt(" #n ")" ::: "memory")
#define PG8_WAIT_L(n) asm volatile("s_waitcnt lgkmcnt(" #n ")" ::: "memory")
#define PG8_BAR __builtin_amdgcn_s_barrier()
#define PG8_SCHED __builtin_amdgcn_sched_barrier(0)
    Unit cur, nxt; int ui = 0;
    if (!S.next(0, cur)) return;
    f32x4 acc[2][2][4][2];
#pragma unroll
    for (int a = 0; a < 2; ++a)
#pragma unroll
        for (int b = 0; b < 2; ++b)
#pragma unroll
            for (int m = 0; m < 4; ++m)
#pragma unroll
                for (int n = 0; n < 2; ++n) acc[a][b][m][n] = (f32x4){0.f, 0.f, 0.f, 0.f};
    bf16x8 At[4][2], B0[2][2], B1[2][2];
    const char* cA = (const char*)g.A + (size_t)cur.pm * tstep; const char* cB = (const char*)g.Bt + (size_t)cur.pn * tstep;
    S.a_ready(cur);
    if constexpr (SP2) {
        PG8_STAGE(PG8_SB(0, 0), cB, voffB); PG8_STAGE(PG8_SB(0, 1), cB + hstep, voffB); PG8_STAGE(PG8_SA(0, 0), cA, voffA); PG8_STAGE(PG8_SA(0, 1), cA + hstep, voffA);
        if (wr == 1) PG8_BAR;
        PG8_WAIT_V(2); PG8_BAR;
        PG8_STAGE(PG8_SB(1, 0), cB + kstep, voffB); PG8_STAGE(PG8_SA(1, 0), cA + kstep, voffA); PG8_STAGE(PG8_SB(1, 1), cB + hstep + kstep, voffB);
        PG8_WAIT_V(6); PG8_BAR;
    } else {
        PG8_STAGE(PG8_SB(0, 0), cB, voffB); PG8_STAGE(PG8_SA(0, 0), cA, voffA); PG8_STAGE(PG8_SB(0, 1), cB + hstep, voffB); PG8_STAGE(PG8_SA(0, 1), cA + hstep, voffA);
        if (wr == 1) PG8_BAR;
        PG8_WAIT_V(4); PG8_BAR;
        PG8_STAGE(PG8_SB(1, 0), cB + kstep, voffB); PG8_STAGE(PG8_SA(1, 0), cA + kstep, voffA); PG8_STAGE(PG8_SB(1, 1), cB + hstep + kstep, voffB);
        PG8_WAIT_V(6); PG8_BAR;
    }
    for (;;) {
        const bool has_next = S.next(ui + 1, nxt);
        const char* nA = has_next ? (const char*)g.A + (size_t)nxt.pm * tstep : cA; const char* nB = has_next ? (const char*)g.Bt + (size_t)nxt.pn * tstep : cB;
        for (int t = 0; t < nt; t += 2) {
            const bool last = (t == nt - 2);
            const char* a1 = cA + (size_t)(t + 1) * kstep;
            const char* a2 = last ? nA : cA + (size_t)(t + 2) * kstep; const char* b2 = last ? nB : cB + (size_t)(t + 2) * kstep;
            const char* a3 = a2 + kstep; const char* b3 = b2 + kstep;
            if (last && has_next) S.a_ready(nxt);
            if constexpr (SP2) {
            PG8_LDB(B0, 0, 0); PG8_LDB(B1, 0, 1); PG8_SCHED; PG8_LDA(At, 0, 0); PG8_STAGE(PG8_SA(1, 1), a1 + hstep, voffA);
            PG8_WAIT_V(8); PG8_WAIT_L(0); PG8_BAR; PG8_MMA(0, 0, At, B0); PG8_MMA(0, 1, At, B1); PG8_BAR; PG8_SCHED;
            PG8_LDA(At, 0, 1); PG8_STAGE(PG8_SB(0, 0), b2, voffB); PG8_STAGE(PG8_SB(0, 1), b2 + hstep, voffB); PG8_STAGE(PG8_SA(0, 0), a2, voffA);
            PG8_WAIT_V(8); PG8_WAIT_L(0); PG8_BAR; PG8_MMA(1, 0, At, B0); PG8_MMA(1, 1, At, B1); PG8_BAR; PG8_SCHED;
            PG8_LDB(B0, 1, 0); PG8_LDB(B1, 1, 1); PG8_SCHED; PG8_LDA(At, 1, 0); PG8_STAGE(PG8_SA(0, 1), a2 + hstep, voffA);
            PG8_WAIT_V(8); PG8_WAIT_L(0); PG8_BAR; PG8_MMA(0, 0, At, B0); PG8_MMA(0, 1, At, B1); PG8_BAR; PG8_SCHED;
            PG8_LDA(At, 1, 1); PG8_STAGE(PG8_SB(1, 0), b3, voffB); PG8_STAGE(PG8_SB(1, 1), b3 + hstep, voffB); PG8_STAGE(PG8_SA(1, 0), a3, voffA);
            PG8_WAIT_V(8); PG8_WAIT_L(0); PG8_BAR; PG8_MMA(1, 0, At, B0); PG8_MMA(1, 1, At, B1); PG8_BAR; PG8_SCHED;
            } else {
            PG8_LDB(B0, 0, 0); PG8_SCHED; PG8_LDA(At, 0, 0); PG8_STAGE(PG8_SA(1, 1), a1 + hstep, voffA);
            PG8_WAIT_L(8); PG8_BAR; PG8_WAIT_L(0); PG8_MMA(0, 0, At, B0); PG8_BAR; PG8_SCHED;
            PG8_LDB(B1, 0, 1); PG8_STAGE(PG8_SB(0, 0), b2, voffB);
            PG8_BAR; PG8_WAIT_L(0); PG8_MMA(0, 1, At, B1); PG8_BAR;
            PG8_LDA(At, 0, 1); PG8_STAGE(PG8_SA(0, 0), a2, voffA);
            PG8_BAR; PG8_WAIT_L(0); PG8_MMA(1, 0, At, B0); PG8_BAR; PG8_SCHED;
            PG8_STAGE(PG8_SB(0, 1), b2 + hstep, voffB);
            PG8_WAIT_V(6); PG8_BAR; PG8_MMA(1, 1, At, B1); PG8_BAR;
            PG8_LDB(B0, 1, 0); PG8_SCHED; PG8_LDA(At, 1, 0); PG8_STAGE(PG8_SA(0, 1), a2 + hstep, voffA);
            PG8_WAIT_L(8); PG8_BAR; PG8_WAIT_L(0); PG8_MMA(0, 0, At, B0); PG8_BAR; PG8_SCHED;
            PG8_LDB(B1, 1, 1); PG8_STAGE(PG8_SB(1, 0), b3, voffB);
            PG8_BAR; PG8_WAIT_L(0); PG8_MMA(0, 1, At, B1); PG8_BAR;
            PG8_LDA(At, 1, 1); PG8_STAGE(PG8_SA(1, 0), a3, voffA);
            PG8_BAR; PG8_WAIT_L(0); PG8_MMA(1, 0, At, B0); PG8_BAR; PG8_SCHED;
            PG8_STAGE(PG8_SB(1, 1), b3 + hstep, voffB);
            PG8_WAIT_V(6); PG8_BAR; PG8_MMA(1, 1, At, B1); PG8_BAR;
            }
        }
        if constexpr (ALIGN_EPI) { if (wr == 0) PG8_BAR; }
        if constexpr (!Epi::AFTER_DRAIN) { E(acc, cur, wr, wc, fr, fq); S.done(cur); }
        if (!has_next) break;
#pragma unroll
        for (int a = 0; a < 2; ++a)
#pragma unroll
            for (int b = 0; b < 2; ++b)
#pragma unroll
                for (int m = 0; m < 4; ++m)
#pragma unroll
                    for (int n = 0; n < 2; ++n) acc[a][b][m][n] = (f32x4){0.f, 0.f, 0.f, 0.f};
        cur = nxt; cA = nA; cB = nB; ++ui;
        if constexpr (ALIGN_EPI) { if (wr == 1) PG8_BAR; }
    }
    PG8_WAIT_V(0);
    if constexpr (!ALIGN_EPI) { if (wr == 0) PG8_BAR; }
    PG8_BAR;
    if constexpr (Epi::AFTER_DRAIN) { E.fused(acc, cur, wr, wc, fr, fq, lds, wid, lane); S.done(cur); }
#undef PG8_SA
#undef PG8_SB
#undef PG8_STAGE
#undef PG8_LDA
#undef PG8_LDB
#undef PG8_MMA
#undef PG8_WAIT_V
#undef PG8_WAIT_L
#undef PG8_BAR
#undef PG8_SCHED
}
}

struct Params { const float* in[22]; float* out; unsigned char* ws; };
typedef const __attribute__((address_space(4))) Params* KP;
DI KP kparams() { KP kp = (KP)__builtin_amdgcn_kernarg_segment_ptr(); asm volatile("" : "+s"(kp)); return kp; }
enum { I_X = 0, I_C, I_CTX, I_CCTX, I_WADA, I_BADA, I_NPRE, I_NPOST, I_W1, I_W3, I_W2, I_WIN, I_SINK, I_MLCONV, I_MLFB, I_MLNORM, I_HGLB, I_HGNORM, I_WBA, I_WBM, I_WBH, I_WOUT };

DI void transpose_item(const float* Wa, const float* Wb, int ldw, int K, bf16_t* dst, int k0, LAS float* scr, int lane) {
    const float* src = (((lane & 31) < 16) ? Wa : Wb) + (lane & 15);
#pragma unroll 8
    for (int i = 0; i < 32; ++i) { const int kk = 2 * i + (lane >> 5); scr[kk * 33 + (lane & 31)] = src[(size_t)(k0 + kk) * ldw]; }
    asm volatile("s_waitcnt lgkmcnt(0)" ::: "memory");
    const int c = lane & 7;
#pragma unroll
    for (int j = 0; j < 4; ++j) { const int n = (lane >> 3) + 8 * j; const LAS float* s = scr + (8 * c) * 33 + n;
        u32x4 o; o.x = pk2(s[0 * 33], s[1 * 33]); o.y = pk2(s[2 * 33], s[3 * 33]); o.z = pk2(s[4 * 33], s[5 * 33]); o.w = pk2(s[6 * 33], s[7 * 33]);
        *(u32x4*)(dst + (size_t)n * K + k0 + 8 * c) = o; }
    asm volatile("s_waitcnt lgkmcnt(0)" ::: "memory");
}
struct Seg { const float* Wa; const float* Wb; int ldw, K, ngroups, colA0, colB0, cstep; bf16_t* dst; };
DI bool seg_run(const Seg& s, int& it, LAS float* scr, int lane) {
    const int nk = s.K / 64, n = s.ngroups * nk;
    if (it >= n) { it -= n; return false; }
    const int gi = it / nk, kb = it % nk;
    transpose_item(s.Wa + s.colA0 + gi * s.cstep, s.Wb + s.colB0 + gi * s.cstep, s.ldw, s.K, s.dst + (size_t)gi * 32 * s.K, kb * 64, scr, lane);
    return true;
}
DI void convert_weights(KP p, int l, LAS unsigned char* lds) {
    int tid_ = threadIdx.x; asm volatile("" : "+v"(tid_));
    const int wave = tid_ >> 6, lane = tid_ & 63;
    LAS float* scr = (LAS float*)(lds + wave * 8704);
    bf16_t* W = (bf16_t*)(p->ws + WS_W);
    const int gw = blockIdx.x * 8 + wave, NGW = gridDim.x * 8;
    constexpr int NITEMS = 2 * 176 * 16 + 2 * 32 * 44 + 128 * 16 + 96 * 16 + 3 * 32 * 8 + 32 * 16;
    for (int item = gw; item < NITEMS; item += NGW) {
        int it = item;
        bool done = false;
#pragma unroll
        for (int f = 0; f < 2 && !done; ++f) {
            const float* w1 = p->in[I_W1] + (size_t)(l * 2 + f) * DM * DFF; const float* w3 = p->in[I_W3] + (size_t)(l * 2 + f) * DM * DFF;
            Seg s{w1, w3, DFF, DM, 176, 0, 0, 16, W + WO_W13 + (size_t)f * 5632 * 1024};
            done = seg_run(s, it, scr, lane);
        }
#pragma unroll
        for (int f = 0; f < 2 && !done; ++f) {
            const float* w2 = p->in[I_W2] + (size_t)(l * 2 + f) * DFF * DM;
            Seg s{w2, w2, DM, DFF, 32, 0, 16, 32, W + WO_W2 + (size_t)f * 1024 * 2816};
            done = seg_run(s, it, scr, lane);
        }
        const float* win = p->in[I_WIN] + (size_t)l * DM * DIN;
        if (!done) { Seg s{win, win, DIN, DM, 72, 0, 16, 32, W + WO_WIN}; done = seg_run(s, it, scr, lane); }
        if (!done) { Seg s{win, win, DIN, DM, 56, 2320, 2336, 32, W + WO_WIN + (size_t)2304 * 1024}; done = seg_run(s, it, scr, lane); }
        if (!done) { Seg s{win, win, DIN, DM, 96, 4112, 4128, 32, W + WO_WG}; done = seg_run(s, it, scr, lane); }
#pragma unroll
        for (int f = 0; f < 3 && !done; ++f) {
            const float* wb = p->in[I_WBA + f] + (size_t)l * 512 * DM;
            Seg s{wb, wb, DM, 512, 32, 0, 16, 32, W + WO_WB + (size_t)f * 1024 * 512};
            done = seg_run(s, it, scr, lane);
        }
        if (!done) { const float* wo = p->in[I_WOUT] + (size_t)l * DM * DM; Seg s{wo, wo, DM, DM, 32, 0, 16, 32, W + WO_WOUT}; done = seg_run(s, it, scr, lane); }
    }
}

DI void mods_phase(KP p, LAS unsigned char* lds, int tid) {
    asm volatile("" : "+v"(tid));
    const int wave = tid >> 6, lane = tid & 63;
    LAS float* sc = (LAS float*)lds;
    LAS float* red = (LAS float*)(lds + 36864);
    for (int i = tid; i < 9 * 1024; i += 512) { const float v = (i < 8192) ? p->in[I_C][i] : p->in[I_CCTX][i - 8192]; sc[i] = v / (1.0f + expf(-v)); }
    __syncthreads();
    float* mod = (float*)(p->ws + WS_MOD);
    for (int it = blockIdx.x; it < 288; it += gridDim.x) {
        const int l = it / 144, cb = it % 144, col = cb * 64 + lane;
        const float* wp = p->in[I_WADA] + ((size_t)l * 1024 + wave * 128) * 9216 + col;
        float acc[9];
#pragma unroll
        for (int i = 0; i < 9; ++i) acc[i] = 0.f;
#pragma unroll 8
        for (int k = 0; k < 128; ++k) { const float wv = wp[(size_t)k * 9216];
#pragma unroll
            for (int i = 0; i < 9; ++i) acc[i] += sc[i * 1024 + wave * 128 + k] * wv; }
#pragma unroll
        for (int i = 0; i < 9; ++i) red[(wave * 9 + i) * 64 + lane] = acc[i];
        __syncthreads();
        for (int o = tid; o < 576; o += 512) { const int i = o >> 6, ln = o & 63; float s = 0.f;
#pragma unroll
            for (int w = 0; w < 8; ++w) s += red[(w * 9 + i) * 64 + ln];
            mod[((size_t)l * 9 + i) * 9216 + cb * 64 + ln] = s + p->in[I_BADA][(size_t)l * 9216 + cb * 64 + ln]; }
        __syncthreads();
    }
    if (blockIdx.x == gridDim.x - 1) {
        f32x2* tab = (f32x2*)(p->ws + WS_ROPE);
        for (int e = tid; e < 1024; e += 512) { const int pos = e >> 4, i = e & 15;
            const float inv = exp2f(-(float)i * (13.287712379549449f / 16.0f));
            const float a = (float)pos * inv; float rev = a * 0.15915494309189535f; rev -= floorf(rev);
            f32x2 cs; cs.x = __builtin_amdgcn_cosf(rev); cs.y = __builtin_amdgcn_sinf(rev); tab[e] = cs; }
    }
}

struct RowArgs {
    const float* xs_lat; const float* xs_ctx; float* xd_lat; float* xd_ctx;
    const bf16_t* Y; bf16_t* H; const float* mod; const float* modpre; const float* gpost; const float* gpre; const float* wgates; float* gates;
    int jpost, jpre, nrows; float wpost;
};
template <bool POST, bool PRE, bool GATES>
DI void row_phase(const RowArgs& a, LAS unsigned char* lds, int tid) {
    asm volatile("" : "+v"(tid));
    const int wave = tid >> 6, lane = tid & 63;
    LAS f32x4* wl = (LAS f32x4*)lds;
    if (GATES) {
        for (int idx = tid; idx < 1024 * 4; idx += 512) { const int k = idx >> 2, c4 = idx & 3; const int ln = (k & 255) >> 2, j = k >> 8, e = k & 3;
            wl[((j * 4 + e) * 4 + c4) * 64 + ln] = *(const f32x4*)(a.wgates + (size_t)k * DIN + 4 * c4); }
        __syncthreads();
    }
    for (int row = blockIdx.x * 8 + wave; row < a.nrows; row += gridDim.x * 8) {
        const int mi = row < MLAT ? (row >> 12) : 8;
        const float* md = a.mod + (size_t)mi * 9216;
        const float* mdp = a.modpre + (size_t)mi * 9216;
        const float* src = row < MLAT ? a.xs_lat + (size_t)row * DM : a.xs_ctx + (size_t)(row - MLAT) * DM;
        f32x4 x[4];
#pragma unroll
        for (int j = 0; j < 4; ++j) x[j] = *(const f32x4*)(src + 4 * lane + 256 * j);
        if (POST) {
            f32x4 y[4]; float s = 0.f;
#pragma unroll
            for (int j = 0; j < 4; ++j) { const u32x2 w = *(const u32x2*)(a.Y + (size_t)row * DM + 4 * lane + 256 * j);
                y[j] = (f32x4){bflo(w.x), bfhi(w.x), bflo(w.y), bfhi(w.y)}; s += (y[j][0] * y[j][0] + y[j][1] * y[j][1]) + (y[j][2] * y[j][2] + y[j][3] * y[j][3]); }
            const float rstd = 1.0f / sqrtf(wave_sum(s) * (1.0f / DM) + EPS);
            float* dst = row < MLAT ? a.xd_lat + (size_t)row * DM : a.xd_ctx + (size_t)(row - MLAT) * DM;
#pragma unroll
            for (int j = 0; j < 4; ++j) { const int c = 4 * lane + 256 * j;
                const f32x4 gt = *(const f32x4*)(md + (3 * a.jpost + 2) * DM + c), gp = *(const f32x4*)(a.gpost + c);
                x[j] = x[j] + a.wpost * gt * (y[j] * rstd * gp);
                *(f32x4*)(dst + c) = x[j]; }
        }
        if (PRE) {
            float s = 0.f;
#pragma unroll
            for (int j = 0; j < 4; ++j) s += (x[j][0] * x[j][0] + x[j][1] * x[j][1]) + (x[j][2] * x[j][2] + x[j][3] * x[j][3]);
            const float rstd = 1.0f / sqrtf(wave_sum(s) * (1.0f / DM) + EPS);
            f32x4 hv[4]; f32x4 g4[4];
#pragma unroll
            for (int c4 = 0; c4 < 4; ++c4) g4[c4] = (f32x4){0.f, 0.f, 0.f, 0.f};
#pragma unroll
            for (int j = 0; j < 4; ++j) { const int c = 4 * lane + 256 * j;
                const f32x4 sh = *(const f32x4*)(mdp + (3 * a.jpre) * DM + c), scl = *(const f32x4*)(mdp + (3 * a.jpre + 1) * DM + c), g = *(const f32x4*)(a.gpre + c);
                hv[j] = (x[j] * rstd * g) * (1.0f + scl) + sh;
                u32x2 w; w.x = pk2(hv[j][0], hv[j][1]); w.y = pk2(hv[j][2], hv[j][3]);
                *(u32x2*)(a.H + (size_t)row * DM + c) = w;
                if (GATES) {
#pragma unroll
                    for (int e = 0; e < 4; ++e)
#pragma unroll
                        for (int c4 = 0; c4 < 4; ++c4) g4[c4] += hv[j][e] * wl[((j * 4 + e) * 4 + c4) * 64 + lane];
                    asm volatile("" ::: "memory");
                } }
            if (GATES) {
#pragma unroll
                for (int c4 = 0; c4 < 4; ++c4)
#pragma unroll
                    for (int k = 0; k < 4; ++k) g4[c4][k] = wave_sum(g4[c4][k]);
                if (lane == 0) {
#pragma unroll
                    for (int c4 = 0; c4 < 4; ++c4) *(f32x4*)(a.gates + (size_t)row * 16 + 4 * c4) = g4[c4]; }
            }
        }
    }
    if (GATES) __syncthreads();
}

constexpr int RS = 144;
constexpr int AT_K = 0, AT_V = 9216, AT_TAB = 18432;
struct AttnArgs { const bf16_t* P; bf16_t* ATT; const float* sink; const f32x2* rope; };

DI void attn_item(const AttnArgs& A, int item, LAS unsigned char* lds, int tid) {
    asm volatile("" : "+v"(tid));
    const int w = tid >> 6, lane = tid & 63, r = lane & 31, hh = lane >> 5;
    const LAS f32x2* tab = (const LAS f32x2*)(lds + AT_TAB);
    int b, g, qb = 0, qrow0; bool lat;
    if (item < 512) { b = item >> 6; g = (item >> 5) & 1; qb = item & 31; lat = true; qrow0 = b * SEQ + qb * 128; }
    else { const int it = item - 512; b = it >> 2; g = (it >> 1) & 1; lat = false; qrow0 = MLAT + b * CTXL + (it & 1) * 128; }
    const int head = g * 4 + (w >> 1), qoff = (w & 1) * 64;
    bf16x8 qf[2][4];
#pragma unroll
    for (int qt = 0; qt < 2; ++qt) {
        const int ql = qoff + 32 * qt + r;
        const bf16_t* qp = A.P + pidx(qrow0 + ql, PC_AQ + head * 64 + 8 * hh);
        float x[4][8];
#pragma unroll
        for (int ks = 0; ks < 4; ++ks) { const u32x4 raw = *(const u32x4*)(qp + 16 * ks);
            x[ks][0] = bflo(raw.x); x[ks][1] = bfhi(raw.x); x[ks][2] = bflo(raw.y); x[ks][3] = bfhi(raw.y); x[ks][4] = bflo(raw.z); x[ks][5] = bfhi(raw.z); x[ks][6] = bflo(raw.w); x[ks][7] = bfhi(raw.w); }
        if (lat) {
            const int t = qb * 128 + ql;
#pragma unroll
            for (int pr = 0; pr < 2; ++pr) { const int pos = pr ? (t & 63) : (t >> 6);
#pragma unroll
                for (int j = 0; j < 8; ++j) { const f32x2 cs = tab[pos * 16 + 8 * hh + j]; const float x1 = x[2 * pr][j], x2 = x[2 * pr + 1][j];
                    x[2 * pr][j] = x1 * cs.x - x2 * cs.y; x[2 * pr + 1][j] = x2 * cs.x + x1 * cs.y; } }
        }
#pragma unroll
        for (int ks = 0; ks < 4; ++ks) qf[qt][ks] = pack8(x[ks][0] * 0.125f, x[ks][1] * 0.125f, x[ks][2] * 0.125f, x[ks][3] * 0.125f, x[ks][4] * 0.125f, x[ks][5] * 0.125f, x[ks][6] * 0.125f, x[ks][7] * 0.125f);
    }
    f32x16 O[2][2];
#pragma unroll
    for (int qt = 0; qt < 2; ++qt)
#pragma unroll
        for (int dt = 0; dt < 2; ++dt)
#pragma unroll
            for (int i = 0; i < 16; ++i) O[qt][dt][i] = 0.f;
    const float sk = A.sink[head];
    float m_run[2] = {sk, sk}, l_run[2];
    l_run[0] = l_run[1] = (hh == 0) ? 1.0f : 0.0f;
    const int ti_hi = (lat && qb == 31) ? 4 : 6;
    int ti = lat ? (qb == 0 ? 2 : 0) : 6;
    const int ss = tid >> 3, sc8 = tid & 7, half = sc8 >> 2, i0 = (sc8 & 3) * 4;
    u32x2 k1, k2; u32x4 vr;
#define ATT_LOAD(tix) do { const int krow_ = ((tix) < 6 ? b * SEQ + 128 * (qb - 1) + 64 * (tix) : MLAT + b * CTXL + 64 * ((tix) - 6)) + ss; \
        const bf16_t* kp_ = A.P + pidx(krow_, PC_AK); \
        k1 = *(const u32x2*)(kp_ + g * 64 + 32 * half + i0); k2 = *(const u32x2*)(kp_ + g * 64 + 32 * half + 16 + i0); \
        vr = *(const u32x4*)(kp_ + (PC_AV - PC_AK) + g * 64 + 8 * sc8); } while (0)
    ATT_LOAD(ti);
    for (;;) {
        {
            float a[4] = {bflo(k1.x), bfhi(k1.x), bflo(k1.y), bfhi(k1.y)}, c[4] = {bflo(k2.x), bfhi(k2.x), bflo(k2.y), bfhi(k2.y)};
            if (ti < 6) { const int kpos = 128 * (qb - 1) + 64 * ti + ss; const int pos = half ? (kpos & 63) : (kpos >> 6);
#pragma unroll
                for (int e = 0; e < 4; ++e) { const f32x2 cs = tab[pos * 16 + i0 + e]; const float x1 = a[e], x2 = c[e]; a[e] = x1 * cs.x - x2 * cs.y; c[e] = x2 * cs.x + x1 * cs.y; } }
            u32x2 o1, o2; o1.x = pk2(a[0], a[1]); o1.y = pk2(a[2], a[3]); o2.x = pk2(c[0], c[1]); o2.y = pk2(c[2], c[3]);
            *(LAS u32x2*)(lds + AT_K + ss * RS + (32 * half + i0) * 2) = o1;
            *(LAS u32x2*)(lds + AT_K + ss * RS + (32 * half + 16 + i0) * 2) = o2;
            const unsigned vv[4] = {vr.x, vr.y, vr.z, vr.w};
#pragma unroll
            for (int e = 0; e < 4; ++e) { *(LAS unsigned short*)(lds + AT_V + (8 * sc8 + 2 * e) * RS + ss * 2) = (unsigned short)(vv[e] & 0xffffu);
                *(LAS unsigned short*)(lds + AT_V + (8 * sc8 + 2 * e + 1) * RS + ss * 2) = (unsigned short)(vv[e] >> 16); }
        }
        LDS_BARRIER();
        const int tn = (ti < 6 && ti + 1 == ti_hi) ? 6 : ti + 1;
        if (tn < 10) ATT_LOAD(tn);
        f32x16 S[2][2];
#pragma unroll
        for (int st = 0; st < 2; ++st) {
            bf16x8 kf[4];
#pragma unroll
            for (int ks = 0; ks < 4; ++ks) kf[ks] = *(const LAS bf16x8*)(lds + AT_K + (32 * st + r) * RS + (16 * ks + 8 * hh) * 2);
#pragma unroll
            for (int qt = 0; qt < 2; ++qt) { f32x16 acc;
#pragma unroll
                for (int i = 0; i < 16; ++i) acc[i] = 0.f;
#pragma unroll
                for (int ks = 0; ks < 4; ++ks) acc = MFMA32(kf[ks], qf[qt][ks], acc);
                S[qt][st] = acc; }
        }
        if (ti < 2 || (ti >= 4 && ti < 6)) {
            const int kp0 = 128 * (qb - 1) + 64 * ti;
#pragma unroll
            for (int qt = 0; qt < 2; ++qt) { const int qpos = qb * 128 + qoff + 32 * qt + r;
#pragma unroll
                for (int st = 0; st < 2; ++st)
#pragma unroll
                    for (int i = 0; i < 16; ++i) { const int df = qpos - (kp0 + 32 * st + crow(i, hh)); if (df > 128 || df < -128) S[qt][st][i] = -INFINITY; } }
        }
#pragma unroll
        for (int qt = 0; qt < 2; ++qt) {
            float mx = S[qt][0][0];
#pragma unroll
            for (int st = 0; st < 2; ++st)
#pragma unroll
                for (int i = 0; i < 16; ++i) mx = fmaxf(mx, S[qt][st][i]);
            mx = fmaxf(mx, __shfl_xor(mx, 32));
            const float mn = fmaxf(m_run[qt], mx), scale = fexp(m_run[qt] - mn);
            m_run[qt] = mn; float ls = 0.f;
#pragma unroll
            for (int st = 0; st < 2; ++st)
#pragma unroll
                for (int i = 0; i < 16; ++i) { const float pv = fexp(S[qt][st][i] - mn); S[qt][st][i] = pv; ls += pv; }
            l_run[qt] = l_run[qt] * scale + ls;
#pragma unroll
            for (int dt = 0; dt < 2; ++dt)
#pragma unroll
                for (int i = 0; i < 16; ++i) O[qt][dt][i] *= scale;
        }
#pragma unroll
        for (int kk = 0; kk < 4; ++kk) { const int st = kk >> 1, s2 = kk & 1;
            bf16x8 pb[2];
#pragma unroll
            for (int qt = 0; qt < 2; ++qt) pb[qt] = pack8(S[qt][st][8 * s2 + 0], S[qt][st][8 * s2 + 1], S[qt][st][8 * s2 + 2], S[qt][st][8 * s2 + 3], S[qt][st][8 * s2 + 4], S[qt][st][8 * s2 + 5], S[qt][st][8 * s2 + 6], S[qt][st][8 * s2 + 7]);
#pragma unroll
            for (int dt = 0; dt < 2; ++dt) {
                const LAS unsigned char* vp = lds + AT_V + (32 * dt + r) * RS + (32 * st + 16 * s2 + 4 * hh) * 2;
                const s16x4 lo = *(const LAS s16x4*)vp, hi = *(const LAS s16x4*)(vp + 16);
                const bf16x8 va = __builtin_shufflevector(lo, hi, 0, 1, 2, 3, 4, 5, 6, 7);
#pragma unroll
                for (int qt = 0; qt < 2; ++qt) O[qt][dt] = MFMA32(va, pb[qt], O[qt][dt]);
            }
        }
        LDS_BARRIER();
        if (tn >= 10) break;
        ti = tn;
    }
#undef ATT_LOAD
#pragma unroll
    for (int qt = 0; qt < 2; ++qt) {
        const float l = l_run[qt] + __shfl_xor(l_run[qt], 32), inv = 1.0f / l;
        bf16_t* op = A.ATT + (size_t)(qrow0 + qoff + 32 * qt + r) * 512 + head * 64;
#pragma unroll
        for (int dt = 0; dt < 2; ++dt)
#pragma unroll
            for (int ig = 0; ig < 4; ++ig) { u32x2 wv; wv.x = pk2(O[qt][dt][4 * ig] * inv, O[qt][dt][4 * ig + 1] * inv); wv.y = pk2(O[qt][dt][4 * ig + 2] * inv, O[qt][dt][4 * ig + 3] * inv);
                *(u32x2*)(op + 32 * dt + 8 * ig + 4 * hh) = wv; }
    }
}

constexpr int SC_QS = 0, SC_KS = 9216, SC_QE = 18432, SC_UKT = 27648, SC_VT = 36864, SC_CBT = 55296, SC_F = 73728;
constexpr int SF_EB = 0, SF_QN = 256, SF_SSQ = 2304, SF_N = 3328, SF_DEC = 3840, SF_CONV = 4096, SF_GN = 5632, SF_CACHE = 6144;
struct ScanArgs { const bf16_t* P; bf16_t* OUT; const float* gates; const float* convw; const float* fbias; const float* gnorm; const float* lbl; int layer; };

template <bool IS_ML>
DI void scan_item(const ScanArgs& A, int b, int hd, const int dir, unsigned* prog_mine, unsigned* prog_other, LAS unsigned char* lds, int tid) {
    asm volatile("" : "+v"(tid));
    const int w = tid >> 6, lane = tid & 63, r = lane & 31, hh = lane >> 5;
    const int etile = w & 3, ttile = w >> 2, dtile = w >> 2;
    LAS float* F = (LAS float*)(lds + SC_F);
    LAS float* eb_s = F + SF_EB / 4; LAS float* qn_s = F + SF_QN / 4; LAS float* ssq_s = F + SF_SSQ / 4; LAS float* n_s = F + SF_N / 4; LAS float* dec_s = F + SF_DEC / 4; LAS float* conv_s = F + SF_CONV / 4;
    LAS float* gn_s = F + SF_GN / 4; LAS unsigned* cache_s = (LAS unsigned*)(F + SF_CACHE / 4);
    const int vcol = (IS_ML ? PC_MV : PC_HI) + hd * 128, gcol = (IS_ML ? PC_MO : PC_HG) + hd * 128;
    float lbv[8];
    __syncthreads();
    if (IS_ML) {
        if (tid < 384) { const int j = tid >> 6, d = tid & 63; conv_s[tid] = A.convw[(j % 3) * 512 + (j / 3) * 256 + hd * 64 + d]; }
    } else {
#pragma unroll
        for (int e = 0; e < 8; ++e) { const int c = hd * 64 + 8 * w + e; lbv[e] = (A.layer == 0) ? 0.f : 1.0f / (1.0f + expf(A.lbl[c] - A.lbl[256 + c])); }
    }
    if (tid < 128) { n_s[tid] = 0.f; gn_s[tid] = A.gnorm[hd * 128 + tid]; }
    if (tid == 0) cache_s[0] = 0u;
    f32x16 Cst;
#pragma unroll
    for (int i = 0; i < 16; ++i) Cst[i] = 0.f;
    float m_run = 0.f;
#pragma unroll
    for (int ig = 0; ig < 4; ++ig) *(LAS u32x2*)(lds + SC_CBT + (32 * etile + r) * RS + (32 * dtile + 8 * ig + 4 * hh) * 2) = (u32x2){0u, 0u};
    const float fb = IS_ML ? A.fbias[dir * 4 + hd] : 0.f;
    bool pending = false;
    u32x4 rq[3], rk[3], rv[2]; float rgi = 0.f, rgf = 0.f;
#define SC_ROWS(c_) const int cc_ = (c_) < 4 ? (dir ? 3 - (c_) : (c_)) : (dir ? 67 - (c_) : (c_) - 4); \
    const int slo_ = (c_) < 4 ? MLAT + b * CTXL : b * SEQ, slen_ = (c_) < 4 ? CTXL : SEQ; const int rb_ = slo_ + 64 * cc_;
#define SC_LOAD(c_) do { SC_ROWS(c_) const int ti_ = 64 * cc_ + (dir ? 63 - lane : lane); const int prow_ = slo_ + ti_; \
    if (IS_ML) { const u32x4 z4_ = (u32x4){0u, 0u, 0u, 0u}; \
        const bf16_t* pq_ = A.P + pidx(prow_, PC_MQ + hd * 64 + 8 * w); const bf16_t* pk_ = A.P + pidx(prow_, PC_MK + hd * 64 + 8 * w); rq[1] = *(const u32x4*)pq_; rk[1] = *(const u32x4*)pk_; \
        rq[0] = ti_ > 0 ? *(const u32x4*)(pq_ - 256) : z4_; rk[0] = ti_ > 0 ? *(const u32x4*)(pk_ - 256) : z4_; \
        rq[2] = ti_ + 1 < slen_ ? *(const u32x4*)(pq_ + 256) : z4_; rk[2] = ti_ + 1 < slen_ ? *(const u32x4*)(pk_ + 256) : z4_; \
        const float* gp_ = A.gates + (size_t)(slo_ + ti_) * 16; rgi = gp_[dir * 4 + hd]; rgf = gp_[8 + dir * 4 + hd]; \
    } else { rq[1] = *(const u32x4*)(A.P + pidx(prow_, PC_HQ + hd * 64 + 8 * w)); rk[1] = *(const u32x4*)(A.P + pidx(prow_, PC_HF + dir * 256 + hd * 64 + 8 * w)); } \
    { const bf16_t* pv_ = A.P + pidx(prow_, vcol + 16 * w); rv[0] = *(const u32x4*)pv_; rv[1] = *(const u32x4*)(pv_ + 8); } } while (0)
    SC_LOAD(0);
    __syncthreads();
#pragma unroll 1
    for (int c = 0; c < 68; ++c) {
        float ea = 1.f, wprev = 0.f, enm = 0.f, a_prev = 0.f;
        {
            const unsigned vv[8] = {rv[0].x, rv[0].y, rv[0].z, rv[0].w, rv[1].x, rv[1].y, rv[1].z, rv[1].w};
#pragma unroll
            for (int e = 0; e < 8; ++e) { *(LAS unsigned short*)(lds + SC_VT + (16 * w + 2 * e) * RS + lane * 2) = (unsigned short)(vv[e] & 0xffffu);
                *(LAS unsigned short*)(lds + SC_VT + (16 * w + 2 * e + 1) * RS + lane * 2) = (unsigned short)(vv[e] >> 16); }
        }
        if (IS_ML) {
            const float li = rgi, xf = rgf + fb;
            const float lf = fminf(xf, 0.f) - flog1p(fexp(-fabsf(xf)));
            float bc = lf;
#pragma unroll
            for (int off = 1; off < 64; off <<= 1) { const float v = __shfl_up(bc, off); if (lane >= off) bc += v; }
            const float beta = li - bc; float pm = beta;
#pragma unroll
            for (int off = 1; off < 64; off <<= 1) { const float v = __shfl_up(pm, off); if (lane >= off) pm = fmaxf(pm, v); }
            const float bl = __shfl(bc, 63), pmx = __shfl(pm, 63);
            const float mm = fmaxf(m_run, pm), mmx = fmaxf(m_run, pmx);
            ea = fexp(-mm); wprev = fexp(m_run - mm); enm = fexp(-(bc + mm));
            a_prev = fexp(m_run - mmx); const float u = fexp(beta - mmx);
            m_run = bl + mmx;
            if (w == 0) eb_s[lane] = fexp(fminf(beta, 80.f));
            float q8[8], k8[8];
            const unsigned q0[4] = {rq[0].x, rq[0].y, rq[0].z, rq[0].w}, q1[4] = {rq[1].x, rq[1].y, rq[1].z, rq[1].w}, q2[4] = {rq[2].x, rq[2].y, rq[2].z, rq[2].w};
            const unsigned k0[4] = {rk[0].x, rk[0].y, rk[0].z, rk[0].w}, k1[4] = {rk[1].x, rk[1].y, rk[1].z, rk[1].w}, k2[4] = {rk[2].x, rk[2].y, rk[2].z, rk[2].w};
            float cw[6][8];
#pragma unroll
            for (int j = 0; j < 6; ++j) { const f32x4 c0 = *(const LAS f32x4*)(conv_s + j * 64 + 8 * w), c1 = *(const LAS f32x4*)(conv_s + j * 64 + 8 * w + 4);
                cw[j][0] = c0[0]; cw[j][1] = c0[1]; cw[j][2] = c0[2]; cw[j][3] = c0[3]; cw[j][4] = c1[0]; cw[j][5] = c1[1]; cw[j][6] = c1[2]; cw[j][7] = c1[3]; }
#pragma unroll
            for (int e = 0; e < 4; ++e) {
                q8[2 * e] = fsilu(bflo(q0[e]) * cw[0][2 * e] + bflo(q1[e]) * cw[1][2 * e] + bflo(q2[e]) * cw[2][2 * e]);
                q8[2 * e + 1] = fsilu(bfhi(q0[e]) * cw[0][2 * e + 1] + bfhi(q1[e]) * cw[1][2 * e + 1] + bfhi(q2[e]) * cw[2][2 * e + 1]);
                k8[2 * e] = 0.125f * fsilu(bflo(k0[e]) * cw[3][2 * e] + bflo(k1[e]) * cw[4][2 * e] + bflo(k2[e]) * cw[5][2 * e]);
                k8[2 * e + 1] = 0.125f * fsilu(bfhi(k0[e]) * cw[3][2 * e + 1] + bfhi(k1[e]) * cw[4][2 * e + 1] + bfhi(k2[e]) * cw[5][2 * e + 1]); }
            *(LAS bf16x8*)(lds + SC_QS + lane * RS + 16 * w) = pack8(q8[0], q8[1], q8[2], q8[3], q8[4], q8[5], q8[6], q8[7]);
            *(LAS bf16x8*)(lds + SC_KS + lane * RS + 16 * w) = pack8(k8[0], k8[1], k8[2], k8[3], k8[4], k8[5], k8[6], k8[7]);
#pragma unroll
            for (int e = 0; e < 4; ++e) { const unsigned pkv = pk2(u * k8[2 * e], u * k8[2 * e + 1]);
                *(LAS unsigned short*)(lds + SC_UKT + (8 * w + 2 * e) * RS + lane * 2) = (unsigned short)(pkv & 0xffffu);
                *(LAS unsigned short*)(lds + SC_UKT + (8 * w + 2 * e + 1) * RS + lane * 2) = (unsigned short)(pkv >> 16); }
            const LAS float* nv = n_s + (c & 1) * 64 + 8 * w; const f32x4 n0 = *(const LAS f32x4*)nv, n1 = *(const LAS f32x4*)(nv + 4);
            qn_s[lane * 8 + w] = (q8[0] * n0[0] + q8[1] * n0[1] + q8[2] * n0[2] + q8[3] * n0[3]) + (q8[4] * n1[0] + q8[5] * n1[1] + q8[6] * n1[2] + q8[7] * n1[3]);
        } else {
            float x[8], kk[8], qs[8];
            const unsigned qr[4] = {rq[1].x, rq[1].y, rq[1].z, rq[1].w}, zr[4] = {rk[1].x, rk[1].y, rk[1].z, rk[1].w};
#pragma unroll
            for (int e = 0; e < 8; ++e) { const float z = (e & 1) ? bfhi(zr[e >> 1]) : bflo(zr[e >> 1]), qv = (e & 1) ? bfhi(qr[e >> 1]) : bflo(qr[e >> 1]);
                const float ez = fexp(-fabsf(z)), sg = (z >= 0.f ? 1.0f : ez) * __builtin_amdgcn_rcpf(1.0f + ez);
                const float lb = lbv[e], f = lb + (1.0f - lb) * sg;
                kk[e] = (1.0f - lb) * (1.0f - sg);
                x[e] = (lb > 0.f) ? flog(f) : (fminf(z, 0.f) - flog1p(ez));
                qs[e] = 0.125f * fsilu(qv); }
#pragma unroll
            for (int off = 1; off < 64; off <<= 1)
#pragma unroll
                for (int e = 0; e < 8; ++e) { const float v = __shfl_up(x[e], off); if (lane >= off) x[e] += v; }
            float qe[8], qt[8], kt[8], ku[8];
#pragma unroll
            for (int e = 0; e < 8; ++e) { const float bb = x[e];
                const float blv = __uint_as_float(__builtin_amdgcn_readlane(__float_as_uint(bb), 63)), ref = __uint_as_float(__builtin_amdgcn_readlane(__float_as_uint(bb), 31));
                qe[e] = qs[e] * fexp(bb); qt[e] = qs[e] * fexp(fminf(bb - ref, 60.f)); kt[e] = kk[e] * fexp(fminf(ref - bb, 60.f)); ku[e] = kk[e] * fexp(blv - bb);
                if (lane == 0) dec_s[8 * w + e] = fexp(blv); }
#pragma unroll
            for (int e = 0; e < 4; ++e) { const unsigned pkv = pk2(ku[2 * e], ku[2 * e + 1]);
                *(LAS unsigned short*)(lds + SC_UKT + (8 * w + 2 * e) * RS + lane * 2) = (unsigned short)(pkv & 0xffffu);
                *(LAS unsigned short*)(lds + SC_UKT + (8 * w + 2 * e + 1) * RS + lane * 2) = (unsigned short)(pkv >> 16); }
            *(LAS bf16x8*)(lds + SC_QE + lane * RS + 16 * w) = pack8(qe[0], qe[1], qe[2], qe[3], qe[4], qe[5], qe[6], qe[7]);
            *(LAS bf16x8*)(lds + SC_QS + lane * RS + 16 * w) = pack8(qt[0], qt[1], qt[2], qt[3], qt[4], qt[5], qt[6], qt[7]);
            *(LAS bf16x8*)(lds + SC_KS + lane * RS + 16 * w) = pack8(kt[0], kt[1], kt[2], kt[3], kt[4], kt[5], kt[6], kt[7]);
        }
        const bool first_role = (c < 2) || (c >= 4 && c < 36);
        if (pending && !first_role) {
            asm volatile("s_waitcnt vmcnt(0)" ::: "memory"); if (lane == 0) __hip_atomic_fetch_add(prog_mine, 1u, __ATOMIC_RELAXED, __HIP_MEMORY_SCOPE_AGENT); pending = false; }
        if (!first_role && tid == 0) {
            const int cp = (c < 4) ? 3 - c : 71 - c; const unsigned need = 8u * (unsigned)((cp < 2 ? cp : cp - 2) + 1);
            if (cache_s[0] < need) {
                unsigned v; unsigned spins = 0;
                for (;;) { v = __hip_atomic_load(prog_other, __ATOMIC_RELAXED, __HIP_MEMORY_SCOPE_AGENT); if (v >= need) break; __builtin_amdgcn_s_sleep(2); if (++spins > (1u << 24)) break; }
                __builtin_amdgcn_fence(__ATOMIC_ACQUIRE, "agent");
                asm volatile("s_waitcnt vmcnt(0)" ::: "memory");
                cache_s[0] = v;
            }
        }
        LDS_BARRIER();
        SC_ROWS(c)
        const int t = 32 * ttile + r;
        const int orow = rb_ + (dir ? 63 - t : t);
        bf16_t* op = A.OUT + (size_t)orow * 512 + hd * 128 + 32 * etile + 4 * hh;
        unsigned long long prevv[4]; u32x2 gwv[4];
        if (!first_role) {
            const bf16_t* gp = A.P + pidx(orow, gcol + 32 * etile + 4 * hh);
#pragma unroll
            for (int ig = 0; ig < 4; ++ig) { prevv[ig] = __hip_atomic_load((const unsigned long long*)(op + 8 * ig), __ATOMIC_RELAXED, __HIP_MEMORY_SCOPE_AGENT); gwv[ig] = *(const u32x2*)(gp + 8 * ig); }
        }
        if (c + 1 < 68) SC_LOAD(c + 1);
        bf16x8 qf[4];
#pragma unroll
        for (int ks = 0; ks < 4; ++ks) qf[ks] = *(const LAS bf16x8*)(lds + SC_QS + t * RS + (16 * ks + 8 * hh) * 2);
        f32x16 S[2];
#pragma unroll
        for (int st = 0; st < 2; ++st) { f32x16 acc;
#pragma unroll
            for (int i = 0; i < 16; ++i) acc[i] = 0.f;
#pragma unroll
            for (int ks = 0; ks < 4; ++ks) { const bf16x8 kf = *(const LAS bf16x8*)(lds + SC_KS + (32 * st + r) * RS + (16 * ks + 8 * hh) * 2); acc = MFMA32(kf, qf[ks], acc); }
            S[st] = acc; }
        float c1 = 1.0f, c2 = 1.0f;
        if (IS_ML) {
            const float ea_t = __shfl(ea, t), en_t = __shfl(enm, t), wprev_t = __shfl(wprev, t);
            float rs = 0.f;
#pragma unroll
            for (int st = 0; st < 2; ++st)
#pragma unroll
                for (int ig = 0; ig < 4; ++ig) { const f32x4 bt = *(const LAS f32x4*)(eb_s + 32 * st + 8 * ig + 4 * hh);
#pragma unroll
                    for (int k = 0; k < 4; ++k) { const int s = 32 * st + 8 * ig + 4 * hh + k; const float v = (s <= t) ? S[st][4 * ig + k] * bt[k] : 0.f; S[st][4 * ig + k] = v; rs += v; } }
            rs += __shfl_xor(rs, 32);
            const f32x4 qa = *(const LAS f32x4*)(qn_s + t * 8), qb4 = *(const LAS f32x4*)(qn_s + t * 8 + 4);
            const float qn = ((qa[0] + qa[1]) + (qa[2] + qa[3])) + ((qb4[0] + qb4[1]) + (qb4[2] + qb4[3]));
            const float den = wprev_t * qn + ea_t * rs;
            const float inv = 1.0f / fmaxf(fabsf(den), en_t);
            c1 = wprev_t * inv; c2 = ea_t * inv;
            {
                const bf16x8 uk = *(const LAS bf16x8*)(lds + SC_UKT + (8 * w + (lane >> 3)) * RS + 16 * (lane & 7));
                float sacc = ((bf1(uk[0]) + bf1(uk[1])) + (bf1(uk[2]) + bf1(uk[3]))) + ((bf1(uk[4]) + bf1(uk[5])) + (bf1(uk[6]) + bf1(uk[7])));
                sacc += __shfl_xor(sacc, 1); sacc += __shfl_xor(sacc, 2); sacc += __shfl_xor(sacc, 4);
                if ((lane & 7) == 0) n_s[((c + 1) & 1) * 64 + 8 * w + (lane >> 3)] = a_prev * n_s[(c & 1) * 64 + 8 * w + (lane >> 3)] + sacc;
            }
        } else {
#pragma unroll
            for (int st = 0; st < 2; ++st)
#pragma unroll
                for (int i = 0; i < 16; ++i) { const int s = 32 * st + crow(i, hh); if (s > t) S[st][i] = 0.f; }
        }
        f32x16 acc1;
#pragma unroll
        for (int i = 0; i < 16; ++i) acc1[i] = 0.f;
#pragma unroll
        for (int ks = 0; ks < 4; ++ks) { const bf16x8 ca = *(const LAS bf16x8*)(lds + SC_CBT + (32 * etile + r) * RS + (16 * ks + 8 * hh) * 2);
            const bf16x8 qb = IS_ML ? qf[ks] : *(const LAS bf16x8*)(lds + SC_QE + t * RS + (16 * ks + 8 * hh) * 2);
            acc1 = MFMA32(ca, qb, acc1); }
        f32x16 acc2;
        if (IS_ML) {
#pragma unroll
            for (int i = 0; i < 16; ++i) acc2[i] = 0.f;
        } else acc2 = acc1;
#pragma unroll
        for (int kk2 = 0; kk2 < 4; ++kk2) { const int st = kk2 >> 1, s2 = kk2 & 1;
            const LAS unsigned char* vp = lds + SC_VT + (32 * etile + r) * RS + (32 * st + 16 * s2 + 4 * hh) * 2;
            const s16x4 lo = *(const LAS s16x4*)vp, hi = *(const LAS s16x4*)(vp + 16);
            const bf16x8 va = __builtin_shufflevector(lo, hi, 0, 1, 2, 3, 4, 5, 6, 7);
            const bf16x8 pb = pack8(S[st][8 * s2 + 0], S[st][8 * s2 + 1], S[st][8 * s2 + 2], S[st][8 * s2 + 3], S[st][8 * s2 + 4], S[st][8 * s2 + 5], S[st][8 * s2 + 6], S[st][8 * s2 + 7]);
            acc2 = MFMA32(va, pb, acc2); }
        f32x16 hv;
        if (IS_ML) {
#pragma unroll
            for (int i = 0; i < 16; ++i) hv[i] = c1 * acc1[i] + c2 * acc2[i];
        } else hv = acc2;
        if (pending) {
            asm volatile("s_waitcnt vmcnt(0)" ::: "memory"); if (lane == 0) __hip_atomic_fetch_add(prog_mine, 1u, __ATOMIC_RELAXED, __HIP_MEMORY_SCOPE_AGENT); pending = false; }
        if (first_role) {
#pragma unroll
            for (int ig = 0; ig < 4; ++ig) { const unsigned lo_ = pk2(hv[4 * ig], hv[4 * ig + 1]), hi_ = pk2(hv[4 * ig + 2], hv[4 * ig + 3]);
                __hip_atomic_store((unsigned long long*)(op + 8 * ig), ((unsigned long long)hi_ << 32) | lo_, __ATOMIC_RELAXED, __HIP_MEMORY_SCOPE_AGENT); }
            pending = true;
        } else {
            float sq = 0.f;
#pragma unroll
            for (int ig = 0; ig < 4; ++ig) { const unsigned a0 = (unsigned)prevv[ig], a1 = (unsigned)(prevv[ig] >> 32);
                hv[4 * ig] += bflo(a0); hv[4 * ig + 1] += bfhi(a0); hv[4 * ig + 2] += bflo(a1); hv[4 * ig + 3] += bfhi(a1);
                sq += (hv[4 * ig] * hv[4 * ig] + hv[4 * ig + 1] * hv[4 * ig + 1]) + (hv[4 * ig + 2] * hv[4 * ig + 2] + hv[4 * ig + 3] * hv[4 * ig + 3]); }
            sq += __shfl_xor(sq, 32);
            if (hh == 0) ssq_s[etile * 64 + t] = sq;
            LDS_BARRIER();
            const float tot = (ssq_s[t] + ssq_s[64 + t]) + (ssq_s[128 + t] + ssq_s[192 + t]);
            const float rstd = 1.0f / sqrtf(tot * (1.0f / 128.0f) + EPS);
#pragma unroll
            for (int ig = 0; ig < 4; ++ig) { const f32x4 g4 = *(const LAS f32x4*)(gn_s + 32 * etile + 4 * hh + 8 * ig);
                const float g0 = bflo(gwv[ig].x), g1 = bfhi(gwv[ig].x), g2 = bflo(gwv[ig].y), g3 = bfhi(gwv[ig].y);
                const float o0 = hv[4 * ig] * rstd * g4[0] * (IS_ML ? fsigmoid(g0) : fsilu(g0)), o1 = hv[4 * ig + 1] * rstd * g4[1] * (IS_ML ? fsigmoid(g1) : fsilu(g1));
                const float o2 = hv[4 * ig + 2] * rstd * g4[2] * (IS_ML ? fsigmoid(g2) : fsilu(g2)), o3 = hv[4 * ig + 3] * rstd * g4[3] * (IS_ML ? fsigmoid(g3) : fsilu(g3));
                u32x2 wv; wv.x = pk2(o0, o1); wv.y = pk2(o2, o3); *(u32x2*)(op + 8 * ig) = wv; }
        }
        if (IS_ML) {
#pragma unroll
            for (int i = 0; i < 16; ++i) Cst[i] *= a_prev;
        } else {
#pragma unroll
            for (int ig = 0; ig < 4; ++ig) { const f32x4 dv = *(const LAS f32x4*)(dec_s + 32 * dtile + 8 * ig + 4 * hh);
#pragma unroll
                for (int k = 0; k < 4; ++k) Cst[4 * ig + k] *= dv[k]; }
        }
#pragma unroll
        for (int ks = 0; ks < 4; ++ks) { const bf16x8 ua = *(const LAS bf16x8*)(lds + SC_UKT + (32 * dtile + r) * RS + (16 * ks + 8 * hh) * 2);
            const bf16x8 vb = *(const LAS bf16x8*)(lds + SC_VT + (32 * etile + r) * RS + (16 * ks + 8 * hh) * 2);
            Cst = MFMA32(ua, vb, Cst); }
        LDS_BARRIER();
#pragma unroll
        for (int ig = 0; ig < 4; ++ig) { u32x2 wv; wv.x = pk2(Cst[4 * ig], Cst[4 * ig + 1]); wv.y = pk2(Cst[4 * ig + 2], Cst[4 * ig + 3]);
            *(LAS u32x2*)(lds + SC_CBT + (32 * etile + r) * RS + (32 * dtile + 8 * ig + 4 * hh) * 2) = wv; }
    }
    if (pending) { asm volatile("s_waitcnt vmcnt(0)" ::: "memory"); if (lane == 0) __hip_atomic_fetch_add(prog_mine, 1u, __ATOMIC_RELAXED, __HIP_MEMORY_SCOPE_AGENT); }
#undef SC_LOAD
#undef SC_ROWS
    __syncthreads();
}
#ifndef PH
#define PH 0xffff
#endif

DI void mix_phase(KP p, int l, LAS unsigned char* lds, int tid) {
    asm volatile("" : "+v"(tid));
    const int G = gridDim.x, bid = blockIdx.x;
    const bf16_t* P = (const bf16_t*)(p->ws + WS_P);
    bf16_t* ATT = (bf16_t*)(p->ws + WS_S); bf16_t* MLB = ATT + (size_t)MTOT * 512; bf16_t* HGB = MLB + (size_t)MTOT * 512;
    const int nattn = 512 + (l == 0 ? 32 : 0);
    if (bid < 128) {
        const int it = bid, dir = it & 1, hd = (it >> 1) & 3, b = (it >> 3) & 7, ty = it >> 6;
        unsigned* prog = (unsigned*)p->ws + (l * 128 + (it & ~1)) * 16;
        if (ty == 0) { ScanArgs A{P, MLB, (const float*)(p->ws + WS_GATES), p->in[I_MLCONV] + (size_t)l * 3 * 512, p->in[I_MLFB] + l * 8, p->in[I_MLNORM] + l * 512, p->in[I_HGLB], l};
#ifndef NO_SCANML
            scan_item<true>(A, b, hd, dir, prog + dir * 16, prog + (dir ^ 1) * 16, lds, tid);
#endif
        } else { ScanArgs A{P, HGB, (const float*)(p->ws + WS_GATES), p->in[I_MLCONV], p->in[I_MLFB], p->in[I_HGNORM] + l * 512, p->in[I_HGLB], l};
#ifndef NO_SCANHG
            scan_item<false>(A, b, hd, dir, prog + dir * 16, prog + (dir ^ 1) * 16, lds, tid);
#endif
        }
    }
    if (bid >= 128) {
        __syncthreads();
        const f32x2* rope = (const f32x2*)(p->ws + WS_ROPE);
        for (int i = tid; i < 1024; i += 512) ((LAS f32x2*)(lds + AT_TAB))[i] = rope[i];
        __syncthreads();
        AttnArgs A{P, ATT, p->in[I_SINK] + l * 8, rope};
        for (int it = bid - 128; it < nattn; it += G - 128) {
#ifndef NO_ATTN
 attn_item(A, it, lds, tid);
#endif
 }
    }
}

template <class Epi> DI void run_gemm(LAS unsigned char* lds, const bf16_t* A, const bf16_t* Bt, int M, int N, int K, const Epi& E) {
    pg8::Gemm g{A, Bt, M, N, K}; pg8::StaticOrder S; S.init(M, N, (int)gridDim.x, (int)blockIdx.x);
    pg8::gemm_phase<Epi, pg8::StaticOrder, true, true>(lds, g, S, E);
}

__global__ void __launch_bounds__(512) fwd_kernel(Params p_unused) {
    extern __shared__ __attribute__((aligned(16))) unsigned char lds_raw[];
    LAS unsigned char* lds = (LAS unsigned char*)lds_raw;
    cg::grid_group grid = cg::this_grid();
#define tid ((int)threadIdx.x)
#define ws (kparams()->ws)
#define W ((bf16_t*)(ws + WS_W))
#define H ((bf16_t*)(ws + WS_H))
#define PB ((bf16_t*)(ws + WS_P))
#define SB ((bf16_t*)(ws + WS_S))
#define XC ((float*)(ws + WS_XC))
#define mod ((const float*)(ws + WS_MOD))
#define gates ((float*)(ws + WS_GATES))
    KP p = kparams();

#if PH & 1
    convert_weights(p, 0, lds);
    __syncthreads();
    mods_phase(p, lds, tid);
#endif
    grid.sync();
    {
        RowArgs a{p->in[I_X], p->in[I_CTX], nullptr, nullptr, nullptr, H, mod, mod, nullptr, p->in[I_NPRE], nullptr, nullptr, 0, 0, MTOT, 0.f};
#if PH & 2
        row_phase<false, true, false>(a, lds, tid);
#endif
    }
    grid.sync();

#pragma unroll 1
    for (int l = 0; l < 2; ++l) {
        p = kparams();
        const float* modl = mod + (size_t)l * 9 * 9216;
        const float* npre = p->in[I_NPRE] + (size_t)l * 3 * DM; const float* npost = p->in[I_NPOST] + (size_t)l * 3 * DM;
        const int M2 = (l == 1) ? MLAT : MTOT;
#if PH & 4
        { pg8::EpiSwiGLU E{PB, DFF}; run_gemm(lds, H, W + WO_W13, MTOT, 5632, DM, E); }
#endif
        grid.sync();
#if PH & 8
        { pg8::EpiBf16<0> E{SB, DM, 0}; run_gemm(lds, PB, W + WO_W2, MTOT, DM, DFF, E); }
#endif
        grid.sync();
        {
            RowArgs a{l == 0 ? p->in[I_X] : p->out, l == 0 ? p->in[I_CTX] : XC, p->out, XC, SB, H, modl, modl, npost, npre + DM, p->in[I_WIN] + (size_t)l * DM * DIN + 2304, gates, 0, 1, MTOT, 0.5f};
#if PH & 16
            row_phase<true, true, true>(a, lds, tid);
#endif
        }
        grid.sync();
#if PH & 32
        { pg8::EpiBf16<0> E{PB, 256, PTS}; run_gemm(lds, H, W + WO_WIN, MTOT, NPC, DM, E); }
#endif
        grid.sync();
#if PH & 64
        mix_phase(p, l, lds, tid);
#endif
        grid.sync();
#if PH & 128
        { pg8::EpiBf16<1> E{PB, NGC, 0}; run_gemm(lds, H, W + WO_WG, M2, NGC, DM, E); }
#endif
        grid.sync();
#if PH & 256
#pragma unroll 1
        for (int gi = 0; gi < 3; ++gi) { pg8::EpiMerge E{H, PB, gi}; run_gemm(lds, SB + (size_t)gi * MTOT * 512, W + WO_WB + (size_t)gi * 1024 * 512, M2, DM, 512, E); }
#endif
        grid.sync();
#if PH & 512
        { pg8::EpiBf16<0> E{SB, DM, 0}; run_gemm(lds, H, W + WO_WOUT, M2, DM, DM, E); }
#endif
        grid.sync();
        {
            RowArgs a{p->out, XC, p->out, XC, SB, H, modl, modl, npost + DM, npre + 2 * DM, nullptr, nullptr, 1, 2, M2, 1.0f};
#if PH & 1024
            row_phase<true, true, false>(a, lds, tid);
#endif
        }
        grid.sync();
#if PH & 2048
        { pg8::EpiSwiGLU E{PB, DFF}; run_gemm(lds, H, W + WO_W13 + (size_t)5632 * 1024, M2, 5632, DM, E); }
#endif
        grid.sync();
#if PH & 4096
        { pg8::EpiBf16<0> E{SB, DM, 0}; run_gemm(lds, PB, W + WO_W2 + (size_t)1024 * 2816, M2, DM, DFF, E); }
#endif
        grid.sync();
        if (l == 0) {
            RowArgs a{p->out, XC, p->out, XC, SB, H, modl, mod + (size_t)9 * 9216, npost + 2 * DM, p->in[I_NPRE] + 3 * DM, nullptr, nullptr, 2, 0, MTOT, 0.5f};
#if PH & 8192
            row_phase<true, true, false>(a, lds, tid);
            __syncthreads();
            convert_weights(p, 1, lds);
#endif
            grid.sync();
        } else {
            RowArgs a{p->out, XC, p->out, XC, SB, H, modl, modl, npost + 2 * DM, nullptr, nullptr, nullptr, 2, 0, MLAT, 0.5f};
#if PH & 16384
            row_phase<true, false, false>(a, lds, tid);
#endif
        }
    }
#undef tid
#undef ws
#undef W
#undef H
#undef PB
#undef SB
#undef XC
#undef mod
#undef gates
}

extern "C" void kernel_launch(void* const* d_in, const int* in_sizes, int n_in, void* d_out, int out_size, void* d_ws, size_t ws_size, hipStream_t stream) {
    static int grid = 0;
    if (grid == 0) {
        if (n_in != 22 || out_size != MLAT * DM || ws_size < WS_END) { fprintf(stderr, "kernel_launch: unexpected shapes (n_in %d out %d ws %zu)\n", n_in, out_size, ws_size); grid = -1; return; }
        int dev = 0, cus = 0, per_cu = 0;
        (void)hipGetDevice(&dev);
        (void)hipDeviceGetAttribute(&cus, hipDeviceAttributeMultiprocessorCount, dev);
        (void)hipFuncSetAttribute((const void*)fwd_kernel, hipFuncAttributeMaxDynamicSharedMemorySize, LDS_BYTES);
        (void)hipOccupancyMaxActiveBlocksPerMultiprocessor(&per_cu, (const void*)fwd_kernel, 512, LDS_BYTES);
        if (per_cu < 1) per_cu = 1;
        if (per_cu > 1) per_cu = 1;
        grid = cus * per_cu;
        if (grid <= 0) grid = 256;
    }
    if (grid < 0) return;
    if (grid < 192) { fprintf(stderr, "kernel_launch: grid %d too small for the paired scans\n", grid); return; }
    (void)hipMemsetAsync(d_ws, 0, 65536, stream);
    Params p{};
    for (int i = 0; i < 22; ++i) p.in[i] = (const float*)d_in[i];
    p.out = (float*)d_out; p.ws = (unsigned char*)d_ws;
    void* args[] = {&p};
    hipError_t e = hipLaunchCooperativeKernel((const void*)fwd_kernel, dim3(grid), dim3(512), args, LDS_BYTES, stream);
    if (e != hipSuccess) fprintf(stderr, "cooperative launch failed: %s (grid %d)\n", hipGetErrorString(e), grid);
}
```

```cpp
#include <hip/hip_runtime.h>
#include <hip/hip_cooperative_groups.h>
#include <cstdio>
#include <cstdint>
namespace cg = cooperative_groups;

#define DI __device__ __forceinline__
#define LAS __attribute__((address_space(3)))
typedef unsigned short bf16_t;
typedef short bf16x8 __attribute__((ext_vector_type(8)));
typedef short s16x4 __attribute__((ext_vector_type(4)));
typedef float f32x2 __attribute__((ext_vector_type(2)));
typedef float f32x4 __attribute__((ext_vector_type(4)));
typedef float f32x16 __attribute__((ext_vector_type(16)));
typedef unsigned u32x2 __attribute__((ext_vector_type(2)));
typedef unsigned u32x4 __attribute__((ext_vector_type(4)));

constexpr int DM = 1024, NB = 8, SEQ = 4096, CTXL = 256, DFF = 2816, DIN = 7184, NMOD = 9;
constexpr int MLAT = NB * SEQ, MCTX = NB * CTXL, MTOT = MLAT + MCTX;
constexpr int NPC = 4096;
constexpr int NGC = 3072;
constexpr float EPS = 1e-6f;
constexpr int PC_AQ = 0, PC_AK = 512, PC_AV = 640, PC_MQ = 768, PC_MK = 1024, PC_MV = 1280, PC_MO = 1792, PC_HQ = 2304, PC_HF = 2560, PC_HI = 3072, PC_HG = 3584;

constexpr size_t MiB = 1u << 20;
constexpr size_t WS_MOD = 1 * MiB;
constexpr size_t WS_ROPE = 2 * MiB;
constexpr size_t WS_GATES = 3 * MiB;
constexpr size_t WS_XC = 6 * MiB;
constexpr size_t WS_W = 14 * MiB;
constexpr size_t WS_H = 66 * MiB;
constexpr size_t WS_P = 134 * MiB;
constexpr size_t WS_S = 406 * MiB;
constexpr size_t WS_END = 508 * MiB;
constexpr size_t WO_W13 = 0;
constexpr size_t WO_W2 = WO_W13 + (size_t)2 * 5632 * 1024;
constexpr size_t WO_WIN = WO_W2 + (size_t)2 * 1024 * 2816;
constexpr size_t WO_WG = WO_WIN + (size_t)4096 * 1024;
constexpr size_t WO_WB = WO_WG + (size_t)3072 * 1024;
constexpr size_t WO_WOUT = WO_WB + (size_t)3 * 1024 * 512;
constexpr size_t WO_END = WO_WOUT + (size_t)1024 * 1024;
static_assert(WO_END * 2 <= 52 * MiB, "weights fit");
static_assert((size_t)MTOT * 1024 * 2 <= 68 * MiB && (size_t)MTOT * 4096 * 2 <= 272 * MiB && (size_t)MTOT * 512 * 2 * 3 <= 102 * MiB, "ws map");

constexpr int LDS_BYTES = 131072 + 64;
constexpr size_t PTS = (size_t)MTOT * 256;
__device__ __forceinline__ size_t pidx(int row, int col) { return (size_t)(col >> 8) * PTS + (size_t)row * 256 + (col & 255); }

DI unsigned f2bf(float f) { unsigned u = __float_as_uint(f); return (u + 0x7fffu + ((u >> 16) & 1u)) >> 16; }
typedef __bf16 bf16v2 __attribute__((ext_vector_type(2)));
DI unsigned pk2(float lo, float hi) { f32x2 v = {lo, hi}; bf16v2 b = __builtin_convertvector(v, bf16v2); return __builtin_bit_cast(unsigned, b); }
DI float bflo(unsigned w) { return __uint_as_float(w << 16); }
DI float bfhi(unsigned w) { return __uint_as_float(w & 0xffff0000u); }
DI float bf1(short s) { return __uint_as_float(((unsigned)(unsigned short)s) << 16); }
DI float fexp(float x) { return __builtin_amdgcn_exp2f(x * 1.4426950408889634f); }
DI float flog(float x) { return __builtin_amdgcn_logf(x) * 0.6931471805599453f; }
DI float flog1p(float e) { const float u = 1.0f + e, d = u - 1.0f; return d == 0.f ? e : flog(u) * e * __builtin_amdgcn_rcpf(d); }
DI float fsigmoid(float x) { return __builtin_amdgcn_rcpf(1.0f + fexp(-x)); }
DI float fsilu(float x) { return x * fsigmoid(x); }
DI float wave_sum(float v) {
#pragma unroll
    for (int o = 1; o < 64; o <<= 1) v += __shfl_xor(v, o);
    return v;
}
DI bf16x8 pack8(float a0, float a1, float a2, float a3, float a4, float a5, float a6, float a7) {
    u32x4 p; p.x = pk2(a0, a1); p.y = pk2(a2, a3); p.z = pk2(a4, a5); p.w = pk2(a6, a7); return __builtin_bit_cast(bf16x8, p);
}
#define MFMA32(a, b, c) __builtin_amdgcn_mfma_f32_32x32x16_bf16((a), (b), (c), 0, 0, 0)
DI int crow(int i, int h) { return (i & 3) + 8 * (i >> 2) + 4 * h; }

#define LDS_BARRIER() do { asm volatile("s_waitcnt lgkmcnt(0)" ::: "memory"); __builtin_amdgcn_s_barrier(); asm volatile("" ::: "memory"); } while (0)
namespace pg8 {
#define PG8_LAS __attribute__((address_space(3)))
typedef unsigned short bf16_t;
typedef short bf16x8 __attribute__((ext_vector_type(8)));
typedef float f32x4 __attribute__((ext_vector_type(4)));
typedef unsigned u32x4 __attribute__((ext_vector_type(4)));
constexpr int BM = 256, BK = 64, HALF = 128, HTB = HALF * BK * 2  , STAGE_BYTES = 8 * HTB, NXCD = 8, WGM = 8;

__host__ __device__ __forceinline__ int lds_byte(int r, int c) { const int st = (r >> 4) * 2 + (c >> 5), rr = r & 15, cc = c & 31, ob = rr * 64 + cc * 2; return st * 1024 + (ob ^ (((ob >> 9) & 1) << 5)); }
__host__ __device__ __forceinline__ void stage_rc(int b, int& R, int& C) { const int st = b / 1024, sb = b % 1024, swz = sb ^ (((sb >> 9) & 1) << 5); R = (st >> 1) * 16 + swz / 64; C = (st & 1) * 32 + (swz % 64) / 2; }
__host__ __device__ __forceinline__ int perm32(int rho) { const int n = rho >> 4, i = rho & 15; return 8 * (i >> 2) + 4 * n + (i & 3); }

struct Unit { int pm, pn; };
struct Gemm { const bf16_t* A; const bf16_t* Bt; int M, N, K; };

struct StaticOrder {
    int nM, nN, nwg, G, c;
    __host__ __device__ void init(int M, int N, int G_, int c_) { nM = M / BM; nN = N / BM; nwg = nM * nN; G = G_; c = c_; }
    __host__ __device__ bool next(int i, Unit& u) const {
        const long L = (long)i * G + c; if (L >= nwg) return false;
        int wgid = (int)L; { const int q = nwg / NXCD, r = nwg % NXCD, xcd = wgid % NXCD, off = wgid / NXCD; wgid = (xcd < r ? xcd * (q + 1) : r * (q + 1) + (xcd - r) * q) + off; }
        const int nig = WGM * nN, gid = wgid / nig, fm = gid * WGM, gsz = (nM - fm) < WGM ? (nM - fm) : WGM;
        u.pm = fm + ((wgid % nig) % gsz); u.pn = (wgid % nig) / gsz; return true;
    }
    __device__ __forceinline__ void a_ready(const Unit&) const {}
    __device__ __forceinline__ void done(const Unit&) const {}
};

template <int ACT  > struct EpiBf16 {
    static constexpr bool PERM = true, AFTER_DRAIN = false;
    bf16_t* O; int ldc; size_t tstride;
    __device__ __forceinline__ void operator()(const f32x4 (&acc)[2][2][4][2], const Unit& u, int wr, int wc, int fr, int fq) const {
        const int row0 = u.pm * BM + wr * 64 + fr, col0 = (tstride ? 0 : u.pn * BM) + wc * 32 + 8 * fq;
        bf16_t* Ob = O + (size_t)u.pn * tstride;
#pragma unroll
        for (int ai = 0; ai < 2; ++ai)
#pragma unroll
            for (int m = 0; m < 4; ++m) { bf16_t* rowp = Ob + (size_t)(row0 + ai * HALF + m * 16) * ldc + col0;
#pragma unroll
                for (int bj = 0; bj < 2; ++bj) { f32x4 v0 = acc[ai][bj][m][0], v1 = acc[ai][bj][m][1];
                    if (ACT == 1) {
#pragma unroll
                        for (int k = 0; k < 4; ++k) { v0[k] = fsigmoid(v0[k]); v1[k] = fsigmoid(v1[k]); } }
                    u32x4 w; w.x = pk2(v0[0], v0[1]); w.y = pk2(v0[2], v0[3]); w.z = pk2(v1[0], v1[1]); w.w = pk2(v1[2], v1[3]);
                    *(u32x4*)(rowp + bj * HALF) = w; } }
    }
};
struct EpiSwiGLU {
    static constexpr bool PERM = false, AFTER_DRAIN = false;
    bf16_t* O; int ldc;
    __device__ __forceinline__ void operator()(const f32x4 (&acc)[2][2][4][2], const Unit& u, int wr, int wc, int fr, int fq) const {
        const int row0 = u.pm * BM + wr * 64 + fr, f0 = u.pn * 128 + wc * 16 + 4 * fq;
#pragma unroll
        for (int ai = 0; ai < 2; ++ai)
#pragma unroll
            for (int m = 0; m < 4; ++m) { bf16_t* rowp = O + (size_t)(row0 + ai * HALF + m * 16) * ldc + f0;
#pragma unroll
                for (int bj = 0; bj < 2; ++bj) { const f32x4 a = acc[ai][bj][m][0], b = acc[ai][bj][m][1];
                    u32x2 w; w.x = pk2(fsilu(a[0]) * b[0], fsilu(a[1]) * b[1]); w.y = pk2(fsilu(a[2]) * b[2], fsilu(a[3]) * b[3]);
                    *(u32x2*)(rowp + bj * 64) = w; } }
    }
};
struct EpiMerge {
    static constexpr bool PERM = true, AFTER_DRAIN = false;
    bf16_t* O; const bf16_t* G; int gi;
    __device__ __forceinline__ void operator()(const f32x4 (&acc)[2][2][4][2], const Unit& u, int wr, int wc, int fr, int fq) const {
        const int row0 = u.pm * BM + wr * 64 + fr, col0 = u.pn * BM + wc * 32 + 8 * fq;
#pragma unroll
        for (int ai = 0; ai < 2; ++ai)
#pragma unroll
            for (int m = 0; m < 4; ++m) { const size_t r = (size_t)(row0 + ai * HALF + m * 16);
#pragma unroll
                for (int bj = 0; bj < 2; ++bj) { const int c = col0 + bj * HALF;
                    const u32x4 g = *(const u32x4*)(G + r * 3072 + gi * 1024 + c);
                    const f32x4 v0 = acc[ai][bj][m][0], v1 = acc[ai][bj][m][1];
                    float o0 = bflo(g.x) * v0[0], o1 = bfhi(g.x) * v0[1], o2 = bflo(g.y) * v0[2], o3 = bfhi(g.y) * v0[3];
                    float o4 = bflo(g.z) * v1[0], o5 = bfhi(g.z) * v1[1], o6 = bflo(g.w) * v1[2], o7 = bfhi(g.w) * v1[3];
                    bf16_t* op = O + r * 1024 + c;
                    if (gi > 0) {
                        const unsigned long long p0 = __hip_atomic_load((const unsigned long long*)op, __ATOMIC_RELAXED, __HIP_MEMORY_SCOPE_AGENT);
                        const unsigned long long p1 = __hip_atomic_load((const unsigned long long*)op + 1, __ATOMIC_RELAXED, __HIP_MEMORY_SCOPE_AGENT);
                        const unsigned a0 = (unsigned)p0, a1 = (unsigned)(p0 >> 32), a2 = (unsigned)p1, a3 = (unsigned)(p1 >> 32);
                        o0 += bflo(a0); o1 += bfhi(a0); o2 += bflo(a1); o3 += bfhi(a1); o4 += bflo(a2); o5 += bfhi(a2); o6 += bflo(a3); o7 += bfhi(a3);
                    }
                    u32x4 w; w.x = pk2(o0, o1); w.y = pk2(o2, o3); w.z = pk2(o4, o5); w.w = pk2(o6, o7);
                    *(u32x4*)op = w; } }
    }
};

template <class Epi, class Sched, bool ALIGN_EPI = false, bool SP2 = false>
__device__ __forceinline__ void gemm_phase(PG8_LAS unsigned char* lds, const Gemm g, const Sched& S, const Epi& E) {
    int tid_ = threadIdx.x; asm volatile("" : "+v"(tid_));
    const int tid = tid_, wid = __builtin_amdgcn_readfirstlane(tid >> 6), lane = tid & 63, wr = wid >> 2, wc = wid & 3, fr = lane & 15, fq = lane >> 4;
    const int K = g.K, nt = K / BK;
    unsigned voffA[2], voffB[2];
#pragma unroll
    for (int i = 0; i < 2; ++i) { int R, C; stage_rc(tid * 16 + i * 8192, R, C); const int Rb = Epi::PERM ? ((R & ~31) + perm32(R & 31)) : R;
        voffA[i] = (unsigned)(R * K + C) * 2u; voffB[i] = (unsigned)(Rb * K + C) * 2u; }
    const size_t kstep = (size_t)(BK * 2);
    const size_t hstep = (size_t)HALF * K * 2;
    const size_t tstep = 2 * hstep;
    const unsigned ldsw = (unsigned)wid * 1024u;
    const int aoff = lds_byte(wr * 64 + fr, fq * 8), boff = lds_byte(wc * 32 + fr, fq * 8);
#define PG8_SA(b, h) (((b) * 2 + (h)) * HTB)
#define PG8_SB(b, h) ((4 + (b) * 2 + (h)) * HTB)
#define PG8_STAGE(bufoff, gbase, voff) do { _Pragma("unroll") for (int _i = 0; _i < 2; ++_i) \
        __builtin_amdgcn_global_load_lds((const unsigned*)((const char*)(gbase) + (voff)[_i]), (PG8_LAS unsigned*)(lds + (bufoff) + ldsw + _i * 8192), 16, 0, 0); } while (0)
#define PG8_LDA(dst, b, h) do { _Pragma("unroll") for (int m = 0; m < 4; ++m) _Pragma("unroll") for (int k = 0; k < 2; ++k) dst[m][k] = *(const PG8_LAS bf16x8*)(lds + PG8_SA(b, h) + aoff + m * 2048 + k * 1024); } while (0)
#define PG8_LDB(dst, b, h) do { _Pragma("unroll") for (int n = 0; n < 2; ++n) _Pragma("unroll") for (int k = 0; k < 2; ++k) dst[n][k] = *(const PG8_LAS bf16x8*)(lds + PG8_SB(b, h) + boff + n * 2048 + k * 1024); } while (0)
#define PG8_MMA(ai, bj, At, Bt) do { __builtin_amdgcn_s_setprio(1); _Pragma("unroll") for (int m = 0; m < 4; ++m) _Pragma("unroll") for (int n = 0; n < 2; ++n) _Pragma("unroll") for (int k = 0; k < 2; ++k) \
        acc[ai][bj][m][n] = __builtin_amdgcn_mfma_f32_16x16x32_bf16(Bt[n][k], At[m][k], acc[ai][bj][m][n], 0, 0, 0); __builtin_amdgcn_s_setprio(0); } while (0)
#define PG8_WAIT_V(n) asm volatile("s_waitcnt vmcnt(" #n ")" ::: "memory")
#define PG8_WAIT_L(n) asm volatile("s_waitcnt lgkmcnt(" #n ")" ::: "memory")
#define PG8_BAR __builtin_amdgcn_s_barrier()
#define PG8_SCHED __builtin_amdgcn_sched_barrier(0)
    Unit cur, nxt; int ui = 0;
    if (!S.next(0, cur)) return;
    f32x4 acc[2][2][4][2];
#pragma unroll
    for (int a = 0; a < 2; ++a)
#pragma unroll
        for (int b = 0; b < 2; ++b)
#pragma unroll
            for (int m = 0; m < 4; ++m)
#pragma unroll
                for (int n = 0; n < 2; ++n) acc[a][b][m][n] = (f32x4){0.f, 0.f, 0.f, 0.f};
    bf16x8 At[4][2], B0[2][2], B1[2][2];
    const char* cA = (const char*)g.A + (size_t)cur.pm * tstep; const char* cB = (const char*)g.Bt + (size_t)cur.pn * tstep;
    S.a_ready(cur);
    if constexpr (SP2) {
        PG8_STAGE(PG8_SB(0, 0), cB, voffB); PG8_STAGE(PG8_SB(0, 1), cB + hstep, voffB); PG8_STAGE(PG8_SA(0, 0), cA, voffA); PG8_STAGE(PG8_SA(0, 1), cA + hstep, voffA);
        if (wr == 1) PG8_BAR;
        PG8_WAIT_V(2); PG8_BAR;
        PG8_STAGE(PG8_SB(1, 0), cB + kstep, voffB); PG8_STAGE(PG8_SA(1, 0), cA + kstep, voffA); PG8_STAGE(PG8_SB(1, 1), cB + hstep + kstep, voffB);
        PG8_WAIT_V(6); PG8_BAR;
    } else {
        PG8_STAGE(PG8_SB(0, 0), cB, voffB); PG8_STAGE(PG8_SA(0, 0), cA, voffA); PG8_STAGE(PG8_SB(0, 1), cB + hstep, voffB); PG8_STAGE(PG8_SA(0, 1), cA + hstep, voffA);
        if (wr == 1) PG8_BAR;
        PG8_WAIT_V(4); PG8_BAR;
        PG8_STAGE(PG8_SB(1, 0), cB + kstep, voffB); PG8_STAGE(PG8_SA(1, 0), cA + kstep, voffA); PG8_STAGE(PG8_SB(1, 1), cB + hstep + kstep, voffB);
        PG8_WAIT_V(6); PG8_BAR;
    }
    for (;;) {
        const bool has_next = S.next(ui + 1, nxt);
        const char* nA = has_next ? (const char*)g.A + (size_t)nxt.pm * tstep : cA; const char* nB = has_next ? (const char*)g.Bt + (size_t)nxt.pn * tstep : cB;
        for (int t = 0; t < nt; t += 2) {
            const bool last = (t == nt - 2);
            const char* a1 = cA + (size_t)(t + 1) * kstep;
            const char* a2 = last ? nA : cA + (size_t)(t + 2) * kstep; const char* b2 = last ? nB : cB + (size_t)(t + 2) * kstep;
            const char* a3 = a2 + kstep; const char* b3 = b2 + kstep;
            if (last && has_next) S.a_ready(nxt);
            if constexpr (SP2) {
            PG8_LDB(B0, 0, 0); PG8_LDB(B1, 0, 1); PG8_SCHED; PG8_LDA(At, 0, 0); PG8_STAGE(PG8_SA(1, 1), a1 + hstep, voffA);
            PG8_WAIT_V(8); PG8_WAIT_L(0); PG8_BAR; PG8_MMA(0, 0, At, B0); PG8_MMA(0, 1, At, B1); PG8_BAR; PG8_SCHED;
            PG8_LDA(At, 0, 1); PG8_STAGE(PG8_SB(0, 0), b2, voffB); PG8_STAGE(PG8_SB(0, 1), b2 + hstep, voffB); PG8_STAGE(PG8_SA(0, 0), a2, voffA);
            PG8_WAIT_V(8); PG8_WAIT_L(0); PG8_BAR; PG8_MMA(1, 0, At, B0); PG8_MMA(1, 1, At, B1); PG8_BAR; PG8_SCHED;
            PG8_LDB(B0, 1, 0); PG8_LDB(B1, 1, 1); PG8_SCHED; PG8_LDA(At, 1, 0); PG8_STAGE(PG8_SA(0, 1), a2 + hstep, voffA);
            PG8_WAIT_V(8); PG8_WAIT_L(0); PG8_BAR; PG8_MMA(0, 0, At, B0); PG8_MMA(0, 1, At, B1); PG8_BAR; PG8_SCHED;
            PG8_LDA(At, 1, 1); PG8_STAGE(PG8_SB(1, 0), b3, voffB); PG8_STAGE(PG8_SB(1, 1), b3 + hstep, voffB); PG8_STAGE(PG8_SA(1, 0), a3, voffA);
            PG8_WAIT_V(8); PG8_WAIT_L(0); PG8_BAR; PG8_MMA(1, 0, At, B0); PG8_MMA(1, 1, At, B1); PG8_BAR; PG8_SCHED;
            } else {
            PG8_LDB(B0, 0, 0); PG8_SCHED; PG8_LDA(At, 0, 0); PG8_STAGE(PG8_SA(1, 1), a1 + hstep, voffA);
            PG8_WAIT_L(8); PG8_BAR; PG8_WAIT_L(0); PG8_MMA(0, 0, At, B0); PG8_BAR; PG8_SCHED;
            PG8_LDB(B1, 0, 1); PG8_STAGE(PG8_SB(0, 0), b2, voffB);
            PG8_BAR; PG8_WAIT_L(0); PG8_MMA(0, 1, At, B1); PG8_BAR;
            PG8_LDA(At, 0, 1); PG8_STAGE(PG8_SA(0, 0), a2, voffA);
            PG8_BAR; PG8_WAIT_L(0); PG8_MMA(1, 0, At, B0); PG8_BAR; PG8_SCHED;
            PG8_STAGE(PG8_SB(0, 1), b2 + hstep, voffB);
            PG8_WAIT_V(6); PG8_BAR; PG8_MMA(1, 1, At, B1); PG8_BAR;
            PG8_LDB(B0, 1, 0); PG8_SCHED; PG8_LDA(At, 1, 0); PG8_STAGE(PG8_SA(0, 1), a2 + hstep, voffA);
            PG8_WAIT_L(8); PG8_BAR; PG8_WAIT_L(0); PG8_MMA(0, 0, At, B0); PG8_BAR; PG8_SCHED;
            PG8_LDB(B1, 1, 1); PG8_STAGE(PG8_SB(1, 0), b3, voffB);
            PG8_BAR; PG8_WAIT_L(0); PG8_MMA(0, 1, At, B1); PG8_BAR;
            PG8_LDA(At, 1, 1); PG8_STAGE(PG8_SA(1, 0), a3, voffA);
            PG8_BAR; PG8_WAIT_L(0); PG8_MMA(1, 0, At, B0); PG8_BAR; PG8_SCHED;
            PG8_STAGE(PG8_SB(1, 1), b3 + hstep, voffB);
            PG8_WAIT_V(6); PG8_BAR; PG8_MMA(1, 1, At, B1); PG8_BAR;
            }
        }
        if constexpr (ALIGN_EPI) { if (wr == 0) PG8_BAR; }
        if constexpr (!Epi::AFTER_DRAIN) { E(acc, cur, wr, wc, fr, fq); S.done(cur); }
        if (!has_next) break;
#pragma unroll
        for (int a = 0; a < 2; ++a)
#pragma unroll
            for (int b = 0; b < 2; ++b)
#pragma unroll
                for (int m = 0; m < 4; ++m)
#pragma unroll
                    for (int n = 0; n < 2; ++n) acc[a][b][m][n] = (f32x4){0.f, 0.f, 0.f, 0.f};
        cur = nxt; cA = nA; cB = nB; ++ui;
        if constexpr (ALIGN_EPI) { if (wr == 1) PG8_BAR; }
    }
    PG8_WAIT_V(0);
    if constexpr (!ALIGN_EPI) { if (wr == 0) PG8_BAR; }
    PG8_BAR;
    if constexpr (Epi::AFTER_DRAIN) { E.fused(acc, cur, wr, wc, fr, fq, lds, wid, lane); S.done(cur); }
#undef PG8_SA
#undef PG8_SB
#undef PG8_STAGE
#undef PG8_LDA
#undef PG8_LDB
#undef PG8_MMA
#undef PG8_WAIT_V
#undef PG8_WAIT_L
#undef PG8_BAR
#undef PG8_SCHED
}
}

struct Params { const float* in[22]; float* out; unsigned char* ws; };
typedef const __attribute__((address_space(4))) Params* KP;
DI KP kparams() { KP kp = (KP)__builtin_amdgcn_kernarg_segment_ptr(); asm volatile("" : "+s"(kp)); return kp; }
enum { I_X = 0, I_C, I_CTX, I_CCTX, I_WADA, I_BADA, I_NPRE, I_NPOST, I_W1, I_W3, I_W2, I_WIN, I_SINK, I_MLCONV, I_MLFB, I_MLNORM, I_HGLB, I_HGNORM, I_WBA, I_WBM, I_WBH, I_WOUT };

DI void transpose_item(const float* Wa, const float* Wb, int ldw, int K, bf16_t* dst, int k0, LAS float* scr, int lane) {
    const float* src = (((lane & 31) < 16) ? Wa : Wb) + (lane & 15);
#pragma unroll 8
    for (int i = 0; i < 32; ++i) { const int kk = 2 * i + (lane >> 5); scr[kk * 33 + (lane & 31)] = src[(size_t)(k0 + kk) * ldw]; }
    asm volatile("s_waitcnt lgkmcnt(0)" ::: "memory");
    const int c = lane & 7;
#pragma unroll
    for (int j = 0; j < 4; ++j) { const int n = (lane >> 3) + 8 * j; const LAS float* s = scr + (8 * c) * 33 + n;
        u32x4 o; o.x = pk2(s[0 * 33], s[1 * 33]); o.y = pk2(s[2 * 33], s[3 * 33]); o.z = pk2(s[4 * 33], s[5 * 33]); o.w = pk2(s[6 * 33], s[7 * 33]);
        *(u32x4*)(dst + (size_t)n * K + k0 + 8 * c) = o; }
    asm volatile("s_waitcnt lgkmcnt(0)" ::: "memory");
}
struct Seg { const float* Wa; const float* Wb; int ldw, K, ngroups, colA0, colB0, cstep; bf16_t* dst; };
DI bool seg_run(const Seg& s, int& it, LAS float* scr, int lane) {
    const int nk = s.K / 64, n = s.ngroups * nk;
    if (it >= n) { it -= n; return false; }
    const int gi = it / nk, kb = it % nk;
    transpose_item(s.Wa + s.colA0 + gi * s.cstep, s.Wb + s.colB0 + gi * s.cstep, s.ldw, s.K, s.dst + (size_t)gi * 32 * s.K, kb * 64, scr, lane);
    return true;
}
DI void convert_weights(KP p, int l, LAS unsigned char* lds) {
    int tid_ = threadIdx.x; asm volatile("" : "+v"(tid_));
    const int wave = tid_ >> 6, lane = tid_ & 63;
    LAS float* scr = (LAS float*)(lds + wave * 8704);
    bf16_t* W = (bf16_t*)(p->ws + WS_W);
    const int gw = blockIdx.x * 8 + wave, NGW = gridDim.x * 8;
    constexpr int NITEMS = 2 * 176 * 16 + 2 * 32 * 44 + 128 * 16 + 96 * 16 + 3 * 32 * 8 + 32 * 16;
    for (int item = gw; item < NITEMS; item += NGW) {
        int it = item;
        bool done = false;
#pragma unroll
        for (int f = 0; f < 2 && !done; ++f) {
            const float* w1 = p->in[I_W1] + (size_t)(l * 2 + f) * DM * DFF; const float* w3 = p->in[I_W3] + (size_t)(l * 2 + f) * DM * DFF;
            Seg s{w1, w3, DFF, DM, 176, 0, 0, 16, W + WO_W13 + (size_t)f * 5632 * 1024};
            done = seg_run(s, it, scr, lane);
        }
#pragma unroll
        for (int f = 0; f < 2 && !done; ++f) {
            const float* w2 = p->in[I_W2] + (size_t)(l * 2 + f) * DFF * DM;
            Seg s{w2, w2, DM, DFF, 32, 0, 16, 32, W + WO_W2 + (size_t)f * 1024 * 2816};
            done = seg_run(s, it, scr, lane);
        }
        const float* win = p->in[I_WIN] + (size_t)l * DM * DIN;
        if (!done) { Seg s{win, win, DIN, DM, 72, 0, 16, 32, W + WO_WIN}; done = seg_run(s, it, scr, lane); }
        if (!done) { Seg s{win, win, DIN, DM, 56, 2320, 2336, 32, W + WO_WIN + (size_t)2304 * 1024}; done = seg_run(s, it, scr, lane); }
        if (!done) { Seg s{win, win, DIN, DM, 96, 4112, 4128, 32, W + WO_WG}; done = seg_run(s, it, scr, lane); }
#pragma unroll
        for (int f = 0; f < 3 && !done; ++f) {
            const float* wb = p->in[I_WBA + f] + (size_t)l * 512 * DM;
            Seg s{wb, wb, DM, 512, 32, 0, 16, 32, W + WO_WB + (size_t)f * 1024 * 512};
            done = seg_run(s, it, scr, lane);
        }
        if (!done) { const float* wo = p->in[I_WOUT] + (size_t)l * DM * DM; Seg s{wo, wo, DM, DM, 32, 0, 16, 32, W + WO_WOUT}; done = seg_run(s, it, scr, lane); }
    }
}

DI void mods_phase(KP p, LAS unsigned char* lds, int tid) {
    asm volatile("" : "+v"(tid));
    const int wave = tid >> 6, lane = tid & 63;
    LAS float* sc = (LAS float*)lds;
    LAS float* red = (LAS float*)(lds + 36864);
    for (int i = tid; i < 9 * 1024; i += 512) { const float v = (i < 8192) ? p->in[I_C][i] : p->in[I_CCTX][i - 8192]; sc[i] = v / (1.0f + expf(-v)); }
    __syncthreads();
    float* mod = (float*)(p->ws + WS_MOD);
    for (int it = blockIdx.x; it < 288; it += gridDim.x) {
        const int l = it / 144, cb = it % 144, col = cb * 64 + lane;
        const float* wp = p->in[I_WADA] + ((size_t)l * 1024 + wave * 128) * 9216 + col;
        float acc[9];
#pragma unroll
        for (int i = 0; i < 9; ++i) acc[i] = 0.f;
#pragma unroll 8
        for (int k = 0; k < 128; ++k) { const float wv = wp[(size_t)k * 9216];
#pragma unroll
            for (int i = 0; i < 9; ++i) acc[i] += sc[i * 1024 + wave * 128 + k] * wv; }
#pragma unroll
        for (int i = 0; i < 9; ++i) red[(wave * 9 + i) * 64 + lane] = acc[i];
        __syncthreads();
        for (int o = tid; o < 576; o += 512) { const int i = o >> 6, ln = o & 63; float s = 0.f;
#pragma unroll
            for (int w = 0; w < 8; ++w) s += red[(w * 9 + i) * 64 + ln];
            mod[((size_t)l * 9 + i) * 9216 + cb * 64 + ln] = s + p->in[I_BADA][(size_t)l * 9216 + cb * 64 + ln]; }
        __syncthreads();
    }
    if (blockIdx.x == gridDim.x - 1) {
        f32x2* tab = (f32x2*)(p->ws + WS_ROPE);
        for (int e = tid; e < 1024; e += 512) { const int pos = e >> 4, i = e & 15;
            const float inv = exp2f(-(float)i * (13.287712379549449f / 16.0f));
            const float a = (float)pos * inv; float rev = a * 0.15915494309189535f; rev -= floorf(rev);
            f32x2 cs; cs.x = __builtin_amdgcn_cosf(rev); cs.y = __builtin_amdgcn_sinf(rev); tab[e] = cs; }
    }
}

struct RowArgs {
    const float* xs_lat; const float* xs_ctx; float* xd_lat; float* xd_ctx;
    const bf16_t* Y; bf16_t* H; const float* mod; const float* modpre; const float* gpost; const float* gpre; const float* wgates; float* gates;
    int jpost, jpre, nrows; float wpost;
};
template <bool POST, bool PRE, bool GATES>
DI void row_phase(const RowArgs& a, LAS unsigned char* lds, int tid) {
    asm volatile("" : "+v"(tid));
    const int wave = tid >> 6, lane = tid & 63;
    LAS f32x4* wl = (LAS f32x4*)lds;
    if (GATES) {
        for (int idx = tid; idx < 1024 * 4; idx += 512) { const int k = idx >> 2, c4 = idx & 3; const int ln = (k & 255) >> 2, j = k >> 8, e = k & 3;
            wl[((j * 4 + e) * 4 + c4) * 64 + ln] = *(const f32x4*)(a.wgates + (size_t)k * DIN + 4 * c4); }
        __syncthreads();
    }
    for (int row = blockIdx.x * 8 + wave; row < a.nrows; row += gridDim.x * 8) {
        const int mi = row < MLAT ? (row >> 12) : 8;
        const float* md = a.mod + (size_t)mi * 9216;
        const float* mdp = a.modpre + (size_t)mi * 9216;
        const float* src = row < MLAT ? a.xs_lat + (size_t)row * DM : a.xs_ctx + (size_t)(row - MLAT) * DM;
        f32x4 x[4];
#pragma unroll
        for (int j = 0; j < 4; ++j) x[j] = *(const f32x4*)(src + 4 * lane + 256 * j);
        if (POST) {
            f32x4 y[4]; float s = 0.f;
#pragma unroll
            for (int j = 0; j < 4; ++j) { const u32x2 w = *(const u32x2*)(a.Y + (size_t)row * DM + 4 * lane + 256 * j);
                y[j] = (f32x4){bflo(w.x), bfhi(w.x), bflo(w.y), bfhi(w.y)}; s += (y[j][0] * y[j][0] + y[j][1] * y[j][1]) + (y[j][2] * y[j][2] + y[j][3] * y[j][3]); }
            const float rstd = 1.0f / sqrtf(wave_sum(s) * (1.0f / DM) + EPS);
            float* dst = row < MLAT ? a.xd_lat + (size_t)row * DM : a.xd_ctx + (size_t)(row - MLAT) * DM;
#pragma unroll
            for (int j = 0; j < 4; ++j) { const int c = 4 * lane + 256 * j;
                const f32x4 gt = *(const f32x4*)(md + (3 * a.jpost + 2) * DM + c), gp = *(const f32x4*)(a.gpost + c);
                x[j] = x[j] + a.wpost * gt * (y[j] * rstd * gp);
                *(f32x4*)(dst + c) = x[j]; }
        }
        if (PRE) {
            float s = 0.f;
#pragma unroll
            for (int j = 0; j < 4; ++j) s += (x[j][0] * x[j][0] + x[j][1] * x[j][1]) + (x[j][2] * x[j][2] + x[j][3] * x[j][3]);
            const float rstd = 1.0f / sqrtf(wave_sum(s) * (1.0f / DM) + EPS);
            f32x4 hv[4]; f32x4 g4[4];
#pragma unroll
            for (int c4 = 0; c4 < 4; ++c4) g4[c4] = (f32x4){0.f, 0.f, 0.f, 0.f};
#pragma unroll
            for (int j = 0; j < 4; ++j) { const int c = 4 * lane + 256 * j;
                const f32x4 sh = *(const f32x4*)(mdp + (3 * a.jpre) * DM + c), scl = *(const f32x4*)(mdp + (3 * a.jpre + 1) * DM + c), g = *(const f32x4*)(a.gpre + c);
                hv[j] = (x[j] * rstd * g) * (1.0f + scl) + sh;
                u32x2 w; w.x = pk2(hv[j][0], hv[j][1]); w.y = pk2(hv[j][2], hv[j][3]);
                *(u32x2*)(a.H + (size_t)row * DM + c) = w;
                if (GATES) {
#pragma unroll
                    for (int e = 0; e < 4; ++e)
#pragma unroll
                        for (int c4 = 0; c4 < 4; ++c4) g4[c4] += hv[j][e] * wl[((j * 4 + e) * 4 + c4) * 64 + lane];
                    asm volatile("" ::: "memory");
                } }
            if (GATES) {
#pragma unroll
                for (int c4 = 0; c4 < 4; ++c4)
#pragma unroll
                    for (int k = 0; k < 4; ++k) g4[c4][k] = wave_sum(g4[c4][k]);
                if (lane == 0) {
#pragma unroll
                    for (int c4 = 0; c4 < 4; ++c4) *(f32x4*)(a.gates + (size_t)row * 16 + 4 * c4) = g4[c4]; }
            }
        }
    }
    if (GATES) __syncthreads();
}

constexpr int RS = 144;
constexpr int AT_K = 0, AT_V = 9216, AT_TAB = 18432;
struct AttnArgs { const bf16_t* P; bf16_t* ATT; const float* sink; const f32x2* rope; };

DI void attn_item(const AttnArgs& A, int item, LAS unsigned char* lds, int tid) {
    asm volatile("" : "+v"(tid));
    const int w = tid >> 6, lane = tid & 63, r = lane & 31, hh = lane >> 5;
    const LAS f32x2* tab = (const LAS f32x2*)(lds + AT_TAB);
    int b, g, qb = 0, qrow0; bool lat;
    if (item < 512) { b = item >> 6; g = (item >> 5) & 1; qb = item & 31; lat = true; qrow0 = b * SEQ + qb * 128; }
    else { const int it = item - 512; b = it >> 2; g = (it >> 1) & 1; lat = false; qrow0 = MLAT + b * CTXL + (it & 1) * 128; }
    const int head = g * 4 + (w >> 1), qoff = (w & 1) * 64;
    bf16x8 qf[2][4];
#pragma unroll
    for (int qt = 0; qt < 2; ++qt) {
        const int ql = qoff + 32 * qt + r;
        const bf16_t* qp = A.P + pidx(qrow0 + ql, PC_AQ + head * 64 + 8 * hh);
        float x[4][8];
#pragma unroll
        for (int ks = 0; ks < 4; ++ks) { const u32x4 raw = *(const u32x4*)(qp + 16 * ks);
            x[ks][0] = bflo(raw.x); x[ks][1] = bfhi(raw.x); x[ks][2] = bflo(raw.y); x[ks][3] = bfhi(raw.y); x[ks][4] = bflo(raw.z); x[ks][5] = bfhi(raw.z); x[ks][6] = bflo(raw.w); x[ks][7] = bfhi(raw.w); }
        if (lat) {
            const int t = qb * 128 + ql;
#pragma unroll
            for (int pr = 0; pr < 2; ++pr) { const int pos = pr ? (t & 63) : (t >> 6);
#pragma unroll
                for (int j = 0; j < 8; ++j) { const f32x2 cs = tab[pos * 16 + 8 * hh + j]; const float x1 = x[2 * pr][j], x2 = x[2 * pr + 1][j];
                    x[2 * pr][j] = x1 * cs.x - x2 * cs.y; x[2 * pr + 1][j] = x2 * cs.x + x1 * cs.y; } }
        }
#pragma unroll
        for (int ks = 0; ks < 4; ++ks) qf[qt][ks] = pack8(x[ks][0] * 0.125f, x[ks][1] * 0.125f, x[ks][2] * 0.125f, x[ks][3] * 0.125f, x[ks][4] * 0.125f, x[ks][5] * 0.125f, x[ks][6] * 0.125f, x[ks][7] * 0.125f);
    }
    f32x16 O[2][2];
#pragma unroll
    for (int qt = 0; qt < 2; ++qt)
#pragma unroll
        for (int dt = 0; dt < 2; ++dt)
#pragma unroll
            for (int i = 0; i < 16; ++i) O[qt][dt][i] = 0.f;
    const float sk = A.sink[head];
    float m_run[2] = {sk, sk}, l_run[2];
    l_run[0] = l_run[1] = (hh == 0) ? 1.0f : 0.0f;
    const int ti_hi = (lat && qb == 31) ? 4 : 6;
    int ti = lat ? (qb == 0 ? 2 : 0) : 6;
    const int ss = tid >> 3, sc8 = tid & 7, half = sc8 >> 2, i0 = (sc8 & 3) * 4;
    u32x2 k1, k2; u32x4 vr;
#define ATT_LOAD(tix) do { const int krow_ = ((tix) < 6 ? b * SEQ + 128 * (qb - 1) + 64 * (tix) : MLAT + b * CTXL + 64 * ((tix) - 6)) + ss; \
        const bf16_t* kp_ = A.P + pidx(krow_, PC_AK); \
        k1 = *(const u32x2*)(kp_ + g * 64 + 32 * half + i0); k2 = *(const u32x2*)(kp_ + g * 64 + 32 * half + 16 + i0); \
        vr = *(const u32x4*)(kp_ + (PC_AV - PC_AK) + g * 64 + 8 * sc8); } while (0)
    ATT_LOAD(ti);
    for (;;) {
        {
            float a[4] = {bflo(k1.x), bfhi(k1.x), bflo(k1.y), bfhi(k1.y)}, c[4] = {bflo(k2.x), bfhi(k2.x), bflo(k2.y), bfhi(k2.y)};
            if (ti < 6) { const int kpos = 128 * (qb - 1) + 64 * ti + ss; const int pos = half ? (kpos & 63) : (kpos >> 6);
#pragma unroll
                for (int e = 0; e < 4; ++e) { const f32x2 cs = tab[pos * 16 + i0 + e]; const float x1 = a[e], x2 = c[e]; a[e] = x1 * cs.x - x2 * cs.y; c[e] = x2 * cs.x + x1 * cs.y; } }
            u32x2 o1, o2; o1.x = pk2(a[0], a[1]); o1.y = pk2(a[2], a[3]); o2.x = pk2(c[0], c[1]); o2.y = pk2(c[2], c[3]);
            *(LAS u32x2*)(lds + AT_K + ss * RS + (32 * half + i0) * 2) = o1;
            *(LAS u32x2*)(lds + AT_K + ss * RS + (32 * half + 16 + i0) * 2) = o2;
            const unsigned vv[4] = {vr.x, vr.y, vr.z, vr.w};
#pragma unroll
            for (int e = 0; e < 4; ++e) { *(LAS unsigned short*)(lds + AT_V + (8 * sc8 + 2 * e) * RS + ss * 2) = (unsigned short)(vv[e] & 0xffffu);
                *(LAS unsigned short*)(lds + AT_V + (8 * sc8 + 2 * e + 1) * RS + ss * 2) = (unsigned short)(vv[e] >> 16); }
        }
        LDS_BARRIER();
        const int tn = (ti < 6 && ti + 1 == ti_hi) ? 6 : ti + 1;
        if (tn < 10) ATT_LOAD(tn);
        f32x16 S[2][2];
#pragma unroll
        for (int st = 0; st < 2; ++st) {
            bf16x8 kf[4];
#pragma unroll
            for (int ks = 0; ks < 4; ++ks) kf[ks] = *(const LAS bf16x8*)(lds + AT_K + (32 * st + r) * RS + (16 * ks + 8 * hh) * 2);
#pragma unroll
            for (int qt = 0; qt < 2; ++qt) { f32x16 acc;
#pragma unroll
                for (int i = 0; i < 16; ++i) acc[i] = 0.f;
#pragma unroll
                for (int ks = 0; ks < 4; ++ks) acc = MFMA32(kf[ks], qf[qt][ks], acc);
                S[qt][st] = acc; }
        }
        if (ti < 2 || (ti >= 4 && ti < 6)) {
            const int kp0 = 128 * (qb - 1) + 64 * ti;
#pragma unroll
            for (int qt = 0; qt < 2; ++qt) { const int qpos = qb * 128 + qoff + 32 * qt + r;
#pragma unroll
                for (int st = 0; st < 2; ++st)
#pragma unroll
                    for (int i = 0; i < 16; ++i) { const int df = qpos - (kp0 + 32 * st + crow(i, hh)); if (df > 128 || df < -128) S[qt][st][i] = -INFINITY; } }
        }
#pragma unroll
        for (int qt = 0; qt < 2; ++qt) {
            float mx = S[qt][0][0];
#pragma unroll
            for (int st = 0; st < 2; ++st)
#pragma unroll
                for (int i = 0; i < 16; ++i) mx = fmaxf(mx, S[qt][st][i]);
            mx = fmaxf(mx, __shfl_xor(mx, 32));
            const float mn = fmaxf(m_run[qt], mx), scale = fexp(m_run[qt] - mn);
            m_run[qt] = mn; float ls = 0.f;
#pragma unroll
            for (int st = 0; st < 2; ++st)
#pragma unroll
                for (int i = 0; i < 16; ++i) { const float pv = fexp(S[qt][st][i] - mn); S[qt][st][i] = pv; ls += pv; }
            l_run[qt] = l_run[qt] * scale + ls;
#pragma unroll
            for (int dt = 0; dt < 2; ++dt)
#pragma unroll
                for (int i = 0; i < 16; ++i) O[qt][dt][i] *= scale;
        }
#pragma unroll
        for (int kk = 0; kk < 4; ++kk) { const int st = kk >> 1, s2 = kk & 1;
            bf16x8 pb[2];
#pragma unroll
            for (int qt = 0; qt < 2; ++qt) pb[qt] = pack8(S[qt][st][8 * s2 + 0], S[qt][st][8 * s2 + 1], S[qt][st][8 * s2 + 2], S[qt][st][8 * s2 + 3], S[qt][st][8 * s2 + 4], S[qt][st][8 * s2 + 5], S[qt][st][8 * s2 + 6], S[qt][st][8 * s2 + 7]);
#pragma unroll
            for (int dt = 0; dt < 2; ++dt) {
                const LAS unsigned char* vp = lds + AT_V + (32 * dt + r) * RS + (32 * st + 16 * s2 + 4 * hh) * 2;
                const s16x4 lo = *(const LAS s16x4*)vp, hi = *(const LAS s16x4*)(vp + 16);
                const bf16x8 va = __builtin_shufflevector(lo, hi, 0, 1, 2, 3, 4, 5, 6, 7);
#pragma unroll
                for (int qt = 0; qt < 2; ++qt) O[qt][dt] = MFMA32(va, pb[qt], O[qt][dt]);
            }
        }
        LDS_BARRIER();
        if (tn >= 10) break;
        ti = tn;
    }
#undef ATT_LOAD
#pragma unroll
    for (int qt = 0; qt < 2; ++qt) {
        const float l = l_run[qt] + __shfl_xor(l_run[qt], 32), inv = 1.0f / l;
        bf16_t* op = A.ATT + (size_t)(qrow0 + qoff + 32 * qt + r) * 512 + head * 64;
#pragma unroll
        for (int dt = 0; dt < 2; ++dt)
#pragma unroll
            for (int ig = 0; ig < 4; ++ig) { u32x2 wv; wv.x = pk2(O[qt][dt][4 * ig] * inv, O[qt][dt][4 * ig + 1] * inv); wv.y = pk2(O[qt][dt][4 * ig + 2] * inv, O[qt][dt][4 * ig + 3] * inv);
                *(u32x2*)(op + 32 * dt + 8 * ig + 4 * hh) = wv; }
    }
}

constexpr int SC_QS = 0, SC_KS = 9216, SC_QE = 18432, SC_UKT = 27648, SC_VT = 36864, SC_CBT = 55296, SC_F = 73728;
constexpr int SF_EB = 0, SF_QN = 256, SF_SSQ = 2304, SF_N = 3328, SF_DEC = 3840, SF_CONV = 4096, SF_GN = 5632, SF_CACHE = 6144;
struct ScanArgs { const bf16_t* P; bf16_t* OUT; const float* gates; const float* convw; const float* fbias; const float* gnorm; const float* lbl; int layer; };

template <bool IS_ML>
DI void scan_item(const ScanArgs& A, int b, int hd, const int dir, unsigned* prog_mine, unsigned* prog_other, LAS unsigned char* lds, int tid) {
    asm volatile("" : "+v"(tid));
    const int w = tid >> 6, lane = tid & 63, r = lane & 31, hh = lane >> 5;
    const int etile = w & 3, ttile = w >> 2, dtile = w >> 2;
    LAS float* F = (LAS float*)(lds + SC_F);
    LAS float* eb_s = F + SF_EB / 4; LAS float* qn_s = F + SF_QN / 4; LAS float* ssq_s = F + SF_SSQ / 4; LAS float* n_s = F + SF_N / 4; LAS float* dec_s = F + SF_DEC / 4; LAS float* conv_s = F + SF_CONV / 4;
    LAS float* gn_s = F + SF_GN / 4; LAS unsigned* cache_s = (LAS unsigned*)(F + SF_CACHE / 4);
    const int vcol = (IS_ML ? PC_MV : PC_HI) + hd * 128, gcol = (IS_ML ? PC_MO : PC_HG) + hd * 128;
    float lbv[8];
    __syncthreads();
    if (IS_ML) {
        if (tid < 384) { const int j = tid >> 6, d = tid & 63; conv_s[tid] = A.convw[(j % 3) * 512 + (j / 3) * 256 + hd * 64 + d]; }
    } else {
#pragma unroll
        for (int e = 0; e < 8; ++e) { const int c = hd * 64 + 8 * w + e; lbv[e] = (A.layer == 0) ? 0.f : 1.0f / (1.0f + expf(A.lbl[c] - A.lbl[256 + c])); }
    }
    if (tid < 128) { n_s[tid] = 0.f; gn_s[tid] = A.gnorm[hd * 128 + tid]; }
    if (tid == 0) cache_s[0] = 0u;
    f32x16 Cst;
#pragma unroll
    for (int i = 0; i < 16; ++i) Cst[i] = 0.f;
    float m_run = 0.f;
#pragma unroll
    for (int ig = 0; ig < 4; ++ig) *(LAS u32x2*)(lds + SC_CBT + (32 * etile + r) * RS + (32 * dtile + 8 * ig + 4 * hh) * 2) = (u32x2){0u, 0u};
    const float fb = IS_ML ? A.fbias[dir * 4 + hd] : 0.f;
    bool pending = false;
    u32x4 rq[3], rk[3], rv[2]; float rgi = 0.f, rgf = 0.f;
#define SC_ROWS(c_) const int cc_ = (c_) < 4 ? (dir ? 3 - (c_) : (c_)) : (dir ? 67 - (c_) : (c_) - 4); \
    const int slo_ = (c_) < 4 ? MLAT + b * CTXL : b * SEQ, slen_ = (c_) < 4 ? CTXL : SEQ; const int rb_ = slo_ + 64 * cc_;
#define SC_LOAD(c_) do { SC_ROWS(c_) const int ti_ = 64 * cc_ + (dir ? 63 - lane : lane); const int prow_ = slo_ + ti_; \
    if (IS_ML) { const u32x4 z4_ = (u32x4){0u, 0u, 0u, 0u}; \
        const bf16_t* pq_ = A.P + pidx(prow_, PC_MQ + hd * 64 + 8 * w); const bf16_t* pk_ = A.P + pidx(prow_, PC_MK + hd * 64 + 8 * w); rq[1] = *(const u32x4*)pq_; rk[1] = *(const u32x4*)pk_; \
        rq[0] = ti_ > 0 ? *(const u32x4*)(pq_ - 256) : z4_; rk[0] = ti_ > 0 ? *(const u32x4*)(pk_ - 256) : z4_; \
        rq[2] = ti_ + 1 < slen_ ? *(const u32x4*)(pq_ + 256) : z4_; rk[2] = ti_ + 1 < slen_ ? *(const u32x4*)(pk_ + 256) : z4_; \
        const float* gp_ = A.gates + (size_t)(slo_ + ti_) * 16; rgi = gp_[dir * 4 + hd]; rgf = gp_[8 + dir * 4 + hd]; \
    } else { rq[1] = *(const u32x4*)(A.P + pidx(prow_, PC_HQ + hd * 64 + 8 * w)); rk[1] = *(const u32x4*)(A.P + pidx(prow_, PC_HF + dir * 256 + hd * 64 + 8 * w)); } \
    { const bf16_t* pv_ = A.P + pidx(prow_, vcol + 16 * w); rv[0] = *(const u32x4*)pv_; rv[1] = *(const u32x4*)(pv_ + 8); } } while (0)
    SC_LOAD(0);
    __syncthreads();
#pragma unroll 1
    for (int c = 0; c < 68; ++c) {
        float ea = 1.f, wprev = 0.f, enm = 0.f, a_prev = 0.f;
        {
            const unsigned vv[8] = {rv[0].x, rv[0].y, rv[0].z, rv[0].w, rv[1].x, rv[1].y, rv[1].z, rv[1].w};
#pragma unroll
            for (int e = 0; e < 8; ++e) { *(LAS unsigned short*)(lds + SC_VT + (16 * w + 2 * e) * RS + lane * 2) = (unsigned short)(vv[e] & 0xffffu);
                *(LAS unsigned short*)(lds + SC_VT + (16 * w + 2 * e + 1) * RS + lane * 2) = (unsigned short)(vv[e] >> 16); }
        }
        if (IS_ML) {
            const float li = rgi, xf = rgf + fb;
            const float lf = fminf(xf, 0.f) - flog1p(fexp(-fabsf(xf)));
            float bc = lf;
#pragma unroll
            for (int off = 1; off < 64; off <<= 1) { const float v = __shfl_up(bc, off); if (lane >= off) bc += v; }
            const float beta = li - bc; float pm = beta;
#pragma unroll
            for (int off = 1; off < 64; off <<= 1) { const float v = __shfl_up(pm, off); if (lane >= off) pm = fmaxf(pm, v); }
            const float bl = __shfl(bc, 63), pmx = __shfl(pm, 63);
            const float mm = fmaxf(m_run, pm), mmx = fmaxf(m_run, pmx);
            ea = fexp(-mm); wprev = fexp(m_run - mm); enm = fexp(-(bc + mm));
            a_prev = fexp(m_run - mmx); const float u = fexp(beta - mmx);
            m_run = bl + mmx;
            if (w == 0) eb_s[lane] = fexp(fminf(beta, 80.f));
            float q8[8], k8[8];
            const unsigned q0[4] = {rq[0].x, rq[0].y, rq[0].z, rq[0].w}, q1[4] = {rq[1].x, rq[1].y, rq[1].z, rq[1].w}, q2[4] = {rq[2].x, rq[2].y, rq[2].z, rq[2].w};
            const unsigned k0[4] = {rk[0].x, rk[0].y, rk[0].z, rk[0].w}, k1[4] = {rk[1].x, rk[1].y, rk[1].z, rk[1].w}, k2[4] = {rk[2].x, rk[2].y, rk[2].z, rk[2].w};
            float cw[6][8];
#pragma unroll
            for (int j = 0; j < 6; ++j) { const f32x4 c0 = *(const LAS f32x4*)(conv_s + j * 64 + 8 * w), c1 = *(const LAS f32x4*)(conv_s + j * 64 + 8 * w + 4);
                cw[j][0] = c0[0]; cw[j][1] = c0[1]; cw[j][2] = c0[2]; cw[j][3] = c0[3]; cw[j][4] = c1[0]; cw[j][5] = c1[1]; cw[j][6] = c1[2]; cw[j][7] = c1[3]; }
#pragma unroll
            for (int e = 0; e < 4; ++e) {
                q8[2 * e] = fsilu(bflo(q0[e]) * cw[0][2 * e] + bflo(q1[e]) * cw[1][2 * e] + bflo(q2[e]) * cw[2][2 * e]);
                q8[2 * e + 1] = fsilu(bfhi(q0[e]) * cw[0][2 * e + 1] + bfhi(q1[e]) * cw[1][2 * e + 1] + bfhi(q2[e]) * cw[2][2 * e + 1]);
                k8[2 * e] = 0.125f * fsilu(bflo(k0[e]) * cw[3][2 * e] + bflo(k1[e]) * cw[4][2 * e] + bflo(k2[e]) * cw[5][2 * e]);
                k8[2 * e + 1] = 0.125f * fsilu(bfhi(k0[e]) * cw[3][2 * e + 1] + bfhi(k1[e]) * cw[4][2 * e + 1] + bfhi(k2[e]) * cw[5][2 * e + 1]); }
            *(LAS bf16x8*)(lds + SC_QS + lane * RS + 16 * w) = pack8(q8[0], q8[1], q8[2], q8[3], q8[4], q8[5], q8[6], q8[7]);
            *(LAS bf16x8*)(lds + SC_KS + lane * RS + 16 * w) = pack8(k8[0], k8[1], k8[2], k8[3], k8[4], k8[5], k8[6], k8[7]);
#pragma unroll
            for (int e = 0; e < 4; ++e) { const unsigned pkv = pk2(u * k8[2 * e], u * k8[2 * e + 1]);
                *(LAS unsigned short*)(lds + SC_UKT + (8 * w + 2 * e) * RS + lane * 2) = (unsigned short)(pkv & 0xffffu);
                *(LAS unsigned short*)(lds + SC_UKT + (8 * w + 2 * e + 1) * RS + lane * 2) = (unsigned short)(pkv >> 16); }
            const LAS float* nv = n_s + (c & 1) * 64 + 8 * w; const f32x4 n0 = *(const LAS f32x4*)nv, n1 = *(const LAS f32x4*)(nv + 4);
            qn_s[lane * 8 + w] = (q8[0] * n0[0] + q8[1] * n0[1] + q8[2] * n0[2] + q8[3] * n0[3]) + (q8[4] * n1[0] + q8[5] * n1[1] + q8[6] * n1[2] + q8[7] * n1[3]);
        } else {
            float x[8], kk[8], qs[8];
            const unsigned qr[4] = {rq[1].x, rq[1].y, rq[1].z, rq[1].w}, zr[4] = {rk[1].x, rk[1].y, rk[1].z, rk[1].w};
#pragma unroll
            for (int e = 0; e < 8; ++e) { const float z = (e & 1) ? bfhi(zr[e >> 1]) : bflo(zr[e >> 1]), qv = (e & 1) ? bfhi(qr[e >> 1]) : bflo(qr[e >> 1]);
                const float ez = fexp(-fabsf(z)), sg = (z >= 0.f ? 1.0f : ez) * __builtin_amdgcn_rcpf(1.0f + ez);
                const float lb = lbv[e], f = lb + (1.0f - lb) * sg;
                kk[e] = (1.0f - lb) * (1.0f - sg);
                x[e] = (lb > 0.f) ? flog(f) : (fminf(z, 0.f) - flog1p(ez));
                qs[e] = 0.125f * fsilu(qv); }
#pragma unroll
            for (int off = 1; off < 64; off <<= 1)
#pragma unroll
                for (int e = 0; e < 8; ++e) { const float v = __shfl_up(x[e], off); if (lane >= off) x[e] += v; }
            float qe[8], qt[8], kt[8], ku[8];
#pragma unroll
            for (int e = 0; e < 8; ++e) { const float bb = x[e];
                const float blv = __uint_as_float(__builtin_amdgcn_readlane(__float_as_uint(bb), 63)), ref = __uint_as_float(__builtin_amdgcn_readlane(__float_as_uint(bb), 31));
                qe[e] = qs[e] * fexp(bb); qt[e] = qs[e] * fexp(fminf(bb - ref, 60.f)); kt[e] = kk[e] * fexp(fminf(ref - bb, 60.f)); ku[e] = kk[e] * fexp(blv - bb);
                if (lane == 0) dec_s[8 * w + e] = fexp(blv); }
#pragma unroll
            for (int e = 0; e < 4; ++e) { const unsigned pkv = pk2(ku[2 * e], ku[2 * e + 1]);
                *(LAS unsigned short*)(lds + SC_UKT + (8 * w + 2 * e) * RS + lane * 2) = (unsigned short)(pkv & 0xffffu);
                *(LAS unsigned short*)(lds + SC_UKT + (8 * w + 2 * e + 1) * RS + lane * 2) = (unsigned short)(pkv >> 16); }
            *(LAS bf16x8*)(lds + SC_QE + lane * RS + 16 * w) = pack8(qe[0], qe[1], qe[2], qe[3], qe[4], qe[5], qe[6], qe[7]);
            *(LAS bf16x8*)(lds + SC_QS + lane * RS + 16 * w) = pack8(qt[0], qt[1], qt[2], qt[3], qt[4], qt[5], qt[6], qt[7]);
            *(LAS bf16x8*)(lds + SC_KS + lane * RS + 16 * w) = pack8(kt[0], kt[1], kt[2], kt[3], kt[4], kt[5], kt[6], kt[7]);
        }
        const bool first_role = (c < 2) || (c >= 4 && c < 36);
        if (pending && !first_role) {
            asm volatile("s_waitcnt vmcnt(0)" ::: "memory"); if (lane == 0) __hip_atomic_fetch_add(prog_mine, 1u, __ATOMIC_RELAXED, __HIP_MEMORY_SCOPE_AGENT); pending = false; }
        if (!first_role && tid == 0) {
            const int cp = (c < 4) ? 3 - c : 71 - c; const unsigned need = 8u * (unsigned)((cp < 2 ? cp : cp - 2) + 1);
            if (cache_s[0] < need) {
                unsigned v; unsigned spins = 0;
                for (;;) { v = __hip_atomic_load(prog_other, __ATOMIC_RELAXED, __HIP_MEMORY_SCOPE_AGENT); if (v >= need) break; __builtin_amdgcn_s_sleep(2); if (++spins > (1u << 24)) break; }
                __builtin_amdgcn_fence(__ATOMIC_ACQUIRE, "agent");
                asm volatile("s_waitcnt vmcnt(0)" ::: "memory");
                cache_s[0] = v;
            }
        }
        LDS_BARRIER();
        SC_ROWS(c)
        const int t = 32 * ttile + r;
        const int orow = rb_ + (dir ? 63 - t : t);
        bf16_t* op = A.OUT + (size_t)orow * 512 + hd * 128 + 32 * etile + 4 * hh;
        unsigned long long prevv[4]; u32x2 gwv[4];
        if (!first_role) {
            const bf16_t* gp = A.P + pidx(orow, gcol + 32 * etile + 4 * hh);
#pragma unroll
            for (int ig = 0; ig < 4; ++ig) { prevv[ig] = __hip_atomic_load((const unsigned long long*)(op + 8 * ig), __ATOMIC_RELAXED, __HIP_MEMORY_SCOPE_AGENT); gwv[ig] = *(const u32x2*)(gp + 8 * ig); }
        }
        if (c + 1 < 68) SC_LOAD(c + 1);
        bf16x8 qf[4];
#pragma unroll
        for (int ks = 0; ks < 4; ++ks) qf[ks] = *(const LAS bf16x8*)(lds + SC_QS + t * RS + (16 * ks + 8 * hh) * 2);
        f32x16 S[2];
#pragma unroll
        for (int st = 0; st < 2; ++st) { f32x16 acc;
#pragma unroll
            for (int i = 0; i < 16; ++i) acc[i] = 0.f;
#pragma unroll
            for (int ks = 0; ks < 4; ++ks) { const bf16x8 kf = *(const LAS bf16x8*)(lds + SC_KS + (32 * st + r) * RS + (16 * ks + 8 * hh) * 2); acc = MFMA32(kf, qf[ks], acc); }
            S[st] = acc; }
        float c1 = 1.0f, c2 = 1.0f;
        if (IS_ML) {
            const float ea_t = __shfl(ea, t), en_t = __shfl(enm, t), wprev_t = __shfl(wprev, t);
            float rs = 0.f;
#pragma unroll
            for (int st = 0; st < 2; ++st)
#pragma unroll
                for (int ig = 0; ig < 4; ++ig) { const f32x4 bt = *(const LAS f32x4*)(eb_s + 32 * st + 8 * ig + 4 * hh);
#pragma unroll
                    for (int k = 0; k < 4; ++k) { const int s = 32 * st + 8 * ig + 4 * hh + k; const float v = (s <= t) ? S[st][4 * ig + k] * bt[k] : 0.f; S[st][4 * ig + k] = v; rs += v; } }
            rs += __shfl_xor(rs, 32);
            const f32x4 qa = *(const LAS f32x4*)(qn_s + t * 8), qb4 = *(const LAS f32x4*)(qn_s + t * 8 + 4);
            const float qn = ((qa[0] + qa[1]) + (qa[2] + qa[3])) + ((qb4[0] + qb4[1]) + (qb4[2] + qb4[3]));
            const float den = wprev_t * qn + ea_t * rs;
            const float inv = 1.0f / fmaxf(fabsf(den), en_t);
            c1 = wprev_t * inv; c2 = ea_t * inv;
            {
                const bf16x8 uk = *(const LAS bf16x8*)(lds + SC_UKT + (8 * w + (lane >> 3)) * RS + 16 * (lane & 7));
                float sacc = ((bf1(uk[0]) + bf1(uk[1])) + (bf1(uk[2]) + bf1(uk[3]))) + ((bf1(uk[4]) + bf1(uk[5])) + (bf1(uk[6]) + bf1(uk[7])));
                sacc += __shfl_xor(sacc, 1); sacc += __shfl_xor(sacc, 2); sacc += __shfl_xor(sacc, 4);
                if ((lane & 7) == 0) n_s[((c + 1) & 1) * 64 + 8 * w + (lane >> 3)] = a_prev * n_s[(c & 1) * 64 + 8 * w + (lane >> 3)] + sacc;
            }
        } else {
#pragma unroll
            for (int st = 0; st < 2; ++st)
#pragma unroll
                for (int i = 0; i < 16; ++i) { const int s = 32 * st + crow(i, hh); if (s > t) S[st][i] = 0.f; }
        }
        f32x16 acc1;
#pragma unroll
        for (int i = 0; i < 16; ++i) acc1[i] = 0.f;
#pragma unroll
        for (int ks = 0; ks < 4; ++ks) { const bf16x8 ca = *(const LAS bf16x8*)(lds + SC_CBT + (32 * etile + r) * RS + (16 * ks + 8 * hh) * 2);
            const bf16x8 qb = IS_ML ? qf[ks] : *(const LAS bf16x8*)(lds + SC_QE + t * RS + (16 * ks + 8 * hh) * 2);
            acc1 = MFMA32(ca, qb, acc1); }
        f32x16 acc2;
        if (IS_ML) {
#pragma unroll
            for (int i = 0; i < 16; ++i) acc2[i] = 0.f;
        } else acc2 = acc1;
#pragma unroll
        for (int kk2 = 0; kk2 < 4; ++kk2) { const int st = kk2 >> 1, s2 = kk2 & 1;
            const LAS unsigned char* vp = lds + SC_VT + (32 * etile + r) * RS + (32 * st + 16 * s2 + 4 * hh) * 2;
            const s16x4 lo = *(const LAS s16x4*)vp, hi = *(const LAS s16x4*)(vp + 16);
            const bf16x8 va = __builtin_shufflevector(lo, hi, 0, 1, 2, 3, 4, 5, 6, 7);
            const bf16x8 pb = pack8(S[st][8 * s2 + 0], S[st][8 * s2 + 1], S[st][8 * s2 + 2], S[st][8 * s2 + 3], S[st][8 * s2 + 4], S[st][8 * s2 + 5], S[st][8 * s2 + 6], S[st][8 * s2 + 7]);
            acc2 = MFMA32(va, pb, acc2); }
        f32x16 hv;
        if (IS_ML) {
#pragma unroll
            for (int i = 0; i < 16; ++i) hv[i] = c1 * acc1[i] + c2 * acc2[i];
        } else hv = acc2;
        if (pending) {
            asm volatile("s_waitcnt vmcnt(0)" ::: "memory"); if (lane == 0) __hip_atomic_fetch_add(prog_mine, 1u, __ATOMIC_RELAXED, __HIP_MEMORY_SCOPE_AGENT); pending = false; }
        if (first_role) {
#pragma unroll
            for (int ig = 0; ig < 4; ++ig) { const unsigned lo_ = pk2(hv[4 * ig], hv[4 * ig + 1]), hi_ = pk2(hv[4 * ig + 2], hv[4 * ig + 3]);
                __hip_atomic_store((unsigned long long*)(op + 8 * ig), ((unsigned long long)hi_ << 32) | lo_, __ATOMIC_RELAXED, __HIP_MEMORY_SCOPE_AGENT); }
            pending = true;
        } else {
            float sq = 0.f;
#pragma unroll
            for (int ig = 0; ig < 4; ++ig) { const unsigned a0 = (unsigned)prevv[ig], a1 = (unsigned)(prevv[ig] >> 32);
                hv[4 * ig] += bflo(a0); hv[4 * ig + 1] += bfhi(a0); hv[4 * ig + 2] += bflo(a1); hv[4 * ig + 3] += bfhi(a1);
                sq += (hv[4 * ig] * hv[4 * ig] + hv[4 * ig + 1] * hv[4 * ig + 1]) + (hv[4 * ig + 2] * hv[4 * ig + 2] + hv[4 * ig + 3] * hv[4 * ig + 3]); }
            sq += __shfl_xor(sq, 32);
            if (hh == 0) ssq_s[etile * 64 + t] = sq;
            LDS_BARRIER();
            const float tot = (ssq_s[t] + ssq_s[64 + t]) + (ssq_s[128 + t] + ssq_s[192 + t]);
            const float rstd = 1.0f / sqrtf(tot * (1.0f / 128.0f) + EPS);
#pragma unroll
            for (int ig = 0; ig < 4; ++ig) { const f32x4 g4 = *(const LAS f32x4*)(gn_s + 32 * etile + 4 * hh + 8 * ig);
                const float g0 = bflo(gwv[ig].x), g1 = bfhi(gwv[ig].x), g2 = bflo(gwv[ig].y), g3 = bfhi(gwv[ig].y);
                const float o0 = hv[4 * ig] * rstd * g4[0] * (IS_ML ? fsigmoid(g0) : fsilu(g0)), o1 = hv[4 * ig + 1] * rstd * g4[1] * (IS_ML ? fsigmoid(g1) : fsilu(g1));
                const float o2 = hv[4 * ig + 2] * rstd * g4[2] * (IS_ML ? fsigmoid(g2) : fsilu(g2)), o3 = hv[4 * ig + 3] * rstd * g4[3] * (IS_ML ? fsigmoid(g3) : fsilu(g3));
                u32x2 wv; wv.x = pk2(o0, o1); wv.y = pk2(o2, o3); *(u32x2*)(op + 8 * ig) = wv; }
        }
        if (IS_ML) {
#pragma unroll
            for (int i = 0; i < 16; ++i) Cst[i] *= a_prev;
        } else {
#pragma unroll
            for (int ig = 0; ig < 4; ++ig) { const f32x4 dv = *(const LAS f32x4*)(dec_s + 32 * dtile + 8 * ig + 4 * hh);
#pragma unroll
                for (int k = 0; k < 4; ++k) Cst[4 * ig + k] *= dv[k]; }
        }
#pragma unroll
        for (int ks = 0; ks < 4; ++ks) { const bf16x8 ua = *(const LAS bf16x8*)(lds + SC_UKT + (32 * dtile + r) * RS + (16 * ks + 8 * hh) * 2);
            const bf16x8 vb = *(const LAS bf16x8*)(lds + SC_VT + (32 * etile + r) * RS + (16 * ks + 8 * hh) * 2);
            Cst = MFMA32(ua, vb, Cst); }
        LDS_BARRIER();
#pragma unroll
        for (int ig = 0; ig < 4; ++ig) { u32x2 wv; wv.x = pk2(Cst[4 * ig], Cst[4 * ig + 1]); wv.y = pk2(Cst[4 * ig + 2], Cst[4 * ig + 3]);
            *(LAS u32x2*)(lds + SC_CBT + (32 * etile + r) * RS + (32 * dtile + 8 * ig + 4 * hh) * 2) = wv; }
    }
    if (pending) { asm volatile("s_waitcnt vmcnt(0)" ::: "memory"); if (lane == 0) __hip_atomic_fetch_add(prog_mine, 1u, __ATOMIC_RELAXED, __HIP_MEMORY_SCOPE_AGENT); }
#undef SC_LOAD
#undef SC_ROWS
    __syncthreads();
}
#ifndef PH
#define PH 0xffff
#endif

#define XB_TMO      128
#define XB_XCNT(j)  (256  + 64 * (j))
#define XB_XSUB(j)  (1280 + 64 * (j))
#define XB_XGEN(j)  (2304 + 64 * (j))
#define XB_TOP      3328
#define XB_TOPGEN   3392
#define XCD_BAR_WORDS 3456
#define XB_SPIN_CAP (1u << 18)

__device__ __forceinline__ unsigned xb_ld(unsigned* p)              { return __hip_atomic_load(p, __ATOMIC_RELAXED, __HIP_MEMORY_SCOPE_AGENT); }
__device__ __forceinline__ unsigned xb_add(unsigned* p, unsigned v) { return __hip_atomic_fetch_add(p, v, __ATOMIC_RELAXED, __HIP_MEMORY_SCOPE_AGENT); }
__device__ __forceinline__ unsigned xb_xcc_id() { return (unsigned)__builtin_amdgcn_s_getreg((3 << 11) | 20) & 0xFu; }
#define XB_SPIN(cond, bar) do { unsigned _sp = 0; while (cond) { __builtin_amdgcn_s_sleep(1); \
    if ((++_sp & 255u) == 0u) { if (xb_ld(&(bar)[XB_TMO])) break; if (_sp > XB_SPIN_CAP) { atomicAdd(&(bar)[XB_TMO], 1u); break; } } } } while (0)

struct XcdBarrier {
    unsigned* bar; unsigned x;
    volatile LAS unsigned* st;
};

__device__ __forceinline__ XcdBarrier xcd_barrier_post(unsigned* bar, volatile LAS unsigned* st) {
    XcdBarrier b; b.bar = bar; b.x = xb_xcc_id(); b.st = st;
    if (threadIdx.x == 0) (void)xb_add(&bar[XB_XCNT(b.x)], 1u);
    return b;
}
__device__ __forceinline__ void xcd_barrier_complete(unsigned* bar, unsigned x, unsigned& nloc, unsigned& nx) {
    const unsigned G = gridDim.x * gridDim.y * gridDim.z;
    unsigned sum, cnt, mine, sp = 0u;
    for (;;) {
        sum = 0u; cnt = 0u; mine = 0u;
#pragma unroll
        for (unsigned j = 0; j < 16; ++j) { const unsigned c = xb_ld(&bar[XB_XCNT(j)]); sum += c; cnt += (c > 0u) ? 1u : 0u; mine = (j == x) ? c : mine; }
        if (sum == G) break;
        __builtin_amdgcn_s_sleep(1);
        if ((++sp & 255u) == 0u) { if (xb_ld(&bar[XB_TMO])) break; if (sp > XB_SPIN_CAP) { atomicAdd(&bar[XB_TMO], 1u); break; } }
    }
    nloc = mine > 0u ? mine : 1u; nx = cnt > 0u ? cnt : 1u;
}

__device__ __forceinline__ void xcd_barrier(const XcdBarrier& b) {
    asm volatile("s_waitcnt vmcnt(0)" ::: "memory");
    __syncthreads();
    if (threadIdx.x == 0) {
        unsigned* bar = b.bar;
        __builtin_amdgcn_s_waitcnt(0);
        unsigned nloc = b.st[0], nx = b.st[1];
        if (nloc == 0u) { xcd_barrier_complete(bar, b.x, nloc, nx); b.st[0] = nloc; b.st[1] = nx; }
        const unsigned old = xb_add(&bar[XB_XSUB(b.x)], 1u);
        const unsigned gen = old / nloc;
        if (old + 1u == (gen + 1u) * nloc) {
            __builtin_amdgcn_fence(__ATOMIC_RELEASE, "agent");
            asm volatile("s_waitcnt vmcnt(0)" ::: "memory");
            const unsigned og = xb_add(&bar[XB_TOP], 1u);
            const unsigned tg = og / nx;
            if (og + 1u == (tg + 1u) * nx) xb_add(&bar[XB_TOPGEN], 1u);
            else XB_SPIN(xb_ld(&bar[XB_TOPGEN]) == tg, bar);
            __builtin_amdgcn_fence(__ATOMIC_ACQUIRE, "agent");
            xb_add(&bar[XB_XGEN(b.x)], 1u);
            asm volatile("s_waitcnt vmcnt(0)" ::: "memory");
        } else {
            XB_SPIN(xb_ld(&bar[XB_XGEN(b.x)]) == gen, bar);
            __builtin_amdgcn_fence(__ATOMIC_ACQUIRE, "agent");
            asm volatile("s_waitcnt vmcnt(0)" ::: "memory");
        }
    }
    __syncthreads();
}


DI void mix_phase(KP p, int l, LAS unsigned char* lds, int tid) {
    asm volatile("" : "+v"(tid));
    const int G = gridDim.x, bid = blockIdx.x;
    const bf16_t* P = (const bf16_t*)(p->ws + WS_P);
    bf16_t* ATT = (bf16_t*)(p->ws + WS_S); bf16_t* MLB = ATT + (size_t)MTOT * 512; bf16_t* HGB = MLB + (size_t)MTOT * 512;
    const int nattn = 512 + (l == 0 ? 32 : 0);
    if (bid < 128) {
        const int it = bid, dir = it & 1, hd = (it >> 1) & 3, b = (it >> 3) & 7, ty = it >> 6;
        unsigned* prog = (unsigned*)p->ws + (l * 128 + (it & ~1)) * 16;
        if (ty == 0) { ScanArgs A{P, MLB, (const float*)(p->ws + WS_GATES), p->in[I_MLCONV] + (size_t)l * 3 * 512, p->in[I_MLFB] + l * 8, p->in[I_MLNORM] + l * 512, p->in[I_HGLB], l};
#ifndef NO_SCANML
            scan_item<true>(A, b, hd, dir, prog + dir * 16, prog + (dir ^ 1) * 16, lds, tid);
#endif
        } else { ScanArgs A{P, HGB, (const float*)(p->ws + WS_GATES), p->in[I_MLCONV], p->in[I_MLFB], p->in[I_HGNORM] + l * 512, p->in[I_HGLB], l};
#ifndef NO_SCANHG
            scan_item<false>(A, b, hd, dir, prog + dir * 16, prog + (dir ^ 1) * 16, lds, tid);
#endif
        }
    }
    if (bid >= 128) {
        __syncthreads();
        const f32x2* rope = (const f32x2*)(p->ws + WS_ROPE);
        for (int i = tid; i < 1024; i += 512) ((LAS f32x2*)(lds + AT_TAB))[i] = rope[i];
        __syncthreads();
        AttnArgs A{P, ATT, p->in[I_SINK] + l * 8, rope};
        for (int it = bid - 128; it < nattn; it += G - 128) {
#ifndef NO_ATTN
 attn_item(A, it, lds, tid);
#endif
 }
    }
}

template <class Epi> DI void run_gemm(LAS unsigned char* lds, const bf16_t* A, const bf16_t* Bt, int M, int N, int K, const Epi& E) {
    pg8::Gemm g{A, Bt, M, N, K}; pg8::StaticOrder S; S.init(M, N, (int)gridDim.x, (int)blockIdx.x);
    pg8::gemm_phase<Epi, pg8::StaticOrder, true, true>(lds, g, S, E);
}

#define GRID_BAR() do { XcdBarrier xb_; xb_.bar = (unsigned*)(ws) + 8192; xb_.x = xb_xcc_id(); xb_.st = (volatile LAS unsigned*)(lds + 131072); xcd_barrier(xb_); } while (0)
__global__ void __launch_bounds__(512) fwd_kernel(Params p_unused) {
    extern __shared__ __attribute__((aligned(16))) unsigned char lds_raw[];
    LAS unsigned char* lds = (LAS unsigned char*)lds_raw;
    cg::grid_group grid = cg::this_grid();
#define tid ((int)threadIdx.x)
#define ws (kparams()->ws)
#define W ((bf16_t*)(ws + WS_W))
#define H ((bf16_t*)(ws + WS_H))
#define PB ((bf16_t*)(ws + WS_P))
#define SB ((bf16_t*)(ws + WS_S))
#define XC ((float*)(ws + WS_XC))
#define mod ((const float*)(ws + WS_MOD))
#define gates ((float*)(ws + WS_GATES))
    KP p = kparams();
    if (threadIdx.x < 16) ((LAS unsigned*)(lds + 131072))[threadIdx.x] = 0u;
    __syncthreads();
    (void)xcd_barrier_post((unsigned*)(ws) + 8192, (volatile LAS unsigned*)(lds + 131072));

#if PH & 1
    convert_weights(p, 0, lds);
    __syncthreads();
    mods_phase(p, lds, tid);
#endif
    grid.sync();
    {
        RowArgs a{p->in[I_X], p->in[I_CTX], nullptr, nullptr, nullptr, H, mod, mod, nullptr, p->in[I_NPRE], nullptr, nullptr, 0, 0, MTOT, 0.f};
#if PH & 2
        row_phase<false, true, false>(a, lds, tid);
#endif
    }
    GRID_BAR();

#pragma unroll 1
    for (int l = 0; l < 2; ++l) {
        p = kparams();
        const float* modl = mod + (size_t)l * 9 * 9216;
        const float* npre = p->in[I_NPRE] + (size_t)l * 3 * DM; const float* npost = p->in[I_NPOST] + (size_t)l * 3 * DM;
        const int M2 = (l == 1) ? MLAT : MTOT;
#if PH & 4
        { pg8::EpiSwiGLU E{PB, DFF}; run_gemm(lds, H, W + WO_W13, MTOT, 5632, DM, E); }
#endif
        GRID_BAR();
#if PH & 8
        { pg8::EpiBf16<0> E{SB, DM, 0}; run_gemm(lds, PB, W + WO_W2, MTOT, DM, DFF, E); }
#endif
        GRID_BAR();
        {
            RowArgs a{l == 0 ? p->in[I_X] : p->out, l == 0 ? p->in[I_CTX] : XC, p->out, XC, SB, H, modl, modl, npost, npre + DM, p->in[I_WIN] + (size_t)l * DM * DIN + 2304, gates, 0, 1, MTOT, 0.5f};
#if PH & 16
            row_phase<true, true, true>(a, lds, tid);
#endif
        }
        GRID_BAR();
#if PH & 32
        { pg8::EpiBf16<0> E{PB, 256, PTS}; run_gemm(lds, H, W + WO_WIN, MTOT, NPC, DM, E); }
#endif
        GRID_BAR();
#if PH & 64
        mix_phase(p, l, lds, tid);
#endif
        GRID_BAR();
#if PH & 128
        { pg8::EpiBf16<1> E{PB, NGC, 0}; run_gemm(lds, H, W + WO_WG, M2, NGC, DM, E); }
#endif
        GRID_BAR();
#if PH & 256
#pragma unroll 1
        for (int gi = 0; gi < 3; ++gi) { pg8::EpiMerge E{H, PB, gi}; run_gemm(lds, SB + (size_t)gi * MTOT * 512, W + WO_WB + (size_t)gi * 1024 * 512, M2, DM, 512, E); }
#endif
        GRID_BAR();
#if PH & 512
        { pg8::EpiBf16<0> E{SB, DM, 0}; run_gemm(lds, H, W + WO_WOUT, M2, DM, DM, E); }
#endif
        GRID_BAR();
        {
            RowArgs a{p->out, XC, p->out, XC, SB, H, modl, modl, npost + DM, npre + 2 * DM, nullptr, nullptr, 1, 2, M2, 1.0f};
#if PH & 1024
            row_phase<true, true, false>(a, lds, tid);
#endif
        }
        GRID_BAR();
#if PH & 2048
        { pg8::EpiSwiGLU E{PB, DFF}; run_gemm(lds, H, W + WO_W13 + (size_t)5632 * 1024, M2, 5632, DM, E); }
#endif
        GRID_BAR();
#if PH & 4096
        { pg8::EpiBf16<0> E{SB, DM, 0}; run_gemm(lds, PB, W + WO_W2 + (size_t)1024 * 2816, M2, DM, DFF, E); }
#endif
        GRID_BAR();
        if (l == 0) {
            RowArgs a{p->out, XC, p->out, XC, SB, H, modl, mod + (size_t)9 * 9216, npost + 2 * DM, p->in[I_NPRE] + 3 * DM, nullptr, nullptr, 2, 0, MTOT, 0.5f};
#if PH & 8192
            row_phase<true, true, false>(a, lds, tid);
            __syncthreads();
            convert_weights(p, 1, lds);
#endif
            GRID_BAR();
        } else {
            RowArgs a{p->out, XC, p->out, XC, SB, H, modl, modl, npost + 2 * DM, nullptr, nullptr, nullptr, 2, 0, MLAT, 0.5f};
#if PH & 16384
            row_phase<true, false, false>(a, lds, tid);
#endif
        }
    }
#undef tid
#undef ws
#undef W
#undef H
#undef PB
#undef SB
#undef XC
#undef mod
#undef gates
}

extern "C" void kernel_launch(void* const* d_in, const int* in_sizes, int n_in, void* d_out, int out_size, void* d_ws, size_t ws_size, hipStream_t stream) {
    static int grid = 0;
    if (grid == 0) {
        if (n_in != 22 || out_size != MLAT * DM || ws_size < WS_END) { fprintf(stderr, "kernel_launch: unexpected shapes (n_in %d out %d ws %zu)\n", n_in, out_size, ws_size); grid = -1; return; }
        int dev = 0, cus = 0, per_cu = 0;
        (void)hipGetDevice(&dev);
        (void)hipDeviceGetAttribute(&cus, hipDeviceAttributeMultiprocessorCount, dev);
        (void)hipFuncSetAttribute((const void*)fwd_kernel, hipFuncAttributeMaxDynamicSharedMemorySize, LDS_BYTES);
        (void)hipOccupancyMaxActiveBlocksPerMultiprocessor(&per_cu, (const void*)fwd_kernel, 512, LDS_BYTES);
        if (per_cu < 1) per_cu = 1;
        if (per_cu > 1) per_cu = 1;
        grid = cus * per_cu;
        if (grid <= 0) grid = 256;
    }
    if (grid < 0) return;
    if (grid < 192) { fprintf(stderr, "kernel_launch: grid %d too small for the paired scans\n", grid); return; }
    (void)hipMemsetAsync(d_ws, 0, 65536, stream);
    Params p{};
    for (int i = 0; i < 22; ++i) p.in[i] = (const float*)d_in[i];
    p.out = (float*)d_out; p.ws = (unsigned char*)d_ws;
    void* args[] = {&p};
    hipError_t e = hipLaunchCooperativeKernel((const void*)fwd_kernel, dim3(grid), dim3(512), args, LDS_BYTES, stream);
    if (e != hipSuccess) fprintf(stderr, "cooperative launch failed: %s (grid %d)\n", hipGetErrorString(e), grid);
}
```

```cpp
#include <hip/hip_runtime.h>
#include <hip/hip_cooperative_groups.h>
#include <cstdio>
#include <cstdint>
namespace cg = cooperative_groups;

#define DI __device__ __forceinline__
#define LAS __attribute__((address_space(3)))
typedef unsigned short bf16_t;
typedef short bf16x8 __attribute__((ext_vector_type(8)));
typedef short s16x4 __attribute__((ext_vector_type(4)));
typedef float f32x2 __attribute__((ext_vector_type(2)));
typedef float f32x4 __attribute__((ext_vector_type(4)));
typedef float f32x16 __attribute__((ext_vector_type(16)));
typedef unsigned u32x2 __attribute__((ext_vector_type(2)));
typedef unsigned u32x4 __attribute__((ext_vector_type(4)));

constexpr int DM = 1024, NB = 8, SEQ = 4096, CTXL = 256, DFF = 2816, DIN = 7184, NMOD = 9;
constexpr int MLAT = NB * SEQ, MCTX = NB * CTXL, MTOT = MLAT + MCTX;
constexpr int NPC = 4096;
constexpr int NGC = 3072;
constexpr float EPS = 1e-6f;
constexpr int PC_AQ = 0, PC_AK = 512, PC_AV = 640, PC_MQ = 768, PC_MK = 1024, PC_MV = 1280, PC_MO = 1792, PC_HQ = 2304, PC_HF = 2560, PC_HI = 3072, PC_HG = 3584;

constexpr size_t MiB = 1u << 20;
constexpr size_t WS_MOD = 1 * MiB;
constexpr size_t WS_ROPE = 2 * MiB;
constexpr size_t WS_GATES = 3 * MiB;
constexpr size_t WS_XC = 6 * MiB;
constexpr size_t WS_W = 14 * MiB;
constexpr size_t WS_H = 66 * MiB;
constexpr size_t WS_P = 134 * MiB;
constexpr size_t WS_S = 406 * MiB;
constexpr size_t WS_END = 508 * MiB;
constexpr size_t WO_W13 = 0;
constexpr size_t WO_W2 = WO_W13 + (size_t)2 * 5632 * 1024;
constexpr size_t WO_WIN = WO_W2 + (size_t)2 * 1024 * 2816;
constexpr size_t WO_WG = WO_WIN + (size_t)4096 * 1024;
constexpr size_t WO_WB = WO_WG + (size_t)3072 * 1024;
constexpr size_t WO_WOUT = WO_WB + (size_t)3 * 1024 * 512;
constexpr size_t WO_END = WO_WOUT + (size_t)1024 * 1024;
static_assert(WO_END * 2 <= 52 * MiB, "weights fit");
static_assert((size_t)MTOT * 1024 * 2 <= 68 * MiB && (size_t)MTOT * 4096 * 2 <= 272 * MiB && (size_t)MTOT * 512 * 2 * 3 <= 102 * MiB, "ws map");

constexpr int LDS_BYTES = 131072 + 64;
constexpr size_t PTS = (size_t)MTOT * 256;
__device__ __forceinline__ size_t pidx(int row, int col) { return (size_t)(col >> 8) * PTS + (size_t)row * 256 + (col & 255); }

DI unsigned f2bf(float f) { unsigned u = __float_as_uint(f); return (u + 0x7fffu + ((u >> 16) & 1u)) >> 16; }
typedef __bf16 bf16v2 __attribute__((ext_vector_type(2)));
DI unsigned pk2(float lo, float hi) { f32x2 v = {lo, hi}; bf16v2 b = __builtin_convertvector(v, bf16v2); return __builtin_bit_cast(unsigned, b); }
DI float bflo(unsigned w) { return __uint_as_float(w << 16); }
DI float bfhi(unsigned w) { return __uint_as_float(w & 0xffff0000u); }
DI float bf1(short s) { return __uint_as_float(((unsigned)(unsigned short)s) << 16); }
DI float fexp(float x) { return __builtin_amdgcn_exp2f(x * 1.4426950408889634f); }
DI float flog(float x) { return __builtin_amdgcn_logf(x) * 0.6931471805599453f; }
DI float flog1p(float e) { const float u = 1.0f + e, d = u - 1.0f; return d == 0.f ? e : flog(u) * e * __builtin_amdgcn_rcpf(d); }
DI float fsigmoid(float x) { return __builtin_amdgcn_rcpf(1.0f + fexp(-x)); }
DI float fsilu(float x) { return x * fsigmoid(x); }
DI float wave_sum(float v) {
#pragma unroll
    for (int o = 1; o < 64; o <<= 1) v += __shfl_xor(v, o);
    return v;
}
DI bf16x8 pack8(float a0, float a1, float a2, float a3, float a4, float a5, float a6, float a7) {
    u32x4 p; p.x = pk2(a0, a1); p.y = pk2(a2, a3); p.z = pk2(a4, a5); p.w = pk2(a6, a7); return __builtin_bit_cast(bf16x8, p);
}
#define MFMA32(a, b, c) __builtin_amdgcn_mfma_f32_32x32x16_bf16((a), (b), (c), 0, 0, 0)
DI int crow(int i, int h) { return (i & 3) + 8 * (i >> 2) + 4 * h; }

#define LDS_BARRIER() do { asm volatile("s_waitcnt lgkmcnt(0)" ::: "memory"); __builtin_amdgcn_s_barrier(); asm volatile("" ::: "memory"); } while (0)
namespace pg8 {
#define PG8_LAS __attribute__((address_space(3)))
typedef unsigned short bf16_t;
typedef short bf16x8 __attribute__((ext_vector_type(8)));
typedef float f32x4 __attribute__((ext_vector_type(4)));
typedef unsigned u32x4 __attribute__((ext_vector_type(4)));
constexpr int BM = 256, BK = 64, HALF = 128, HTB = HALF * BK * 2  , STAGE_BYTES = 8 * HTB, NXCD = 8, WGM = 8;

__host__ __device__ __forceinline__ int lds_byte(int r, int c) { const int st = (r >> 4) * 2 + (c >> 5), rr = r & 15, cc = c & 31, ob = rr * 64 + cc * 2; return st * 1024 + (ob ^ (((ob >> 9) & 1) << 5)); }
__host__ __device__ __forceinline__ void stage_rc(int b, int& R, int& C) { const int st = b / 1024, sb = b % 1024, swz = sb ^ (((sb >> 9) & 1) << 5); R = (st >> 1) * 16 + swz / 64; C = (st & 1) * 32 + (swz % 64) / 2; }
__host__ __device__ __forceinline__ int perm32(int rho) { const int n = rho >> 4, i = rho & 15; return 8 * (i >> 2) + 4 * n + (i & 3); }

struct Unit { int pm, pn; };
struct Gemm { const bf16_t* A; const bf16_t* Bt; int M, N, K; };

struct StaticOrder {
    int nM, nN, nwg, G, c;
    __host__ __device__ void init(int M, int N, int G_, int c_) { nM = M / BM; nN = N / BM; nwg = nM * nN; G = G_; c = c_; }
    __host__ __device__ bool next(int i, Unit& u) const {
        const long L = (long)i * G + c; if (L >= nwg) return false;
        int wgid = (int)L; { const int q = nwg / NXCD, r = nwg % NXCD, xcd = wgid % NXCD, off = wgid / NXCD; wgid = (xcd < r ? xcd * (q + 1) : r * (q + 1) + (xcd - r) * q) + off; }
        const int nig = WGM * nN, gid = wgid / nig, fm = gid * WGM, gsz = (nM - fm) < WGM ? (nM - fm) : WGM;
        u.pm = fm + ((wgid % nig) % gsz); u.pn = (wgid % nig) / gsz; return true;
    }
    __device__ __forceinline__ void a_ready(const Unit&) const {}
    __device__ __forceinline__ void done(const Unit&) const {}
};

struct CtxOrder {
    int first, pm0;
    __host__ __device__ bool next(int i, Unit& u) const { const int idx = (int)blockIdx.x - first; if (i != 0 || idx < 0 || idx >= 32) return false; u.pm = pm0 + (idx >> 2); u.pn = idx & 3; return true; }
    __device__ __forceinline__ void a_ready(const Unit&) const {}
    __device__ __forceinline__ void done(const Unit&) const {}
};

template <int ACT  > struct EpiBf16 {
    static constexpr bool PERM = true, AFTER_DRAIN = false;
    bf16_t* O; int ldc; size_t tstride;
    __device__ __forceinline__ void operator()(const f32x4 (&acc)[2][2][4][2], const Unit& u, int wr, int wc, int fr, int fq) const {
        const int row0 = u.pm * BM + wr * 64 + fr, col0 = (tstride ? 0 : u.pn * BM) + wc * 32 + 8 * fq;
        bf16_t* Ob = O + (size_t)u.pn * tstride;
#pragma unroll
        for (int ai = 0; ai < 2; ++ai)
#pragma unroll
            for (int m = 0; m < 4; ++m) { bf16_t* rowp = Ob + (size_t)(row0 + ai * HALF + m * 16) * ldc + col0;
#pragma unroll
                for (int bj = 0; bj < 2; ++bj) { f32x4 v0 = acc[ai][bj][m][0], v1 = acc[ai][bj][m][1];
                    if (ACT == 1) {
#pragma unroll
                        for (int k = 0; k < 4; ++k) { v0[k] = fsigmoid(v0[k]); v1[k] = fsigmoid(v1[k]); } }
                    u32x4 w; w.x = pk2(v0[0], v0[1]); w.y = pk2(v0[2], v0[3]); w.z = pk2(v1[0], v1[1]); w.w = pk2(v1[2], v1[3]);
                    *(u32x4*)(rowp + bj * HALF) = w; } }
    }
};
struct EpiSwiGLU {
    static constexpr bool PERM = false, AFTER_DRAIN = false;
    bf16_t* O; int ldc;
    __device__ __forceinline__ void operator()(const f32x4 (&acc)[2][2][4][2], const Unit& u, int wr, int wc, int fr, int fq) const {
        const int row0 = u.pm * BM + wr * 64 + fr, f0 = u.pn * 128 + wc * 16 + 4 * fq;
#pragma unroll
        for (int ai = 0; ai < 2; ++ai)
#pragma unroll
            for (int m = 0; m < 4; ++m) { bf16_t* rowp = O + (size_t)(row0 + ai * HALF + m * 16) * ldc + f0;
#pragma unroll
                for (int bj = 0; bj < 2; ++bj) { const f32x4 a = acc[ai][bj][m][0], b = acc[ai][bj][m][1];
                    u32x2 w; w.x = pk2(fsilu(a[0]) * b[0], fsilu(a[1]) * b[1]); w.y = pk2(fsilu(a[2]) * b[2], fsilu(a[3]) * b[3]);
                    *(u32x2*)(rowp + bj * 64) = w; } }
    }
};
struct EpiMerge {
    static constexpr bool PERM = true, AFTER_DRAIN = false;
    bf16_t* O; const bf16_t* G; int gi;
    __device__ __forceinline__ void operator()(const f32x4 (&acc)[2][2][4][2], const Unit& u, int wr, int wc, int fr, int fq) const {
        const int row0 = u.pm * BM + wr * 64 + fr, col0 = u.pn * BM + wc * 32 + 8 * fq;
#pragma unroll
        for (int ai = 0; ai < 2; ++ai)
#pragma unroll
            for (int m = 0; m < 4; ++m) { const size_t r = (size_t)(row0 + ai * HALF + m * 16);
#pragma unroll
                for (int bj = 0; bj < 2; ++bj) { const int c = col0 + bj * HALF;
                    const u32x4 g = *(const u32x4*)(G + r * 3072 + gi * 1024 + c);
                    const f32x4 v0 = acc[ai][bj][m][0], v1 = acc[ai][bj][m][1];
                    float o0 = bflo(g.x) * v0[0], o1 = bfhi(g.x) * v0[1], o2 = bflo(g.y) * v0[2], o3 = bfhi(g.y) * v0[3];
                    float o4 = bflo(g.z) * v1[0], o5 = bfhi(g.z) * v1[1], o6 = bflo(g.w) * v1[2], o7 = bfhi(g.w) * v1[3];
                    bf16_t* op = O + r * 1024 + c;
                    if (gi > 0) {
                        const unsigned long long p0 = __hip_atomic_load((const unsigned long long*)op, __ATOMIC_RELAXED, __HIP_MEMORY_SCOPE_AGENT);
                        const unsigned long long p1 = __hip_atomic_load((const unsigned long long*)op + 1, __ATOMIC_RELAXED, __HIP_MEMORY_SCOPE_AGENT);
                        const unsigned a0 = (unsigned)p0, a1 = (unsigned)(p0 >> 32), a2 = (unsigned)p1, a3 = (unsigned)(p1 >> 32);
                        o0 += bflo(a0); o1 += bfhi(a0); o2 += bflo(a1); o3 += bfhi(a1); o4 += bflo(a2); o5 += bfhi(a2); o6 += bflo(a3); o7 += bfhi(a3);
                    }
                    u32x4 w; w.x = pk2(o0, o1); w.y = pk2(o2, o3); w.z = pk2(o4, o5); w.w = pk2(o6, o7);
                    *(u32x4*)op = w; } }
    }
};

template <class Epi, class Sched, bool ALIGN_EPI = false, bool SP2 = false>
__device__ __forceinline__ void gemm_phase(PG8_LAS unsigned char* lds, const Gemm g, const Sched& S, const Epi& E) {
    int tid_ = threadIdx.x; asm volatile("" : "+v"(tid_));
    const int tid = tid_, wid = __builtin_amdgcn_readfirstlane(tid >> 6), lane = tid & 63, wr = wid >> 2, wc = wid & 3, fr = lane & 15, fq = lane >> 4;
    const int K = g.K, nt = K / BK;
    unsigned voffA[2], voffB[2];
#pragma unroll
    for (int i = 0; i < 2; ++i) { int R, C; stage_rc(tid * 16 + i * 8192, R, C); const int Rb = Epi::PERM ? ((R & ~31) + perm32(R & 31)) : R;
        voffA[i] = (unsigned)(R * K + C) * 2u; voffB[i] = (unsigned)(Rb * K + C) * 2u; }
    const size_t kstep = (size_t)(BK * 2);
    const size_t hstep = (size_t)HALF * K * 2;
    const size_t tstep = 2 * hstep;
    const unsigned ldsw = (unsigned)wid * 1024u;
    const int aoff = lds_byte(wr * 64 + fr, fq * 8), boff = lds_byte(wc * 32 + fr, fq * 8);
#define PG8_SA(b, h) (((b) * 2 + (h)) * HTB)
#define PG8_SB(b, h) ((4 + (b) * 2 + (h)) * HTB)
#define PG8_STAGE(bufoff, gbase, voff) do { _Pragma("unroll") for (int _i = 0; _i < 2; ++_i) \
        __builtin_amdgcn_global_load_lds((const unsigned*)((const char*)(gbase) + (voff)[_i]), (PG8_LAS unsigned*)(lds + (bufoff) + ldsw + _i * 8192), 16, 0, 0); } while (0)
#define PG8_LDA(dst, b, h) do { _Pragma("unroll") for (int m = 0; m < 4; ++m) _Pragma("unroll") for (int k = 0; k < 2; ++k) dst[m][k] = *(const PG8_LAS bf16x8*)(lds + PG8_SA(b, h) + aoff + m * 2048 + k * 1024); } while (0)
#define PG8_LDB(dst, b, h) do { _Pragma("unroll") for (int n = 0; n < 2; ++n) _Pragma("unroll") for (int k = 0; k < 2; ++k) dst[n][k] = *(const PG8_LAS bf16x8*)(lds + PG8_SB(b, h) + boff + n * 2048 + k * 1024); } while (0)
#define PG8_MMA(ai, bj, At, Bt) do { __builtin_amdgcn_s_setprio(1); _Pragma("unroll") for (int m = 0; m < 4; ++m) _Pragma("unroll") for (int n = 0; n < 2; ++n) _Pragma("unroll") for (int k = 0; k < 2; ++k) \
        acc[ai][bj][m][n] = __builtin_amdgcn_mfma_f32_16x16x32_bf16(Bt[n][k], At[m][k], acc[ai][bj][m][n], 0, 0, 0); __builtin_amdgcn_s_setprio(0); } while (0)
#define PG8_WAIT_V(n) asm volatile("s_waitcnt vmcnt(" #n ")" ::: "memory")
#define PG8_WAIT_L(n) asm volatile("s_waitcnt lgkmcnt(" #n ")" ::: "memory")
#define PG8_BAR __builtin_amdgcn_s_barrier()
#define PG8_SCHED __builtin_amdgcn_sched_barrier(0)
    Unit cur, nxt; int ui = 0;
    if (!S.next(0, cur)) return;
    f32x4 acc[2][2][4][2];
#pragma unroll
    for (int a = 0; a < 2; ++a)
#pragma unroll
        for (int b = 0; b < 2; ++b)
#pragma unroll
            for (int m = 0; m < 4; ++m)
#pragma unroll
                for (int n = 0; n < 2; ++n) acc[a][b][m][n] = (f32x4){0.f, 0.f, 0.f, 0.f};
    bf16x8 At[4][2], B0[2][2], B1[2][2];
    const char* cA = (const char*)g.A + (size_t)cur.pm * tstep; const char* cB = (const char*)g.Bt + (size_t)cur.pn * tstep;
    S.a_ready(cur);
    if constexpr (SP2) {
        PG8_STAGE(PG8_SB(0, 0), cB, voffB); PG8_STAGE(PG8_SB(0, 1), cB + hstep, voffB); PG8_STAGE(PG8_SA(0, 0), cA, voffA); PG8_STAGE(PG8_SA(0, 1), cA + hstep, voffA);
        if (wr == 1) PG8_BAR;
        PG8_WAIT_V(2); PG8_BAR;
        PG8_STAGE(PG8_SB(1, 0), cB + kstep, voffB); PG8_STAGE(PG8_SA(1, 0), cA + kstep, voffA); PG8_STAGE(PG8_SB(1, 1), cB + hstep + kstep, voffB);
        PG8_WAIT_V(6); PG8_BAR;
    } else {
        PG8_STAGE(PG8_SB(0, 0), cB, voffB); PG8_STAGE(PG8_SA(0, 0), cA, voffA); PG8_STAGE(PG8_SB(0, 1), cB + hstep, voffB); PG8_STAGE(PG8_SA(0, 1), cA + hstep, voffA);
        if (wr == 1) PG8_BAR;
        PG8_WAIT_V(4); PG8_BAR;
        PG8_STAGE(PG8_SB(1, 0), cB + kstep, voffB); PG8_STAGE(PG8_SA(1, 0), cA + kstep, voffA); PG8_STAGE(PG8_SB(1, 1), cB + hstep + kstep, voffB);
        PG8_WAIT_V(6); PG8_BAR;
    }
    for (;;) {
        const bool has_next = S.next(ui + 1, nxt);
        const char* nA = has_next ? (const char*)g.A + (size_t)nxt.pm * tstep : cA; const char* nB = has_next ? (const char*)g.Bt + (size_t)nxt.pn * tstep : cB;
        for (int t = 0; t < nt; t += 2) {
            const bool last = (t == nt - 2);
            const char* a1 = cA + (size_t)(t + 1) * kstep;
            const char* a2 = last ? nA : cA + (size_t)(t + 2) * kstep; const char* b2 = last ? nB : cB + (size_t)(t + 2) * kstep;
            const char* a3 = a2 + kstep; const char* b3 = b2 + kstep;
            if (last && has_next) S.a_ready(nxt);
            if constexpr (SP2) {
            PG8_LDB(B0, 0, 0); PG8_LDB(B1, 0, 1); PG8_SCHED; PG8_LDA(At, 0, 0); PG8_STAGE(PG8_SA(1, 1), a1 + hstep, voffA);
            PG8_WAIT_V(8); PG8_WAIT_L(0); PG8_BAR; PG8_MMA(0, 0, At, B0); PG8_MMA(0, 1, At, B1); PG8_BAR; PG8_SCHED;
            PG8_LDA(At, 0, 1); PG8_STAGE(PG8_SB(0, 0), b2, voffB); PG8_STAGE(PG8_SB(0, 1), b2 + hstep, voffB); PG8_STAGE(PG8_SA(0, 0), a2, voffA);
            PG8_WAIT_V(8); PG8_WAIT_L(0); PG8_BAR; PG8_MMA(1, 0, At, B0); PG8_MMA(1, 1, At, B1); PG8_BAR; PG8_SCHED;
            PG8_LDB(B0, 1, 0); PG8_LDB(B1, 1, 1); PG8_SCHED; PG8_LDA(At, 1, 0); PG8_STAGE(PG8_SA(0, 1), a2 + hstep, voffA);
            PG8_WAIT_V(8); PG8_WAIT_L(0); PG8_BAR; PG8_MMA(0, 0, At, B0); PG8_MMA(0, 1, At, B1); PG8_BAR; PG8_SCHED;
            PG8_LDA(At, 1, 1); PG8_STAGE(PG8_SB(1, 0), b3, voffB); PG8_STAGE(PG8_SB(1, 1), b3 + hstep, voffB); PG8_STAGE(PG8_SA(1, 0), a3, voffA);
            PG8_WAIT_V(8); PG8_WAIT_L(0); PG8_BAR; PG8_MMA(1, 0, At, B0); PG8_MMA(1, 1, At, B1); PG8_BAR; PG8_SCHED;
            } else {
            PG8_LDB(B0, 0, 0); PG8_SCHED; PG8_LDA(At, 0, 0); PG8_STAGE(PG8_SA(1, 1), a1 + hstep, voffA);
            PG8_WAIT_L(8); PG8_BAR; PG8_WAIT_L(0); PG8_MMA(0, 0, At, B0); PG8_BAR; PG8_SCHED;
            PG8_LDB(B1, 0, 1); PG8_STAGE(PG8_SB(0, 0), b2, voffB);
            PG8_BAR; PG8_WAIT_L(0); PG8_MMA(0, 1, At, B1); PG8_BAR;
            PG8_LDA(At, 0, 1); PG8_STAGE(PG8_SA(0, 0), a2, voffA);
            PG8_BAR; PG8_WAIT_L(0); PG8_MMA(1, 0, At, B0); PG8_BAR; PG8_SCHED;
            PG8_STAGE(PG8_SB(0, 1), b2 + hstep, voffB);
            PG8_WAIT_V(6); PG8_BAR; PG8_MMA(1, 1, At, B1); PG8_BAR;
            PG8_LDB(B0, 1, 0); PG8_SCHED; PG8_LDA(At, 1, 0); PG8_STAGE(PG8_SA(0, 1), a2 + hstep, voffA);
            PG8_WAIT_L(8); PG8_BAR; PG8_WAIT_L(0); PG8_MMA(0, 0, At, B0); PG8_BAR; PG8_SCHED;
            PG8_LDB(B1, 1, 1); PG8_STAGE(PG8_SB(1, 0), b3, voffB);
            PG8_BAR; PG8_WAIT_L(0); PG8_MMA(0, 1, At, B1); PG8_BAR;
            PG8_LDA(At, 1, 1); PG8_STAGE(PG8_SA(1, 0), a3, voffA);
            PG8_BAR; PG8_WAIT_L(0); PG8_MMA(1, 0, At, B0); PG8_BAR; PG8_SCHED;
            PG8_STAGE(PG8_SB(1, 1), b3 + hstep, voffB);
            PG8_WAIT_V(6); PG8_BAR; PG8_MMA(1, 1, At, B1); PG8_BAR;
            }
        }
        if constexpr (ALIGN_EPI) { if (wr == 0) PG8_BAR; }
        if constexpr (!Epi::AFTER_DRAIN) { E(acc, cur, wr, wc, fr, fq); S.done(cur); }
        if (!has_next) break;
#pragma unroll
        for (int a = 0; a < 2; ++a)
#pragma unroll
            for (int b = 0; b < 2; ++b)
#pragma unroll
                for (int m = 0; m < 4; ++m)
#pragma unroll
                    for (int n = 0; n < 2; ++n) acc[a][b][m][n] = (f32x4){0.f, 0.f, 0.f, 0.f};
        cur = nxt; cA = nA; cB = nB; ++ui;
        if constexpr (ALIGN_EPI) { if (wr == 1) PG8_BAR; }
    }
    PG8_WAIT_V(0);
    if constexpr (!ALIGN_EPI) { if (wr == 0) PG8_BAR; }
    PG8_BAR;
    if constexpr (Epi::AFTER_DRAIN) { E.fused(acc, cur, wr, wc, fr, fq, lds, wid, lane); S.done(cur); }
#undef PG8_SA
#undef PG8_SB
#undef PG8_STAGE
#undef PG8_LDA
#undef PG8_LDB
#undef PG8_MMA
#undef PG8_WAIT_V
#undef PG8_WAIT_L
#undef PG8_BAR
#undef PG8_SCHED
}
}

struct Params { const float* in[22]; float* out; unsigned char* ws; };
typedef const __attribute__((address_space(4))) Params* KP;
DI KP kparams() { KP kp = (KP)__builtin_amdgcn_kernarg_segment_ptr(); asm volatile("" : "+s"(kp)); return kp; }
enum { I_X = 0, I_C, I_CTX, I_CCTX, I_WADA, I_BADA, I_NPRE, I_NPOST, I_W1, I_W3, I_W2, I_WIN, I_SINK, I_MLCONV, I_MLFB, I_MLNORM, I_HGLB, I_HGNORM, I_WBA, I_WBM, I_WBH, I_WOUT };

DI void transpose_item(const float* Wa, const float* Wb, int ldw, int K, bf16_t* dst, int k0, LAS float* scr, int lane) {
    const float* src = (((lane & 31) < 16) ? Wa : Wb) + (lane & 15);
#pragma unroll 8
    for (int i = 0; i < 32; ++i) { const int kk = 2 * i + (lane >> 5); scr[kk * 33 + (lane & 31)] = src[(size_t)(k0 + kk) * ldw]; }
    asm volatile("s_waitcnt lgkmcnt(0)" ::: "memory");
    const int c = lane & 7;
#pragma unroll
    for (int j = 0; j < 4; ++j) { const int n = (lane >> 3) + 8 * j; const LAS float* s = scr + (8 * c) * 33 + n;
        u32x4 o; o.x = pk2(s[0 * 33], s[1 * 33]); o.y = pk2(s[2 * 33], s[3 * 33]); o.z = pk2(s[4 * 33], s[5 * 33]); o.w = pk2(s[6 * 33], s[7 * 33]);
        *(u32x4*)(dst + (size_t)n * K + k0 + 8 * c) = o; }
    asm volatile("s_waitcnt lgkmcnt(0)" ::: "memory");
}
struct Seg { const float* Wa; const float* Wb; int ldw, K, ngroups, colA0, colB0, cstep; bf16_t* dst; };
DI bool seg_run(const Seg& s, int& it, LAS float* scr, int lane) {
    const int nk = s.K / 64, n = s.ngroups * nk;
    if (it >= n) { it -= n; return false; }
    const int gi = it / nk, kb = it % nk;
    transpose_item(s.Wa + s.colA0 + gi * s.cstep, s.Wb + s.colB0 + gi * s.cstep, s.ldw, s.K, s.dst + (size_t)gi * 32 * s.K, kb * 64, scr, lane);
    return true;
}
DI void convert_weights(KP p, int l, LAS unsigned char* lds) {
    int tid_ = threadIdx.x; asm volatile("" : "+v"(tid_));
    const int wave = tid_ >> 6, lane = tid_ & 63;
    LAS float* scr = (LAS float*)(lds + wave * 8704);
    bf16_t* W = (bf16_t*)(p->ws + WS_W);
    const int gw = blockIdx.x * 8 + wave, NGW = gridDim.x * 8;
    constexpr int NITEMS = 2 * 176 * 16 + 2 * 32 * 44 + 128 * 16 + 96 * 16 + 3 * 32 * 8 + 32 * 16;
    for (int item = gw; item < NITEMS; item += NGW) {
        int it = item;
        bool done = false;
#pragma unroll
        for (int f = 0; f < 2 && !done; ++f) {
            const float* w1 = p->in[I_W1] + (size_t)(l * 2 + f) * DM * DFF; const float* w3 = p->in[I_W3] + (size_t)(l * 2 + f) * DM * DFF;
            Seg s{w1, w3, DFF, DM, 176, 0, 0, 16, W + WO_W13 + (size_t)f * 5632 * 1024};
            done = seg_run(s, it, scr, lane);
        }
#pragma unroll
        for (int f = 0; f < 2 && !done; ++f) {
            const float* w2 = p->in[I_W2] + (size_t)(l * 2 + f) * DFF * DM;
            Seg s{w2, w2, DM, DFF, 32, 0, 16, 32, W + WO_W2 + (size_t)f * 1024 * 2816};
            done = seg_run(s, it, scr, lane);
        }
        const float* win = p->in[I_WIN] + (size_t)l * DM * DIN;
        if (!done) { Seg s{win, win, DIN, DM, 72, 0, 16, 32, W + WO_WIN}; done = seg_run(s, it, scr, lane); }
        if (!done) { Seg s{win, win, DIN, DM, 56, 2320, 2336, 32, W + WO_WIN + (size_t)2304 * 1024}; done = seg_run(s, it, scr, lane); }
        if (!done) { Seg s{win, win, DIN, DM, 96, 4112, 4128, 32, W + WO_WG}; done = seg_run(s, it, scr, lane); }
#pragma unroll
        for (int f = 0; f < 3 && !done; ++f) {
            const float* wb = p->in[I_WBA + f] + (size_t)l * 512 * DM;
            Seg s{wb, wb, DM, 512, 32, 0, 16, 32, W + WO_WB + (size_t)f * 1024 * 512};
            done = seg_run(s, it, scr, lane);
        }
        if (!done) { const float* wo = p->in[I_WOUT] + (size_t)l * DM * DM; Seg s{wo, wo, DM, DM, 32, 0, 16, 32, W + WO_WOUT}; done = seg_run(s, it, scr, lane); }
    }
}

DI void mods_phase(KP p, LAS unsigned char* lds, int tid) {
    asm volatile("" : "+v"(tid));
    const int wave = tid >> 6, lane = tid & 63;
    LAS float* sc = (LAS float*)lds;
    LAS float* red = (LAS float*)(lds + 36864);
    for (int i = tid; i < 9 * 1024; i += 512) { const float v = (i < 8192) ? p->in[I_C][i] : p->in[I_CCTX][i - 8192]; sc[i] = v / (1.0f + expf(-v)); }
    __syncthreads();
    float* mod = (float*)(p->ws + WS_MOD);
    for (int it = blockIdx.x; it < 288; it += gridDim.x) {
        const int l = it / 144, cb = it % 144, col = cb * 64 + lane;
        const float* wp = p->in[I_WADA] + ((size_t)l * 1024 + wave * 128) * 9216 + col;
        float acc[9];
#pragma unroll
        for (int i = 0; i < 9; ++i) acc[i] = 0.f;
#pragma unroll 8
        for (int k = 0; k < 128; ++k) { const float wv = wp[(size_t)k * 9216];
#pragma unroll
            for (int i = 0; i < 9; ++i) acc[i] += sc[i * 1024 + wave * 128 + k] * wv; }
#pragma unroll
        for (int i = 0; i < 9; ++i) red[(wave * 9 + i) * 64 + lane] = acc[i];
        __syncthreads();
        for (int o = tid; o < 576; o += 512) { const int i = o >> 6, ln = o & 63; float s = 0.f;
#pragma unroll
            for (int w = 0; w < 8; ++w) s += red[(w * 9 + i) * 64 + ln];
            mod[((size_t)l * 9 + i) * 9216 + cb * 64 + ln] = s + p->in[I_BADA][(size_t)l * 9216 + cb * 64 + ln]; }
        __syncthreads();
    }
    if (blockIdx.x == gridDim.x - 1) {
        f32x2* tab = (f32x2*)(p->ws + WS_ROPE);
        for (int e = tid; e < 1024; e += 512) { const int pos = e >> 4, i = e & 15;
            const float inv = exp2f(-(float)i * (13.287712379549449f / 16.0f));
            const float a = (float)pos * inv; float rev = a * 0.15915494309189535f; rev -= floorf(rev);
            f32x2 cs; cs.x = __builtin_amdgcn_cosf(rev); cs.y = __builtin_amdgcn_sinf(rev); tab[e] = cs; }
    }
}

struct RowArgs {
    const float* xs_lat; const float* xs_ctx; float* xd_lat; float* xd_ctx;
    const bf16_t* Y; bf16_t* H; const float* mod; const float* modpre; const float* gpost; const float* gpre; const float* wgates; float* gates;
    int jpost, jpre, row0, row1, vb, vg; float wpost;
};
template <bool POST, bool PRE, bool GATES>
DI void row_phase(const RowArgs& a, LAS unsigned char* lds, int tid) {
    asm volatile("" : "+v"(tid));
    const int wave = tid >> 6, lane = tid & 63;
    LAS f32x4* wl = (LAS f32x4*)lds;
    if (GATES) {
        for (int idx = tid; idx < 1024 * 4; idx += 512) { const int k = idx >> 2, c4 = idx & 3; const int ln = (k & 255) >> 2, j = k >> 8, e = k & 3;
            wl[((j * 4 + e) * 4 + c4) * 64 + ln] = *(const f32x4*)(a.wgates + (size_t)k * DIN + 4 * c4); }
        __syncthreads();
    }
    for (int row = a.row0 + a.vb * 8 + wave; a.vb >= 0 && row < a.row1; row += a.vg * 8) {
        const int mi = row < MLAT ? (row >> 12) : 8;
        const float* md = a.mod + (size_t)mi * 9216;
        const float* mdp = a.modpre + (size_t)mi * 9216;
        const float* src = row < MLAT ? a.xs_lat + (size_t)row * DM : a.xs_ctx + (size_t)(row - MLAT) * DM;
        f32x4 x[4];
#pragma unroll
        for (int j = 0; j < 4; ++j) x[j] = *(const f32x4*)(src + 4 * lane + 256 * j);
        if (POST) {
            f32x4 y[4]; float s = 0.f;
#pragma unroll
            for (int j = 0; j < 4; ++j) { const u32x2 w = *(const u32x2*)(a.Y + (size_t)row * DM + 4 * lane + 256 * j);
                y[j] = (f32x4){bflo(w.x), bfhi(w.x), bflo(w.y), bfhi(w.y)}; s += (y[j][0] * y[j][0] + y[j][1] * y[j][1]) + (y[j][2] * y[j][2] + y[j][3] * y[j][3]); }
            const float rstd = 1.0f / sqrtf(wave_sum(s) * (1.0f / DM) + EPS);
            float* dst = row < MLAT ? a.xd_lat + (size_t)row * DM : a.xd_ctx + (size_t)(row - MLAT) * DM;
#pragma unroll
            for (int j = 0; j < 4; ++j) { const int c = 4 * lane + 256 * j;
                const f32x4 gt = *(const f32x4*)(md + (3 * a.jpost + 2) * DM + c), gp = *(const f32x4*)(a.gpost + c);
                x[j] = x[j] + a.wpost * gt * (y[j] * rstd * gp);
                *(f32x4*)(dst + c) = x[j]; }
        }
        if (PRE) {
            float s = 0.f;
#pragma unroll
            for (int j = 0; j < 4; ++j) s += (x[j][0] * x[j][0] + x[j][1] * x[j][1]) + (x[j][2] * x[j][2] + x[j][3] * x[j][3]);
            const float rstd = 1.0f / sqrtf(wave_sum(s) * (1.0f / DM) + EPS);
            f32x4 hv[4]; f32x4 g4[4];
#pragma unroll
            for (int c4 = 0; c4 < 4; ++c4) g4[c4] = (f32x4){0.f, 0.f, 0.f, 0.f};
#pragma unroll
            for (int j = 0; j < 4; ++j) { const int c = 4 * lane + 256 * j;
                const f32x4 sh = *(const f32x4*)(mdp + (3 * a.jpre) * DM + c), scl = *(const f32x4*)(mdp + (3 * a.jpre + 1) * DM + c), g = *(const f32x4*)(a.gpre + c);
                hv[j] = (x[j] * rstd * g) * (1.0f + scl) + sh;
                u32x2 w; w.x = pk2(hv[j][0], hv[j][1]); w.y = pk2(hv[j][2], hv[j][3]);
                *(u32x2*)(a.H + (size_t)row * DM + c) = w;
                if (GATES) {
#pragma unroll
                    for (int e = 0; e < 4; ++e)
#pragma unroll
                        for (int c4 = 0; c4 < 4; ++c4) g4[c4] += hv[j][e] * wl[((j * 4 + e) * 4 + c4) * 64 + lane];
                    asm volatile("" ::: "memory");
                } }
            if (GATES) {
#pragma unroll
                for (int c4 = 0; c4 < 4; ++c4)
#pragma unroll
                    for (int k = 0; k < 4; ++k) g4[c4][k] = wave_sum(g4[c4][k]);
                if (lane == 0) {
#pragma unroll
                    for (int c4 = 0; c4 < 4; ++c4) *(f32x4*)(a.gates + (size_t)row * 16 + 4 * c4) = g4[c4]; }
            }
        }
    }
    if (GATES) __syncthreads();
}

constexpr int RS = 144;
constexpr int AT_K = 0, AT_V = 9216, AT_TAB = 18432;
struct AttnArgs { const bf16_t* P; bf16_t* ATT; const float* sink; const f32x2* rope; };

DI void attn_item(const AttnArgs& A, int item, LAS unsigned char* lds, int tid) {
    asm volatile("" : "+v"(tid));
    const int w = tid >> 6, lane = tid & 63, r = lane & 31, hh = lane >> 5;
    const LAS f32x2* tab = (const LAS f32x2*)(lds + AT_TAB);
    int b, g, qb = 0, qrow0; bool lat;
    if (item < 512) { b = item >> 6; g = (item >> 5) & 1; qb = item & 31; lat = true; qrow0 = b * SEQ + qb * 128; }
    else { const int it = item - 512; b = it >> 2; g = (it >> 1) & 1; lat = false; qrow0 = MLAT + b * CTXL + (it & 1) * 128; }
    const int head = g * 4 + (w >> 1), qoff = (w & 1) * 64;
    bf16x8 qf[2][4];
#pragma unroll
    for (int qt = 0; qt < 2; ++qt) {
        const int ql = qoff + 32 * qt + r;
        const bf16_t* qp = A.P + pidx(qrow0 + ql, PC_AQ + head * 64 + 8 * hh);
        float x[4][8];
#pragma unroll
        for (int ks = 0; ks < 4; ++ks) { const u32x4 raw = *(const u32x4*)(qp + 16 * ks);
            x[ks][0] = bflo(raw.x); x[ks][1] = bfhi(raw.x); x[ks][2] = bflo(raw.y); x[ks][3] = bfhi(raw.y); x[ks][4] = bflo(raw.z); x[ks][5] = bfhi(raw.z); x[ks][6] = bflo(raw.w); x[ks][7] = bfhi(raw.w); }
        if (lat) {
            const int t = qb * 128 + ql;
#pragma unroll
            for (int pr = 0; pr < 2; ++pr) { const int pos = pr ? (t & 63) : (t >> 6);
#pragma unroll
                for (int j = 0; j < 8; ++j) { const f32x2 cs = tab[pos * 16 + 8 * hh + j]; const float x1 = x[2 * pr][j], x2 = x[2 * pr + 1][j];
                    x[2 * pr][j] = x1 * cs.x - x2 * cs.y; x[2 * pr + 1][j] = x2 * cs.x + x1 * cs.y; } }
        }
#pragma unroll
        for (int ks = 0; ks < 4; ++ks) qf[qt][ks] = pack8(x[ks][0] * 0.125f, x[ks][1] * 0.125f, x[ks][2] * 0.125f, x[ks][3] * 0.125f, x[ks][4] * 0.125f, x[ks][5] * 0.125f, x[ks][6] * 0.125f, x[ks][7] * 0.125f);
    }
    f32x16 O[2][2];
#pragma unroll
    for (int qt = 0; qt < 2; ++qt)
#pragma unroll
        for (int dt = 0; dt < 2; ++dt)
#pragma unroll
            for (int i = 0; i < 16; ++i) O[qt][dt][i] = 0.f;
    const float sk = A.sink[head];
    float m_run[2] = {sk, sk}, l_run[2];
    l_run[0] = l_run[1] = (hh == 0) ? 1.0f : 0.0f;
    const int ti_hi = (lat && qb == 31) ? 4 : 6;
    int ti = lat ? (qb == 0 ? 2 : 0) : 6;
    const int ss = tid >> 3, sc8 = tid & 7, half = sc8 >> 2, i0 = (sc8 & 3) * 4;
    u32x2 k1, k2; u32x4 vr;
#define ATT_LOAD(tix) do { const int krow_ = ((tix) < 6 ? b * SEQ + 128 * (qb - 1) + 64 * (tix) : MLAT + b * CTXL + 64 * ((tix) - 6)) + ss; \
        const bf16_t* kp_ = A.P + pidx(krow_, PC_AK); \
        k1 = *(const u32x2*)(kp_ + g * 64 + 32 * half + i0); k2 = *(const u32x2*)(kp_ + g * 64 + 32 * half + 16 + i0); \
        vr = *(const u32x4*)(kp_ + (PC_AV - PC_AK) + g * 64 + 8 * sc8); } while (0)
    ATT_LOAD(ti);
    for (;;) {
        {
            float a[4] = {bflo(k1.x), bfhi(k1.x), bflo(k1.y), bfhi(k1.y)}, c[4] = {bflo(k2.x), bfhi(k2.x), bflo(k2.y), bfhi(k2.y)};
            if (ti < 6) { const int kpos = 128 * (qb - 1) + 64 * ti + ss; const int pos = half ? (kpos & 63) : (kpos >> 6);
#pragma unroll
                for (int e = 0; e < 4; ++e) { const f32x2 cs = tab[pos * 16 + i0 + e]; const float x1 = a[e], x2 = c[e]; a[e] = x1 * cs.x - x2 * cs.y; c[e] = x2 * cs.x + x1 * cs.y; } }
            u32x2 o1, o2; o1.x = pk2(a[0], a[1]); o1.y = pk2(a[2], a[3]); o2.x = pk2(c[0], c[1]); o2.y = pk2(c[2], c[3]);
            *(LAS u32x2*)(lds + AT_K + ss * RS + (32 * half + i0) * 2) = o1;
            *(LAS u32x2*)(lds + AT_K + ss * RS + (32 * half + 16 + i0) * 2) = o2;
            const unsigned vv[4] = {vr.x, vr.y, vr.z, vr.w};
#pragma unroll
            for (int e = 0; e < 4; ++e) { *(LAS unsigned short*)(lds + AT_V + (8 * sc8 + 2 * e) * RS + ss * 2) = (unsigned short)(vv[e] & 0xffffu);
                *(LAS unsigned short*)(lds + AT_V + (8 * sc8 + 2 * e + 1) * RS + ss * 2) = (unsigned short)(vv[e] >> 16); }
        }
        LDS_BARRIER();
        const int tn = (ti < 6 && ti + 1 == ti_hi) ? 6 : ti + 1;
        if (tn < 10) ATT_LOAD(tn);
        f32x16 S[2][2];
#pragma unroll
        for (int st = 0; st < 2; ++st) {
            bf16x8 kf[4];
#pragma unroll
            for (int ks = 0; ks < 4; ++ks) kf[ks] = *(const LAS bf16x8*)(lds + AT_K + (32 * st + r) * RS + (16 * ks + 8 * hh) * 2);
#pragma unroll
            for (int qt = 0; qt < 2; ++qt) { f32x16 acc;
#pragma unroll
                for (int i = 0; i < 16; ++i) acc[i] = 0.f;
#pragma unroll
                for (int ks = 0; ks < 4; ++ks) acc = MFMA32(kf[ks], qf[qt][ks], acc);
                S[qt][st] = acc; }
        }
        if (ti < 2 || (ti >= 4 && ti < 6)) {
            const int kp0 = 128 * (qb - 1) + 64 * ti;
#pragma unroll
            for (int qt = 0; qt < 2; ++qt) { const int qpos = qb * 128 + qoff + 32 * qt + r;
#pragma unroll
                for (int st = 0; st < 2; ++st)
#pragma unroll
                    for (int i = 0; i < 16; ++i) { const int df = qpos - (kp0 + 32 * st + crow(i, hh)); if (df > 128 || df < -128) S[qt][st][i] = -INFINITY; } }
        }
#pragma unroll
        for (int qt = 0; qt < 2; ++qt) {
            float mx = S[qt][0][0];
#pragma unroll
            for (int st = 0; st < 2; ++st)
#pragma unroll
                for (int i = 0; i < 16; ++i) mx = fmaxf(mx, S[qt][st][i]);
            mx = fmaxf(mx, __shfl_xor(mx, 32));
            const float mn = fmaxf(m_run[qt], mx), scale = fexp(m_run[qt] - mn);
            m_run[qt] = mn; float ls = 0.f;
#pragma unroll
            for (int st = 0; st < 2; ++st)
#pragma unroll
                for (int i = 0; i < 16; ++i) { const float pv = fexp(S[qt][st][i] - mn); S[qt][st][i] = pv; ls += pv; }
            l_run[qt] = l_run[qt] * scale + ls;
#pragma unroll
            for (int dt = 0; dt < 2; ++dt)
#pragma unroll
                for (int i = 0; i < 16; ++i) O[qt][dt][i] *= scale;
        }
#pragma unroll
        for (int kk = 0; kk < 4; ++kk) { const int st = kk >> 1, s2 = kk & 1;
            bf16x8 pb[2];
#pragma unroll
            for (int qt = 0; qt < 2; ++qt) pb[qt] = pack8(S[qt][st][8 * s2 + 0], S[qt][st][8 * s2 + 1], S[qt][st][8 * s2 + 2], S[qt][st][8 * s2 + 3], S[qt][st][8 * s2 + 4], S[qt][st][8 * s2 + 5], S[qt][st][8 * s2 + 6], S[qt][st][8 * s2 + 7]);
#pragma unroll
            for (int dt = 0; dt < 2; ++dt) {
                const LAS unsigned char* vp = lds + AT_V + (32 * dt + r) * RS + (32 * st + 16 * s2 + 4 * hh) * 2;
                const s16x4 lo = *(const LAS s16x4*)vp, hi = *(const LAS s16x4*)(vp + 16);
                const bf16x8 va = __builtin_shufflevector(lo, hi, 0, 1, 2, 3, 4, 5, 6, 7);
#pragma unroll
                for (int qt = 0; qt < 2; ++qt) O[qt][dt] = MFMA32(va, pb[qt], O[qt][dt]);
            }
        }
        LDS_BARRIER();
        if (tn >= 10) break;
        ti = tn;
    }
#undef ATT_LOAD
#pragma unroll
    for (int qt = 0; qt < 2; ++qt) {
        const float l = l_run[qt] + __shfl_xor(l_run[qt], 32), inv = 1.0f / l;
        bf16_t* op = A.ATT + (size_t)(qrow0 + qoff + 32 * qt + r) * 512 + head * 64;
#pragma unroll
        for (int dt = 0; dt < 2; ++dt)
#pragma unroll
            for (int ig = 0; ig < 4; ++ig) { u32x2 wv; wv.x = pk2(O[qt][dt][4 * ig] * inv, O[qt][dt][4 * ig + 1] * inv); wv.y = pk2(O[qt][dt][4 * ig + 2] * inv, O[qt][dt][4 * ig + 3] * inv);
                *(u32x2*)(op + 32 * dt + 8 * ig + 4 * hh) = wv; }
    }
}

constexpr int SC_QS = 0, SC_KS = 9216, SC_QE = 18432, SC_UKT = 27648, SC_VT = 36864, SC_CBT = 55296, SC_F = 73728;
constexpr int SF_EB = 0, SF_QN = 256, SF_SSQ = 2304, SF_N = 3328, SF_DEC = 3840, SF_CONV = 4096, SF_GN = 5632, SF_CACHE = 6144;
struct ScanArgs { const bf16_t* P; bf16_t* OUT; const float* gates; const float* convw; const float* fbias; const float* gnorm; const float* lbl; int layer; };

template <bool IS_ML>
DI void scan_item(const ScanArgs& A, int b, int hd, const int dir, unsigned* prog_mine, unsigned* prog_other, LAS unsigned char* lds, int tid) {
    asm volatile("" : "+v"(tid));
    const int w = tid >> 6, lane = tid & 63, r = lane & 31, hh = lane >> 5;
    const int etile = w & 3, ttile = w >> 2, dtile = w >> 2;
    LAS float* F = (LAS float*)(lds + SC_F);
    LAS float* eb_s = F + SF_EB / 4; LAS float* qn_s = F + SF_QN / 4; LAS float* ssq_s = F + SF_SSQ / 4; LAS float* n_s = F + SF_N / 4; LAS float* dec_s = F + SF_DEC / 4; LAS float* conv_s = F + SF_CONV / 4;
    LAS float* gn_s = F + SF_GN / 4; LAS unsigned* cache_s = (LAS unsigned*)(F + SF_CACHE / 4);
    const int vcol = (IS_ML ? PC_MV : PC_HI) + hd * 128, gcol = (IS_ML ? PC_MO : PC_HG) + hd * 128;
    float lbv[8];
    __syncthreads();
    if (IS_ML) {
        if (tid < 384) { const int j = tid >> 6, d = tid & 63; conv_s[tid] = A.convw[(j % 3) * 512 + (j / 3) * 256 + hd * 64 + d]; }
    } else {
#pragma unroll
        for (int e = 0; e < 8; ++e) { const int c = hd * 64 + 8 * w + e; lbv[e] = (A.layer == 0) ? 0.f : 1.0f / (1.0f + expf(A.lbl[c] - A.lbl[256 + c])); }
    }
    if (tid < 128) { n_s[tid] = 0.f; gn_s[tid] = A.gnorm[hd * 128 + tid]; }
    if (tid == 0) cache_s[0] = 0u;
    f32x16 Cst;
#pragma unroll
    for (int i = 0; i < 16; ++i) Cst[i] = 0.f;
    float m_run = 0.f;
#pragma unroll
    for (int ig = 0; ig < 4; ++ig) *(LAS u32x2*)(lds + SC_CBT + (32 * etile + r) * RS + (32 * dtile + 8 * ig + 4 * hh) * 2) = (u32x2){0u, 0u};
    const float fb = IS_ML ? A.fbias[dir * 4 + hd] : 0.f;
    bool pending = false;
    u32x4 rq[3], rk[3], rv[2]; float rgi = 0.f, rgf = 0.f;
#define SC_ROWS(c_) const int cc_ = (c_) < 4 ? (dir ? 3 - (c_) : (c_)) : (dir ? 67 - (c_) : (c_) - 4); \
    const int slo_ = (c_) < 4 ? MLAT + b * CTXL : b * SEQ, slen_ = (c_) < 4 ? CTXL : SEQ; const int rb_ = slo_ + 64 * cc_;
#define SC_LOAD(c_) do { SC_ROWS(c_) const int ti_ = 64 * cc_ + (dir ? 63 - lane : lane); const int prow_ = slo_ + ti_; \
    if (IS_ML) { const u32x4 z4_ = (u32x4){0u, 0u, 0u, 0u}; \
        const bf16_t* pq_ = A.P + pidx(prow_, PC_MQ + hd * 64 + 8 * w); const bf16_t* pk_ = A.P + pidx(prow_, PC_MK + hd * 64 + 8 * w); rq[1] = *(const u32x4*)pq_; rk[1] = *(const u32x4*)pk_; \
        rq[0] = ti_ > 0 ? *(const u32x4*)(pq_ - 256) : z4_; rk[0] = ti_ > 0 ? *(const u32x4*)(pk_ - 256) : z4_; \
        rq[2] = ti_ + 1 < slen_ ? *(const u32x4*)(pq_ + 256) : z4_; rk[2] = ti_ + 1 < slen_ ? *(const u32x4*)(pk_ + 256) : z4_; \
        const float* gp_ = A.gates + (size_t)(slo_ + ti_) * 16; rgi = gp_[dir * 4 + hd]; rgf = gp_[8 + dir * 4 + hd]; \
    } else { rq[1] = *(const u32x4*)(A.P + pidx(prow_, PC_HQ + hd * 64 + 8 * w)); rk[1] = *(const u32x4*)(A.P + pidx(prow_, PC_HF + dir * 256 + hd * 64 + 8 * w)); } \
    { const bf16_t* pv_ = A.P + pidx(prow_, vcol + 16 * w); rv[0] = *(const u32x4*)pv_; rv[1] = *(const u32x4*)(pv_ + 8); } } while (0)
    SC_LOAD(0);
    __syncthreads();
#pragma unroll 1
    for (int c = 0; c < 68; ++c) {
        float ea = 1.f, wprev = 0.f, enm = 0.f, a_prev = 0.f;
        {
            const unsigned vv[8] = {rv[0].x, rv[0].y, rv[0].z, rv[0].w, rv[1].x, rv[1].y, rv[1].z, rv[1].w};
#pragma unroll
            for (int e = 0; e < 8; ++e) { *(LAS unsigned short*)(lds + SC_VT + (16 * w + 2 * e) * RS + lane * 2) = (unsigned short)(vv[e] & 0xffffu);
                *(LAS unsigned short*)(lds + SC_VT + (16 * w + 2 * e + 1) * RS + lane * 2) = (unsigned short)(vv[e] >> 16); }
        }
        if (IS_ML) {
            const float li = rgi, xf = rgf + fb;
            const float lf = fminf(xf, 0.f) - flog1p(fexp(-fabsf(xf)));
            float bc = lf;
#pragma unroll
            for (int off = 1; off < 64; off <<= 1) { const float v = __shfl_up(bc, off); if (lane >= off) bc += v; }
            const float beta = li - bc; float pm = beta;
#pragma unroll
            for (int off = 1; off < 64; off <<= 1) { const float v = __shfl_up(pm, off); if (lane >= off) pm = fmaxf(pm, v); }
            const float bl = __shfl(bc, 63), pmx = __shfl(pm, 63);
            const float mm = fmaxf(m_run, pm), mmx = fmaxf(m_run, pmx);
            ea = fexp(-mm); wprev = fexp(m_run - mm); enm = fexp(-(bc + mm));
            a_prev = fexp(m_run - mmx); const float u = fexp(beta - mmx);
            m_run = bl + mmx;
            if (w == 0) eb_s[lane] = fexp(fminf(beta, 80.f));
            float q8[8], k8[8];
            const unsigned q0[4] = {rq[0].x, rq[0].y, rq[0].z, rq[0].w}, q1[4] = {rq[1].x, rq[1].y, rq[1].z, rq[1].w}, q2[4] = {rq[2].x, rq[2].y, rq[2].z, rq[2].w};
            const unsigned k0[4] = {rk[0].x, rk[0].y, rk[0].z, rk[0].w}, k1[4] = {rk[1].x, rk[1].y, rk[1].z, rk[1].w}, k2[4] = {rk[2].x, rk[2].y, rk[2].z, rk[2].w};
            float cw[6][8];
#pragma unroll
            for (int j = 0; j < 6; ++j) { const f32x4 c0 = *(const LAS f32x4*)(conv_s + j * 64 + 8 * w), c1 = *(const LAS f32x4*)(conv_s + j * 64 + 8 * w + 4);
                cw[j][0] = c0[0]; cw[j][1] = c0[1]; cw[j][2] = c0[2]; cw[j][3] = c0[3]; cw[j][4] = c1[0]; cw[j][5] = c1[1]; cw[j][6] = c1[2]; cw[j][7] = c1[3]; }
#pragma unroll
            for (int e = 0; e < 4; ++e) {
                q8[2 * e] = fsilu(bflo(q0[e]) * cw[0][2 * e] + bflo(q1[e]) * cw[1][2 * e] + bflo(q2[e]) * cw[2][2 * e]);
                q8[2 * e + 1] = fsilu(bfhi(q0[e]) * cw[0][2 * e + 1] + bfhi(q1[e]) * cw[1][2 * e + 1] + bfhi(q2[e]) * cw[2][2 * e + 1]);
                k8[2 * e] = 0.125f * fsilu(bflo(k0[e]) * cw[3][2 * e] + bflo(k1[e]) * cw[4][2 * e] + bflo(k2[e]) * cw[5][2 * e]);
                k8[2 * e + 1] = 0.125f * fsilu(bfhi(k0[e]) * cw[3][2 * e + 1] + bfhi(k1[e]) * cw[4][2 * e + 1] + bfhi(k2[e]) * cw[5][2 * e + 1]); }
            *(LAS bf16x8*)(lds + SC_QS + lane * RS + 16 * w) = pack8(q8[0], q8[1], q8[2], q8[3], q8[4], q8[5], q8[6], q8[7]);
            *(LAS bf16x8*)(lds + SC_KS + lane * RS + 16 * w) = pack8(k8[0], k8[1], k8[2], k8[3], k8[4], k8[5], k8[6], k8[7]);
#pragma unroll
            for (int e = 0; e < 4; ++e) { const unsigned pkv = pk2(u * k8[2 * e], u * k8[2 * e + 1]);
                *(LAS unsigned short*)(lds + SC_UKT + (8 * w + 2 * e) * RS + lane * 2) = (unsigned short)(pkv & 0xffffu);
                *(LAS unsigned short*)(lds + SC_UKT + (8 * w + 2 * e + 1) * RS + lane * 2) = (unsigned short)(pkv >> 16); }
            const LAS float* nv = n_s + (c & 1) * 64 + 8 * w; const f32x4 n0 = *(const LAS f32x4*)nv, n1 = *(const LAS f32x4*)(nv + 4);
            qn_s[lane * 8 + w] = (q8[0] * n0[0] + q8[1] * n0[1] + q8[2] * n0[2] + q8[3] * n0[3]) + (q8[4] * n1[0] + q8[5] * n1[1] + q8[6] * n1[2] + q8[7] * n1[3]);
        } else {
            float x[8], kk[8], qs[8];
            const unsigned qr[4] = {rq[1].x, rq[1].y, rq[1].z, rq[1].w}, zr[4] = {rk[1].x, rk[1].y, rk[1].z, rk[1].w};
#pragma unroll
            for (int e = 0; e < 8; ++e) { const float z = (e & 1) ? bfhi(zr[e >> 1]) : bflo(zr[e >> 1]), qv = (e & 1) ? bfhi(qr[e >> 1]) : bflo(qr[e >> 1]);
                const float ez = fexp(-fabsf(z)), sg = (z >= 0.f ? 1.0f : ez) * __builtin_amdgcn_rcpf(1.0f + ez);
                const float lb = lbv[e], f = lb + (1.0f - lb) * sg;
                kk[e] = (1.0f - lb) * (1.0f - sg);
                x[e] = (lb > 0.f) ? flog(f) : (fminf(z, 0.f) - flog1p(ez));
                qs[e] = 0.125f * fsilu(qv); }
#pragma unroll
            for (int off = 1; off < 64; off <<= 1)
#pragma unroll
                for (int e = 0; e < 8; ++e) { const float v = __shfl_up(x[e], off); if (lane >= off) x[e] += v; }
            float qe[8], qt[8], kt[8], ku[8];
#pragma unroll
            for (int e = 0; e < 8; ++e) { const float bb = x[e];
                const float blv = __uint_as_float(__builtin_amdgcn_readlane(__float_as_uint(bb), 63)), ref = __uint_as_float(__builtin_amdgcn_readlane(__float_as_uint(bb), 31));
                qe[e] = qs[e] * fexp(bb); qt[e] = qs[e] * fexp(fminf(bb - ref, 60.f)); kt[e] = kk[e] * fexp(fminf(ref - bb, 60.f)); ku[e] = kk[e] * fexp(blv - bb);
                if (lane == 0) dec_s[8 * w + e] = fexp(blv); }
#pragma unroll
            for (int e = 0; e < 4; ++e) { const unsigned pkv = pk2(ku[2 * e], ku[2 * e + 1]);
                *(LAS unsigned short*)(lds + SC_UKT + (8 * w + 2 * e) * RS + lane * 2) = (unsigned short)(pkv & 0xffffu);
                *(LAS unsigned short*)(lds + SC_UKT + (8 * w + 2 * e + 1) * RS + lane * 2) = (unsigned short)(pkv >> 16); }
            *(LAS bf16x8*)(lds + SC_QE + lane * RS + 16 * w) = pack8(qe[0], qe[1], qe[2], qe[3], qe[4], qe[5], qe[6], qe[7]);
            *(LAS bf16x8*)(lds + SC_QS + lane * RS + 16 * w) = pack8(qt[0], qt[1], qt[2], qt[3], qt[4], qt[5], qt[6], qt[7]);
            *(LAS bf16x8*)(lds + SC_KS + lane * RS + 16 * w) = pack8(kt[0], kt[1], kt[2], kt[3], kt[4], kt[5], kt[6], kt[7]);
        }
        const bool first_role = (c < 2) || (c >= 4 && c < 36);
        if (pending && !first_role) {
            asm volatile("s_waitcnt vmcnt(0)" ::: "memory"); if (lane == 0) __hip_atomic_fetch_add(prog_mine, 1u, __ATOMIC_RELAXED, __HIP_MEMORY_SCOPE_AGENT); pending = false; }
        if (!first_role && tid == 0) {
            const int cp = (c < 4) ? 3 - c : 71 - c; const unsigned need = 8u * (unsigned)((cp < 2 ? cp : cp - 2) + 1);
            if (cache_s[0] < need) {
                unsigned v; unsigned spins = 0;
                for (;;) { v = __hip_atomic_load(prog_other, __ATOMIC_RELAXED, __HIP_MEMORY_SCOPE_AGENT); if (v >= need) break; __builtin_amdgcn_s_sleep(2); if (++spins > (1u << 24)) break; }
                __builtin_amdgcn_fence(__ATOMIC_ACQUIRE, "agent");
                asm volatile("s_waitcnt vmcnt(0)" ::: "memory");
                cache_s[0] = v;
            }
        }
        LDS_BARRIER();
        SC_ROWS(c)
        const int t = 32 * ttile + r;
        const int orow = rb_ + (dir ? 63 - t : t);
        bf16_t* op = A.OUT + (size_t)orow * 512 + hd * 128 + 32 * etile + 4 * hh;
        unsigned long long prevv[4]; u32x2 gwv[4];
        if (!first_role) {
            const bf16_t* gp = A.P + pidx(orow, gcol + 32 * etile + 4 * hh);
#pragma unroll
            for (int ig = 0; ig < 4; ++ig) { prevv[ig] = __hip_atomic_load((const unsigned long long*)(op + 8 * ig), __ATOMIC_RELAXED, __HIP_MEMORY_SCOPE_AGENT); gwv[ig] = *(const u32x2*)(gp + 8 * ig); }
        }
        if (c + 1 < 68) SC_LOAD(c + 1);
        bf16x8 qf[4];
#pragma unroll
        for (int ks = 0; ks < 4; ++ks) qf[ks] = *(const LAS bf16x8*)(lds + SC_QS + t * RS + (16 * ks + 8 * hh) * 2);
        f32x16 S[2];
#pragma unroll
        for (int st = 0; st < 2; ++st) { f32x16 acc;
#pragma unroll
            for (int i = 0; i < 16; ++i) acc[i] = 0.f;
#pragma unroll
            for (int ks = 0; ks < 4; ++ks) { const bf16x8 kf = *(const LAS bf16x8*)(lds + SC_KS + (32 * st + r) * RS + (16 * ks + 8 * hh) * 2); acc = MFMA32(kf, qf[ks], acc); }
            S[st] = acc; }
        float c1 = 1.0f, c2 = 1.0f;
        if (IS_ML) {
            const float ea_t = __shfl(ea, t), en_t = __shfl(enm, t), wprev_t = __shfl(wprev, t);
            float rs = 0.f;
#pragma unroll
            for (int st = 0; st < 2; ++st)
#pragma unroll
                for (int ig = 0; ig < 4; ++ig) { const f32x4 bt = *(const LAS f32x4*)(eb_s + 32 * st + 8 * ig + 4 * hh);
#pragma unroll
                    for (int k = 0; k < 4; ++k) { const int s = 32 * st + 8 * ig + 4 * hh + k; const float v = (s <= t) ? S[st][4 * ig + k] * bt[k] : 0.f; S[st][4 * ig + k] = v; rs += v; } }
            rs += __shfl_xor(rs, 32);
            const f32x4 qa = *(const LAS f32x4*)(qn_s + t * 8), qb4 = *(const LAS f32x4*)(qn_s + t * 8 + 4);
            const float qn = ((qa[0] + qa[1]) + (qa[2] + qa[3])) + ((qb4[0] + qb4[1]) + (qb4[2] + qb4[3]));
            const float den = wprev_t * qn + ea_t * rs;
            const float inv = 1.0f / fmaxf(fabsf(den), en_t);
            c1 = wprev_t * inv; c2 = ea_t * inv;
            {
                const bf16x8 uk = *(const LAS bf16x8*)(lds + SC_UKT + (8 * w + (lane >> 3)) * RS + 16 * (lane & 7));
                float sacc = ((bf1(uk[0]) + bf1(uk[1])) + (bf1(uk[2]) + bf1(uk[3]))) + ((bf1(uk[4]) + bf1(uk[5])) + (bf1(uk[6]) + bf1(uk[7])));
                sacc += __shfl_xor(sacc, 1); sacc += __shfl_xor(sacc, 2); sacc += __shfl_xor(sacc, 4);
                if ((lane & 7) == 0) n_s[((c + 1) & 1) * 64 + 8 * w + (lane >> 3)] = a_prev * n_s[(c & 1) * 64 + 8 * w + (lane >> 3)] + sacc;
            }
        } else {
#pragma unroll
            for (int st = 0; st < 2; ++st)
#pragma unroll
                for (int i = 0; i < 16; ++i) { const int s = 32 * st + crow(i, hh); if (s > t) S[st][i] = 0.f; }
        }
        f32x16 acc1;
#pragma unroll
        for (int i = 0; i < 16; ++i) acc1[i] = 0.f;
#pragma unroll
        for (int ks = 0; ks < 4; ++ks) { const bf16x8 ca = *(const LAS bf16x8*)(lds + SC_CBT + (32 * etile + r) * RS + (16 * ks + 8 * hh) * 2);
            const bf16x8 qb = IS_ML ? qf[ks] : *(const LAS bf16x8*)(lds + SC_QE + t * RS + (16 * ks + 8 * hh) * 2);
            acc1 = MFMA32(ca, qb, acc1); }
        f32x16 acc2;
        if (IS_ML) {
#pragma unroll
            for (int i = 0; i < 16; ++i) acc2[i] = 0.f;
        } else acc2 = acc1;
#pragma unroll
        for (int kk2 = 0; kk2 < 4; ++kk2) { const int st = kk2 >> 1, s2 = kk2 & 1;
            const LAS unsigned char* vp = lds + SC_VT + (32 * etile + r) * RS + (32 * st + 16 * s2 + 4 * hh) * 2;
            const s16x4 lo = *(const LAS s16x4*)vp, hi = *(const LAS s16x4*)(vp + 16);
            const bf16x8 va = __builtin_shufflevector(lo, hi, 0, 1, 2, 3, 4, 5, 6, 7);
            const bf16x8 pb = pack8(S[st][8 * s2 + 0], S[st][8 * s2 + 1], S[st][8 * s2 + 2], S[st][8 * s2 + 3], S[st][8 * s2 + 4], S[st][8 * s2 + 5], S[st][8 * s2 + 6], S[st][8 * s2 + 7]);
            acc2 = MFMA32(va, pb, acc2); }
        f32x16 hv;
        if (IS_ML) {
#pragma unroll
            for (int i = 0; i < 16; ++i) hv[i] = c1 * acc1[i] + c2 * acc2[i];
        } else hv = acc2;
        if (pending) {
            asm volatile("s_waitcnt vmcnt(0)" ::: "memory"); if (lane == 0) __hip_atomic_fetch_add(prog_mine, 1u, __ATOMIC_RELAXED, __HIP_MEMORY_SCOPE_AGENT); pending = false; }
        if (first_role) {
#pragma unroll
            for (int ig = 0; ig < 4; ++ig) { const unsigned lo_ = pk2(hv[4 * ig], hv[4 * ig + 1]), hi_ = pk2(hv[4 * ig + 2], hv[4 * ig + 3]);
                __hip_atomic_store((unsigned long long*)(op + 8 * ig), ((unsigned long long)hi_ << 32) | lo_, __ATOMIC_RELAXED, __HIP_MEMORY_SCOPE_AGENT); }
            pending = true;
        } else {
            float sq = 0.f;
#pragma unroll
            for (int ig = 0; ig < 4; ++ig) { const unsigned a0 = (unsigned)prevv[ig], a1 = (unsigned)(prevv[ig] >> 32);
                hv[4 * ig] += bflo(a0); hv[4 * ig + 1] += bfhi(a0); hv[4 * ig + 2] += bflo(a1); hv[4 * ig + 3] += bfhi(a1);
                sq += (hv[4 * ig] * hv[4 * ig] + hv[4 * ig + 1] * hv[4 * ig + 1]) + (hv[4 * ig + 2] * hv[4 * ig + 2] + hv[4 * ig + 3] * hv[4 * ig + 3]); }
            sq += __shfl_xor(sq, 32);
            if (hh == 0) ssq_s[etile * 64 + t] = sq;
            LDS_BARRIER();
            const float tot = (ssq_s[t] + ssq_s[64 + t]) + (ssq_s[128 + t] + ssq_s[192 + t]);
            const float rstd = 1.0f / sqrtf(tot * (1.0f / 128.0f) + EPS);
#pragma unroll
            for (int ig = 0; ig < 4; ++ig) { const f32x4 g4 = *(const LAS f32x4*)(gn_s + 32 * etile + 4 * hh + 8 * ig);
                const float g0 = bflo(gwv[ig].x), g1 = bfhi(gwv[ig].x), g2 = bflo(gwv[ig].y), g3 = bfhi(gwv[ig].y);
                const float o0 = hv[4 * ig] * rstd * g4[0] * (IS_ML ? fsigmoid(g0) : fsilu(g0)), o1 = hv[4 * ig + 1] * rstd * g4[1] * (IS_ML ? fsigmoid(g1) : fsilu(g1));
                const float o2 = hv[4 * ig + 2] * rstd * g4[2] * (IS_ML ? fsigmoid(g2) : fsilu(g2)), o3 = hv[4 * ig + 3] * rstd * g4[3] * (IS_ML ? fsigmoid(g3) : fsilu(g3));
                u32x2 wv; wv.x = pk2(o0, o1); wv.y = pk2(o2, o3); *(u32x2*)(op + 8 * ig) = wv; }
        }
        if (IS_ML) {
#pragma unroll
            for (int i = 0; i < 16; ++i) Cst[i] *= a_prev;
        } else {
#pragma unroll
            for (int ig = 0; ig < 4; ++ig) { const f32x4 dv = *(const LAS f32x4*)(dec_s + 32 * dtile + 8 * ig + 4 * hh);
#pragma unroll
                for (int k = 0; k < 4; ++k) Cst[4 * ig + k] *= dv[k]; }
        }
#pragma unroll
        for (int ks = 0; ks < 4; ++ks) { const bf16x8 ua = *(const LAS bf16x8*)(lds + SC_UKT + (32 * dtile + r) * RS + (16 * ks + 8 * hh) * 2);
            const bf16x8 vb = *(const LAS bf16x8*)(lds + SC_VT + (32 * etile + r) * RS + (16 * ks + 8 * hh) * 2);
            Cst = MFMA32(ua, vb, Cst); }
        LDS_BARRIER();
#pragma unroll
        for (int ig = 0; ig < 4; ++ig) { u32x2 wv; wv.x = pk2(Cst[4 * ig], Cst[4 * ig + 1]); wv.y = pk2(Cst[4 * ig + 2], Cst[4 * ig + 3]);
            *(LAS u32x2*)(lds + SC_CBT + (32 * etile + r) * RS + (32 * dtile + 8 * ig + 4 * hh) * 2) = wv; }
    }
    if (pending) { asm volatile("s_waitcnt vmcnt(0)" ::: "memory"); if (lane == 0) __hip_atomic_fetch_add(prog_mine, 1u, __ATOMIC_RELAXED, __HIP_MEMORY_SCOPE_AGENT); }
#undef SC_LOAD
#undef SC_ROWS
    __syncthreads();
}
#ifndef PH
#define PH 0xffff
#endif

#define XB_TMO      128
#define XB_XCNT(j)  (256  + 64 * (j))
#define XB_XSUB(j)  (1280 + 64 * (j))
#define XB_XGEN(j)  (2304 + 64 * (j))
#define XB_TOP      3328
#define XB_TOPGEN   3392
#define XCD_BAR_WORDS 3456
#define XB_SPIN_CAP (1u << 18)

__device__ __forceinline__ unsigned xb_ld(unsigned* p)              { return __hip_atomic_load(p, __ATOMIC_RELAXED, __HIP_MEMORY_SCOPE_AGENT); }
__device__ __forceinline__ unsigned xb_add(unsigned* p, unsigned v) { return __hip_atomic_fetch_add(p, v, __ATOMIC_RELAXED, __HIP_MEMORY_SCOPE_AGENT); }
__device__ __forceinline__ unsigned xb_xcc_id() { return (unsigned)__builtin_amdgcn_s_getreg((3 << 11) | 20) & 0xFu; }
#define XB_SPIN(cond, bar) do { unsigned _sp = 0; while (cond) { __builtin_amdgcn_s_sleep(1); \
    if ((++_sp & 255u) == 0u) { if (xb_ld(&(bar)[XB_TMO])) break; if (_sp > XB_SPIN_CAP) { atomicAdd(&(bar)[XB_TMO], 1u); break; } } } } while (0)

struct XcdBarrier {
    unsigned* bar; unsigned x;
    volatile LAS unsigned* st;
};

__device__ __forceinline__ XcdBarrier xcd_barrier_post(unsigned* bar, volatile LAS unsigned* st) {
    XcdBarrier b; b.bar = bar; b.x = xb_xcc_id(); b.st = st;
    if (threadIdx.x == 0) (void)xb_add(&bar[XB_XCNT(b.x)], 1u);
    return b;
}
__device__ __forceinline__ void xcd_barrier_complete(unsigned* bar, unsigned x, unsigned& nloc, unsigned& nx) {
    const unsigned G = gridDim.x * gridDim.y * gridDim.z;
    unsigned sum, cnt, mine, sp = 0u;
    for (;;) {
        sum = 0u; cnt = 0u; mine = 0u;
#pragma unroll
        for (unsigned j = 0; j < 16; ++j) { const unsigned c = xb_ld(&bar[XB_XCNT(j)]); sum += c; cnt += (c > 0u) ? 1u : 0u; mine = (j == x) ? c : mine; }
        if (sum == G) break;
        __builtin_amdgcn_s_sleep(1);
        if ((++sp & 255u) == 0u) { if (xb_ld(&bar[XB_TMO])) break; if (sp > XB_SPIN_CAP) { atomicAdd(&bar[XB_TMO], 1u); break; } }
    }
    nloc = mine > 0u ? mine : 1u; nx = cnt > 0u ? cnt : 1u;
}

__device__ __forceinline__ void xcd_barrier(const XcdBarrier& b) {
    asm volatile("s_waitcnt vmcnt(0)" ::: "memory");
    __syncthreads();
    if (threadIdx.x == 0) {
        unsigned* bar = b.bar;
        __builtin_amdgcn_s_waitcnt(0);
        unsigned nloc = b.st[0], nx = b.st[1];
        if (nloc == 0u) { xcd_barrier_complete(bar, b.x, nloc, nx); b.st[0] = nloc; b.st[1] = nx; }
        const unsigned old = xb_add(&bar[XB_XSUB(b.x)], 1u);
        const unsigned gen = old / nloc;
        if (old + 1u == (gen + 1u) * nloc) {
            __builtin_amdgcn_fence(__ATOMIC_RELEASE, "agent");
            asm volatile("s_waitcnt vmcnt(0)" ::: "memory");
            const unsigned og = xb_add(&bar[XB_TOP], 1u);
            const unsigned tg = og / nx;
            if (og + 1u == (tg + 1u) * nx) xb_add(&bar[XB_TOPGEN], 1u);
            else XB_SPIN(xb_ld(&bar[XB_TOPGEN]) == tg, bar);
            __builtin_amdgcn_fence(__ATOMIC_ACQUIRE, "agent");
            xb_add(&bar[XB_XGEN(b.x)], 1u);
            asm volatile("s_waitcnt vmcnt(0)" ::: "memory");
        } else {
            XB_SPIN(xb_ld(&bar[XB_XGEN(b.x)]) == gen, bar);
            __builtin_amdgcn_fence(__ATOMIC_ACQUIRE, "agent");
            asm volatile("s_waitcnt vmcnt(0)" ::: "memory");
        }
    }
    __syncthreads();
}


DI void mix_phase(KP p, int l, LAS unsigned char* lds, int tid) {
    asm volatile("" : "+v"(tid));
    const int G = gridDim.x, bid = blockIdx.x;
    const bf16_t* P = (const bf16_t*)(p->ws + WS_P);
    bf16_t* ATT = (bf16_t*)(p->ws + WS_S); bf16_t* MLB = ATT + (size_t)MTOT * 512; bf16_t* HGB = MLB + (size_t)MTOT * 512;
    const int nattn = 512 + (l == 0 ? 32 : 0);
    if (bid < 128) {
        const int it = bid, dir = it & 1, hd = (it >> 1) & 3, b = (it >> 3) & 7, ty = it >> 6;
        unsigned* prog = (unsigned*)p->ws + (l * 128 + (it & ~1)) * 16;
        if (ty == 0) { ScanArgs A{P, MLB, (const float*)(p->ws + WS_GATES), p->in[I_MLCONV] + (size_t)l * 3 * 512, p->in[I_MLFB] + l * 8, p->in[I_MLNORM] + l * 512, p->in[I_HGLB], l};
#ifndef NO_SCANML
            scan_item<true>(A, b, hd, dir, prog + dir * 16, prog + (dir ^ 1) * 16, lds, tid);
#endif
        } else { ScanArgs A{P, HGB, (const float*)(p->ws + WS_GATES), p->in[I_MLCONV], p->in[I_MLFB], p->in[I_HGNORM] + l * 512, p->in[I_HGLB], l};
#ifndef NO_SCANHG
            scan_item<false>(A, b, hd, dir, prog + dir * 16, prog + (dir ^ 1) * 16, lds, tid);
#endif
        }
    }
    if (bid >= 128) {
        __syncthreads();
        const f32x2* rope = (const f32x2*)(p->ws + WS_ROPE);
        for (int i = tid; i < 1024; i += 512) ((LAS f32x2*)(lds + AT_TAB))[i] = rope[i];
        __syncthreads();
        AttnArgs A{P, ATT, p->in[I_SINK] + l * 8, rope};
        for (int it = bid - 128; it < nattn; it += G - 128) {
#ifndef NO_ATTN
 attn_item(A, it, lds, tid);
#endif
 }
    }
}

template <class Epi> DI void run_gemm(LAS unsigned char* lds, const bf16_t* A, const bf16_t* Bt, int M, int N, int K, const Epi& E) {
    pg8::Gemm g{A, Bt, M, N, K}; pg8::StaticOrder S; S.init(M, N, (int)gridDim.x, (int)blockIdx.x);
    pg8::gemm_phase<Epi, pg8::StaticOrder, true, true>(lds, g, S, E);
}

template <class Epi> DI void run_gemm_ctx(LAS unsigned char* lds, const bf16_t* A, const bf16_t* Bt, int N, int K, const Epi& E) {
    pg8::Gemm g{A, Bt, MTOT, N, K}; pg8::CtxOrder S{224, MLAT / 256};
    pg8::gemm_phase<Epi, pg8::CtxOrder, true, true>(lds, g, S, E);
}

#define GRID_BAR() do { XcdBarrier xb_; xb_.bar = (unsigned*)(ws) + 8192; xb_.x = xb_xcc_id(); xb_.st = (volatile LAS unsigned*)(lds + 131072); xcd_barrier(xb_); } while (0)
__global__ void __launch_bounds__(512) fwd_kernel(Params p_unused) {
    extern __shared__ __attribute__((aligned(16))) unsigned char lds_raw[];
    LAS unsigned char* lds = (LAS unsigned char*)lds_raw;
    cg::grid_group grid = cg::this_grid();
#define tid ((int)threadIdx.x)
#define ws (kparams()->ws)
#define W ((bf16_t*)(ws + WS_W))
#define H ((bf16_t*)(ws + WS_H))
#define PB ((bf16_t*)(ws + WS_P))
#define SB ((bf16_t*)(ws + WS_S))
#define XC ((float*)(ws + WS_XC))
#define mod ((const float*)(ws + WS_MOD))
#define gates ((float*)(ws + WS_GATES))
    KP p = kparams();
    if (threadIdx.x < 16) ((LAS unsigned*)(lds + 131072))[threadIdx.x] = 0u;
    __syncthreads();
    (void)xcd_barrier_post((unsigned*)(ws) + 8192, (volatile LAS unsigned*)(lds + 131072));

#if PH & 1
    convert_weights(p, 0, lds);
    __syncthreads();
    mods_phase(p, lds, tid);
#endif
    grid.sync();
    {
        RowArgs a{p->in[I_X], p->in[I_CTX], nullptr, nullptr, nullptr, H, mod, mod, nullptr, p->in[I_NPRE], nullptr, nullptr, 0, 0, 0, MTOT, (int)blockIdx.x, (int)gridDim.x, 0.f};
#if PH & 2
        row_phase<false, true, false>(a, lds, tid);
#endif
    }
    GRID_BAR();

#pragma unroll 1
    for (int l = 0; l < 2; ++l) {
#pragma unroll 1
      for (int f = 0; f < 2; ++f) {
        p = kparams();
        const float* modl = mod + (size_t)l * 9 * 9216;
        const float* npre = p->in[I_NPRE] + (size_t)l * 3 * DM; const float* npost = p->in[I_NPOST] + (size_t)l * 3 * DM;
        const bool ctx2 = (l == 0);
        const int bid = (int)blockIdx.x, G = (int)gridDim.x;
        if (f == 1) {
            { pg8::EpiBf16<0> E{PB, 256, PTS}; run_gemm(lds, H, W + WO_WIN, MTOT, NPC, DM, E); }
            GRID_BAR();
            mix_phase(p, l, lds, tid);
            GRID_BAR();
            { pg8::EpiBf16<1> E{PB, NGC, 0}; run_gemm(lds, H, W + WO_WG, ctx2 ? MTOT : MLAT, NGC, DM, E); }
            GRID_BAR();
#pragma unroll 1
            for (int gi = 0; gi < 3; ++gi) { pg8::EpiMerge E{H, PB, gi}; run_gemm(lds, SB + (size_t)gi * MTOT * 512, W + WO_WB + (size_t)gi * 1024 * 512, ctx2 ? MTOT : MLAT, DM, 512, E); }
            GRID_BAR();
            { pg8::EpiBf16<0> E{SB, DM, 0}; run_gemm(lds, H, W + WO_WOUT, MLAT, DM, DM, E); }
            GRID_BAR();
            {
                const int vg = ctx2 ? 224 : G;
                RowArgs a{p->out, XC, p->out, XC, SB, H, modl, modl, npost + DM, npre + 2 * DM, nullptr, nullptr, 1, 2, 0, MLAT, bid < vg ? bid : -1, vg, 1.0f};
                if (bid < vg) row_phase<true, true, false>(a, lds, tid);
                else { pg8::EpiBf16<0> E{SB, DM, 0}; run_gemm_ctx(lds, H, W + WO_WOUT, DM, DM, E); }
            }
            GRID_BAR();
            if (ctx2) {
                RowArgs a{p->out, XC, p->out, XC, SB, H, modl, modl, npost + DM, npre + 2 * DM, nullptr, nullptr, 1, 2, MLAT, MTOT, bid, G, 1.0f};
                row_phase<true, true, false>(a, lds, tid);
                GRID_BAR();
            }
        }
        const bool hc = (f == 0) || ctx2;
        { pg8::EpiSwiGLU E{PB, DFF}; run_gemm(lds, H, W + WO_W13 + (size_t)f * 5632 * 1024, hc ? MTOT : MLAT, 5632, DM, E); }
        GRID_BAR();
        { pg8::EpiBf16<0> E{SB, DM, 0}; run_gemm(lds, PB, W + WO_W2 + (size_t)f * 1024 * 2816, MLAT, DM, DFF, E); }
        GRID_BAR();
        {
            const int vg = hc ? 224 : G;
            const bool has_pre = (f == 0) || (l == 0);
            RowArgs a{(l == 0 && f == 0) ? p->in[I_X] : p->out, (l == 0 && f == 0) ? p->in[I_CTX] : XC, p->out, XC, SB, H, modl, f == 0 ? modl : mod + (size_t)9 * 9216,
                      npost + (f == 0 ? 0 : 2 * DM), f == 0 ? npre + DM : p->in[I_NPRE] + 3 * DM, p->in[I_WIN] + (size_t)l * DM * DIN + 2304, gates, f == 0 ? 0 : 2, f == 0 ? 1 : 0, 0, MLAT, bid < vg ? bid : -1, vg, 0.5f};
            if (bid < vg) {
                if (f == 0) row_phase<true, true, true>(a, lds, tid);
                else if (has_pre) row_phase<true, true, false>(a, lds, tid);
                else row_phase<true, false, false>(a, lds, tid);
            } else { pg8::EpiBf16<0> E{SB, DM, 0}; run_gemm_ctx(lds, PB, W + WO_W2 + (size_t)f * 1024 * 2816, DM, DFF, E); }
            if (hc) {
                GRID_BAR();
                RowArgs c = a; c.row0 = MLAT; c.row1 = MTOT; c.vb = bid; c.vg = G;
                if (f == 0) row_phase<true, true, true>(c, lds, tid);
                else { row_phase<true, true, false>(c, lds, tid); __syncthreads(); convert_weights(p, 1, lds); }
            }
        }
        if (!(l == 1 && f == 1)) GRID_BAR();
      }
    }
#undef tid
#undef ws
#undef W
#undef H
#undef PB
#undef SB
#undef XC
#undef mod
#undef gates
}

extern "C" void kernel_launch(void* const* d_in, const int* in_sizes, int n_in, void* d_out, int out_size, void* d_ws, size_t ws_size, hipStream_t stream) {
    static int grid = 0;
    if (grid == 0) {
        if (n_in != 22 || out_size != MLAT * DM || ws_size < WS_END) { fprintf(stderr, "kernel_launch: unexpected shapes (n_in %d out %d ws %zu)\n", n_in, out_size, ws_size); grid = -1; return; }
        int dev = 0, cus = 0, per_cu = 0;
        (void)hipGetDevice(&dev);
        (void)hipDeviceGetAttribute(&cus, hipDeviceAttributeMultiprocessorCount, dev);
        (void)hipFuncSetAttribute((const void*)fwd_kernel, hipFuncAttributeMaxDynamicSharedMemorySize, LDS_BYTES);
        (void)hipOccupancyMaxActiveBlocksPerMultiprocessor(&per_cu, (const void*)fwd_kernel, 512, LDS_BYTES);
        if (per_cu < 1) per_cu = 1;
        if (per_cu > 1) per_cu = 1;
        grid = cus * per_cu;
        if (grid <= 0) grid = 256;
    }
    if (grid < 0) return;
    if (grid < 192) { fprintf(stderr, "kernel_launch: grid %d too small for the paired scans\n", grid); return; }
    (void)hipMemsetAsync(d_ws, 0, 65536, stream);
    Params p{};
    for (int i = 0; i < 22; ++i) p.in[i] = (const float*)d_in[i];
    p.out = (float*)d_out; p.ws = (unsigned char*)d_ws;
    void* args[] = {&p};
    hipError_t e = hipLaunchCooperativeKernel((const void*)fwd_kernel, dim3(grid), dim3(512), args, LDS_BYTES, stream);
    if (e != hipSuccess) fprintf(stderr, "cooperative launch failed: %s (grid %d)\n", hipGetErrorString(e), grid);
}
```

```cpp
#include <hip/hip_runtime.h>
#include <hip/hip_cooperative_groups.h>
#include <cstdio>
#include <cstdint>
namespace cg = cooperative_groups;

#define DI __device__ __forceinline__
#define LAS __attribute__((address_space(3)))
typedef unsigned short bf16_t;
typedef short bf16x8 __attribute__((ext_vector_type(8)));
typedef short s16x4 __attribute__((ext_vector_type(4)));
typedef float f32x2 __attribute__((ext_vector_type(2)));
typedef float f32x4 __attribute__((ext_vector_type(4)));
typedef float f32x16 __attribute__((ext_vector_type(16)));
typedef unsigned u32x2 __attribute__((ext_vector_type(2)));
typedef unsigned u32x4 __attribute__((ext_vector_type(4)));

constexpr int DM = 1024, NB = 8, SEQ = 4096, CTXL = 256, DFF = 2816, DIN = 7184, NMOD = 9;
constexpr int MLAT = NB * SEQ, MCTX = NB * CTXL, MTOT = MLAT + MCTX;
constexpr int NPC = 4096;
constexpr int NGC = 3072;
constexpr float EPS = 1e-6f;
constexpr int PC_AQ = 0, PC_AK = 512, PC_AV = 640, PC_MQ = 768, PC_MK = 1024, PC_MV = 1280, PC_MO = 1792, PC_HQ = 2304, PC_HF = 2560, PC_HI = 3072, PC_HG = 3584;

constexpr size_t MiB = 1u << 20;
constexpr size_t WS_MOD = 1 * MiB;
constexpr size_t WS_ROPE = 2 * MiB;
constexpr size_t WS_GATES = 3 * MiB;
constexpr size_t WS_XC = 6 * MiB;
constexpr size_t WS_W = 14 * MiB;
constexpr size_t WS_H = 66 * MiB;
constexpr size_t WS_P = 134 * MiB;
constexpr size_t WS_S = 406 * MiB;
constexpr size_t WS_END = 508 * MiB;
constexpr size_t WO_W13 = 0;
constexpr size_t WO_W2 = WO_W13 + (size_t)2 * 5632 * 1024;
constexpr size_t WO_WIN = WO_W2 + (size_t)2 * 1024 * 2816;
constexpr size_t WO_WG = WO_WIN + (size_t)4096 * 1024;
constexpr size_t WO_WB = WO_WG + (size_t)3072 * 1024;
constexpr size_t WO_WOUT = WO_WB + (size_t)3 * 1024 * 512;
constexpr size_t WO_END = WO_WOUT + (size_t)1024 * 1024;
static_assert(WO_END * 2 <= 52 * MiB, "weights fit");
static_assert((size_t)MTOT * 1024 * 2 <= 68 * MiB && (size_t)MTOT * 4096 * 2 <= 272 * MiB && (size_t)MTOT * 512 * 2 * 3 <= 102 * MiB, "ws map");

constexpr int LDS_BYTES = 131072 + 64;
constexpr size_t PTS = (size_t)MTOT * 256;
__device__ __forceinline__ size_t pidx(int row, int col) { return (size_t)(col >> 8) * PTS + (size_t)row * 256 + (col & 255); }

DI unsigned f2bf(float f) { unsigned u = __float_as_uint(f); return (u + 0x7fffu + ((u >> 16) & 1u)) >> 16; }
typedef __bf16 bf16v2 __attribute__((ext_vector_type(2)));
DI unsigned pk2(float lo, float hi) { f32x2 v = {lo, hi}; bf16v2 b = __builtin_convertvector(v, bf16v2); return __builtin_bit_cast(unsigned, b); }
DI float bflo(unsigned w) { return __uint_as_float(w << 16); }
DI float bfhi(unsigned w) { return __uint_as_float(w & 0xffff0000u); }
DI float bf1(short s) { return __uint_as_float(((unsigned)(unsigned short)s) << 16); }
DI float fexp(float x) { return __builtin_amdgcn_exp2f(x * 1.4426950408889634f); }
DI float flog(float x) { return __builtin_amdgcn_logf(x) * 0.6931471805599453f; }
DI float flog1p(float e) { const float u = 1.0f + e, d = u - 1.0f; return d == 0.f ? e : flog(u) * e * __builtin_amdgcn_rcpf(d); }
DI float fsigmoid(float x) { return __builtin_amdgcn_rcpf(1.0f + fexp(-x)); }
DI float fsilu(float x) { return x * fsigmoid(x); }
DI float wave_sum(float v) {
#pragma unroll
    for (int o = 1; o < 64; o <<= 1) v += __shfl_xor(v, o);
    return v;
}
DI bf16x8 pack8(float a0, float a1, float a2, float a3, float a4, float a5, float a6, float a7) {
    u32x4 p; p.x = pk2(a0, a1); p.y = pk2(a2, a3); p.z = pk2(a4, a5); p.w = pk2(a6, a7); return __builtin_bit_cast(bf16x8, p);
}
#define MFMA32(a, b, c) __builtin_amdgcn_mfma_f32_32x32x16_bf16((a), (b), (c), 0, 0, 0)
DI int crow(int i, int h) { return (i & 3) + 8 * (i >> 2) + 4 * h; }

#define LDS_BARRIER() do { asm volatile("s_waitcnt lgkmcnt(0)" ::: "memory"); __builtin_amdgcn_s_barrier(); asm volatile("" ::: "memory"); } while (0)
namespace pg8 {
#define PG8_LAS __attribute__((address_space(3)))
typedef unsigned short bf16_t;
typedef short bf16x8 __attribute__((ext_vector_type(8)));
typedef float f32x4 __attribute__((ext_vector_type(4)));
typedef unsigned u32x4 __attribute__((ext_vector_type(4)));
constexpr int BM = 256, BK = 64, HALF = 128, HTB = HALF * BK * 2  , STAGE_BYTES = 8 * HTB, NXCD = 8, WGM = 8;

__host__ __device__ __forceinline__ int lds_byte(int r, int c) { const int st = (r >> 4) * 2 + (c >> 5), rr = r & 15, cc = c & 31, ob = rr * 64 + cc * 2; return st * 1024 + (ob ^ (((ob >> 9) & 1) << 5)); }
__host__ __device__ __forceinline__ void stage_rc(int b, int& R, int& C) { const int st = b / 1024, sb = b % 1024, swz = sb ^ (((sb >> 9) & 1) << 5); R = (st >> 1) * 16 + swz / 64; C = (st & 1) * 32 + (swz % 64) / 2; }
__host__ __device__ __forceinline__ int perm32(int rho) { const int n = rho >> 4, i = rho & 15; return 8 * (i >> 2) + 4 * n + (i & 3); }

struct Unit { int pm, pn; };
struct Gemm { const bf16_t* A; const bf16_t* Bt; int M, N, K; };

struct StaticOrder {
    int nM, nN, nwg, G, c;
    __host__ __device__ void init(int M, int N, int G_, int c_) { nM = M / BM; nN = N / BM; nwg = nM * nN; G = G_; c = c_; }
    __host__ __device__ bool next(int i, Unit& u) const {
        const long L = (long)i * G + c; if (L >= nwg) return false;
        int wgid = (int)L; { const int q = nwg / NXCD, r = nwg % NXCD, xcd = wgid % NXCD, off = wgid / NXCD; wgid = (xcd < r ? xcd * (q + 1) : r * (q + 1) + (xcd - r) * q) + off; }
        const int nig = WGM * nN, gid = wgid / nig, fm = gid * WGM, gsz = (nM - fm) < WGM ? (nM - fm) : WGM;
        u.pm = fm + ((wgid % nig) % gsz); u.pn = (wgid % nig) / gsz; return true;
    }
    __device__ __forceinline__ void a_ready(const Unit&) const {}
    __device__ __forceinline__ void done(const Unit&) const {}
};

struct CtxOrder {
    int first, pm0;
    __host__ __device__ bool next(int i, Unit& u) const { const int idx = (int)blockIdx.x - first; if (i != 0 || idx < 0 || idx >= 32) return false; u.pm = pm0 + (idx >> 2); u.pn = idx & 3; return true; }
    __device__ __forceinline__ void a_ready(const Unit&) const {}
    __device__ __forceinline__ void done(const Unit&) const {}
};

template <int ACT  > struct EpiBf16 {
    static constexpr bool PERM = true, AFTER_DRAIN = false;
    bf16_t* O; int ldc; size_t tstride;
    __device__ __forceinline__ void operator()(const f32x4 (&acc)[2][2][4][2], const Unit& u, int wr, int wc, int fr, int fq) const {
        const int row0 = u.pm * BM + wr * 64 + fr, col0 = (tstride ? 0 : u.pn * BM) + wc * 32 + 8 * fq;
        bf16_t* Ob = O + (size_t)u.pn * tstride;
#pragma unroll
        for (int ai = 0; ai < 2; ++ai)
#pragma unroll
            for (int m = 0; m < 4; ++m) { bf16_t* rowp = Ob + (size_t)(row0 + ai * HALF + m * 16) * ldc + col0;
#pragma unroll
                for (int bj = 0; bj < 2; ++bj) { f32x4 v0 = acc[ai][bj][m][0], v1 = acc[ai][bj][m][1];
                    if (ACT == 1) {
#pragma unroll
                        for (int k = 0; k < 4; ++k) { v0[k] = fsigmoid(v0[k]); v1[k] = fsigmoid(v1[k]); } }
                    u32x4 w; w.x = pk2(v0[0], v0[1]); w.y = pk2(v0[2], v0[3]); w.z = pk2(v1[0], v1[1]); w.w = pk2(v1[2], v1[3]);
                    *(u32x4*)(rowp + bj * HALF) = w; } }
    }
};
struct EpiSwiGLU {
    static constexpr bool PERM = false, AFTER_DRAIN = false;
    bf16_t* O; int ldc;
    __device__ __forceinline__ void operator()(const f32x4 (&acc)[2][2][4][2], const Unit& u, int wr, int wc, int fr, int fq) const {
        const int row0 = u.pm * BM + wr * 64 + fr, f0 = u.pn * 128 + wc * 16 + 4 * fq;
#pragma unroll
        for (int ai = 0; ai < 2; ++ai)
#pragma unroll
            for (int m = 0; m < 4; ++m) { bf16_t* rowp = O + (size_t)(row0 + ai * HALF + m * 16) * ldc + f0;
#pragma unroll
                for (int bj = 0; bj < 2; ++bj) { const f32x4 a = acc[ai][bj][m][0], b = acc[ai][bj][m][1];
                    u32x2 w; w.x = pk2(fsilu(a[0]) * b[0], fsilu(a[1]) * b[1]); w.y = pk2(fsilu(a[2]) * b[2], fsilu(a[3]) * b[3]);
                    *(u32x2*)(rowp + bj * 64) = w; } }
    }
};
struct EpiMerge {
    static constexpr bool PERM = true, AFTER_DRAIN = false;
    bf16_t* O; const bf16_t* G; int gi;
    __device__ __forceinline__ void operator()(const f32x4 (&acc)[2][2][4][2], const Unit& u, int wr, int wc, int fr, int fq) const {
        const int row0 = u.pm * BM + wr * 64 + fr, col0 = u.pn * BM + wc * 32 + 8 * fq;
#pragma unroll
        for (int ai = 0; ai < 2; ++ai)
#pragma unroll
            for (int m = 0; m < 4; ++m) { const size_t r = (size_t)(row0 + ai * HALF + m * 16);
#pragma unroll
                for (int bj = 0; bj < 2; ++bj) { const int c = col0 + bj * HALF;
                    const u32x4 g = *(const u32x4*)(G + r * 3072 + gi * 1024 + c);
                    const f32x4 v0 = acc[ai][bj][m][0], v1 = acc[ai][bj][m][1];
                    float o0 = bflo(g.x) * v0[0], o1 = bfhi(g.x) * v0[1], o2 = bflo(g.y) * v0[2], o3 = bfhi(g.y) * v0[3];
                    float o4 = bflo(g.z) * v1[0], o5 = bfhi(g.z) * v1[1], o6 = bflo(g.w) * v1[2], o7 = bfhi(g.w) * v1[3];
                    bf16_t* op = O + r * 1024 + c;
                    if (gi > 0) {
                        const unsigned long long p0 = __hip_atomic_load((const unsigned long long*)op, __ATOMIC_RELAXED, __HIP_MEMORY_SCOPE_AGENT);
                        const unsigned long long p1 = __hip_atomic_load((const unsigned long long*)op + 1, __ATOMIC_RELAXED, __HIP_MEMORY_SCOPE_AGENT);
                        const unsigned a0 = (unsigned)p0, a1 = (unsigned)(p0 >> 32), a2 = (unsigned)p1, a3 = (unsigned)(p1 >> 32);
                        o0 += bflo(a0); o1 += bfhi(a0); o2 += bflo(a1); o3 += bfhi(a1); o4 += bflo(a2); o5 += bfhi(a2); o6 += bflo(a3); o7 += bfhi(a3);
                    }
                    u32x4 w; w.x = pk2(o0, o1); w.y = pk2(o2, o3); w.z = pk2(o4, o5); w.w = pk2(o6, o7);
                    *(u32x4*)op = w; } }
    }
};

template <class Epi, class Sched, bool ALIGN_EPI = false, bool SP2 = false>
__device__ __forceinline__ void gemm_phase(PG8_LAS unsigned char* lds, const Gemm g, const Sched& S, const Epi& E) {
    int tid_ = threadIdx.x; asm volatile("" : "+v"(tid_));
    const int tid = tid_, wid = __builtin_amdgcn_readfirstlane(tid >> 6), lane = tid & 63, wr = wid >> 2, wc = wid & 3, fr = lane & 15, fq = lane >> 4;
    const int K = g.K, nt = K / BK;
    unsigned voffA[2], voffB[2];
#pragma unroll
    for (int i = 0; i < 2; ++i) { int R, C; stage_rc(tid * 16 + i * 8192, R, C); const int Rb = Epi::PERM ? ((R & ~31) + perm32(R & 31)) : R;
        voffA[i] = (unsigned)(R * K + C) * 2u; voffB[i] = (unsigned)(Rb * K + C) * 2u; }
    const size_t kstep = (size_t)(BK * 2);
    const size_t hstep = (size_t)HALF * K * 2;
    const size_t tstep = 2 * hstep;
    const unsigned ldsw = (unsigned)wid * 1024u;
    const int aoff = lds_byte(wr * 64 + fr, fq * 8), boff = lds_byte(wc * 32 + fr, fq * 8);
#define PG8_SA(b, h) (((b) * 2 + (h)) * HTB)
#define PG8_SB(b, h) ((4 + (b) * 2 + (h)) * HTB)
#define PG8_STAGE(bufoff, gbase, voff) do { _Pragma("unroll") for (int _i = 0; _i < 2; ++_i) \
        __builtin_amdgcn_global_load_lds((const unsigned*)((const char*)(gbase) + (voff)[_i]), (PG8_LAS unsigned*)(lds + (bufoff) + ldsw + _i * 8192), 16, 0, 0); } while (0)
#define PG8_LDA(dst, b, h) do { _Pragma("unroll") for (int m = 0; m < 4; ++m) _Pragma("unroll") for (int k = 0; k < 2; ++k) dst[m][k] = *(const PG8_LAS bf16x8*)(lds + PG8_SA(b, h) + aoff + m * 2048 + k * 1024); } while (0)
#define PG8_LDB(dst, b, h) do { _Pragma("unroll") for (int n = 0; n < 2; ++n) _Pragma("unroll") for (int k = 0; k < 2; ++k) dst[n][k] = *(const PG8_LAS bf16x8*)(lds + PG8_SB(b, h) + boff + n * 2048 + k * 1024); } while (0)
#define PG8_MMA(ai, bj, At, Bt) do { __builtin_amdgcn_s_setprio(1); _Pragma("unroll") for (int m = 0; m < 4; ++m) _Pragma("unroll") for (int n = 0; n < 2; ++n) _Pragma("unroll") for (int k = 0; k < 2; ++k) \
        acc[ai][bj][m][n] = __builtin_amdgcn_mfma_f32_16x16x32_bf16(Bt[n][k], At[m][k], acc[ai][bj][m][n], 0, 0, 0); __builtin_amdgcn_s_setprio(0); } while (0)
#define PG8_WAIT_V(n) asm volatile("s_waitcnt vmcnt(" #n ")" ::: "memory")
#define PG8_WAIT_L(n) asm volatile("s_waitcnt lgkmcnt(" #n ")" ::: "memory")
#define PG8_BAR __builtin_amdgcn_s_barrier()
#define PG8_SCHED __builtin_amdgcn_sched_barrier(0)
    Unit cur, nxt; int ui = 0;
    if (!S.next(0, cur)) return;
    f32x4 acc[2][2][4][2];
#pragma unroll
    for (int a = 0; a < 2; ++a)
#pragma unroll
        for (int b = 0; b < 2; ++b)
#pragma unroll
            for (int m = 0; m < 4; ++m)
#pragma unroll
                for (int n = 0; n < 2; ++n) acc[a][b][m][n] = (f32x4){0.f, 0.f, 0.f, 0.f};
    bf16x8 At[4][2], B0[2][2], B1[2][2];
    const char* cA = (const char*)g.A + (size_t)cur.pm * tstep; const char* cB = (const char*)g.Bt + (size_t)cur.pn * tstep;
    S.a_ready(cur);
    if constexpr (SP2) {
        PG8_STAGE(PG8_SB(0, 0), cB, voffB); PG8_STAGE(PG8_SB(0, 1), cB + hstep, voffB); PG8_STAGE(PG8_SA(0, 0), cA, voffA); PG8_STAGE(PG8_SA(0, 1), cA + hstep, voffA);
        if (wr == 1) PG8_BAR;
        PG8_WAIT_V(2); PG8_BAR;
        PG8_STAGE(PG8_SB(1, 0), cB + kstep, voffB); PG8_STAGE(PG8_SA(1, 0), cA + kstep, voffA); PG8_STAGE(PG8_SB(1, 1), cB + hstep + kstep, voffB);
        PG8_WAIT_V(6); PG8_BAR;
    } else {
        PG8_STAGE(PG8_SB(0, 0), cB, voffB); PG8_STAGE(PG8_SA(0, 0), cA, voffA); PG8_STAGE(PG8_SB(0, 1), cB + hstep, voffB); PG8_STAGE(PG8_SA(0, 1), cA + hstep, voffA);
        if (wr == 1) PG8_BAR;
        PG8_WAIT_V(4); PG8_BAR;
        PG8_STAGE(PG8_SB(1, 0), cB + kstep, voffB); PG8_STAGE(PG8_SA(1, 0), cA + kstep, voffA); PG8_STAGE(PG8_SB(1, 1), cB + hstep + kstep, voffB);
        PG8_WAIT_V(6); PG8_BAR;
    }
    for (;;) {
        const bool has_next = S.next(ui + 1, nxt);
        const char* nA = has_next ? (const char*)g.A + (size_t)nxt.pm * tstep : cA; const char* nB = has_next ? (const char*)g.Bt + (size_t)nxt.pn * tstep : cB;
        for (int t = 0; t < nt; t += 2) {
            const bool last = (t == nt - 2);
            const char* a1 = cA + (size_t)(t + 1) * kstep;
            const char* a2 = last ? nA : cA + (size_t)(t + 2) * kstep; const char* b2 = last ? nB : cB + (size_t)(t + 2) * kstep;
            const char* a3 = a2 + kstep; const char* b3 = b2 + kstep;
            if (last && has_next) S.a_ready(nxt);
            if constexpr (SP2) {
            PG8_LDB(B0, 0, 0); PG8_LDB(B1, 0, 1); PG8_SCHED; PG8_LDA(At, 0, 0); PG8_STAGE(PG8_SA(1, 1), a1 + hstep, voffA);
            PG8_WAIT_V(8); PG8_WAIT_L(0); PG8_BAR; PG8_MMA(0, 0, At, B0); PG8_MMA(0, 1, At, B1); PG8_BAR; PG8_SCHED;
            PG8_LDA(At, 0, 1); PG8_STAGE(PG8_SB(0, 0), b2, voffB); PG8_STAGE(PG8_SB(0, 1), b2 + hstep, voffB); PG8_STAGE(PG8_SA(0, 0), a2, voffA);
            PG8_WAIT_V(8); PG8_WAIT_L(0); PG8_BAR; PG8_MMA(1, 0, At, B0); PG8_MMA(1, 1, At, B1); PG8_BAR; PG8_SCHED;
            PG8_LDB(B0, 1, 0); PG8_LDB(B1, 1, 1); PG8_SCHED; PG8_LDA(At, 1, 0); PG8_STAGE(PG8_SA(0, 1), a2 + hstep, voffA);
            PG8_WAIT_V(8); PG8_WAIT_L(0); PG8_BAR; PG8_MMA(0, 0, At, B0); PG8_MMA(0, 1, At, B1); PG8_BAR; PG8_SCHED;
            PG8_LDA(At, 1, 1); PG8_STAGE(PG8_SB(1, 0), b3, voffB); PG8_STAGE(PG8_SB(1, 1), b3 + hstep, voffB); PG8_STAGE(PG8_SA(1, 0), a3, voffA);
            PG8_WAIT_V(8); PG8_WAIT_L(0); PG8_BAR; PG8_MMA(1, 0, At, B0); PG8_MMA(1, 1, At, B1); PG8_BAR; PG8_SCHED;
            } else {
            PG8_LDB(B0, 0, 0); PG8_SCHED; PG8_LDA(At, 0, 0); PG8_STAGE(PG8_SA(1, 1), a1 + hstep, voffA);
            PG8_WAIT_L(8); PG8_BAR; PG8_WAIT_L(0); PG8_MMA(0, 0, At, B0); PG8_BAR; PG8_SCHED;
            PG8_LDB(B1, 0, 1); PG8_STAGE(PG8_SB(0, 0), b2, voffB);
            PG8_BAR; PG8_WAIT_L(0); PG8_MMA(0, 1, At, B1); PG8_BAR;
            PG8_LDA(At, 0, 1); PG8_STAGE(PG8_SA(0, 0), a2, voffA);
            PG8_BAR; PG8_WAIT_L(0); PG8_MMA(1, 0, At, B0); PG8_BAR; PG8_SCHED;
            PG8_STAGE(PG8_SB(0, 1), b2 + hstep, voffB);
            PG8_WAIT_V(6); PG8_BAR; PG8_MMA(1, 1, At, B1); PG8_BAR;
            PG8_LDB(B0, 1, 0); PG8_SCHED; PG8_LDA(At, 1, 0); PG8_STAGE(PG8_SA(0, 1), a2 + hstep, voffA);
            PG8_WAIT_L(8); PG8_BAR; PG8_WAIT_L(0); PG8_MMA(0, 0, At, B0); PG8_BAR; PG8_SCHED;
            PG8_LDB(B1, 1, 1); PG8_STAGE(PG8_SB(1, 0), b3, voffB);
            PG8_BAR; PG8_WAIT_L(0); PG8_MMA(0, 1, At, B1); PG8_BAR;
            PG8_LDA(At, 1, 1); PG8_STAGE(PG8_SA(1, 0), a3, voffA);
            PG8_BAR; PG8_WAIT_L(0); PG8_MMA(1, 0, At, B0); PG8_BAR; PG8_SCHED;
            PG8_STAGE(PG8_SB(1, 1), b3 + hstep, voffB);
            PG8_WAIT_V(6); PG8_BAR; PG8_MMA(1, 1, At, B1); PG8_BAR;
            }
        }
        if constexpr (ALIGN_EPI) { if (wr == 0) PG8_BAR; }
        if constexpr (!Epi::AFTER_DRAIN) { E(acc, cur, wr, wc, fr, fq); S.done(cur); }
        if (!has_next) break;
#pragma unroll
        for (int a = 0; a < 2; ++a)
#pragma unroll
            for (int b = 0; b < 2; ++b)
#pragma unroll
                for (int m = 0; m < 4; ++m)
#pragma unroll
                    for (int n = 0; n < 2; ++n) acc[a][b][m][n] = (f32x4){0.f, 0.f, 0.f, 0.f};
        cur = nxt; cA = nA; cB = nB; ++ui;
        if constexpr (ALIGN_EPI) { if (wr == 1) PG8_BAR; }
    }
    PG8_WAIT_V(0);
    if constexpr (!ALIGN_EPI) { if (wr == 0) PG8_BAR; }
    PG8_BAR;
    if constexpr (Epi::AFTER_DRAIN) { E.fused(acc, cur, wr, wc, fr, fq, lds, wid, lane); S.done(cur); }
#undef PG8_SA
#undef PG8_SB
#undef PG8_STAGE
#undef PG8_LDA
#undef PG8_LDB
#undef PG8_MMA
#undef PG8_WAIT_V
#undef PG8_WAIT_L
#undef PG8_BAR
#undef PG8_SCHED
}
}

struct Params { const float* in[22]; float* out; unsigned char* ws; };
typedef const __attribute__((address_space(4))) Params* KP;
DI KP kparams() { KP kp = (KP)__builtin_amdgcn_kernarg_segment_ptr(); asm volatile("" : "+s"(kp)); return kp; }
enum { I_X = 0, I_C, I_CTX, I_CCTX, I_WADA, I_BADA, I_NPRE, I_NPOST, I_W1, I_W3, I_W2, I_WIN, I_SINK, I_MLCONV, I_MLFB, I_MLNORM, I_HGLB, I_HGNORM, I_WBA, I_WBM, I_WBH, I_WOUT };

DI void transpose_item(const float* Wa, const float* Wb, int ldw, int K, bf16_t* dst, int k0, LAS float* scr, int lane) {
    const float* src = (((lane & 31) < 16) ? Wa : Wb) + (lane & 15);
#pragma unroll 8
    for (int i = 0; i < 32; ++i) { const int kk = 2 * i + (lane >> 5); scr[kk * 33 + (lane & 31)] = src[(size_t)(k0 + kk) * ldw]; }
    asm volatile("s_waitcnt lgkmcnt(0)" ::: "memory");
    const int c = lane & 7;
#pragma unroll
    for (int j = 0; j < 4; ++j) { const int n = (lane >> 3) + 8 * j; const LAS float* s = scr + (8 * c) * 33 + n;
        u32x4 o; o.x = pk2(s[0 * 33], s[1 * 33]); o.y = pk2(s[2 * 33], s[3 * 33]); o.z = pk2(s[4 * 33], s[5 * 33]); o.w = pk2(s[6 * 33], s[7 * 33]);
        *(u32x4*)(dst + (size_t)n * K + k0 + 8 * c) = o; }
    asm volatile("s_waitcnt lgkmcnt(0)" ::: "memory");
}
struct Seg { const float* Wa; const float* Wb; int ldw, K, ngroups, colA0, colB0, cstep; bf16_t* dst; };
DI bool seg_run(const Seg& s, int& it, LAS float* scr, int lane) {
    const int nk = s.K / 64, n = s.ngroups * nk;
    if (it >= n) { it -= n; return false; }
    const int gi = it / nk, kb = it % nk;
    transpose_item(s.Wa + s.colA0 + gi * s.cstep, s.Wb + s.colB0 + gi * s.cstep, s.ldw, s.K, s.dst + (size_t)gi * 32 * s.K, kb * 64, scr, lane);
    return true;
}
DI void convert_weights(KP p, int l, LAS unsigned char* lds) {
    int tid_ = threadIdx.x; asm volatile("" : "+v"(tid_));
    const int wave = tid_ >> 6, lane = tid_ & 63;
    LAS float* scr = (LAS float*)(lds + wave * 8704);
    bf16_t* W = (bf16_t*)(p->ws + WS_W);
    const int gw = blockIdx.x * 8 + wave, NGW = gridDim.x * 8;
    constexpr int NITEMS = 2 * 176 * 16 + 2 * 32 * 44 + 128 * 16 + 96 * 16 + 3 * 32 * 8 + 32 * 16;
    for (int item = gw; item < NITEMS; item += NGW) {
        int it = item;
        bool done = false;
#pragma unroll
        for (int f = 0; f < 2 && !done; ++f) {
            const float* w1 = p->in[I_W1] + (size_t)(l * 2 + f) * DM * DFF; const float* w3 = p->in[I_W3] + (size_t)(l * 2 + f) * DM * DFF;
            Seg s{w1, w3, DFF, DM, 176, 0, 0, 16, W + WO_W13 + (size_t)f * 5632 * 1024};
            done = seg_run(s, it, scr, lane);
        }
#pragma unroll
        for (int f = 0; f < 2 && !done; ++f) {
            const float* w2 = p->in[I_W2] + (size_t)(l * 2 + f) * DFF * DM;
            Seg s{w2, w2, DM, DFF, 32, 0, 16, 32, W + WO_W2 + (size_t)f * 1024 * 2816};
            done = seg_run(s, it, scr, lane);
        }
        const float* win = p->in[I_WIN] + (size_t)l * DM * DIN;
        if (!done) { Seg s{win, win, DIN, DM, 72, 0, 16, 32, W + WO_WIN}; done = seg_run(s, it, scr, lane); }
        if (!done) { Seg s{win, win, DIN, DM, 56, 2320, 2336, 32, W + WO_WIN + (size_t)2304 * 1024}; done = seg_run(s, it, scr, lane); }
        if (!done) { Seg s{win, win, DIN, DM, 96, 4112, 4128, 32, W + WO_WG}; done = seg_run(s, it, scr, lane); }
#pragma unroll
        for (int f = 0; f < 3 && !done; ++f) {
            const float* wb = p->in[I_WBA + f] + (size_t)l * 512 * DM;
            Seg s{wb, wb, DM, 512, 32, 0, 16, 32, W + WO_WB + (size_t)f * 1024 * 512};
            done = seg_run(s, it, scr, lane);
        }
        if (!done) { const float* wo = p->in[I_WOUT] + (size_t)l * DM * DM; Seg s{wo, wo, DM, DM, 32, 0, 16, 32, W + WO_WOUT}; done = seg_run(s, it, scr, lane); }
    }
}

DI void mods_phase(KP p, LAS unsigned char* lds, int tid) {
    asm volatile("" : "+v"(tid));
    const int wave = tid >> 6, lane = tid & 63;
    LAS float* sc = (LAS float*)lds;
    LAS float* red = (LAS float*)(lds + 36864);
    for (int i = tid; i < 9 * 1024; i += 512) { const float v = (i < 8192) ? p->in[I_C][i] : p->in[I_CCTX][i - 8192]; sc[i] = v / (1.0f + expf(-v)); }
    __syncthreads();
    float* mod = (float*)(p->ws + WS_MOD);
    for (int it = blockIdx.x; it < 288; it += gridDim.x) {
        const int l = it / 144, cb = it % 144, col = cb * 64 + lane;
        const float* wp = p->in[I_WADA] + ((size_t)l * 1024 + wave * 128) * 9216 + col;
        float acc[9];
#pragma unroll
        for (int i = 0; i < 9; ++i) acc[i] = 0.f;
#pragma unroll 32
        for (int k = 0; k < 128; ++k) { const float wv = wp[(size_t)k * 9216];
#pragma unroll
            for (int i = 0; i < 9; ++i) acc[i] += sc[i * 1024 + wave * 128 + k] * wv; }
#pragma unroll
        for (int i = 0; i < 9; ++i) red[(wave * 9 + i) * 64 + lane] = acc[i];
        __syncthreads();
        for (int o = tid; o < 576; o += 512) { const int i = o >> 6, ln = o & 63; float s = 0.f;
#pragma unroll
            for (int w = 0; w < 8; ++w) s += red[(w * 9 + i) * 64 + ln];
            mod[((size_t)l * 9 + i) * 9216 + cb * 64 + ln] = s + p->in[I_BADA][(size_t)l * 9216 + cb * 64 + ln]; }
        __syncthreads();
    }
    if (blockIdx.x == gridDim.x - 1) {
        f32x2* tab = (f32x2*)(p->ws + WS_ROPE);
        for (int e = tid; e < 1024; e += 512) { const int pos = e >> 4, i = e & 15;
            const float inv = exp2f(-(float)i * (13.287712379549449f / 16.0f));
            const float a = (float)pos * inv; float rev = a * 0.15915494309189535f; rev -= floorf(rev);
            f32x2 cs; cs.x = __builtin_amdgcn_cosf(rev); cs.y = __builtin_amdgcn_sinf(rev); tab[e] = cs; }
    }
}

struct RowArgs {
    const float* xs_lat; const float* xs_ctx; float* xd_lat; float* xd_ctx;
    const bf16_t* Y; bf16_t* H; const float* mod; const float* modpre; const float* gpost; const float* gpre; const float* wgates; float* gates;
    int jpost, jpre, row0, row1, vb, vg; float wpost;
};
template <bool POST, bool PRE, bool GATES>
DI void row_phase(const RowArgs& a, LAS unsigned char* lds, int tid) {
    asm volatile("" : "+v"(tid));
    const int wave = tid >> 6, lane = tid & 63;
    LAS f32x4* wl = (LAS f32x4*)lds;
    if (GATES) {
        for (int idx = tid; idx < 1024 * 4; idx += 512) { const int k = idx >> 2, c4 = idx & 3; const int ln = (k & 255) >> 2, j = k >> 8, e = k & 3;
            wl[((j * 4 + e) * 4 + c4) * 64 + ln] = *(const f32x4*)(a.wgates + (size_t)k * DIN + 4 * c4); }
        __syncthreads();
    }
    for (int row = a.row0 + a.vb * 8 + wave; a.vb >= 0 && row < a.row1; row += a.vg * 8) {
        const int mi = row < MLAT ? (row >> 12) : 8;
        const float* md = a.mod + (size_t)mi * 9216;
        const float* mdp = a.modpre + (size_t)mi * 9216;
        const float* src = row < MLAT ? a.xs_lat + (size_t)row * DM : a.xs_ctx + (size_t)(row - MLAT) * DM;
        f32x4 x[4];
#pragma unroll
        for (int j = 0; j < 4; ++j) x[j] = *(const f32x4*)(src + 4 * lane + 256 * j);
        if (POST) {
            f32x4 y[4]; float s = 0.f;
#pragma unroll
            for (int j = 0; j < 4; ++j) { const u32x2 w = *(const u32x2*)(a.Y + (size_t)row * DM + 4 * lane + 256 * j);
                y[j] = (f32x4){bflo(w.x), bfhi(w.x), bflo(w.y), bfhi(w.y)}; s += (y[j][0] * y[j][0] + y[j][1] * y[j][1]) + (y[j][2] * y[j][2] + y[j][3] * y[j][3]); }
            const float rstd = 1.0f / sqrtf(wave_sum(s) * (1.0f / DM) + EPS);
            float* dst = row < MLAT ? a.xd_lat + (size_t)row * DM : a.xd_ctx + (size_t)(row - MLAT) * DM;
#pragma unroll
            for (int j = 0; j < 4; ++j) { const int c = 4 * lane + 256 * j;
                const f32x4 gt = *(const f32x4*)(md + (3 * a.jpost + 2) * DM + c), gp = *(const f32x4*)(a.gpost + c);
                x[j] = x[j] + a.wpost * gt * (y[j] * rstd * gp);
                *(f32x4*)(dst + c) = x[j]; }
        }
        if (PRE) {
            float s = 0.f;
#pragma unroll
            for (int j = 0; j < 4; ++j) s += (x[j][0] * x[j][0] + x[j][1] * x[j][1]) + (x[j][2] * x[j][2] + x[j][3] * x[j][3]);
            const float rstd = 1.0f / sqrtf(wave_sum(s) * (1.0f / DM) + EPS);
            f32x4 hv[4]; f32x4 g4[4];
#pragma unroll
            for (int c4 = 0; c4 < 4; ++c4) g4[c4] = (f32x4){0.f, 0.f, 0.f, 0.f};
#pragma unroll
            for (int j = 0; j < 4; ++j) { const int c = 4 * lane + 256 * j;
                const f32x4 sh = *(const f32x4*)(mdp + (3 * a.jpre) * DM + c), scl = *(const f32x4*)(mdp + (3 * a.jpre + 1) * DM + c), g = *(const f32x4*)(a.gpre + c);
                hv[j] = (x[j] * rstd * g) * (1.0f + scl) + sh;
                u32x2 w; w.x = pk2(hv[j][0], hv[j][1]); w.y = pk2(hv[j][2], hv[j][3]);
                *(u32x2*)(a.H + (size_t)row * DM + c) = w;
                if (GATES) {
#pragma unroll
                    for (int e = 0; e < 4; ++e)
#pragma unroll
                        for (int c4 = 0; c4 < 4; ++c4) g4[c4] += hv[j][e] * wl[((j * 4 + e) * 4 + c4) * 64 + lane];
                    asm volatile("" ::: "memory");
                } }
            if (GATES) {
#pragma unroll
                for (int c4 = 0; c4 < 4; ++c4)
#pragma unroll
                    for (int k = 0; k < 4; ++k) g4[c4][k] = wave_sum(g4[c4][k]);
                if (lane == 0) {
#pragma unroll
                    for (int c4 = 0; c4 < 4; ++c4) *(f32x4*)(a.gates + (size_t)row * 16 + 4 * c4) = g4[c4]; }
            }
        }
    }
    if (GATES) __syncthreads();
}

constexpr int RS = 144;
constexpr int AT_K = 0, AT_V = 9216, AT_TAB = 18432;
struct AttnArgs { const bf16_t* P; bf16_t* ATT; const float* sink; const f32x2* rope; };

DI void attn_item(const AttnArgs& A, int item, LAS unsigned char* lds, int tid) {
    asm volatile("" : "+v"(tid));
    const int w = tid >> 6, lane = tid & 63, r = lane & 31, hh = lane >> 5;
    const LAS f32x2* tab = (const LAS f32x2*)(lds + AT_TAB);
    int b, g, qb = 0, qrow0; bool lat;
    if (item < 512) { b = item >> 6; g = (item >> 5) & 1; qb = item & 31; lat = true; qrow0 = b * SEQ + qb * 128; }
    else { const int it = item - 512; b = it >> 2; g = (it >> 1) & 1; lat = false; qrow0 = MLAT + b * CTXL + (it & 1) * 128; }
    const int head = g * 4 + (w >> 1), qoff = (w & 1) * 64;
    bf16x8 qf[2][4];
#pragma unroll
    for (int qt = 0; qt < 2; ++qt) {
        const int ql = qoff + 32 * qt + r;
        const bf16_t* qp = A.P + pidx(qrow0 + ql, PC_AQ + head * 64 + 8 * hh);
        float x[4][8];
#pragma unroll
        for (int ks = 0; ks < 4; ++ks) { const u32x4 raw = *(const u32x4*)(qp + 16 * ks);
            x[ks][0] = bflo(raw.x); x[ks][1] = bfhi(raw.x); x[ks][2] = bflo(raw.y); x[ks][3] = bfhi(raw.y); x[ks][4] = bflo(raw.z); x[ks][5] = bfhi(raw.z); x[ks][6] = bflo(raw.w); x[ks][7] = bfhi(raw.w); }
        if (lat) {
            const int t = qb * 128 + ql;
#pragma unroll
            for (int pr = 0; pr < 2; ++pr) { const int pos = pr ? (t & 63) : (t >> 6);
#pragma unroll
                for (int j = 0; j < 8; ++j) { const f32x2 cs = tab[pos * 16 + 8 * hh + j]; const float x1 = x[2 * pr][j], x2 = x[2 * pr + 1][j];
                    x[2 * pr][j] = x1 * cs.x - x2 * cs.y; x[2 * pr + 1][j] = x2 * cs.x + x1 * cs.y; } }
        }
#pragma unroll
        for (int ks = 0; ks < 4; ++ks) qf[qt][ks] = pack8(x[ks][0] * 0.125f, x[ks][1] * 0.125f, x[ks][2] * 0.125f, x[ks][3] * 0.125f, x[ks][4] * 0.125f, x[ks][5] * 0.125f, x[ks][6] * 0.125f, x[ks][7] * 0.125f);
    }
    f32x16 O[2][2];
#pragma unroll
    for (int qt = 0; qt < 2; ++qt)
#pragma unroll
        for (int dt = 0; dt < 2; ++dt)
#pragma unroll
            for (int i = 0; i < 16; ++i) O[qt][dt][i] = 0.f;
    const float sk = A.sink[head];
    float m_run[2] = {sk, sk}, l_run[2];
    l_run[0] = l_run[1] = (hh == 0) ? 1.0f : 0.0f;
    const int ti_hi = (lat && qb == 31) ? 4 : 6;
    int ti = lat ? (qb == 0 ? 2 : 0) : 6;
    const int ss = tid >> 3, sc8 = tid & 7, half = sc8 >> 2, i0 = (sc8 & 3) * 4;
    u32x2 k1, k2; u32x4 vr;
#define ATT_LOAD(tix) do { const int krow_ = ((tix) < 6 ? b * SEQ + 128 * (qb - 1) + 64 * (tix) : MLAT + b * CTXL + 64 * ((tix) - 6)) + ss; \
        const bf16_t* kp_ = A.P + pidx(krow_, PC_AK); \
        k1 = *(const u32x2*)(kp_ + g * 64 + 32 * half + i0); k2 = *(const u32x2*)(kp_ + g * 64 + 32 * half + 16 + i0); \
        vr = *(const u32x4*)(kp_ + (PC_AV - PC_AK) + g * 64 + 8 * sc8); } while (0)
    ATT_LOAD(ti);
    for (;;) {
        {
            float a[4] = {bflo(k1.x), bfhi(k1.x), bflo(k1.y), bfhi(k1.y)}, c[4] = {bflo(k2.x), bfhi(k2.x), bflo(k2.y), bfhi(k2.y)};
            if (ti < 6) { const int kpos = 128 * (qb - 1) + 64 * ti + ss; const int pos = half ? (kpos & 63) : (kpos >> 6);
#pragma unroll
                for (int e = 0; e < 4; ++e) { const f32x2 cs = tab[pos * 16 + i0 + e]; const float x1 = a[e], x2 = c[e]; a[e] = x1 * cs.x - x2 * cs.y; c[e] = x2 * cs.x + x1 * cs.y; } }
            u32x2 o1, o2; o1.x = pk2(a[0], a[1]); o1.y = pk2(a[2], a[3]); o2.x = pk2(c[0], c[1]); o2.y = pk2(c[2], c[3]);
            *(LAS u32x2*)(lds + AT_K + ss * RS + (32 * half + i0) * 2) = o1;
            *(LAS u32x2*)(lds + AT_K + ss * RS + (32 * half + 16 + i0) * 2) = o2;
            const unsigned vv[4] = {vr.x, vr.y, vr.z, vr.w};
#pragma unroll
            for (int e = 0; e < 4; ++e) { *(LAS unsigned short*)(lds + AT_V + (8 * sc8 + 2 * e) * RS + ss * 2) = (unsigned short)(vv[e] & 0xffffu);
                *(LAS unsigned short*)(lds + AT_V + (8 * sc8 + 2 * e + 1) * RS + ss * 2) = (unsigned short)(vv[e] >> 16); }
        }
        LDS_BARRIER();
        const int tn = (ti < 6 && ti + 1 == ti_hi) ? 6 : ti + 1;
        if (tn < 10) ATT_LOAD(tn);
        f32x16 S[2][2];
#pragma unroll
        for (int st = 0; st < 2; ++st) {
            bf16x8 kf[4];
#pragma unroll
            for (int ks = 0; ks < 4; ++ks) kf[ks] = *(const LAS bf16x8*)(lds + AT_K + (32 * st + r) * RS + (16 * ks + 8 * hh) * 2);
#pragma unroll
            for (int qt = 0; qt < 2; ++qt) { f32x16 acc;
#pragma unroll
                for (int i = 0; i < 16; ++i) acc[i] = 0.f;
#pragma unroll
                for (int ks = 0; ks < 4; ++ks) acc = MFMA32(kf[ks], qf[qt][ks], acc);
                S[qt][st] = acc; }
        }
        if (ti < 2 || (ti >= 4 && ti < 6)) {
            const int kp0 = 128 * (qb - 1) + 64 * ti;
#pragma unroll
            for (int qt = 0; qt < 2; ++qt) { const int qpos = qb * 128 + qoff + 32 * qt + r;
#pragma unroll
                for (int st = 0; st < 2; ++st)
#pragma unroll
                    for (int i = 0; i < 16; ++i) { const int df = qpos - (kp0 + 32 * st + crow(i, hh)); if (df > 128 || df < -128) S[qt][st][i] = -INFINITY; } }
        }
#pragma unroll
        for (int qt = 0; qt < 2; ++qt) {
            float mx = S[qt][0][0];
#pragma unroll
            for (int st = 0; st < 2; ++st)
#pragma unroll
                for (int i = 0; i < 16; ++i) mx = fmaxf(mx, S[qt][st][i]);
            mx = fmaxf(mx, __shfl_xor(mx, 32));
            const float mn = fmaxf(m_run[qt], mx), scale = fexp(m_run[qt] - mn);
            m_run[qt] = mn; float ls = 0.f;
#pragma unroll
            for (int st = 0; st < 2; ++st)
#pragma unroll
                for (int i = 0; i < 16; ++i) { const float pv = fexp(S[qt][st][i] - mn); S[qt][st][i] = pv; ls += pv; }
            l_run[qt] = l_run[qt] * scale + ls;
#pragma unroll
            for (int dt = 0; dt < 2; ++dt)
#pragma unroll
                for (int i = 0; i < 16; ++i) O[qt][dt][i] *= scale;
        }
#pragma unroll
        for (int kk = 0; kk < 4; ++kk) { const int st = kk >> 1, s2 = kk & 1;
            bf16x8 pb[2];
#pragma unroll
            for (int qt = 0; qt < 2; ++qt) pb[qt] = pack8(S[qt][st][8 * s2 + 0], S[qt][st][8 * s2 + 1], S[qt][st][8 * s2 + 2], S[qt][st][8 * s2 + 3], S[qt][st][8 * s2 + 4], S[qt][st][8 * s2 + 5], S[qt][st][8 * s2 + 6], S[qt][st][8 * s2 + 7]);
#pragma unroll
            for (int dt = 0; dt < 2; ++dt) {
                const LAS unsigned char* vp = lds + AT_V + (32 * dt + r) * RS + (32 * st + 16 * s2 + 4 * hh) * 2;
                const s16x4 lo = *(const LAS s16x4*)vp, hi = *(const LAS s16x4*)(vp + 16);
                const bf16x8 va = __builtin_shufflevector(lo, hi, 0, 1, 2, 3, 4, 5, 6, 7);
#pragma unroll
                for (int qt = 0; qt < 2; ++qt) O[qt][dt] = MFMA32(va, pb[qt], O[qt][dt]);
            }
        }
        LDS_BARRIER();
        if (tn >= 10) break;
        ti = tn;
    }
#undef ATT_LOAD
#pragma unroll
    for (int qt = 0; qt < 2; ++qt) {
        const float l = l_run[qt] + __shfl_xor(l_run[qt], 32), inv = 1.0f / l;
        bf16_t* op = A.ATT + (size_t)(qrow0 + qoff + 32 * qt + r) * 512 + head * 64;
#pragma unroll
        for (int dt = 0; dt < 2; ++dt)
#pragma unroll
            for (int ig = 0; ig < 4; ++ig) { u32x2 wv; wv.x = pk2(O[qt][dt][4 * ig] * inv, O[qt][dt][4 * ig + 1] * inv); wv.y = pk2(O[qt][dt][4 * ig + 2] * inv, O[qt][dt][4 * ig + 3] * inv);
                *(u32x2*)(op + 32 * dt + 8 * ig + 4 * hh) = wv; }
    }
}

constexpr int SC_QS = 0, SC_KS = 9216, SC_QE = 18432, SC_UKT = 27648, SC_VT = 36864, SC_CBT = 55296, SC_F = 73728;
constexpr int SF_EB = 0, SF_QN = 256, SF_SSQ = 2304, SF_N = 3328, SF_DEC = 3840, SF_CONV = 4096, SF_GN = 5632, SF_CACHE = 6144;
struct ScanArgs { const bf16_t* P; bf16_t* OUT; const float* gates; const float* convw; const float* fbias; const float* gnorm; const float* lbl; int layer; };

template <bool IS_ML>
DI void scan_item(const ScanArgs& A, int b, int hd, const int dir, unsigned* prog_mine, unsigned* prog_other, LAS unsigned char* lds, int tid) {
    asm volatile("" : "+v"(tid));
    const int w = tid >> 6, lane = tid & 63, r = lane & 31, hh = lane >> 5;
    const int etile = w & 3, ttile = w >> 2, dtile = w >> 2;
    LAS float* F = (LAS float*)(lds + SC_F);
    LAS float* eb_s = F + SF_EB / 4; LAS float* qn_s = F + SF_QN / 4; LAS float* ssq_s = F + SF_SSQ / 4; LAS float* n_s = F + SF_N / 4; LAS float* dec_s = F + SF_DEC / 4; LAS float* conv_s = F + SF_CONV / 4;
    LAS float* gn_s = F + SF_GN / 4; LAS unsigned* cache_s = (LAS unsigned*)(F + SF_CACHE / 4);
    const int vcol = (IS_ML ? PC_MV : PC_HI) + hd * 128, gcol = (IS_ML ? PC_MO : PC_HG) + hd * 128;
    float lbv[8];
    __syncthreads();
    if (IS_ML) {
        if (tid < 384) { const int j = tid >> 6, d = tid & 63; conv_s[tid] = A.convw[(j % 3) * 512 + (j / 3) * 256 + hd * 64 + d]; }
    } else {
#pragma unroll
        for (int e = 0; e < 8; ++e) { const int c = hd * 64 + 8 * w + e; lbv[e] = (A.layer == 0) ? 0.f : 1.0f / (1.0f + expf(A.lbl[c] - A.lbl[256 + c])); }
    }
    if (tid < 128) { n_s[tid] = 0.f; gn_s[tid] = A.gnorm[hd * 128 + tid]; }
    if (tid == 0) cache_s[0] = 0u;
    f32x16 Cst;
#pragma unroll
    for (int i = 0; i < 16; ++i) Cst[i] = 0.f;
    float m_run = 0.f;
#pragma unroll
    for (int ig = 0; ig < 4; ++ig) *(LAS u32x2*)(lds + SC_CBT + (32 * etile + r) * RS + (32 * dtile + 8 * ig + 4 * hh) * 2) = (u32x2){0u, 0u};
    const float fb = IS_ML ? A.fbias[dir * 4 + hd] : 0.f;
    bool pending = false;
    u32x4 rq[3], rk[3], rv[2]; float rgi = 0.f, rgf = 0.f;
#define SC_ROWS(c_) const int cc_ = (c_) < 4 ? (dir ? 3 - (c_) : (c_)) : (dir ? 67 - (c_) : (c_) - 4); \
    const int slo_ = (c_) < 4 ? MLAT + b * CTXL : b * SEQ, slen_ = (c_) < 4 ? CTXL : SEQ; const int rb_ = slo_ + 64 * cc_;
#define SC_LOAD(c_) do { SC_ROWS(c_) const int ti_ = 64 * cc_ + (dir ? 63 - lane : lane); const int prow_ = slo_ + ti_; \
    if (IS_ML) { const u32x4 z4_ = (u32x4){0u, 0u, 0u, 0u}; \
        const bf16_t* pq_ = A.P + pidx(prow_, PC_MQ + hd * 64 + 8 * w); const bf16_t* pk_ = A.P + pidx(prow_, PC_MK + hd * 64 + 8 * w); rq[1] = *(const u32x4*)pq_; rk[1] = *(const u32x4*)pk_; \
        rq[0] = ti_ > 0 ? *(const u32x4*)(pq_ - 256) : z4_; rk[0] = ti_ > 0 ? *(const u32x4*)(pk_ - 256) : z4_; \
        rq[2] = ti_ + 1 < slen_ ? *(const u32x4*)(pq_ + 256) : z4_; rk[2] = ti_ + 1 < slen_ ? *(const u32x4*)(pk_ + 256) : z4_; \
        const float* gp_ = A.gates + (size_t)(slo_ + ti_) * 16; rgi = gp_[dir * 4 + hd]; rgf = gp_[8 + dir * 4 + hd]; \
    } else { rq[1] = *(const u32x4*)(A.P + pidx(prow_, PC_HQ + hd * 64 + 8 * w)); rk[1] = *(const u32x4*)(A.P + pidx(prow_, PC_HF + dir * 256 + hd * 64 + 8 * w)); } \
    { const bf16_t* pv_ = A.P + pidx(prow_, vcol + 16 * w); rv[0] = *(const u32x4*)pv_; rv[1] = *(const u32x4*)(pv_ + 8); } } while (0)
    SC_LOAD(0);
    __syncthreads();
#pragma unroll 1
    for (int c = 0; c < 68; ++c) {
        float ea = 1.f, wprev = 0.f, enm = 0.f, a_prev = 0.f;
        {
            const unsigned vv[8] = {rv[0].x, rv[0].y, rv[0].z, rv[0].w, rv[1].x, rv[1].y, rv[1].z, rv[1].w};
#pragma unroll
            for (int e = 0; e < 8; ++e) { *(LAS unsigned short*)(lds + SC_VT + (16 * w + 2 * e) * RS + lane * 2) = (unsigned short)(vv[e] & 0xffffu);
                *(LAS unsigned short*)(lds + SC_VT + (16 * w + 2 * e + 1) * RS + lane * 2) = (unsigned short)(vv[e] >> 16); }
        }
        if (IS_ML) {
            const float li = rgi, xf = rgf + fb;
            const float lf = fminf(xf, 0.f) - flog1p(fexp(-fabsf(xf)));
            float bc = lf;
#pragma unroll
            for (int off = 1; off < 64; off <<= 1) { const float v = __shfl_up(bc, off); if (lane >= off) bc += v; }
            const float beta = li - bc; float pm = beta;
#pragma unroll
            for (int off = 1; off < 64; off <<= 1) { const float v = __shfl_up(pm, off); if (lane >= off) pm = fmaxf(pm, v); }
            const float bl = __shfl(bc, 63), pmx = __shfl(pm, 63);
            const float mm = fmaxf(m_run, pm), mmx = fmaxf(m_run, pmx);
            ea = fexp(-mm); wprev = fexp(m_run - mm); enm = fexp(-(bc + mm));
            a_prev = fexp(m_run - mmx); const float u = fexp(beta - mmx);
            m_run = bl + mmx;
            if (w == 0) eb_s[lane] = fexp(fminf(beta, 80.f));
            float q8[8], k8[8];
            const unsigned q0[4] = {rq[0].x, rq[0].y, rq[0].z, rq[0].w}, q1[4] = {rq[1].x, rq[1].y, rq[1].z, rq[1].w}, q2[4] = {rq[2].x, rq[2].y, rq[2].z, rq[2].w};
            const unsigned k0[4] = {rk[0].x, rk[0].y, rk[0].z, rk[0].w}, k1[4] = {rk[1].x, rk[1].y, rk[1].z, rk[1].w}, k2[4] = {rk[2].x, rk[2].y, rk[2].z, rk[2].w};
            float cw[6][8];
#pragma unroll
            for (int j = 0; j < 6; ++j) { const f32x4 c0 = *(const LAS f32x4*)(conv_s + j * 64 + 8 * w), c1 = *(const LAS f32x4*)(conv_s + j * 64 + 8 * w + 4);
                cw[j][0] = c0[0]; cw[j][1] = c0[1]; cw[j][2] = c0[2]; cw[j][3] = c0[3]; cw[j][4] = c1[0]; cw[j][5] = c1[1]; cw[j][6] = c1[2]; cw[j][7] = c1[3]; }
#pragma unroll
            for (int e = 0; e < 4; ++e) {
                q8[2 * e] = fsilu(bflo(q0[e]) * cw[0][2 * e] + bflo(q1[e]) * cw[1][2 * e] + bflo(q2[e]) * cw[2][2 * e]);
                q8[2 * e + 1] = fsilu(bfhi(q0[e]) * cw[0][2 * e + 1] + bfhi(q1[e]) * cw[1][2 * e + 1] + bfhi(q2[e]) * cw[2][2 * e + 1]);
                k8[2 * e] = 0.125f * fsilu(bflo(k0[e]) * cw[3][2 * e] + bflo(k1[e]) * cw[4][2 * e] + bflo(k2[e]) * cw[5][2 * e]);
                k8[2 * e + 1] = 0.125f * fsilu(bfhi(k0[e]) * cw[3][2 * e + 1] + bfhi(k1[e]) * cw[4][2 * e + 1] + bfhi(k2[e]) * cw[5][2 * e + 1]); }
            *(LAS bf16x8*)(lds + SC_QS + lane * RS + 16 * w) = pack8(q8[0], q8[1], q8[2], q8[3], q8[4], q8[5], q8[6], q8[7]);
            *(LAS bf16x8*)(lds + SC_KS + lane * RS + 16 * w) = pack8(k8[0], k8[1], k8[2], k8[3], k8[4], k8[5], k8[6], k8[7]);
#pragma unroll
            for (int e = 0; e < 4; ++e) { const unsigned pkv = pk2(u * k8[2 * e], u * k8[2 * e + 1]);
                *(LAS unsigned short*)(lds + SC_UKT + (8 * w + 2 * e) * RS + lane * 2) = (unsigned short)(pkv & 0xffffu);
                *(LAS unsigned short*)(lds + SC_UKT + (8 * w + 2 * e + 1) * RS + lane * 2) = (unsigned short)(pkv >> 16); }
            const LAS float* nv = n_s + (c & 1) * 64 + 8 * w; const f32x4 n0 = *(const LAS f32x4*)nv, n1 = *(const LAS f32x4*)(nv + 4);
            qn_s[lane * 8 + w] = (q8[0] * n0[0] + q8[1] * n0[1] + q8[2] * n0[2] + q8[3] * n0[3]) + (q8[4] * n1[0] + q8[5] * n1[1] + q8[6] * n1[2] + q8[7] * n1[3]);
        } else {
            float x[8], kk[8], qs[8];
            const unsigned qr[4] = {rq[1].x, rq[1].y, rq[1].z, rq[1].w}, zr[4] = {rk[1].x, rk[1].y, rk[1].z, rk[1].w};
#pragma unroll
            for (int e = 0; e < 8; ++e) { const float z = (e & 1) ? bfhi(zr[e >> 1]) : bflo(zr[e >> 1]), qv = (e & 1) ? bfhi(qr[e >> 1]) : bflo(qr[e >> 1]);
                const float ez = fexp(-fabsf(z)), sg = (z >= 0.f ? 1.0f : ez) * __builtin_amdgcn_rcpf(1.0f + ez);
                const float lb = lbv[e], f = lb + (1.0f - lb) * sg;
                kk[e] = (1.0f - lb) * (1.0f - sg);
                x[e] = (lb > 0.f) ? flog(f) : (fminf(z, 0.f) - flog1p(ez));
                qs[e] = 0.125f * fsilu(qv); }
#pragma unroll
            for (int off = 1; off < 64; off <<= 1)
#pragma unroll
                for (int e = 0; e < 8; ++e) { const float v = __shfl_up(x[e], off); if (lane >= off) x[e] += v; }
            float qe[8], qt[8], kt[8], ku[8];
#pragma unroll
            for (int e = 0; e < 8; ++e) { const float bb = x[e];
                const float blv = __uint_as_float(__builtin_amdgcn_readlane(__float_as_uint(bb), 63)), ref = __uint_as_float(__builtin_amdgcn_readlane(__float_as_uint(bb), 31));
                qe[e] = qs[e] * fexp(bb); qt[e] = qs[e] * fexp(fminf(bb - ref, 60.f)); kt[e] = kk[e] * fexp(fminf(ref - bb, 60.f)); ku[e] = kk[e] * fexp(blv - bb);
                if (lane == 0) dec_s[8 * w + e] = fexp(blv); }
#pragma unroll
            for (int e = 0; e < 4; ++e) { const unsigned pkv = pk2(ku[2 * e], ku[2 * e + 1]);
                *(LAS unsigned short*)(lds + SC_UKT + (8 * w + 2 * e) * RS + lane * 2) = (unsigned short)(pkv & 0xffffu);
                *(LAS unsigned short*)(lds + SC_UKT + (8 * w + 2 * e + 1) * RS + lane * 2) = (unsigned short)(pkv >> 16); }
            *(LAS bf16x8*)(lds + SC_QE + lane * RS + 16 * w) = pack8(qe[0], qe[1], qe[2], qe[3], qe[4], qe[5], qe[6], qe[7]);
            *(LAS bf16x8*)(lds + SC_QS + lane * RS + 16 * w) = pack8(qt[0], qt[1], qt[2], qt[3], qt[4], qt[5], qt[6], qt[7]);
            *(LAS bf16x8*)(lds + SC_KS + lane * RS + 16 * w) = pack8(kt[0], kt[1], kt[2], kt[3], kt[4], kt[5], kt[6], kt[7]);
        }
        const bool first_role = (c < 2) || (c >= 4 && c < 36);
        if (pending && !first_role) {
            asm volatile("s_waitcnt vmcnt(0)" ::: "memory"); if (lane == 0) __hip_atomic_fetch_add(prog_mine, 1u, __ATOMIC_RELAXED, __HIP_MEMORY_SCOPE_AGENT); pending = false; }
        if (!first_role && tid == 0) {
            const int cp = (c < 4) ? 3 - c : 71 - c; const unsigned need = 8u * (unsigned)((cp < 2 ? cp : cp - 2) + 1);
            if (cache_s[0] < need) {
                unsigned v; unsigned spins = 0;
                for (;;) { v = __hip_atomic_load(prog_other, __ATOMIC_RELAXED, __HIP_MEMORY_SCOPE_AGENT); if (v >= need) break; __builtin_amdgcn_s_sleep(2); if (++spins > (1u << 24)) break; }
                __builtin_amdgcn_fence(__ATOMIC_ACQUIRE, "agent");
                asm volatile("s_waitcnt vmcnt(0)" ::: "memory");
                cache_s[0] = v;
            }
        }
        LDS_BARRIER();
        SC_ROWS(c)
        const int t = 32 * ttile + r;
        const int orow = rb_ + (dir ? 63 - t : t);
        bf16_t* op = A.OUT + (size_t)orow * 512 + hd * 128 + 32 * etile + 4 * hh;
        unsigned long long prevv[4]; u32x2 gwv[4];
        if (!first_role) {
            const bf16_t* gp = A.P + pidx(orow, gcol + 32 * etile + 4 * hh);
#pragma unroll
            for (int ig = 0; ig < 4; ++ig) { prevv[ig] = __hip_atomic_load((const unsigned long long*)(op + 8 * ig), __ATOMIC_RELAXED, __HIP_MEMORY_SCOPE_AGENT); gwv[ig] = *(const u32x2*)(gp + 8 * ig); }
        }
        if (c + 1 < 68) SC_LOAD(c + 1);
        bf16x8 qf[4];
#pragma unroll
        for (int ks = 0; ks < 4; ++ks) qf[ks] = *(const LAS bf16x8*)(lds + SC_QS + t * RS + (16 * ks + 8 * hh) * 2);
        f32x16 S[2];
#pragma unroll
        for (int st = 0; st < 2; ++st) { f32x16 acc;
#pragma unroll
            for (int i = 0; i < 16; ++i) acc[i] = 0.f;
#pragma unroll
            for (int ks = 0; ks < 4; ++ks) { const bf16x8 kf = *(const LAS bf16x8*)(lds + SC_KS + (32 * st + r) * RS + (16 * ks + 8 * hh) * 2); acc = MFMA32(kf, qf[ks], acc); }
            S[st] = acc; }
        float c1 = 1.0f, c2 = 1.0f;
        if (IS_ML) {
            const float ea_t = __shfl(ea, t), en_t = __shfl(enm, t), wprev_t = __shfl(wprev, t);
            float rs = 0.f;
#pragma unroll
            for (int st = 0; st < 2; ++st)
#pragma unroll
                for (int ig = 0; ig < 4; ++ig) { const f32x4 bt = *(const LAS f32x4*)(eb_s + 32 * st + 8 * ig + 4 * hh);
#pragma unroll
                    for (int k = 0; k < 4; ++k) { const int s = 32 * st + 8 * ig + 4 * hh + k; const float v = (s <= t) ? S[st][4 * ig + k] * bt[k] : 0.f; S[st][4 * ig + k] = v; rs += v; } }
            rs += __shfl_xor(rs, 32);
            const f32x4 qa = *(const LAS f32x4*)(qn_s + t * 8), qb4 = *(const LAS f32x4*)(qn_s + t * 8 + 4);
            const float qn = ((qa[0] + qa[1]) + (qa[2] + qa[3])) + ((qb4[0] + qb4[1]) + (qb4[2] + qb4[3]));
            const float den = wprev_t * qn + ea_t * rs;
            const float inv = 1.0f / fmaxf(fabsf(den), en_t);
            c1 = wprev_t * inv; c2 = ea_t * inv;
            {
                const bf16x8 uk = *(const LAS bf16x8*)(lds + SC_UKT + (8 * w + (lane >> 3)) * RS + 16 * (lane & 7));
                float sacc = ((bf1(uk[0]) + bf1(uk[1])) + (bf1(uk[2]) + bf1(uk[3]))) + ((bf1(uk[4]) + bf1(uk[5])) + (bf1(uk[6]) + bf1(uk[7])));
                sacc += __shfl_xor(sacc, 1); sacc += __shfl_xor(sacc, 2); sacc += __shfl_xor(sacc, 4);
                if ((lane & 7) == 0) n_s[((c + 1) & 1) * 64 + 8 * w + (lane >> 3)] = a_prev * n_s[(c & 1) * 64 + 8 * w + (lane >> 3)] + sacc;
            }
        } else {
#pragma unroll
            for (int st = 0; st < 2; ++st)
#pragma unroll
                for (int i = 0; i < 16; ++i) { const int s = 32 * st + crow(i, hh); if (s > t) S[st][i] = 0.f; }
        }
        f32x16 acc1;
#pragma unroll
        for (int i = 0; i < 16; ++i) acc1[i] = 0.f;
#pragma unroll
        for (int ks = 0; ks < 4; ++ks) { const bf16x8 ca = *(const LAS bf16x8*)(lds + SC_CBT + (32 * etile + r) * RS + (16 * ks + 8 * hh) * 2);
            const bf16x8 qb = IS_ML ? qf[ks] : *(const LAS bf16x8*)(lds + SC_QE + t * RS + (16 * ks + 8 * hh) * 2);
            acc1 = MFMA32(ca, qb, acc1); }
        f32x16 acc2;
        if (IS_ML) {
#pragma unroll
            for (int i = 0; i < 16; ++i) acc2[i] = 0.f;
        } else acc2 = acc1;
#pragma unroll
        for (int kk2 = 0; kk2 < 4; ++kk2) { const int st = kk2 >> 1, s2 = kk2 & 1;
            const LAS unsigned char* vp = lds + SC_VT + (32 * etile + r) * RS + (32 * st + 16 * s2 + 4 * hh) * 2;
            const s16x4 lo = *(const LAS s16x4*)vp, hi = *(const LAS s16x4*)(vp + 16);
            const bf16x8 va = __builtin_shufflevector(lo, hi, 0, 1, 2, 3, 4, 5, 6, 7);
            const bf16x8 pb = pack8(S[st][8 * s2 + 0], S[st][8 * s2 + 1], S[st][8 * s2 + 2], S[st][8 * s2 + 3], S[st][8 * s2 + 4], S[st][8 * s2 + 5], S[st][8 * s2 + 6], S[st][8 * s2 + 7]);
            acc2 = MFMA32(va, pb, acc2); }
        f32x16 hv;
        if (IS_ML) {
#pragma unroll
            for (int i = 0; i < 16; ++i) hv[i] = c1 * acc1[i] + c2 * acc2[i];
        } else hv = acc2;
        if (pending) {
            asm volatile("s_waitcnt vmcnt(0)" ::: "memory"); if (lane == 0) __hip_atomic_fetch_add(prog_mine, 1u, __ATOMIC_RELAXED, __HIP_MEMORY_SCOPE_AGENT); pending = false; }
        if (first_role) {
#pragma unroll
            for (int ig = 0; ig < 4; ++ig) { const unsigned lo_ = pk2(hv[4 * ig], hv[4 * ig + 1]), hi_ = pk2(hv[4 * ig + 2], hv[4 * ig + 3]);
                __hip_atomic_store((unsigned long long*)(op + 8 * ig), ((unsigned long long)hi_ << 32) | lo_, __ATOMIC_RELAXED, __HIP_MEMORY_SCOPE_AGENT); }
            pending = true;
        } else {
            float sq = 0.f;
#pragma unroll
            for (int ig = 0; ig < 4; ++ig) { const unsigned a0 = (unsigned)prevv[ig], a1 = (unsigned)(prevv[ig] >> 32);
                hv[4 * ig] += bflo(a0); hv[4 * ig + 1] += bfhi(a0); hv[4 * ig + 2] += bflo(a1); hv[4 * ig + 3] += bfhi(a1);
                sq += (hv[4 * ig] * hv[4 * ig] + hv[4 * ig + 1] * hv[4 * ig + 1]) + (hv[4 * ig + 2] * hv[4 * ig + 2] + hv[4 * ig + 3] * hv[4 * ig + 3]); }
            sq += __shfl_xor(sq, 32);
            if (hh == 0) ssq_s[etile * 64 + t] = sq;
            LDS_BARRIER();
            const float tot = (ssq_s[t] + ssq_s[64 + t]) + (ssq_s[128 + t] + ssq_s[192 + t]);
            const float rstd = 1.0f / sqrtf(tot * (1.0f / 128.0f) + EPS);
#pragma unroll
            for (int ig = 0; ig < 4; ++ig) { const f32x4 g4 = *(const LAS f32x4*)(gn_s + 32 * etile + 4 * hh + 8 * ig);
                const float g0 = bflo(gwv[ig].x), g1 = bfhi(gwv[ig].x), g2 = bflo(gwv[ig].y), g3 = bfhi(gwv[ig].y);
                const float o0 = hv[4 * ig] * rstd * g4[0] * (IS_ML ? fsigmoid(g0) : fsilu(g0)), o1 = hv[4 * ig + 1] * rstd * g4[1] * (IS_ML ? fsigmoid(g1) : fsilu(g1));
                const float o2 = hv[4 * ig + 2] * rstd * g4[2] * (IS_ML ? fsigmoid(g2) : fsilu(g2)), o3 = hv[4 * ig + 3] * rstd * g4[3] * (IS_ML ? fsigmoid(g3) : fsilu(g3));
                u32x2 wv; wv.x = pk2(o0, o1); wv.y = pk2(o2, o3); *(u32x2*)(op + 8 * ig) = wv; }
        }
        if (IS_ML) {
#pragma unroll
            for (int i = 0; i < 16; ++i) Cst[i] *= a_prev;
        } else {
#pragma unroll
            for (int ig = 0; ig < 4; ++ig) { const f32x4 dv = *(const LAS f32x4*)(dec_s + 32 * dtile + 8 * ig + 4 * hh);
#pragma unroll
                for (int k = 0; k < 4; ++k) Cst[4 * ig + k] *= dv[k]; }
        }
#pragma unroll
        for (int ks = 0; ks < 4; ++ks) { const bf16x8 ua = *(const LAS bf16x8*)(lds + SC_UKT + (32 * dtile + r) * RS + (16 * ks + 8 * hh) * 2);
            const bf16x8 vb = *(const LAS bf16x8*)(lds + SC_VT + (32 * etile + r) * RS + (16 * ks + 8 * hh) * 2);
            Cst = MFMA32(ua, vb, Cst); }
        LDS_BARRIER();
#pragma unroll
        for (int ig = 0; ig < 4; ++ig) { u32x2 wv; wv.x = pk2(Cst[4 * ig], Cst[4 * ig + 1]); wv.y = pk2(Cst[4 * ig + 2], Cst[4 * ig + 3]);
            *(LAS u32x2*)(lds + SC_CBT + (32 * etile + r) * RS + (32 * dtile + 8 * ig + 4 * hh) * 2) = wv; }
    }
    if (pending) { asm volatile("s_waitcnt vmcnt(0)" ::: "memory"); if (lane == 0) __hip_atomic_fetch_add(prog_mine, 1u, __ATOMIC_RELAXED, __HIP_MEMORY_SCOPE_AGENT); }
#undef SC_LOAD
#undef SC_ROWS
    __syncthreads();
}
#ifndef PH
#define PH 0xffff
#endif

#define XB_TMO      128
#define XB_XCNT(j)  (256  + 64 * (j))
#define XB_XSUB(j)  (1280 + 64 * (j))
#define XB_XGEN(j)  (2304 + 64 * (j))
#define XB_TOP      3328
#define XB_TOPGEN   3392
#define XCD_BAR_WORDS 3456
#define XB_SPIN_CAP (1u << 18)

__device__ __forceinline__ unsigned xb_ld(unsigned* p)              { return __hip_atomic_load(p, __ATOMIC_RELAXED, __HIP_MEMORY_SCOPE_AGENT); }
__device__ __forceinline__ unsigned xb_add(unsigned* p, unsigned v) { return __hip_atomic_fetch_add(p, v, __ATOMIC_RELAXED, __HIP_MEMORY_SCOPE_AGENT); }
__device__ __forceinline__ unsigned xb_xcc_id() { return (unsigned)__builtin_amdgcn_s_getreg((3 << 11) | 20) & 0xFu; }
#define XB_SPIN(cond, bar) do { unsigned _sp = 0; while (cond) { __builtin_amdgcn_s_sleep(1); \
    if ((++_sp & 255u) == 0u) { if (xb_ld(&(bar)[XB_TMO])) break; if (_sp > XB_SPIN_CAP) { atomicAdd(&(bar)[XB_TMO], 1u); break; } } } } while (0)

struct XcdBarrier {
    unsigned* bar; unsigned x;
    volatile LAS unsigned* st;
};

__device__ __forceinline__ XcdBarrier xcd_barrier_post(unsigned* bar, volatile LAS unsigned* st) {
    XcdBarrier b; b.bar = bar; b.x = xb_xcc_id(); b.st = st;
    if (threadIdx.x == 0) (void)xb_add(&bar[XB_XCNT(b.x)], 1u);
    return b;
}
__device__ __forceinline__ void xcd_barrier_complete(unsigned* bar, unsigned x, unsigned& nloc, unsigned& nx) {
    const unsigned G = gridDim.x * gridDim.y * gridDim.z;
    unsigned sum, cnt, mine, sp = 0u;
    for (;;) {
        sum = 0u; cnt = 0u; mine = 0u;
#pragma unroll
        for (unsigned j = 0; j < 16; ++j) { const unsigned c = xb_ld(&bar[XB_XCNT(j)]); sum += c; cnt += (c > 0u) ? 1u : 0u; mine = (j == x) ? c : mine; }
        if (sum == G) break;
        __builtin_amdgcn_s_sleep(1);
        if ((++sp & 255u) == 0u) { if (xb_ld(&bar[XB_TMO])) break; if (sp > XB_SPIN_CAP) { atomicAdd(&bar[XB_TMO], 1u); break; } }
    }
    nloc = mine > 0u ? mine : 1u; nx = cnt > 0u ? cnt : 1u;
}

__device__ __forceinline__ void xcd_barrier(const XcdBarrier& b) {
    asm volatile("s_waitcnt vmcnt(0)" ::: "memory");
    __syncthreads();
    if (threadIdx.x == 0) {
        unsigned* bar = b.bar;
        __builtin_amdgcn_s_waitcnt(0);
        unsigned nloc = b.st[0], nx = b.st[1];
        if (nloc == 0u) { xcd_barrier_complete(bar, b.x, nloc, nx); b.st[0] = nloc; b.st[1] = nx; }
        const unsigned old = xb_add(&bar[XB_XSUB(b.x)], 1u);
        const unsigned gen = old / nloc;
        if (old + 1u == (gen + 1u) * nloc) {
            __builtin_amdgcn_fence(__ATOMIC_RELEASE, "agent");
            asm volatile("s_waitcnt vmcnt(0)" ::: "memory");
            const unsigned og = xb_add(&bar[XB_TOP], 1u);
            const unsigned tg = og / nx;
            if (og + 1u == (tg + 1u) * nx) xb_add(&bar[XB_TOPGEN], 1u);
            else XB_SPIN(xb_ld(&bar[XB_TOPGEN]) == tg, bar);
            __builtin_amdgcn_fence(__ATOMIC_ACQUIRE, "agent");
            xb_add(&bar[XB_XGEN(b.x)], 1u);
            asm volatile("s_waitcnt vmcnt(0)" ::: "memory");
        } else {
            XB_SPIN(xb_ld(&bar[XB_XGEN(b.x)]) == gen, bar);
            __builtin_amdgcn_fence(__ATOMIC_ACQUIRE, "agent");
            asm volatile("s_waitcnt vmcnt(0)" ::: "memory");
        }
    }
    __syncthreads();
}


DI void mix_phase(KP p, int l, LAS unsigned char* lds, int tid) {
    asm volatile("" : "+v"(tid));
    const int G = gridDim.x, bid = blockIdx.x;
    const bf16_t* P = (const bf16_t*)(p->ws + WS_P);
    bf16_t* ATT = (bf16_t*)(p->ws + WS_S); bf16_t* MLB = ATT + (size_t)MTOT * 512; bf16_t* HGB = MLB + (size_t)MTOT * 512;
    const int nattn = 512 + (l == 0 ? 32 : 0);
    if (bid < 128) {
        const int it = bid, dir = it & 1, hd = (it >> 1) & 3, b = (it >> 3) & 7, ty = it >> 6;
        unsigned* prog = (unsigned*)p->ws + (l * 128 + (it & ~1)) * 16;
        if (ty == 0) { ScanArgs A{P, MLB, (const float*)(p->ws + WS_GATES), p->in[I_MLCONV] + (size_t)l * 3 * 512, p->in[I_MLFB] + l * 8, p->in[I_MLNORM] + l * 512, p->in[I_HGLB], l};
#ifndef NO_SCANML
            scan_item<true>(A, b, hd, dir, prog + dir * 16, prog + (dir ^ 1) * 16, lds, tid);
#endif
        } else { ScanArgs A{P, HGB, (const float*)(p->ws + WS_GATES), p->in[I_MLCONV], p->in[I_MLFB], p->in[I_HGNORM] + l * 512, p->in[I_HGLB], l};
#ifndef NO_SCANHG
            scan_item<false>(A, b, hd, dir, prog + dir * 16, prog + (dir ^ 1) * 16, lds, tid);
#endif
        }
    }
    if (bid >= 128) {
        __syncthreads();
        const f32x2* rope = (const f32x2*)(p->ws + WS_ROPE);
        for (int i = tid; i < 1024; i += 512) ((LAS f32x2*)(lds + AT_TAB))[i] = rope[i];
        __syncthreads();
        AttnArgs A{P, ATT, p->in[I_SINK] + l * 8, rope};
        for (int it = bid - 128; it < nattn; it += G - 128) {
#ifndef NO_ATTN
 attn_item(A, it, lds, tid);
#endif
 }
    }
}

template <class Epi> DI void run_gemm(LAS unsigned char* lds, const bf16_t* A, const bf16_t* Bt, int M, int N, int K, const Epi& E) {
    pg8::Gemm g{A, Bt, M, N, K}; pg8::StaticOrder S; S.init(M, N, (int)gridDim.x, (int)blockIdx.x);
    pg8::gemm_phase<Epi, pg8::StaticOrder, true, true>(lds, g, S, E);
}

template <class Epi> DI void run_gemm_ctx(LAS unsigned char* lds, const bf16_t* A, const bf16_t* Bt, int N, int K, const Epi& E) {
    pg8::Gemm g{A, Bt, MTOT, N, K}; pg8::CtxOrder S{224, MLAT / 256};
    pg8::gemm_phase<Epi, pg8::CtxOrder, true, true>(lds, g, S, E);
}

#define GRID_BAR() do { XcdBarrier xb_; xb_.bar = (unsigned*)(ws) + 8192; xb_.x = xb_xcc_id(); xb_.st = (volatile LAS unsigned*)(lds + 131072); xcd_barrier(xb_); } while (0)
__global__ void __launch_bounds__(512) fwd_kernel(Params p_unused) {
    extern __shared__ __attribute__((aligned(16))) unsigned char lds_raw[];
    LAS unsigned char* lds = (LAS unsigned char*)lds_raw;
    cg::grid_group grid = cg::this_grid();
#define tid ((int)threadIdx.x)
#define ws (kparams()->ws)
#define W ((bf16_t*)(ws + WS_W))
#define H ((bf16_t*)(ws + WS_H))
#define PB ((bf16_t*)(ws + WS_P))
#define SB ((bf16_t*)(ws + WS_S))
#define XC ((float*)(ws + WS_XC))
#define mod ((const float*)(ws + WS_MOD))
#define gates ((float*)(ws + WS_GATES))
    KP p = kparams();
    if (threadIdx.x < 16) ((LAS unsigned*)(lds + 131072))[threadIdx.x] = 0u;
    __syncthreads();
    (void)xcd_barrier_post((unsigned*)(ws) + 8192, (volatile LAS unsigned*)(lds + 131072));

#if PH & 1
    convert_weights(p, 0, lds);
    __syncthreads();
    mods_phase(p, lds, tid);
#endif
    if (ws == nullptr) grid.sync();
    GRID_BAR();
    {
        RowArgs a{p->in[I_X], p->in[I_CTX], nullptr, nullptr, nullptr, H, mod, mod, nullptr, p->in[I_NPRE], nullptr, nullptr, 0, 0, 0, MTOT, (int)blockIdx.x, (int)gridDim.x, 0.f};
#if PH & 2
        row_phase<false, true, false>(a, lds, tid);
#endif
    }
    GRID_BAR();

#pragma unroll 1
    for (int l = 0; l < 2; ++l) {
#pragma unroll 1
      for (int f = 0; f < 2; ++f) {
        p = kparams();
        const float* modl = mod + (size_t)l * 9 * 9216;
        const float* npre = p->in[I_NPRE] + (size_t)l * 3 * DM; const float* npost = p->in[I_NPOST] + (size_t)l * 3 * DM;
        const bool ctx2 = (l == 0);
        const int bid = (int)blockIdx.x, G = (int)gridDim.x;
        if (f == 1) {
            { pg8::EpiBf16<0> E{PB, 256, PTS}; run_gemm(lds, H, W + WO_WIN, MTOT, NPC, DM, E); }
            GRID_BAR();
            mix_phase(p, l, lds, tid);
            GRID_BAR();
            { pg8::EpiBf16<1> E{PB, NGC, 0}; run_gemm(lds, H, W + WO_WG, ctx2 ? MTOT : MLAT, NGC, DM, E); }
            GRID_BAR();
#pragma unroll 1
            for (int gi = 0; gi < 3; ++gi) { pg8::EpiMerge E{H, PB, gi}; run_gemm(lds, SB + (size_t)gi * MTOT * 512, W + WO_WB + (size_t)gi * 1024 * 512, ctx2 ? MTOT : MLAT, DM, 512, E); }
            GRID_BAR();
            { pg8::EpiBf16<0> E{SB, DM, 0}; run_gemm(lds, H, W + WO_WOUT, MLAT, DM, DM, E); }
            GRID_BAR();
            {
                const int vg = ctx2 ? 224 : G;
                RowArgs a{p->out, XC, p->out, XC, SB, H, modl, modl, npost + DM, npre + 2 * DM, nullptr, nullptr, 1, 2, 0, MLAT, bid < vg ? bid : -1, vg, 1.0f};
                if (bid < vg) row_phase<true, true, false>(a, lds, tid);
                else { pg8::EpiBf16<0> E{SB, DM, 0}; run_gemm_ctx(lds, H, W + WO_WOUT, DM, DM, E); }
            }
            GRID_BAR();
            if (ctx2) {
                RowArgs a{p->out, XC, p->out, XC, SB, H, modl, modl, npost + DM, npre + 2 * DM, nullptr, nullptr, 1, 2, MLAT, MTOT, bid, G, 1.0f};
                row_phase<true, true, false>(a, lds, tid);
                GRID_BAR();
            }
        }
        const bool hc = (f == 0) || ctx2;
        { pg8::EpiSwiGLU E{PB, DFF}; run_gemm(lds, H, W + WO_W13 + (size_t)f * 5632 * 1024, hc ? MTOT : MLAT, 5632, DM, E); }
        GRID_BAR();
        { pg8::EpiBf16<0> E{SB, DM, 0}; run_gemm(lds, PB, W + WO_W2 + (size_t)f * 1024 * 2816, MLAT, DM, DFF, E); }
        GRID_BAR();
        {
            const int vg = hc ? 224 : G;
            const bool has_pre = (f == 0) || (l == 0);
            RowArgs a{(l == 0 && f == 0) ? p->in[I_X] : p->out, (l == 0 && f == 0) ? p->in[I_CTX] : XC, p->out, XC, SB, H, modl, f == 0 ? modl : mod + (size_t)9 * 9216,
                      npost + (f == 0 ? 0 : 2 * DM), f == 0 ? npre + DM : p->in[I_NPRE] + 3 * DM, p->in[I_WIN] + (size_t)l * DM * DIN + 2304, gates, f == 0 ? 0 : 2, f == 0 ? 1 : 0, 0, MLAT, bid < vg ? bid : -1, vg, 0.5f};
            if (bid < vg) {
                if (f == 0) row_phase<true, true, true>(a, lds, tid);
                else if (has_pre) row_phase<true, true, false>(a, lds, tid);
                else row_phase<true, false, false>(a, lds, tid);
            } else { pg8::EpiBf16<0> E{SB, DM, 0}; run_gemm_ctx(lds, PB, W + WO_W2 + (size_t)f * 1024 * 2816, DM, DFF, E); }
            if (hc) {
                GRID_BAR();
                RowArgs c = a; c.row0 = MLAT; c.row1 = MTOT; c.vb = bid; c.vg = G;
                if (f == 0) row_phase<true, true, true>(c, lds, tid);
                else { row_phase<true, true, false>(c, lds, tid); __syncthreads(); convert_weights(p, 1, lds); }
            }
        }
        if (!(l == 1 && f == 1)) GRID_BAR();
      }
    }
#undef tid
#undef ws
#undef W
#undef H
#undef PB
#undef SB
#undef XC
#undef mod
#undef gates
}

extern "C" void kernel_launch(void* const* d_in, const int* in_sizes, int n_in, void* d_out, int out_size, void* d_ws, size_t ws_size, hipStream_t stream) {
    static int grid = 0;
    if (grid == 0) {
        if (n_in != 22 || out_size != MLAT * DM || ws_size < WS_END) { fprintf(stderr, "kernel_launch: unexpected shapes (n_in %d out %d ws %zu)\n", n_in, out_size, ws_size); grid = -1; return; }
        int dev = 0, cus = 0, per_cu = 0;
        (void)hipGetDevice(&dev);
        (void)hipDeviceGetAttribute(&cus, hipDeviceAttributeMultiprocessorCount, dev);
        (void)hipFuncSetAttribute((const void*)fwd_kernel, hipFuncAttributeMaxDynamicSharedMemorySize, LDS_BYTES);
        (void)hipOccupancyMaxActiveBlocksPerMultiprocessor(&per_cu, (const void*)fwd_kernel, 512, LDS_BYTES);
        if (per_cu < 1) per_cu = 1;
        if (per_cu > 1) per_cu = 1;
        grid = cus * per_cu;
        if (grid <= 0) grid = 256;
    }
    if (grid < 0) return;
    if (grid < 192) { fprintf(stderr, "kernel_launch: grid %d too small for the paired scans\n", grid); return; }
    (void)hipMemsetAsync(d_ws, 0, 65536, stream);
    Params p{};
    for (int i = 0; i < 22; ++i) p.in[i] = (const float*)d_in[i];
    p.out = (float*)d_out; p.ws = (unsigned char*)d_ws;
    void* args[] = {&p};
    hipError_t e = hipLaunchCooperativeKernel((const void*)fwd_kernel, dim3(grid), dim3(512), args, LDS_BYTES, stream);
    if (e != hipSuccess) fprintf(stderr, "cooperative launch failed: %s (grid %d)\n", hipGetErrorString(e), grid);
}
```

```cpp
#include <hip/hip_runtime.h>
#include <hip/hip_cooperative_groups.h>
#include <cstdio>
#include <cstdint>
namespace cg = cooperative_groups;

#define DI __device__ __forceinline__
#define LAS __attribute__((address_space(3)))
typedef unsigned short bf16_t;
typedef short bf16x8 __attribute__((ext_vector_type(8)));
typedef short s16x4 __attribute__((ext_vector_type(4)));
typedef float f32x2 __attribute__((ext_vector_type(2)));
typedef float f32x4 __attribute__((ext_vector_type(4)));
typedef float f32x16 __attribute__((ext_vector_type(16)));
typedef unsigned u32x2 __attribute__((ext_vector_type(2)));
typedef unsigned u32x4 __attribute__((ext_vector_type(4)));

constexpr int DM = 1024, NB = 8, SEQ = 4096, CTXL = 256, DFF = 2816, DIN = 7184, NMOD = 9;
constexpr int MLAT = NB * SEQ, MCTX = NB * CTXL, MTOT = MLAT + MCTX;
constexpr int NPC = 4096;
constexpr int NGC = 3072;
constexpr float EPS = 1e-6f;
constexpr int PC_AQ = 0, PC_AK = 512, PC_AV = 640, PC_MQ = 768, PC_MK = 1024, PC_MV = 1280, PC_MO = 1792, PC_HQ = 2304, PC_HF = 2560, PC_HI = 3072, PC_HG = 3584;

constexpr size_t MiB = 1u << 20;
constexpr size_t WS_MOD = 1 * MiB;
constexpr size_t WS_ROPE = 2 * MiB;
constexpr size_t WS_GATES = 3 * MiB;
constexpr size_t WS_XC = 6 * MiB;
constexpr size_t WS_W = 14 * MiB;
constexpr size_t WS_H = 66 * MiB;
constexpr size_t WS_P = 134 * MiB;
constexpr size_t WS_S = 406 * MiB;
constexpr size_t WS_END = 508 * MiB;
constexpr size_t WO_W13 = 0;
constexpr size_t WO_W2 = WO_W13 + (size_t)2 * 5632 * 1024;
constexpr size_t WO_WIN = WO_W2 + (size_t)2 * 1024 * 2816;
constexpr size_t WO_WG = WO_WIN + (size_t)4096 * 1024;
constexpr size_t WO_WB = WO_WG + (size_t)3072 * 1024;
constexpr size_t WO_WOUT = WO_WB + (size_t)3 * 1024 * 512;
constexpr size_t WO_END = WO_WOUT + (size_t)1024 * 1024;
static_assert(WO_END * 2 <= 52 * MiB, "weights fit");
static_assert((size_t)MTOT * 1024 * 2 <= 68 * MiB && (size_t)MTOT * 4096 * 2 <= 272 * MiB && (size_t)MTOT * 512 * 2 * 3 <= 102 * MiB, "ws map");

constexpr int LDS_BYTES = 131072 + 64;
constexpr size_t PTS = (size_t)MTOT * 256;
__device__ __forceinline__ size_t pidx(int row, int col) { return (size_t)(col >> 8) * PTS + (size_t)row * 256 + (col & 255); }

DI unsigned f2bf(float f) { unsigned u = __float_as_uint(f); return (u + 0x7fffu + ((u >> 16) & 1u)) >> 16; }
typedef __bf16 bf16v2 __attribute__((ext_vector_type(2)));
DI unsigned pk2(float lo, float hi) { f32x2 v = {lo, hi}; bf16v2 b = __builtin_convertvector(v, bf16v2); return __builtin_bit_cast(unsigned, b); }
DI float bflo(unsigned w) { return __uint_as_float(w << 16); }
DI float bfhi(unsigned w) { return __uint_as_float(w & 0xffff0000u); }
DI float bf1(short s) { return __uint_as_float(((unsigned)(unsigned short)s) << 16); }
DI float fexp(float x) { return __builtin_amdgcn_exp2f(x * 1.4426950408889634f); }
DI float flog(float x) { return __builtin_amdgcn_logf(x) * 0.6931471805599453f; }
DI float flog1p(float e) { const float u = 1.0f + e, d = u - 1.0f; return d == 0.f ? e : flog(u) * e * __builtin_amdgcn_rcpf(d); }
DI float fsigmoid(float x) { return __builtin_amdgcn_rcpf(1.0f + fexp(-x)); }
DI float fsilu(float x) { return x * fsigmoid(x); }
DI float wave_sum(float v) {
#pragma unroll
    for (int o = 1; o < 64; o <<= 1) v += __shfl_xor(v, o);
    return v;
}
DI bf16x8 pack8(float a0, float a1, float a2, float a3, float a4, float a5, float a6, float a7) {
    u32x4 p; p.x = pk2(a0, a1); p.y = pk2(a2, a3); p.z = pk2(a4, a5); p.w = pk2(a6, a7); return __builtin_bit_cast(bf16x8, p);
}
#define MFMA32(a, b, c) __builtin_amdgcn_mfma_f32_32x32x16_bf16((a), (b), (c), 0, 0, 0)
DI int crow(int i, int h) { return (i & 3) + 8 * (i >> 2) + 4 * h; }

#define LDS_BARRIER() do { asm volatile("s_waitcnt lgkmcnt(0)" ::: "memory"); __builtin_amdgcn_s_barrier(); asm volatile("" ::: "memory"); } while (0)
namespace pg8 {
#define PG8_LAS __attribute__((address_space(3)))
typedef unsigned short bf16_t;
typedef short bf16x8 __attribute__((ext_vector_type(8)));
typedef float f32x4 __attribute__((ext_vector_type(4)));
typedef unsigned u32x4 __attribute__((ext_vector_type(4)));
constexpr int BM = 256, BK = 64, HALF = 128, HTB = HALF * BK * 2  , STAGE_BYTES = 8 * HTB, NXCD = 8, WGM = 8;

__host__ __device__ __forceinline__ int lds_byte(int r, int c) { const int st = (r >> 4) * 2 + (c >> 5), rr = r & 15, cc = c & 31, ob = rr * 64 + cc * 2; return st * 1024 + (ob ^ (((ob >> 9) & 1) << 5)); }
__host__ __device__ __forceinline__ void stage_rc(int b, int& R, int& C) { const int st = b / 1024, sb = b % 1024, swz = sb ^ (((sb >> 9) & 1) << 5); R = (st >> 1) * 16 + swz / 64; C = (st & 1) * 32 + (swz % 64) / 2; }
__host__ __device__ __forceinline__ int perm32(int rho) { const int n = rho >> 4, i = rho & 15; return 8 * (i >> 2) + 4 * n + (i & 3); }

struct Unit { int pm, pn; };
struct Gemm { const bf16_t* A; const bf16_t* Bt; int M, N, K; };

struct StaticOrder {
    int nM, nN, nwg, G, c;
    __host__ __device__ void init(int M, int N, int G_, int c_) { nM = M / BM; nN = N / BM; nwg = nM * nN; G = G_; c = c_; }
    __host__ __device__ bool next(int i, Unit& u) const {
        const long L = (long)i * G + c; if (L >= nwg) return false;
        int wgid = (int)L; { const int q = nwg / NXCD, r = nwg % NXCD, xcd = wgid % NXCD, off = wgid / NXCD; wgid = (xcd < r ? xcd * (q + 1) : r * (q + 1) + (xcd - r) * q) + off; }
        const int nig = WGM * nN, gid = wgid / nig, fm = gid * WGM, gsz = (nM - fm) < WGM ? (nM - fm) : WGM;
        u.pm = fm + ((wgid % nig) % gsz); u.pn = (wgid % nig) / gsz; return true;
    }
    __device__ __forceinline__ void a_ready(const Unit&) const {}
    __device__ __forceinline__ void done(const Unit&) const {}
};

struct CtxOrder {
    int first, pm0;
    __host__ __device__ bool next(int i, Unit& u) const { const int idx = (int)blockIdx.x - first; if (i != 0 || idx < 0 || idx >= 32) return false; u.pm = pm0 + (idx >> 2); u.pn = idx & 3; return true; }
    __device__ __forceinline__ void a_ready(const Unit&) const {}
    __device__ __forceinline__ void done(const Unit&) const {}
};

template <int ACT  > struct EpiBf16 {
    static constexpr bool PERM = true, AFTER_DRAIN = false;
    bf16_t* O; int ldc; size_t tstride;
    __device__ __forceinline__ void operator()(const f32x4 (&acc)[2][2][4][2], const Unit& u, int wr, int wc, int fr, int fq) const {
        const int row0 = u.pm * BM + wr * 64 + fr, col0 = (tstride ? 0 : u.pn * BM) + wc * 32 + 8 * fq;
        bf16_t* Ob = O + (size_t)u.pn * tstride;
#pragma unroll
        for (int ai = 0; ai < 2; ++ai)
#pragma unroll
            for (int m = 0; m < 4; ++m) { bf16_t* rowp = Ob + (size_t)(row0 + ai * HALF + m * 16) * ldc + col0;
#pragma unroll
                for (int bj = 0; bj < 2; ++bj) { f32x4 v0 = acc[ai][bj][m][0], v1 = acc[ai][bj][m][1];
                    if (ACT == 1) {
#pragma unroll
                        for (int k = 0; k < 4; ++k) { v0[k] = fsigmoid(v0[k]); v1[k] = fsigmoid(v1[k]); } }
                    u32x4 w; w.x = pk2(v0[0], v0[1]); w.y = pk2(v0[2], v0[3]); w.z = pk2(v1[0], v1[1]); w.w = pk2(v1[2], v1[3]);
                    *(u32x4*)(rowp + bj * HALF) = w; } }
    }
};
struct EpiSwiGLU {
    static constexpr bool PERM = false, AFTER_DRAIN = false;
    bf16_t* O; int ldc;
    __device__ __forceinline__ void operator()(const f32x4 (&acc)[2][2][4][2], const Unit& u, int wr, int wc, int fr, int fq) const {
        const int row0 = u.pm * BM + wr * 64 + fr, f0 = u.pn * 128 + wc * 16 + 4 * fq;
#pragma unroll
        for (int ai = 0; ai < 2; ++ai)
#pragma unroll
            for (int m = 0; m < 4; ++m) { bf16_t* rowp = O + (size_t)(row0 + ai * HALF + m * 16) * ldc + f0;
#pragma unroll
                for (int bj = 0; bj < 2; ++bj) { const f32x4 a = acc[ai][bj][m][0], b = acc[ai][bj][m][1];
                    u32x2 w; w.x = pk2(fsilu(a[0]) * b[0], fsilu(a[1]) * b[1]); w.y = pk2(fsilu(a[2]) * b[2], fsilu(a[3]) * b[3]);
                    *(u32x2*)(rowp + bj * 64) = w; } }
    }
};
struct EpiMerge {
    static constexpr bool PERM = true, AFTER_DRAIN = false;
    bf16_t* O; const bf16_t* G; int gi;
    __device__ __forceinline__ void operator()(const f32x4 (&acc)[2][2][4][2], const Unit& u, int wr, int wc, int fr, int fq) const {
        const int row0 = u.pm * BM + wr * 64 + fr, col0 = u.pn * BM + wc * 32 + 8 * fq;
#pragma unroll
        for (int ai = 0; ai < 2; ++ai)
#pragma unroll
            for (int m = 0; m < 4; ++m) { const size_t r = (size_t)(row0 + ai * HALF + m * 16);
#pragma unroll
                for (int bj = 0; bj < 2; ++bj) { const int c = col0 + bj * HALF;
                    const u32x4 g = *(const u32x4*)(G + r * 3072 + gi * 1024 + c);
                    const f32x4 v0 = acc[ai][bj][m][0], v1 = acc[ai][bj][m][1];
                    float o0 = bflo(g.x) * v0[0], o1 = bfhi(g.x) * v0[1], o2 = bflo(g.y) * v0[2], o3 = bfhi(g.y) * v0[3];
                    float o4 = bflo(g.z) * v1[0], o5 = bfhi(g.z) * v1[1], o6 = bflo(g.w) * v1[2], o7 = bfhi(g.w) * v1[3];
                    bf16_t* op = O + r * 1024 + c;
                    if (gi > 0) {
                        const unsigned long long p0 = __hip_atomic_load((const unsigned long long*)op, __ATOMIC_RELAXED, __HIP_MEMORY_SCOPE_AGENT);
                        const unsigned long long p1 = __hip_atomic_load((const unsigned long long*)op + 1, __ATOMIC_RELAXED, __HIP_MEMORY_SCOPE_AGENT);
                        const unsigned a0 = (unsigned)p0, a1 = (unsigned)(p0 >> 32), a2 = (unsigned)p1, a3 = (unsigned)(p1 >> 32);
                        o0 += bflo(a0); o1 += bfhi(a0); o2 += bflo(a1); o3 += bfhi(a1); o4 += bflo(a2); o5 += bfhi(a2); o6 += bflo(a3); o7 += bfhi(a3);
                    }
                    u32x4 w; w.x = pk2(o0, o1); w.y = pk2(o2, o3); w.z = pk2(o4, o5); w.w = pk2(o6, o7);
                    *(u32x4*)op = w; } }
    }
};

template <class Epi, class Sched, bool ALIGN_EPI = false, bool SP2 = false>
__device__ __forceinline__ void gemm_phase(PG8_LAS unsigned char* lds, const Gemm g, const Sched& S, const Epi& E) {
    int tid_ = threadIdx.x; asm volatile("" : "+v"(tid_));
    const int tid = tid_, wid = __builtin_amdgcn_readfirstlane(tid >> 6), lane = tid & 63, wr = wid >> 2, wc = wid & 3, fr = lane & 15, fq = lane >> 4;
    const int K = g.K, nt = K / BK;
    unsigned voffA[2], voffB[2];
#pragma unroll
    for (int i = 0; i < 2; ++i) { int R, C; stage_rc(tid * 16 + i * 8192, R, C); const int Rb = Epi::PERM ? ((R & ~31) + perm32(R & 31)) : R;
        voffA[i] = (unsigned)(R * K + C) * 2u; voffB[i] = (unsigned)(Rb * K + C) * 2u; }
    const size_t kstep = (size_t)(BK * 2);
    const size_t hstep = (size_t)HALF * K * 2;
    const size_t tstep = 2 * hstep;
    const unsigned ldsw = (unsigned)wid * 1024u;
    const int aoff = lds_byte(wr * 64 + fr, fq * 8), boff = lds_byte(wc * 32 + fr, fq * 8);
#define PG8_SA(b, h) (((b) * 2 + (h)) * HTB)
#define PG8_SB(b, h) ((4 + (b) * 2 + (h)) * HTB)
#define PG8_STAGE(bufoff, gbase, voff) do { _Pragma("unroll") for (int _i = 0; _i < 2; ++_i) \
        __builtin_amdgcn_global_load_lds((const unsigned*)((const char*)(gbase) + (voff)[_i]), (PG8_LAS unsigned*)(lds + (bufoff) + ldsw + _i * 8192), 16, 0, 0); } while (0)
#define PG8_LDA(dst, b, h) do { _Pragma("unroll") for (int m = 0; m < 4; ++m) _Pragma("unroll") for (int k = 0; k < 2; ++k) dst[m][k] = *(const PG8_LAS bf16x8*)(lds + PG8_SA(b, h) + aoff + m * 2048 + k * 1024); } while (0)
#define PG8_LDB(dst, b, h) do { _Pragma("unroll") for (int n = 0; n < 2; ++n) _Pragma("unroll") for (int k = 0; k < 2; ++k) dst[n][k] = *(const PG8_LAS bf16x8*)(lds + PG8_SB(b, h) + boff + n * 2048 + k * 1024); } while (0)
#define PG8_MMA(ai, bj, At, Bt) do { __builtin_amdgcn_s_setprio(1); _Pragma("unroll") for (int m = 0; m < 4; ++m) _Pragma("unroll") for (int n = 0; n < 2; ++n) _Pragma("unroll") for (int k = 0; k < 2; ++k) \
        acc[ai][bj][m][n] = __builtin_amdgcn_mfma_f32_16x16x32_bf16(Bt[n][k], At[m][k], acc[ai][bj][m][n], 0, 0, 0); __builtin_amdgcn_s_setprio(0); } while (0)
#define PG8_WAIT_V(n) asm volatile("s_waitcnt vmcnt(" #n ")" ::: "memory")
#define PG8_WAIT_L(n) asm volatile("s_waitcnt lgkmcnt(" #n ")" ::: "memory")
#define PG8_BAR __builtin_amdgcn_s_barrier()
#define PG8_SCHED __builtin_amdgcn_sched_barrier(0)
    Unit cur, nxt; int ui = 0;
    if (!S.next(0, cur)) return;
    f32x4 acc[2][2][4][2];
#pragma unroll
    for (int a = 0; a < 2; ++a)
#pragma unroll
        for (int b = 0; b < 2; ++b)
#pragma unroll
            for (int m = 0; m < 4; ++m)
#pragma unroll
                for (int n = 0; n < 2; ++n) acc[a][b][m][n] = (f32x4){0.f, 0.f, 0.f, 0.f};
    bf16x8 At[4][2], B0[2][2], B1[2][2];
    const char* cA = (const char*)g.A + (size_t)cur.pm * tstep; const char* cB = (const char*)g.Bt + (size_t)cur.pn * tstep;
    S.a_ready(cur);
    if constexpr (SP2) {
        PG8_STAGE(PG8_SB(0, 0), cB, voffB); PG8_STAGE(PG8_SB(0, 1), cB + hstep, voffB); PG8_STAGE(PG8_SA(0, 0), cA, voffA); PG8_STAGE(PG8_SA(0, 1), cA + hstep, voffA);
        if (wr == 1) PG8_BAR;
        PG8_WAIT_V(2); PG8_BAR;
        PG8_STAGE(PG8_SB(1, 0), cB + kstep, voffB); PG8_STAGE(PG8_SA(1, 0), cA + kstep, voffA); PG8_STAGE(PG8_SB(1, 1), cB + hstep + kstep, voffB);
        PG8_WAIT_V(6); PG8_BAR;
    } else {
        PG8_STAGE(PG8_SB(0, 0), cB, voffB); PG8_STAGE(PG8_SA(0, 0), cA, voffA); PG8_STAGE(PG8_SB(0, 1), cB + hstep, voffB); PG8_STAGE(PG8_SA(0, 1), cA + hstep, voffA);
        if (wr == 1) PG8_BAR;
        PG8_WAIT_V(4); PG8_BAR;
        PG8_STAGE(PG8_SB(1, 0), cB + kstep, voffB); PG8_STAGE(PG8_SA(1, 0), cA + kstep, voffA); PG8_STAGE(PG8_SB(1, 1), cB + hstep + kstep, voffB);
        PG8_WAIT_V(6); PG8_BAR;
    }
    for (;;) {
        const bool has_next = S.next(ui + 1, nxt);
        const char* nA = has_next ? (const char*)g.A + (size_t)nxt.pm * tstep : cA; const char* nB = has_next ? (const char*)g.Bt + (size_t)nxt.pn * tstep : cB;
        for (int t = 0; t < nt; t += 2) {
            const bool last = (t == nt - 2);
            const char* a1 = cA + (size_t)(t + 1) * kstep;
            const char* a2 = last ? nA : cA + (size_t)(t + 2) * kstep; const char* b2 = last ? nB : cB + (size_t)(t + 2) * kstep;
            const char* a3 = a2 + kstep; const char* b3 = b2 + kstep;
            if (last && has_next) S.a_ready(nxt);
            if constexpr (SP2) {
            PG8_LDB(B0, 0, 0); PG8_LDB(B1, 0, 1); PG8_SCHED; PG8_LDA(At, 0, 0); PG8_STAGE(PG8_SA(1, 1), a1 + hstep, voffA);
            PG8_WAIT_V(8); PG8_WAIT_L(0); PG8_BAR; PG8_MMA(0, 0, At, B0); PG8_MMA(0, 1, At, B1); PG8_BAR; PG8_SCHED;
            PG8_LDA(At, 0, 1); PG8_STAGE(PG8_SB(0, 0), b2, voffB); PG8_STAGE(PG8_SB(0, 1), b2 + hstep, voffB); PG8_STAGE(PG8_SA(0, 0), a2, voffA);
            PG8_WAIT_V(8); PG8_WAIT_L(0); PG8_BAR; PG8_MMA(1, 0, At, B0); PG8_MMA(1, 1, At, B1); PG8_BAR; PG8_SCHED;
            PG8_LDB(B0, 1, 0); PG8_LDB(B1, 1, 1); PG8_SCHED; PG8_LDA(At, 1, 0); PG8_STAGE(PG8_SA(0, 1), a2 + hstep, voffA);
            PG8_WAIT_V(8); PG8_WAIT_L(0); PG8_BAR; PG8_MMA(0, 0, At, B0); PG8_MMA(0, 1, At, B1); PG8_BAR; PG8_SCHED;
            PG8_LDA(At, 1, 1); PG8_STAGE(PG8_SB(1, 0), b3, voffB); PG8_STAGE(PG8_SB(1, 1), b3 + hstep, voffB); PG8_STAGE(PG8_SA(1, 0), a3, voffA);
            PG8_WAIT_V(8); PG8_WAIT_L(0); PG8_BAR; PG8_MMA(1, 0, At, B0); PG8_MMA(1, 1, At, B1); PG8_BAR; PG8_SCHED;
            } else {
            PG8_LDB(B0, 0, 0); PG8_SCHED; PG8_LDA(At, 0, 0); PG8_STAGE(PG8_SA(1, 1), a1 + hstep, voffA);
            PG8_WAIT_L(8); PG8_BAR; PG8_WAIT_L(0); PG8_MMA(0, 0, At, B0); PG8_BAR; PG8_SCHED;
            PG8_LDB(B1, 0, 1); PG8_STAGE(PG8_SB(0, 0), b2, voffB);
            PG8_BAR; PG8_WAIT_L(0); PG8_MMA(0, 1, At, B1); PG8_BAR;
            PG8_LDA(At, 0, 1); PG8_STAGE(PG8_SA(0, 0), a2, voffA);
            PG8_BAR; PG8_WAIT_L(0); PG8_MMA(1, 0, At, B0); PG8_BAR; PG8_SCHED;
            PG8_STAGE(PG8_SB(0, 1), b2 + hstep, voffB);
            PG8_WAIT_V(6); PG8_BAR; PG8_MMA(1, 1, At, B1); PG8_BAR;
            PG8_LDB(B0, 1, 0); PG8_SCHED; PG8_LDA(At, 1, 0); PG8_STAGE(PG8_SA(0, 1), a2 + hstep, voffA);
            PG8_WAIT_L(8); PG8_BAR; PG8_WAIT_L(0); PG8_MMA(0, 0, At, B0); PG8_BAR; PG8_SCHED;
            PG8_LDB(B1, 1, 1); PG8_STAGE(PG8_SB(1, 0), b3, voffB);
            PG8_BAR; PG8_WAIT_L(0); PG8_MMA(0, 1, At, B1); PG8_BAR;
            PG8_LDA(At, 1, 1); PG8_STAGE(PG8_SA(1, 0), a3, voffA);
            PG8_BAR; PG8_WAIT_L(0); PG8_MMA(1, 0, At, B0); PG8_BAR; PG8_SCHED;
            PG8_STAGE(PG8_SB(1, 1), b3 + hstep, voffB);
            PG8_WAIT_V(6); PG8_BAR; PG8_MMA(1, 1, At, B1); PG8_BAR;
            }
        }
        if constexpr (ALIGN_EPI) { if (wr == 0) PG8_BAR; }
        if constexpr (!Epi::AFTER_DRAIN) { E(acc, cur, wr, wc, fr, fq); S.done(cur); }
        if (!has_next) break;
#pragma unroll
        for (int a = 0; a < 2; ++a)
#pragma unroll
            for (int b = 0; b < 2; ++b)
#pragma unroll
                for (int m = 0; m < 4; ++m)
#pragma unroll
                    for (int n = 0; n < 2; ++n) acc[a][b][m][n] = (f32x4){0.f, 0.f, 0.f, 0.f};
        cur = nxt; cA = nA; cB = nB; ++ui;
        if constexpr (ALIGN_EPI) { if (wr == 1) PG8_BAR; }
    }
    PG8_WAIT_V(0);
    if constexpr (!ALIGN_EPI) { if (wr == 0) PG8_BAR; }
    PG8_BAR;
    if constexpr (Epi::AFTER_DRAIN) { E.fused(acc, cur, wr, wc, fr, fq, lds, wid, lane); S.done(cur); }
#undef PG8_SA
#undef PG8_SB
#undef PG8_STAGE
#undef PG8_LDA
#undef PG8_LDB
#undef PG8_MMA
#undef PG8_WAIT_V
#undef PG8_WAIT_L
#undef PG8_BAR
#undef PG8_SCHED
}
}

struct Params { const float* in[22]; float* out; unsigned char* ws; };
typedef const __attribute__((address_space(4))) Params* KP;
DI KP kparams() { KP kp = (KP)__builtin_amdgcn_kernarg_segment_ptr(); asm volatile("" : "+s"(kp)); return kp; }
enum { I_X = 0, I_C, I_CTX, I_CCTX, I_WADA, I_BADA, I_NPRE, I_NPOST, I_W1, I_W3, I_W2, I_WIN, I_SINK, I_MLCONV, I_MLFB, I_MLNORM, I_HGLB, I_HGNORM, I_WBA, I_WBM, I_WBH, I_WOUT };

DI void transpose_item(const float* Wa, const float* Wb, int ldw, int K, bf16_t* dst, int k0, LAS float* scr, int lane) {
    const float* src = (((lane & 31) < 16) ? Wa : Wb) + (lane & 15);
#pragma unroll 8
    for (int i = 0; i < 32; ++i) { const int kk = 2 * i + (lane >> 5); scr[kk * 33 + (lane & 31)] = src[(size_t)(k0 + kk) * ldw]; }
    asm volatile("s_waitcnt lgkmcnt(0)" ::: "memory");
    const int c = lane & 7;
#pragma unroll
    for (int j = 0; j < 4; ++j) { const int n = (lane >> 3) + 8 * j; const LAS float* s = scr + (8 * c) * 33 + n;
        u32x4 o; o.x = pk2(s[0 * 33], s[1 * 33]); o.y = pk2(s[2 * 33], s[3 * 33]); o.z = pk2(s[4 * 33], s[5 * 33]); o.w = pk2(s[6 * 33], s[7 * 33]);
        *(u32x4*)(dst + (size_t)n * K + k0 + 8 * c) = o; }
    asm volatile("s_waitcnt lgkmcnt(0)" ::: "memory");
}
struct Seg { const float* Wa; const float* Wb; int ldw, K, ngroups, colA0, colB0, cstep; bf16_t* dst; };
DI bool seg_run(const Seg& s, int& it, LAS float* scr, int lane) {
    const int nk = s.K / 64, n = s.ngroups * nk;
    if (it >= n) { it -= n; return false; }
    const int gi = it / nk, kb = it % nk;
    transpose_item(s.Wa + s.colA0 + gi * s.cstep, s.Wb + s.colB0 + gi * s.cstep, s.ldw, s.K, s.dst + (size_t)gi * 32 * s.K, kb * 64, scr, lane);
    return true;
}
DI void convert_weights(KP p, int l, LAS unsigned char* lds, const unsigned mask, const int vb, const int vg) {
    int tid_ = threadIdx.x; asm volatile("" : "+v"(tid_));
    const int wave = tid_ >> 6, lane = tid_ & 63;
    if (vb < 0) return;
    LAS float* scr = (LAS float*)(lds + wave * 8704);
    bf16_t* W = (bf16_t*)(p->ws + WS_W);
    const int gw = vb * 8 + wave, NGW = vg * 8;
    constexpr int NITEMS = 2 * 176 * 16 + 2 * 32 * 44 + 128 * 16 + 96 * 16 + 3 * 32 * 8 + 32 * 16;
    for (int item = gw; item < NITEMS; item += NGW) {
        int it = item;
        if (it < 2 * 2816) { const int f = it / 2816; if (!((mask >> f) & 1u)) continue; it -= f * 2816;
            const float* w1 = p->in[I_W1] + (size_t)(l * 2 + f) * DM * DFF; const float* w3 = p->in[I_W3] + (size_t)(l * 2 + f) * DM * DFF;
            Seg s{w1, w3, DFF, DM, 176, 0, 0, 16, W + WO_W13 + (size_t)f * 5632 * 1024}; seg_run(s, it, scr, lane); continue; }
        it -= 2 * 2816;
        if (it < 2 * 1408) { const int f = it / 1408; if (!((mask >> (2 + f)) & 1u)) continue; it -= f * 1408;
            const float* w2 = p->in[I_W2] + (size_t)(l * 2 + f) * DFF * DM;
            Seg s{w2, w2, DM, DFF, 32, 0, 16, 32, W + WO_W2 + (size_t)f * 1024 * 2816}; seg_run(s, it, scr, lane); continue; }
        it -= 2 * 1408;
        const float* win = p->in[I_WIN] + (size_t)l * DM * DIN;
        if (it < 72 * 16) { if (!((mask >> 4) & 1u)) continue; Seg s{win, win, DIN, DM, 72, 0, 16, 32, W + WO_WIN}; seg_run(s, it, scr, lane); continue; }
        it -= 72 * 16;
        if (it < 56 * 16) { if (!((mask >> 5) & 1u)) continue; Seg s{win, win, DIN, DM, 56, 2320, 2336, 32, W + WO_WIN + (size_t)2304 * 1024}; seg_run(s, it, scr, lane); continue; }
        it -= 56 * 16;
        if (it < 96 * 16) { if (!((mask >> 6) & 1u)) continue; Seg s{win, win, DIN, DM, 96, 4112, 4128, 32, W + WO_WG}; seg_run(s, it, scr, lane); continue; }
        it -= 96 * 16;
        if (it < 3 * 256) { const int f = it / 256; if (!((mask >> (7 + f)) & 1u)) continue; it -= f * 256;
            const float* wb = p->in[I_WBA + f] + (size_t)l * 512 * DM;
            Seg s{wb, wb, DM, 512, 32, 0, 16, 32, W + WO_WB + (size_t)f * 1024 * 512}; seg_run(s, it, scr, lane); continue; }
        it -= 3 * 256;
        if (!((mask >> 10) & 1u)) continue;
        { const float* wo = p->in[I_WOUT] + (size_t)l * DM * DM; Seg s{wo, wo, DM, DM, 32, 0, 16, 32, W + WO_WOUT}; seg_run(s, it, scr, lane); }
    }
}

DI void mods_phase(KP p, LAS unsigned char* lds, int tid) {
    asm volatile("" : "+v"(tid));
    const int wave = tid >> 6, lane = tid & 63;
    LAS float* sc = (LAS float*)lds;
    LAS float* red = (LAS float*)(lds + 36864);
    for (int i = tid; i < 9 * 1024; i += 512) { const float v = (i < 8192) ? p->in[I_C][i] : p->in[I_CCTX][i - 8192]; sc[i] = v / (1.0f + expf(-v)); }
    __syncthreads();
    float* mod = (float*)(p->ws + WS_MOD);
    for (int it = blockIdx.x; it < 288; it += gridDim.x) {
        const int l = it / 144, cb = it % 144, col = cb * 64 + lane;
        const float* wp = p->in[I_WADA] + ((size_t)l * 1024 + wave * 128) * 9216 + col;
        float acc[9];
#pragma unroll
        for (int i = 0; i < 9; ++i) acc[i] = 0.f;
#pragma unroll 32
        for (int k = 0; k < 128; ++k) { const float wv = wp[(size_t)k * 9216];
#pragma unroll
            for (int i = 0; i < 9; ++i) acc[i] += sc[i * 1024 + wave * 128 + k] * wv; }
#pragma unroll
        for (int i = 0; i < 9; ++i) red[(wave * 9 + i) * 64 + lane] = acc[i];
        __syncthreads();
        for (int o = tid; o < 576; o += 512) { const int i = o >> 6, ln = o & 63; float s = 0.f;
#pragma unroll
            for (int w = 0; w < 8; ++w) s += red[(w * 9 + i) * 64 + ln];
            mod[((size_t)l * 9 + i) * 9216 + cb * 64 + ln] = s + p->in[I_BADA][(size_t)l * 9216 + cb * 64 + ln]; }
        __syncthreads();
    }
    if (blockIdx.x == gridDim.x - 1) {
        f32x2* tab = (f32x2*)(p->ws + WS_ROPE);
        for (int e = tid; e < 1024; e += 512) { const int pos = e >> 4, i = e & 15;
            const float inv = exp2f(-(float)i * (13.287712379549449f / 16.0f));
            const float a = (float)pos * inv; float rev = a * 0.15915494309189535f; rev -= floorf(rev);
            f32x2 cs; cs.x = __builtin_amdgcn_cosf(rev); cs.y = __builtin_amdgcn_sinf(rev); tab[e] = cs; }
    }
}

struct RowArgs {
    const float* xs_lat; const float* xs_ctx; float* xd_lat; float* xd_ctx;
    const bf16_t* Y; bf16_t* H; const float* mod; const float* modpre; const float* gpost; const float* gpre; const float* wgates; float* gates;
    int jpost, jpre, row0, row1, vb, vg; float wpost;
};
template <bool POST, bool PRE, bool GATES>
DI void row_phase(const RowArgs& a, LAS unsigned char* lds, int tid) {
    asm volatile("" : "+v"(tid));
    const int wave = tid >> 6, lane = tid & 63;
    LAS f32x4* wl = (LAS f32x4*)lds;
    if (GATES) {
        for (int idx = tid; idx < 1024 * 4; idx += 512) { const int k = idx >> 2, c4 = idx & 3; const int ln = (k & 255) >> 2, j = k >> 8, e = k & 3;
            wl[((j * 4 + e) * 4 + c4) * 64 + ln] = *(const f32x4*)(a.wgates + (size_t)k * DIN + 4 * c4); }
        __syncthreads();
    }
    for (int row = a.row0 + a.vb * 8 + wave; a.vb >= 0 && row < a.row1; row += a.vg * 8) {
        const int mi = row < MLAT ? (row >> 12) : 8;
        const float* md = a.mod + (size_t)mi * 9216;
        const float* mdp = a.modpre + (size_t)mi * 9216;
        const float* src = row < MLAT ? a.xs_lat + (size_t)row * DM : a.xs_ctx + (size_t)(row - MLAT) * DM;
        f32x4 x[4];
#pragma unroll
        for (int j = 0; j < 4; ++j) x[j] = *(const f32x4*)(src + 4 * lane + 256 * j);
        if (POST) {
            f32x4 y[4]; float s = 0.f;
#pragma unroll
            for (int j = 0; j < 4; ++j) { const u32x2 w = *(const u32x2*)(a.Y + (size_t)row * DM + 4 * lane + 256 * j);
                y[j] = (f32x4){bflo(w.x), bfhi(w.x), bflo(w.y), bfhi(w.y)}; s += (y[j][0] * y[j][0] + y[j][1] * y[j][1]) + (y[j][2] * y[j][2] + y[j][3] * y[j][3]); }
            const float rstd = 1.0f / sqrtf(wave_sum(s) * (1.0f / DM) + EPS);
            float* dst = row < MLAT ? a.xd_lat + (size_t)row * DM : a.xd_ctx + (size_t)(row - MLAT) * DM;
#pragma unroll
            for (int j = 0; j < 4; ++j) { const int c = 4 * lane + 256 * j;
                const f32x4 gt = *(const f32x4*)(md + (3 * a.jpost + 2) * DM + c), gp = *(const f32x4*)(a.gpost + c);
                x[j] = x[j] + a.wpost * gt * (y[j] * rstd * gp);
                *(f32x4*)(dst + c) = x[j]; }
        }
        if (PRE) {
            float s = 0.f;
#pragma unroll
            for (int j = 0; j < 4; ++j) s += (x[j][0] * x[j][0] + x[j][1] * x[j][1]) + (x[j][2] * x[j][2] + x[j][3] * x[j][3]);
            const float rstd = 1.0f / sqrtf(wave_sum(s) * (1.0f / DM) + EPS);
            f32x4 hv[4]; f32x4 g4[4];
#pragma unroll
            for (int c4 = 0; c4 < 4; ++c4) g4[c4] = (f32x4){0.f, 0.f, 0.f, 0.f};
#pragma unroll
            for (int j = 0; j < 4; ++j) { const int c = 4 * lane + 256 * j;
                const f32x4 sh = *(const f32x4*)(mdp + (3 * a.jpre) * DM + c), scl = *(const f32x4*)(mdp + (3 * a.jpre + 1) * DM + c), g = *(const f32x4*)(a.gpre + c);
                hv[j] = (x[j] * rstd * g) * (1.0f + scl) + sh;
                u32x2 w; w.x = pk2(hv[j][0], hv[j][1]); w.y = pk2(hv[j][2], hv[j][3]);
                *(u32x2*)(a.H + (size_t)row * DM + c) = w;
                if (GATES) {
#pragma unroll
                    for (int e = 0; e < 4; ++e)
#pragma unroll
                        for (int c4 = 0; c4 < 4; ++c4) g4[c4] += hv[j][e] * wl[((j * 4 + e) * 4 + c4) * 64 + lane];
                    asm volatile("" ::: "memory");
                } }
            if (GATES) {
#pragma unroll
                for (int c4 = 0; c4 < 4; ++c4)
#pragma unroll
                    for (int k = 0; k < 4; ++k) g4[c4][k] = wave_sum(g4[c4][k]);
                if (lane == 0) {
#pragma unroll
                    for (int c4 = 0; c4 < 4; ++c4) *(f32x4*)(a.gates + (size_t)row * 16 + 4 * c4) = g4[c4]; }
            }
        }
    }
    if (GATES) __syncthreads();
}

constexpr int RS = 144;
constexpr int AT_K = 0, AT_V = 9216, AT_TAB = 18432;
struct AttnArgs { const bf16_t* P; bf16_t* ATT; const float* sink; const f32x2* rope; };

DI void attn_item(const AttnArgs& A, int item, LAS unsigned char* lds, int tid) {
    asm volatile("" : "+v"(tid));
    const int w = tid >> 6, lane = tid & 63, r = lane & 31, hh = lane >> 5;
    const LAS f32x2* tab = (const LAS f32x2*)(lds + AT_TAB);
    int b, g, qb = 0, qrow0; bool lat;
    if (item < 512) { b = item >> 6; g = (item >> 5) & 1; qb = item & 31; lat = true; qrow0 = b * SEQ + qb * 128; }
    else { const int it = item - 512; b = it >> 2; g = (it >> 1) & 1; lat = false; qrow0 = MLAT + b * CTXL + (it & 1) * 128; }
    const int head = g * 4 + (w >> 1), qoff = (w & 1) * 64;
    bf16x8 qf[2][4];
#pragma unroll
    for (int qt = 0; qt < 2; ++qt) {
        const int ql = qoff + 32 * qt + r;
        const bf16_t* qp = A.P + pidx(qrow0 + ql, PC_AQ + head * 64 + 8 * hh);
        float x[4][8];
#pragma unroll
        for (int ks = 0; ks < 4; ++ks) { const u32x4 raw = *(const u32x4*)(qp + 16 * ks);
            x[ks][0] = bflo(raw.x); x[ks][1] = bfhi(raw.x); x[ks][2] = bflo(raw.y); x[ks][3] = bfhi(raw.y); x[ks][4] = bflo(raw.z); x[ks][5] = bfhi(raw.z); x[ks][6] = bflo(raw.w); x[ks][7] = bfhi(raw.w); }
        if (lat) {
            const int t = qb * 128 + ql;
#pragma unroll
            for (int pr = 0; pr < 2; ++pr) { const int pos = pr ? (t & 63) : (t >> 6);
#pragma unroll
                for (int j = 0; j < 8; ++j) { const f32x2 cs = tab[pos * 16 + 8 * hh + j]; const float x1 = x[2 * pr][j], x2 = x[2 * pr + 1][j];
                    x[2 * pr][j] = x1 * cs.x - x2 * cs.y; x[2 * pr + 1][j] = x2 * cs.x + x1 * cs.y; } }
        }
#pragma unroll
        for (int ks = 0; ks < 4; ++ks) qf[qt][ks] = pack8(x[ks][0] * 0.125f, x[ks][1] * 0.125f, x[ks][2] * 0.125f, x[ks][3] * 0.125f, x[ks][4] * 0.125f, x[ks][5] * 0.125f, x[ks][6] * 0.125f, x[ks][7] * 0.125f);
    }
    f32x16 O[2][2];
#pragma unroll
    for (int qt = 0; qt < 2; ++qt)
#pragma unroll
        for (int dt = 0; dt < 2; ++dt)
#pragma unroll
            for (int i = 0; i < 16; ++i) O[qt][dt][i] = 0.f;
    const float sk = A.sink[head];
    float m_run[2] = {sk, sk}, l_run[2];
    l_run[0] = l_run[1] = (hh == 0) ? 1.0f : 0.0f;
    const int ti_hi = (lat && qb == 31) ? 4 : 6;
    int ti = lat ? (qb == 0 ? 2 : 0) : 6;
    const int ss = tid >> 3, sc8 = tid & 7, half = sc8 >> 2, i0 = (sc8 & 3) * 4;
    u32x2 k1, k2; u32x4 vr;
#define ATT_LOAD(tix) do { const int krow_ = ((tix) < 6 ? b * SEQ + 128 * (qb - 1) + 64 * (tix) : MLAT + b * CTXL + 64 * ((tix) - 6)) + ss; \
        const bf16_t* kp_ = A.P + pidx(krow_, PC_AK); \
        k1 = *(const u32x2*)(kp_ + g * 64 + 32 * half + i0); k2 = *(const u32x2*)(kp_ + g * 64 + 32 * half + 16 + i0); \
        vr = *(const u32x4*)(kp_ + (PC_AV - PC_AK) + g * 64 + 8 * sc8); } while (0)
    ATT_LOAD(ti);
    for (;;) {
        {
            float a[4] = {bflo(k1.x), bfhi(k1.x), bflo(k1.y), bfhi(k1.y)}, c[4] = {bflo(k2.x), bfhi(k2.x), bflo(k2.y), bfhi(k2.y)};
            if (ti < 6) { const int kpos = 128 * (qb - 1) + 64 * ti + ss; const int pos = half ? (kpos & 63) : (kpos >> 6);
#pragma unroll
                for (int e = 0; e < 4; ++e) { const f32x2 cs = tab[pos * 16 + i0 + e]; const float x1 = a[e], x2 = c[e]; a[e] = x1 * cs.x - x2 * cs.y; c[e] = x2 * cs.x + x1 * cs.y; } }
            u32x2 o1, o2; o1.x = pk2(a[0], a[1]); o1.y = pk2(a[2], a[3]); o2.x = pk2(c[0], c[1]); o2.y = pk2(c[2], c[3]);
            *(LAS u32x2*)(lds + AT_K + ss * RS + (32 * half + i0) * 2) = o1;
            *(LAS u32x2*)(lds + AT_K + ss * RS + (32 * half + 16 + i0) * 2) = o2;
            const unsigned vv[4] = {vr.x, vr.y, vr.z, vr.w};
#pragma unroll
            for (int e = 0; e < 4; ++e) { *(LAS unsigned short*)(lds + AT_V + (8 * sc8 + 2 * e) * RS + ss * 2) = (unsigned short)(vv[e] & 0xffffu);
                *(LAS unsigned short*)(lds + AT_V + (8 * sc8 + 2 * e + 1) * RS + ss * 2) = (unsigned short)(vv[e] >> 16); }
        }
        LDS_BARRIER();
        const int tn = (ti < 6 && ti + 1 == ti_hi) ? 6 : ti + 1;
        if (tn < 10) ATT_LOAD(tn);
        f32x16 S[2][2];
#pragma unroll
        for (int st = 0; st < 2; ++st) {
            bf16x8 kf[4];
#pragma unroll
            for (int ks = 0; ks < 4; ++ks) kf[ks] = *(const LAS bf16x8*)(lds + AT_K + (32 * st + r) * RS + (16 * ks + 8 * hh) * 2);
#pragma unroll
            for (int qt = 0; qt < 2; ++qt) { f32x16 acc;
#pragma unroll
                for (int i = 0; i < 16; ++i) acc[i] = 0.f;
#pragma unroll
                for (int ks = 0; ks < 4; ++ks) acc = MFMA32(kf[ks], qf[qt][ks], acc);
                S[qt][st] = acc; }
        }
        if (ti < 2 || (ti >= 4 && ti < 6)) {
            const int kp0 = 128 * (qb - 1) + 64 * ti;
#pragma unroll
            for (int qt = 0; qt < 2; ++qt) { const int qpos = qb * 128 + qoff + 32 * qt + r;
#pragma unroll
                for (int st = 0; st < 2; ++st)
#pragma unroll
                    for (int i = 0; i < 16; ++i) { const int df = qpos - (kp0 + 32 * st + crow(i, hh)); if (df > 128 || df < -128) S[qt][st][i] = -INFINITY; } }
        }
#pragma unroll
        for (int qt = 0; qt < 2; ++qt) {
            float mx = S[qt][0][0];
#pragma unroll
            for (int st = 0; st < 2; ++st)
#pragma unroll
                for (int i = 0; i < 16; ++i) mx = fmaxf(mx, S[qt][st][i]);
            mx = fmaxf(mx, __shfl_xor(mx, 32));
            const float mn = fmaxf(m_run[qt], mx), scale = fexp(m_run[qt] - mn);
            m_run[qt] = mn; float ls = 0.f;
#pragma unroll
            for (int st = 0; st < 2; ++st)
#pragma unroll
                for (int i = 0; i < 16; ++i) { const float pv = fexp(S[qt][st][i] - mn); S[qt][st][i] = pv; ls += pv; }
            l_run[qt] = l_run[qt] * scale + ls;
#pragma unroll
            for (int dt = 0; dt < 2; ++dt)
#pragma unroll
                for (int i = 0; i < 16; ++i) O[qt][dt][i] *= scale;
        }
#pragma unroll
        for (int kk = 0; kk < 4; ++kk) { const int st = kk >> 1, s2 = kk & 1;
            bf16x8 pb[2];
#pragma unroll
            for (int qt = 0; qt < 2; ++qt) pb[qt] = pack8(S[qt][st][8 * s2 + 0], S[qt][st][8 * s2 + 1], S[qt][st][8 * s2 + 2], S[qt][st][8 * s2 + 3], S[qt][st][8 * s2 + 4], S[qt][st][8 * s2 + 5], S[qt][st][8 * s2 + 6], S[qt][st][8 * s2 + 7]);
#pragma unroll
            for (int dt = 0; dt < 2; ++dt) {
                const LAS unsigned char* vp = lds + AT_V + (32 * dt + r) * RS + (32 * st + 16 * s2 + 4 * hh) * 2;
                const s16x4 lo = *(const LAS s16x4*)vp, hi = *(const LAS s16x4*)(vp + 16);
                const bf16x8 va = __builtin_shufflevector(lo, hi, 0, 1, 2, 3, 4, 5, 6, 7);
#pragma unroll
                for (int qt = 0; qt < 2; ++qt) O[qt][dt] = MFMA32(va, pb[qt], O[qt][dt]);
            }
        }
        LDS_BARRIER();
        if (tn >= 10) break;
        ti = tn;
    }
#undef ATT_LOAD
#pragma unroll
    for (int qt = 0; qt < 2; ++qt) {
        const float l = l_run[qt] + __shfl_xor(l_run[qt], 32), inv = 1.0f / l;
        bf16_t* op = A.ATT + (size_t)(qrow0 + qoff + 32 * qt + r) * 512 + head * 64;
#pragma unroll
        for (int dt = 0; dt < 2; ++dt)
#pragma unroll
            for (int ig = 0; ig < 4; ++ig) { u32x2 wv; wv.x = pk2(O[qt][dt][4 * ig] * inv, O[qt][dt][4 * ig + 1] * inv); wv.y = pk2(O[qt][dt][4 * ig + 2] * inv, O[qt][dt][4 * ig + 3] * inv);
                *(u32x2*)(op + 32 * dt + 8 * ig + 4 * hh) = wv; }
    }
}

constexpr int SC_QS = 0, SC_KS = 9216, SC_QE = 18432, SC_UKT = 27648, SC_VT = 36864, SC_CBT = 55296, SC_F = 73728;
constexpr int SF_EB = 0, SF_QN = 256, SF_SSQ = 2304, SF_N = 3328, SF_DEC = 3840, SF_CONV = 4096, SF_GN = 5632, SF_CACHE = 6144;
struct ScanArgs { const bf16_t* P; bf16_t* OUT; const float* gates; const float* convw; const float* fbias; const float* gnorm; const float* lbl; int layer; };

template <bool IS_ML>
DI void scan_item(const ScanArgs& A, int b, int hd, const int dir, unsigned* prog_mine, unsigned* prog_other, LAS unsigned char* lds, int tid) {
    asm volatile("" : "+v"(tid));
    const int w = tid >> 6, lane = tid & 63, r = lane & 31, hh = lane >> 5;
    const int etile = w & 3, ttile = w >> 2, dtile = w >> 2;
    LAS float* F = (LAS float*)(lds + SC_F);
    LAS float* eb_s = F + SF_EB / 4; LAS float* qn_s = F + SF_QN / 4; LAS float* ssq_s = F + SF_SSQ / 4; LAS float* n_s = F + SF_N / 4; LAS float* dec_s = F + SF_DEC / 4; LAS float* conv_s = F + SF_CONV / 4;
    LAS float* gn_s = F + SF_GN / 4; LAS unsigned* cache_s = (LAS unsigned*)(F + SF_CACHE / 4);
    const int vcol = (IS_ML ? PC_MV : PC_HI) + hd * 128, gcol = (IS_ML ? PC_MO : PC_HG) + hd * 128;
    float lbv[8];
    __syncthreads();
    if (IS_ML) {
        if (tid < 384) { const int j = tid >> 6, d = tid & 63; conv_s[tid] = A.convw[(j % 3) * 512 + (j / 3) * 256 + hd * 64 + d]; }
    } else {
#pragma unroll
        for (int e = 0; e < 8; ++e) { const int c = hd * 64 + 8 * w + e; lbv[e] = (A.layer == 0) ? 0.f : 1.0f / (1.0f + expf(A.lbl[c] - A.lbl[256 + c])); }
    }
    if (tid < 128) { n_s[tid] = 0.f; gn_s[tid] = A.gnorm[hd * 128 + tid]; }
    if (tid == 0) cache_s[0] = 0u;
    f32x16 Cst;
#pragma unroll
    for (int i = 0; i < 16; ++i) Cst[i] = 0.f;
    float m_run = 0.f;
#pragma unroll
    for (int ig = 0; ig < 4; ++ig) *(LAS u32x2*)(lds + SC_CBT + (32 * etile + r) * RS + (32 * dtile + 8 * ig + 4 * hh) * 2) = (u32x2){0u, 0u};
    const float fb = IS_ML ? A.fbias[dir * 4 + hd] : 0.f;
    bool pending = false;
    u32x4 rq[3], rk[3], rv[2]; float rgi = 0.f, rgf = 0.f;
#define SC_ROWS(c_) const int cc_ = (c_) < 4 ? (dir ? 3 - (c_) : (c_)) : (dir ? 67 - (c_) : (c_) - 4); \
    const int slo_ = (c_) < 4 ? MLAT + b * CTXL : b * SEQ, slen_ = (c_) < 4 ? CTXL : SEQ; const int rb_ = slo_ + 64 * cc_;
#define SC_LOAD(c_) do { SC_ROWS(c_) const int ti_ = 64 * cc_ + (dir ? 63 - lane : lane); const int prow_ = slo_ + ti_; \
    if (IS_ML) { const u32x4 z4_ = (u32x4){0u, 0u, 0u, 0u}; \
        const bf16_t* pq_ = A.P + pidx(prow_, PC_MQ + hd * 64 + 8 * w); const bf16_t* pk_ = A.P + pidx(prow_, PC_MK + hd * 64 + 8 * w); rq[1] = *(const u32x4*)pq_; rk[1] = *(const u32x4*)pk_; \
        rq[0] = ti_ > 0 ? *(const u32x4*)(pq_ - 256) : z4_; rk[0] = ti_ > 0 ? *(const u32x4*)(pk_ - 256) : z4_; \
        rq[2] = ti_ + 1 < slen_ ? *(const u32x4*)(pq_ + 256) : z4_; rk[2] = ti_ + 1 < slen_ ? *(const u32x4*)(pk_ + 256) : z4_; \
        const float* gp_ = A.gates + (size_t)(slo_ + ti_) * 16; rgi = gp_[dir * 4 + hd]; rgf = gp_[8 + dir * 4 + hd]; \
    } else { rq[1] = *(const u32x4*)(A.P + pidx(prow_, PC_HQ + hd * 64 + 8 * w)); rk[1] = *(const u32x4*)(A.P + pidx(prow_, PC_HF + dir * 256 + hd * 64 + 8 * w)); } \
    { const bf16_t* pv_ = A.P + pidx(prow_, vcol + 16 * w); rv[0] = *(const u32x4*)pv_; rv[1] = *(const u32x4*)(pv_ + 8); } } while (0)
    SC_LOAD(0);
    __syncthreads();
#pragma unroll 1
    for (int c = 0; c < 68; ++c) {
        float ea = 1.f, wprev = 0.f, enm = 0.f, a_prev = 0.f;
        {
            const unsigned vv[8] = {rv[0].x, rv[0].y, rv[0].z, rv[0].w, rv[1].x, rv[1].y, rv[1].z, rv[1].w};
#pragma unroll
            for (int e = 0; e < 8; ++e) { *(LAS unsigned short*)(lds + SC_VT + (16 * w + 2 * e) * RS + lane * 2) = (unsigned short)(vv[e] & 0xffffu);
                *(LAS unsigned short*)(lds + SC_VT + (16 * w + 2 * e + 1) * RS + lane * 2) = (unsigned short)(vv[e] >> 16); }
        }
        if (IS_ML) {
            const float li = rgi, xf = rgf + fb;
            const float lf = fminf(xf, 0.f) - flog1p(fexp(-fabsf(xf)));
            float bc = lf;
#pragma unroll
            for (int off = 1; off < 64; off <<= 1) { const float v = __shfl_up(bc, off); if (lane >= off) bc += v; }
            const float beta = li - bc; float pm = beta;
#pragma unroll
            for (int off = 1; off < 64; off <<= 1) { const float v = __shfl_up(pm, off); if (lane >= off) pm = fmaxf(pm, v); }
            const float bl = __shfl(bc, 63), pmx = __shfl(pm, 63);
            const float mm = fmaxf(m_run, pm), mmx = fmaxf(m_run, pmx);
            ea = fexp(-mm); wprev = fexp(m_run - mm); enm = fexp(-(bc + mm));
            a_prev = fexp(m_run - mmx); const float u = fexp(beta - mmx);
            m_run = bl + mmx;
            if (w == 0) eb_s[lane] = fexp(fminf(beta, 80.f));
            float q8[8], k8[8];
            const unsigned q0[4] = {rq[0].x, rq[0].y, rq[0].z, rq[0].w}, q1[4] = {rq[1].x, rq[1].y, rq[1].z, rq[1].w}, q2[4] = {rq[2].x, rq[2].y, rq[2].z, rq[2].w};
            const unsigned k0[4] = {rk[0].x, rk[0].y, rk[0].z, rk[0].w}, k1[4] = {rk[1].x, rk[1].y, rk[1].z, rk[1].w}, k2[4] = {rk[2].x, rk[2].y, rk[2].z, rk[2].w};
            float cw[6][8];
#pragma unroll
            for (int j = 0; j < 6; ++j) { const f32x4 c0 = *(const LAS f32x4*)(conv_s + j * 64 + 8 * w), c1 = *(const LAS f32x4*)(conv_s + j * 64 + 8 * w + 4);
                cw[j][0] = c0[0]; cw[j][1] = c0[1]; cw[j][2] = c0[2]; cw[j][3] = c0[3]; cw[j][4] = c1[0]; cw[j][5] = c1[1]; cw[j][6] = c1[2]; cw[j][7] = c1[3]; }
#pragma unroll
            for (int e = 0; e < 4; ++e) {
                q8[2 * e] = fsilu(bflo(q0[e]) * cw[0][2 * e] + bflo(q1[e]) * cw[1][2 * e] + bflo(q2[e]) * cw[2][2 * e]);
                q8[2 * e + 1] = fsilu(bfhi(q0[e]) * cw[0][2 * e + 1] + bfhi(q1[e]) * cw[1][2 * e + 1] + bfhi(q2[e]) * cw[2][2 * e + 1]);
                k8[2 * e] = 0.125f * fsilu(bflo(k0[e]) * cw[3][2 * e] + bflo(k1[e]) * cw[4][2 * e] + bflo(k2[e]) * cw[5][2 * e]);
                k8[2 * e + 1] = 0.125f * fsilu(bfhi(k0[e]) * cw[3][2 * e + 1] + bfhi(k1[e]) * cw[4][2 * e + 1] + bfhi(k2[e]) * cw[5][2 * e + 1]); }
            *(LAS bf16x8*)(lds + SC_QS + lane * RS + 16 * w) = pack8(q8[0], q8[1], q8[2], q8[3], q8[4], q8[5], q8[6], q8[7]);
            *(LAS bf16x8*)(lds + SC_KS + lane * RS + 16 * w) = pack8(k8[0], k8[1], k8[2], k8[3], k8[4], k8[5], k8[6], k8[7]);
#pragma unroll
            for (int e = 0; e < 4; ++e) { const unsigned pkv = pk2(u * k8[2 * e], u * k8[2 * e + 1]);
                *(LAS unsigned short*)(lds + SC_UKT + (8 * w + 2 * e) * RS + lane * 2) = (unsigned short)(pkv & 0xffffu);
                *(LAS unsigned short*)(lds + SC_UKT + (8 * w + 2 * e + 1) * RS + lane * 2) = (unsigned short)(pkv >> 16); }
            const LAS float* nv = n_s + (c & 1) * 64 + 8 * w; const f32x4 n0 = *(const LAS f32x4*)nv, n1 = *(const LAS f32x4*)(nv + 4);
            qn_s[lane * 8 + w] = (q8[0] * n0[0] + q8[1] * n0[1] + q8[2] * n0[2] + q8[3] * n0[3]) + (q8[4] * n1[0] + q8[5] * n1[1] + q8[6] * n1[2] + q8[7] * n1[3]);
        } else {
            float x[8], kk[8], qs[8];
            const unsigned qr[4] = {rq[1].x, rq[1].y, rq[1].z, rq[1].w}, zr[4] = {rk[1].x, rk[1].y, rk[1].z, rk[1].w};
#pragma unroll
            for (int e = 0; e < 8; ++e) { const float z = (e & 1) ? bfhi(zr[e >> 1]) : bflo(zr[e >> 1]), qv = (e & 1) ? bfhi(qr[e >> 1]) : bflo(qr[e >> 1]);
                const float ez = fexp(-fabsf(z)), sg = (z >= 0.f ? 1.0f : ez) * __builtin_amdgcn_rcpf(1.0f + ez);
                const float lb = lbv[e], f = lb + (1.0f - lb) * sg;
                kk[e] = (1.0f - lb) * (1.0f - sg);
                x[e] = (lb > 0.f) ? flog(f) : (fminf(z, 0.f) - flog1p(ez));
                qs[e] = 0.125f * fsilu(qv); }
#pragma unroll
            for (int off = 1; off < 64; off <<= 1)
#pragma unroll
                for (int e = 0; e < 8; ++e) { const float v = __shfl_up(x[e], off); if (lane >= off) x[e] += v; }
            float qe[8], qt[8], kt[8], ku[8];
#pragma unroll
            for (int e = 0; e < 8; ++e) { const float bb = x[e];
                const float blv = __uint_as_float(__builtin_amdgcn_readlane(__float_as_uint(bb), 63)), ref = __uint_as_float(__builtin_amdgcn_readlane(__float_as_uint(bb), 31));
                qe[e] = qs[e] * fexp(bb); qt[e] = qs[e] * fexp(fminf(bb - ref, 60.f)); kt[e] = kk[e] * fexp(fminf(ref - bb, 60.f)); ku[e] = kk[e] * fexp(blv - bb);
                if (lane == 0) dec_s[8 * w + e] = fexp(blv); }
#pragma unroll
            for (int e = 0; e < 4; ++e) { const unsigned pkv = pk2(ku[2 * e], ku[2 * e + 1]);
                *(LAS unsigned short*)(lds + SC_UKT + (8 * w + 2 * e) * RS + lane * 2) = (unsigned short)(pkv & 0xffffu);
                *(LAS unsigned short*)(lds + SC_UKT + (8 * w + 2 * e + 1) * RS + lane * 2) = (unsigned short)(pkv >> 16); }
            *(LAS bf16x8*)(lds + SC_QE + lane * RS + 16 * w) = pack8(qe[0], qe[1], qe[2], qe[3], qe[4], qe[5], qe[6], qe[7]);
            *(LAS bf16x8*)(lds + SC_QS + lane * RS + 16 * w) = pack8(qt[0], qt[1], qt[2], qt[3], qt[4], qt[5], qt[6], qt[7]);
            *(LAS bf16x8*)(lds + SC_KS + lane * RS + 16 * w) = pack8(kt[0], kt[1], kt[2], kt[3], kt[4], kt[5], kt[6], kt[7]);
        }
        const bool first_role = (c < 2) || (c >= 4 && c < 36);
        if (pending && !first_role) {
            asm volatile("s_waitcnt vmcnt(0)" ::: "memory"); if (lane == 0) __hip_atomic_fetch_add(prog_mine, 1u, __ATOMIC_RELAXED, __HIP_MEMORY_SCOPE_AGENT); pending = false; }
        if (!first_role && tid == 0) {
            const int cp = (c < 4) ? 3 - c : 71 - c; const unsigned need = 8u * (unsigned)((cp < 2 ? cp : cp - 2) + 1);
            if (cache_s[0] < need) {
                unsigned v; unsigned spins = 0;
                for (;;) { v = __hip_atomic_load(prog_other, __ATOMIC_RELAXED, __HIP_MEMORY_SCOPE_AGENT); if (v >= need) break; __builtin_amdgcn_s_sleep(2); if (++spins > (1u << 24)) break; }
                __builtin_amdgcn_fence(__ATOMIC_ACQUIRE, "agent");
                asm volatile("s_waitcnt vmcnt(0)" ::: "memory");
                cache_s[0] = v;
            }
        }
        LDS_BARRIER();
        SC_ROWS(c)
        const int t = 32 * ttile + r;
        const int orow = rb_ + (dir ? 63 - t : t);
        bf16_t* op = A.OUT + (size_t)orow * 512 + hd * 128 + 32 * etile + 4 * hh;
        unsigned long long prevv[4]; u32x2 gwv[4];
        if (!first_role) {
            const bf16_t* gp = A.P + pidx(orow, gcol + 32 * etile + 4 * hh);
#pragma unroll
            for (int ig = 0; ig < 4; ++ig) { prevv[ig] = __hip_atomic_load((const unsigned long long*)(op + 8 * ig), __ATOMIC_RELAXED, __HIP_MEMORY_SCOPE_AGENT); gwv[ig] = *(const u32x2*)(gp + 8 * ig); }
        }
        if (c + 1 < 68) SC_LOAD(c + 1);
        bf16x8 qf[4];
#pragma unroll
        for (int ks = 0; ks < 4; ++ks) qf[ks] = *(const LAS bf16x8*)(lds + SC_QS + t * RS + (16 * ks + 8 * hh) * 2);
        f32x16 S[2];
#pragma unroll
        for (int st = 0; st < 2; ++st) { f32x16 acc;
#pragma unroll
            for (int i = 0; i < 16; ++i) acc[i] = 0.f;
#pragma unroll
            for (int ks = 0; ks < 4; ++ks) { const bf16x8 kf = *(const LAS bf16x8*)(lds + SC_KS + (32 * st + r) * RS + (16 * ks + 8 * hh) * 2); acc = MFMA32(kf, qf[ks], acc); }
            S[st] = acc; }
        float c1 = 1.0f, c2 = 1.0f;
        if (IS_ML) {
            const float ea_t = __shfl(ea, t), en_t = __shfl(enm, t), wprev_t = __shfl(wprev, t);
            float rs = 0.f;
#pragma unroll
            for (int st = 0; st < 2; ++st)
#pragma unroll
                for (int ig = 0; ig < 4; ++ig) { const f32x4 bt = *(const LAS f32x4*)(eb_s + 32 * st + 8 * ig + 4 * hh);
#pragma unroll
                    for (int k = 0; k < 4; ++k) { const int s = 32 * st + 8 * ig + 4 * hh + k; const float v = (s <= t) ? S[st][4 * ig + k] * bt[k] : 0.f; S[st][4 * ig + k] = v; rs += v; } }
            rs += __shfl_xor(rs, 32);
            const f32x4 qa = *(const LAS f32x4*)(qn_s + t * 8), qb4 = *(const LAS f32x4*)(qn_s + t * 8 + 4);
            const float qn = ((qa[0] + qa[1]) + (qa[2] + qa[3])) + ((qb4[0] + qb4[1]) + (qb4[2] + qb4[3]));
            const float den = wprev_t * qn + ea_t * rs;
            const float inv = 1.0f / fmaxf(fabsf(den), en_t);
            c1 = wprev_t * inv; c2 = ea_t * inv;
            {
                const bf16x8 uk = *(const LAS bf16x8*)(lds + SC_UKT + (8 * w + (lane >> 3)) * RS + 16 * (lane & 7));
                float sacc = ((bf1(uk[0]) + bf1(uk[1])) + (bf1(uk[2]) + bf1(uk[3]))) + ((bf1(uk[4]) + bf1(uk[5])) + (bf1(uk[6]) + bf1(uk[7])));
                sacc += __shfl_xor(sacc, 1); sacc += __shfl_xor(sacc, 2); sacc += __shfl_xor(sacc, 4);
                if ((lane & 7) == 0) n_s[((c + 1) & 1) * 64 + 8 * w + (lane >> 3)] = a_prev * n_s[(c & 1) * 64 + 8 * w + (lane >> 3)] + sacc;
            }
        } else {
#pragma unroll
            for (int st = 0; st < 2; ++st)
#pragma unroll
                for (int i = 0; i < 16; ++i) { const int s = 32 * st + crow(i, hh); if (s > t) S[st][i] = 0.f; }
        }
        f32x16 acc1;
#pragma unroll
        for (int i = 0; i < 16; ++i) acc1[i] = 0.f;
#pragma unroll
        for (int ks = 0; ks < 4; ++ks) { const bf16x8 ca = *(const LAS bf16x8*)(lds + SC_CBT + (32 * etile + r) * RS + (16 * ks + 8 * hh) * 2);
            const bf16x8 qb = IS_ML ? qf[ks] : *(const LAS bf16x8*)(lds + SC_QE + t * RS + (16 * ks + 8 * hh) * 2);
            acc1 = MFMA32(ca, qb, acc1); }
        f32x16 acc2;
        if (IS_ML) {
#pragma unroll
            for (int i = 0; i < 16; ++i) acc2[i] = 0.f;
        } else acc2 = acc1;
#pragma unroll
        for (int kk2 = 0; kk2 < 4; ++kk2) { const int st = kk2 >> 1, s2 = kk2 & 1;
            const LAS unsigned char* vp = lds + SC_VT + (32 * etile + r) * RS + (32 * st + 16 * s2 + 4 * hh) * 2;
            const s16x4 lo = *(const LAS s16x4*)vp, hi = *(const LAS s16x4*)(vp + 16);
            const bf16x8 va = __builtin_shufflevector(lo, hi, 0, 1, 2, 3, 4, 5, 6, 7);
            const bf16x8 pb = pack8(S[st][8 * s2 + 0], S[st][8 * s2 + 1], S[st][8 * s2 + 2], S[st][8 * s2 + 3], S[st][8 * s2 + 4], S[st][8 * s2 + 5], S[st][8 * s2 + 6], S[st][8 * s2 + 7]);
            acc2 = MFMA32(va, pb, acc2); }
        f32x16 hv;
        if (IS_ML) {
#pragma unroll
            for (int i = 0; i < 16; ++i) hv[i] = c1 * acc1[i] + c2 * acc2[i];
        } else hv = acc2;
        if (pending) {
            asm volatile("s_waitcnt vmcnt(0)" ::: "memory"); if (lane == 0) __hip_atomic_fetch_add(prog_mine, 1u, __ATOMIC_RELAXED, __HIP_MEMORY_SCOPE_AGENT); pending = false; }
        if (first_role) {
#pragma unroll
            for (int ig = 0; ig < 4; ++ig) { const unsigned lo_ = pk2(hv[4 * ig], hv[4 * ig + 1]), hi_ = pk2(hv[4 * ig + 2], hv[4 * ig + 3]);
                __hip_atomic_store((unsigned long long*)(op + 8 * ig), ((unsigned long long)hi_ << 32) | lo_, __ATOMIC_RELAXED, __HIP_MEMORY_SCOPE_AGENT); }
            pending = true;
        } else {
            float sq = 0.f;
#pragma unroll
            for (int ig = 0; ig < 4; ++ig) { const unsigned a0 = (unsigned)prevv[ig], a1 = (unsigned)(prevv[ig] >> 32);
                hv[4 * ig] += bflo(a0); hv[4 * ig + 1] += bfhi(a0); hv[4 * ig + 2] += bflo(a1); hv[4 * ig + 3] += bfhi(a1);
                sq += (hv[4 * ig] * hv[4 * ig] + hv[4 * ig + 1] * hv[4 * ig + 1]) + (hv[4 * ig + 2] * hv[4 * ig + 2] + hv[4 * ig + 3] * hv[4 * ig + 3]); }
            sq += __shfl_xor(sq, 32);
            if (hh == 0) ssq_s[etile * 64 + t] = sq;
            LDS_BARRIER();
            const float tot = (ssq_s[t] + ssq_s[64 + t]) + (ssq_s[128 + t] + ssq_s[192 + t]);
            const float rstd = 1.0f / sqrtf(tot * (1.0f / 128.0f) + EPS);
#pragma unroll
            for (int ig = 0; ig < 4; ++ig) { const f32x4 g4 = *(const LAS f32x4*)(gn_s + 32 * etile + 4 * hh + 8 * ig);
                const float g0 = bflo(gwv[ig].x), g1 = bfhi(gwv[ig].x), g2 = bflo(gwv[ig].y), g3 = bfhi(gwv[ig].y);
                const float o0 = hv[4 * ig] * rstd * g4[0] * (IS_ML ? fsigmoid(g0) : fsilu(g0)), o1 = hv[4 * ig + 1] * rstd * g4[1] * (IS_ML ? fsigmoid(g1) : fsilu(g1));
                const float o2 = hv[4 * ig + 2] * rstd * g4[2] * (IS_ML ? fsigmoid(g2) : fsilu(g2)), o3 = hv[4 * ig + 3] * rstd * g4[3] * (IS_ML ? fsigmoid(g3) : fsilu(g3));
                u32x2 wv; wv.x = pk2(o0, o1); wv.y = pk2(o2, o3); *(u32x2*)(op + 8 * ig) = wv; }
        }
        if (IS_ML) {
#pragma unroll
            for (int i = 0; i < 16; ++i) Cst[i] *= a_prev;
        } else {
#pragma unroll
            for (int ig = 0; ig < 4; ++ig) { const f32x4 dv = *(const LAS f32x4*)(dec_s + 32 * dtile + 8 * ig + 4 * hh);
#pragma unroll
                for (int k = 0; k < 4; ++k) Cst[4 * ig + k] *= dv[k]; }
        }
#pragma unroll
        for (int ks = 0; ks < 4; ++ks) { const bf16x8 ua = *(const LAS bf16x8*)(lds + SC_UKT + (32 * dtile + r) * RS + (16 * ks + 8 * hh) * 2);
            const bf16x8 vb = *(const LAS bf16x8*)(lds + SC_VT + (32 * etile + r) * RS + (16 * ks + 8 * hh) * 2);
            Cst = MFMA32(ua, vb, Cst); }
        LDS_BARRIER();
#pragma unroll
        for (int ig = 0; ig < 4; ++ig) { u32x2 wv; wv.x = pk2(Cst[4 * ig], Cst[4 * ig + 1]); wv.y = pk2(Cst[4 * ig + 2], Cst[4 * ig + 3]);
            *(LAS u32x2*)(lds + SC_CBT + (32 * etile + r) * RS + (32 * dtile + 8 * ig + 4 * hh) * 2) = wv; }
    }
    if (pending) { asm volatile("s_waitcnt vmcnt(0)" ::: "memory"); if (lane == 0) __hip_atomic_fetch_add(prog_mine, 1u, __ATOMIC_RELAXED, __HIP_MEMORY_SCOPE_AGENT); }
#undef SC_LOAD
#undef SC_ROWS
    __syncthreads();
}
#ifndef PH
#define PH 0xffff
#endif

#define XB_TMO      128
#define XB_XCNT(j)  (256  + 64 * (j))
#define XB_XSUB(j)  (1280 + 64 * (j))
#define XB_XGEN(j)  (2304 + 64 * (j))
#define XB_TOP      3328
#define XB_TOPGEN   3392
#define XCD_BAR_WORDS 3456
#define XB_SPIN_CAP (1u << 18)

__device__ __forceinline__ unsigned xb_ld(unsigned* p)              { return __hip_atomic_load(p, __ATOMIC_RELAXED, __HIP_MEMORY_SCOPE_AGENT); }
__device__ __forceinline__ unsigned xb_add(unsigned* p, unsigned v) { return __hip_atomic_fetch_add(p, v, __ATOMIC_RELAXED, __HIP_MEMORY_SCOPE_AGENT); }
__device__ __forceinline__ unsigned xb_xcc_id() { return (unsigned)__builtin_amdgcn_s_getreg((3 << 11) | 20) & 0xFu; }
#define XB_SPIN(cond, bar) do { unsigned _sp = 0; while (cond) { __builtin_amdgcn_s_sleep(1); \
    if ((++_sp & 255u) == 0u) { if (xb_ld(&(bar)[XB_TMO])) break; if (_sp > XB_SPIN_CAP) { atomicAdd(&(bar)[XB_TMO], 1u); break; } } } } while (0)

struct XcdBarrier {
    unsigned* bar; unsigned x;
    volatile LAS unsigned* st;
};

__device__ __forceinline__ XcdBarrier xcd_barrier_post(unsigned* bar, volatile LAS unsigned* st) {
    XcdBarrier b; b.bar = bar; b.x = xb_xcc_id(); b.st = st;
    if (threadIdx.x == 0) (void)xb_add(&bar[XB_XCNT(b.x)], 1u);
    return b;
}
__device__ __forceinline__ void xcd_barrier_complete(unsigned* bar, unsigned x, unsigned& nloc, unsigned& nx) {
    const unsigned G = gridDim.x * gridDim.y * gridDim.z;
    unsigned sum, cnt, mine, sp = 0u;
    for (;;) {
        sum = 0u; cnt = 0u; mine = 0u;
#pragma unroll
        for (unsigned j = 0; j < 16; ++j) { const unsigned c = xb_ld(&bar[XB_XCNT(j)]); sum += c; cnt += (c > 0u) ? 1u : 0u; mine = (j == x) ? c : mine; }
        if (sum == G) break;
        __builtin_amdgcn_s_sleep(1);
        if ((++sp & 255u) == 0u) { if (xb_ld(&bar[XB_TMO])) break; if (sp > XB_SPIN_CAP) { atomicAdd(&bar[XB_TMO], 1u); break; } }
    }
    nloc = mine > 0u ? mine : 1u; nx = cnt > 0u ? cnt : 1u;
}

__device__ __forceinline__ void xcd_barrier(const XcdBarrier& b) {
    asm volatile("s_waitcnt vmcnt(0)" ::: "memory");
    __syncthreads();
    if (threadIdx.x == 0) {
        unsigned* bar = b.bar;
        __builtin_amdgcn_s_waitcnt(0);
        unsigned nloc = b.st[0], nx = b.st[1];
        if (nloc == 0u) { xcd_barrier_complete(bar, b.x, nloc, nx); b.st[0] = nloc; b.st[1] = nx; }
        const unsigned old = xb_add(&bar[XB_XSUB(b.x)], 1u);
        const unsigned gen = old / nloc;
        if (old + 1u == (gen + 1u) * nloc) {
            __builtin_amdgcn_fence(__ATOMIC_RELEASE, "agent");
            asm volatile("s_waitcnt vmcnt(0)" ::: "memory");
            const unsigned og = xb_add(&bar[XB_TOP], 1u);
            const unsigned tg = og / nx;
            if (og + 1u == (tg + 1u) * nx) xb_add(&bar[XB_TOPGEN], 1u);
            else XB_SPIN(xb_ld(&bar[XB_TOPGEN]) == tg, bar);
            __builtin_amdgcn_fence(__ATOMIC_ACQUIRE, "agent");
            xb_add(&bar[XB_XGEN(b.x)], 1u);
            asm volatile("s_waitcnt vmcnt(0)" ::: "memory");
        } else {
            XB_SPIN(xb_ld(&bar[XB_XGEN(b.x)]) == gen, bar);
            __builtin_amdgcn_fence(__ATOMIC_ACQUIRE, "agent");
            asm volatile("s_waitcnt vmcnt(0)" ::: "memory");
        }
    }
    __syncthreads();
}


DI void mix_phase(KP p, int l, LAS unsigned char* lds, int tid) {
    asm volatile("" : "+v"(tid));
    const int G = gridDim.x, bid = blockIdx.x;
    const bf16_t* P = (const bf16_t*)(p->ws + WS_P);
    bf16_t* ATT = (bf16_t*)(p->ws + WS_S); bf16_t* MLB = ATT + (size_t)MTOT * 512; bf16_t* HGB = MLB + (size_t)MTOT * 512;
    const int nattn = 512 + (l == 0 ? 32 : 0);
    if (bid < 128) {
        const int it = bid, dir = it & 1, hd = (it >> 1) & 3, b = (it >> 3) & 7, ty = it >> 6;
        unsigned* prog = (unsigned*)p->ws + (l * 128 + (it & ~1)) * 16;
        if (ty == 0) { ScanArgs A{P, MLB, (const float*)(p->ws + WS_GATES), p->in[I_MLCONV] + (size_t)l * 3 * 512, p->in[I_MLFB] + l * 8, p->in[I_MLNORM] + l * 512, p->in[I_HGLB], l};
#ifndef NO_SCANML
            scan_item<true>(A, b, hd, dir, prog + dir * 16, prog + (dir ^ 1) * 16, lds, tid);
#endif
        } else { ScanArgs A{P, HGB, (const float*)(p->ws + WS_GATES), p->in[I_MLCONV], p->in[I_MLFB], p->in[I_HGNORM] + l * 512, p->in[I_HGLB], l};
#ifndef NO_SCANHG
            scan_item<false>(A, b, hd, dir, prog + dir * 16, prog + (dir ^ 1) * 16, lds, tid);
#endif
        }
    }
    if (bid >= 128) {
        __syncthreads();
        const f32x2* rope = (const f32x2*)(p->ws + WS_ROPE);
        for (int i = tid; i < 1024; i += 512) ((LAS f32x2*)(lds + AT_TAB))[i] = rope[i];
        __syncthreads();
        AttnArgs A{P, ATT, p->in[I_SINK] + l * 8, rope};
        for (int it = bid - 128; it < nattn; it += G - 128) {
#ifndef NO_ATTN
 attn_item(A, it, lds, tid);
#endif
 }
        __syncthreads();
        convert_weights(p, l, lds, 0x7cau, bid - 128, G - 128);
        if (l == 0) convert_weights(p, 1, lds, 0x35u, bid - 128, G - 128);
    }
}

template <class Epi> DI void run_gemm(LAS unsigned char* lds, const bf16_t* A, const bf16_t* Bt, int M, int N, int K, const Epi& E) {
    pg8::Gemm g{A, Bt, M, N, K}; pg8::StaticOrder S; S.init(M, N, (int)gridDim.x, (int)blockIdx.x);
    pg8::gemm_phase<Epi, pg8::StaticOrder, true, true>(lds, g, S, E);
}

template <class Epi> DI void run_gemm_ctx(LAS unsigned char* lds, const bf16_t* A, const bf16_t* Bt, int N, int K, const Epi& E) {
    pg8::Gemm g{A, Bt, MTOT, N, K}; pg8::CtxOrder S{224, MLAT / 256};
    pg8::gemm_phase<Epi, pg8::CtxOrder, true, true>(lds, g, S, E);
}

#define GRID_BAR() do { XcdBarrier xb_; xb_.bar = (unsigned*)(ws) + 8192; xb_.x = xb_xcc_id(); xb_.st = (volatile LAS unsigned*)(lds + 131072); xcd_barrier(xb_); } while (0)
__global__ void __launch_bounds__(512) fwd_kernel(Params p_unused) {
    extern __shared__ __attribute__((aligned(16))) unsigned char lds_raw[];
    LAS unsigned char* lds = (LAS unsigned char*)lds_raw;
    cg::grid_group grid = cg::this_grid();
#define tid ((int)threadIdx.x)
#define ws (kparams()->ws)
#define W ((bf16_t*)(ws + WS_W))
#define H ((bf16_t*)(ws + WS_H))
#define PB ((bf16_t*)(ws + WS_P))
#define SB ((bf16_t*)(ws + WS_S))
#define XC ((float*)(ws + WS_XC))
#define mod ((const float*)(ws + WS_MOD))
#define gates ((float*)(ws + WS_GATES))
    KP p = kparams();
    if (threadIdx.x < 16) ((LAS unsigned*)(lds + 131072))[threadIdx.x] = 0u;
    __syncthreads();
    (void)xcd_barrier_post((unsigned*)(ws) + 8192, (volatile LAS unsigned*)(lds + 131072));

#if PH & 1
    convert_weights(p, 0, lds, 0x35u, (int)blockIdx.x, (int)gridDim.x);
    __syncthreads();
    mods_phase(p, lds, tid);
#endif
    if (ws == nullptr) grid.sync();
    GRID_BAR();
    {
        RowArgs a{p->in[I_X], p->in[I_CTX], nullptr, nullptr, nullptr, H, mod, mod, nullptr, p->in[I_NPRE], nullptr, nullptr, 0, 0, 0, MTOT, (int)blockIdx.x, (int)gridDim.x, 0.f};
#if PH & 2
        row_phase<false, true, false>(a, lds, tid);
#endif
    }
    GRID_BAR();

#pragma unroll 1
    for (int l = 0; l < 2; ++l) {
#pragma unroll 1
      for (int f = 0; f < 2; ++f) {
        p = kparams();
        const float* modl = mod + (size_t)l * 9 * 9216;
        const float* npre = p->in[I_NPRE] + (size_t)l * 3 * DM; const float* npost = p->in[I_NPOST] + (size_t)l * 3 * DM;
        const bool ctx2 = (l == 0);
        const int bid = (int)blockIdx.x, G = (int)gridDim.x;
        if (f == 1) {
            { pg8::EpiBf16<0> E{PB, 256, PTS}; run_gemm(lds, H, W + WO_WIN, MTOT, NPC, DM, E); }
            GRID_BAR();
            mix_phase(p, l, lds, tid);
            GRID_BAR();
            { pg8::EpiBf16<1> E{PB, NGC, 0}; run_gemm(lds, H, W + WO_WG, ctx2 ? MTOT : MLAT, NGC, DM, E); }
            GRID_BAR();
#pragma unroll 1
            for (int gi = 0; gi < 3; ++gi) { pg8::EpiMerge E{H, PB, gi}; run_gemm(lds, SB + (size_t)gi * MTOT * 512, W + WO_WB + (size_t)gi * 1024 * 512, ctx2 ? MTOT : MLAT, DM, 512, E); }
            GRID_BAR();
            { pg8::EpiBf16<0> E{SB, DM, 0}; run_gemm(lds, H, W + WO_WOUT, MLAT, DM, DM, E); }
            GRID_BAR();
            {
                const int vg = ctx2 ? 224 : G;
                RowArgs a{p->out, XC, p->out, XC, SB, H, modl, modl, npost + DM, npre + 2 * DM, nullptr, nullptr, 1, 2, 0, MLAT, bid < vg ? bid : -1, vg, 1.0f};
                if (bid < vg) row_phase<true, true, false>(a, lds, tid);
                else { pg8::EpiBf16<0> E{SB, DM, 0}; run_gemm_ctx(lds, H, W + WO_WOUT, DM, DM, E); }
            }
            GRID_BAR();
            if (ctx2) {
                RowArgs a{p->out, XC, p->out, XC, SB, H, modl, modl, npost + DM, npre + 2 * DM, nullptr, nullptr, 1, 2, MLAT, MTOT, bid, G, 1.0f};
                row_phase<true, true, false>(a, lds, tid);
                GRID_BAR();
            }
        }
        const bool hc = (f == 0) || ctx2;
        { pg8::EpiSwiGLU E{PB, DFF}; run_gemm(lds, H, W + WO_W13 + (size_t)f * 5632 * 1024, hc ? MTOT : MLAT, 5632, DM, E); }
        GRID_BAR();
        { pg8::EpiBf16<0> E{SB, DM, 0}; run_gemm(lds, PB, W + WO_W2 + (size_t)f * 1024 * 2816, MLAT, DM, DFF, E); }
        GRID_BAR();
        {
            const int vg = hc ? 224 : G;
            const bool has_pre = (f == 0) || (l == 0);
            RowArgs a{(l == 0 && f == 0) ? p->in[I_X] : p->out, (l == 0 && f == 0) ? p->in[I_CTX] : XC, p->out, XC, SB, H, modl, f == 0 ? modl : mod + (size_t)9 * 9216,
                      npost + (f == 0 ? 0 : 2 * DM), f == 0 ? npre + DM : p->in[I_NPRE] + 3 * DM, p->in[I_WIN] + (size_t)l * DM * DIN + 2304, gates, f == 0 ? 0 : 2, f == 0 ? 1 : 0, 0, MLAT, bid < vg ? bid : -1, vg, 0.5f};
            if (bid < vg) {
                if (f == 0) row_phase<true, true, true>(a, lds, tid);
                else if (has_pre) row_phase<true, true, false>(a, lds, tid);
                else row_phase<true, false, false>(a, lds, tid);
            } else { pg8::EpiBf16<0> E{SB, DM, 0}; run_gemm_ctx(lds, PB, W + WO_W2 + (size_t)f * 1024 * 2816, DM, DFF, E); }
            if (hc) {
                GRID_BAR();
                RowArgs c = a; c.row0 = MLAT; c.row1 = MTOT; c.vb = bid; c.vg = G;
                if (f == 0) row_phase<true, true, true>(c, lds, tid);
                else row_phase<true, true, false>(c, lds, tid);
            }
        }
        if (!(l == 1 && f == 1)) GRID_BAR();
      }
    }
#undef tid
#undef ws
#undef W
#undef H
#undef PB
#undef SB
#undef XC
#undef mod
#undef gates
}

extern "C" void kernel_launch(void* const* d_in, const int* in_sizes, int n_in, void* d_out, int out_size, void* d_ws, size_t ws_size, hipStream_t stream) {
    static int grid = 0;
    if (grid == 0) {
        if (n_in != 22 || out_size != MLAT * DM || ws_size < WS_END) { fprintf(stderr, "kernel_launch: unexpected shapes (n_in %d out %d ws %zu)\n", n_in, out_size, ws_size); grid = -1; return; }
        int dev = 0, cus = 0, per_cu = 0;
        (void)hipGetDevice(&dev);
        (void)hipDeviceGetAttribute(&cus, hipDeviceAttributeMultiprocessorCount, dev);
        (void)hipFuncSetAttribute((const void*)fwd_kernel, hipFuncAttributeMaxDynamicSharedMemorySize, LDS_BYTES);
        (void)hipOccupancyMaxActiveBlocksPerMultiprocessor(&per_cu, (const void*)fwd_kernel, 512, LDS_BYTES);
        if (per_cu < 1) per_cu = 1;
        if (per_cu > 1) per_cu = 1;
        grid = cus * per_cu;
        if (grid <= 0) grid = 256;
    }
    if (grid < 0) return;
    if (grid < 192) { fprintf(stderr, "kernel_launch: grid %d too small for the paired scans\n", grid); return; }
    (void)hipMemsetAsync(d_ws, 0, 65536, stream);
    Params p{};
    for (int i = 0; i < 22; ++i) p.in[i] = (const float*)d_in[i];
    p.out = (float*)d_out; p.ws = (unsigned char*)d_ws;
    void* args[] = {&p};
    hipError_t e = hipLaunchCooperativeKernel((const void*)fwd_kernel, dim3(grid), dim3(512), args, LDS_BYTES, stream);
    if (e != hipSuccess) fprintf(stderr, "cooperative launch failed: %s (grid %d)\n", hipGetErrorString(e), grid);
}
```

```cpp
#include <hip/hip_runtime.h>
#include <hip/hip_cooperative_groups.h>
#include <cstdio>
#include <cstdint>
namespace cg = cooperative_groups;

#define DI __device__ __forceinline__
#define LAS __attribute__((address_space(3)))
typedef unsigned short bf16_t;
typedef short bf16x8 __attribute__((ext_vector_type(8)));
typedef short s16x4 __attribute__((ext_vector_type(4)));
typedef float f32x2 __attribute__((ext_vector_type(2)));
typedef float f32x4 __attribute__((ext_vector_type(4)));
typedef float f32x16 __attribute__((ext_vector_type(16)));
typedef unsigned u32x2 __attribute__((ext_vector_type(2)));
typedef unsigned u32x4 __attribute__((ext_vector_type(4)));

constexpr int DM = 1024, NB = 8, SEQ = 4096, CTXL = 256, DFF = 2816, DIN = 7184, NMOD = 9;
constexpr int MLAT = NB * SEQ, MCTX = NB * CTXL, MTOT = MLAT + MCTX;
constexpr int NPC = 4096;
constexpr int NGC = 3072;
constexpr float EPS = 1e-6f;
constexpr int PC_AQ = 0, PC_AK = 512, PC_AV = 640, PC_MQ = 768, PC_MK = 1024, PC_MV = 1280, PC_MO = 1792, PC_HQ = 2304, PC_HF = 2560, PC_HI = 3072, PC_HG = 3584;

constexpr size_t MiB = 1u << 20;
constexpr size_t WS_MOD = 1 * MiB;
constexpr size_t WS_ROPE = 2 * MiB;
constexpr size_t WS_LB = 2 * MiB + 65536;
constexpr size_t WS_GATES = 3 * MiB;
constexpr size_t WS_XC = 6 * MiB;
constexpr size_t WS_W = 14 * MiB;
constexpr size_t WS_H = 66 * MiB;
constexpr size_t WS_P = 134 * MiB;
constexpr size_t WS_S = 406 * MiB;
constexpr size_t WS_END = 508 * MiB;
constexpr size_t WO_W13 = 0;
constexpr size_t WO_W2 = WO_W13 + (size_t)2 * 5632 * 1024;
constexpr size_t WO_WIN = WO_W2 + (size_t)2 * 1024 * 2816;
constexpr size_t WO_WG = WO_WIN + (size_t)4096 * 1024;
constexpr size_t WO_WB = WO_WG + (size_t)3072 * 1024;
constexpr size_t WO_WOUT = WO_WB + (size_t)3 * 1024 * 512;
constexpr size_t WO_END = WO_WOUT + (size_t)1024 * 1024;
static_assert(WO_END * 2 <= 52 * MiB, "weights fit");
static_assert((size_t)MTOT * 1024 * 2 <= 68 * MiB && (size_t)MTOT * 4096 * 2 <= 272 * MiB && (size_t)MTOT * 512 * 2 * 3 <= 102 * MiB, "ws map");

constexpr int LDS_BYTES = 131072 + 64;
constexpr size_t PTS = (size_t)MTOT * 256;
__device__ __forceinline__ size_t pidx(int row, int col) { return (size_t)(col >> 8) * PTS + (size_t)row * 256 + (col & 255); }

DI unsigned f2bf(float f) { unsigned u = __float_as_uint(f); return (u + 0x7fffu + ((u >> 16) & 1u)) >> 16; }
typedef __bf16 bf16v2 __attribute__((ext_vector_type(2)));
DI unsigned pk2(float lo, float hi) { f32x2 v = {lo, hi}; bf16v2 b = __builtin_convertvector(v, bf16v2); return __builtin_bit_cast(unsigned, b); }
DI float bflo(unsigned w) { return __uint_as_float(w << 16); }
DI float bfhi(unsigned w) { return __uint_as_float(w & 0xffff0000u); }
DI float bf1(short s) { return __uint_as_float(((unsigned)(unsigned short)s) << 16); }
DI float fexp(float x) { return __builtin_amdgcn_exp2f(x * 1.4426950408889634f); }
DI float flog(float x) { return __builtin_amdgcn_logf(x) * 0.6931471805599453f; }
DI float flog1p(float e) { const float u = 1.0f + e, d = u - 1.0f; return d == 0.f ? e : flog(u) * e * __builtin_amdgcn_rcpf(d); }
DI float fsigmoid(float x) { return __builtin_amdgcn_rcpf(1.0f + fexp(-x)); }
DI float fsilu(float x) { return x * fsigmoid(x); }
DI bf16x8 pack8(float a0, float a1, float a2, float a3, float a4, float a5, float a6, float a7) {
    u32x4 p; p.x = pk2(a0, a1); p.y = pk2(a2, a3); p.z = pk2(a4, a5); p.w = pk2(a6, a7); return __builtin_bit_cast(bf16x8, p);
}
#define MFMA32(a, b, c) __builtin_amdgcn_mfma_f32_32x32x16_bf16((a), (b), (c), 0, 0, 0)
DI int crow(int i, int h) { return (i & 3) + 8 * (i >> 2) + 4 * h; }

#define LDS_BARRIER() do { asm volatile("s_waitcnt lgkmcnt(0)" ::: "memory"); __builtin_amdgcn_s_barrier(); asm volatile("" ::: "memory"); } while (0)
template <int CTRL, int ROWMASK> DI float dpp_f(float oldv, float v) { return __uint_as_float((unsigned)__builtin_amdgcn_update_dpp((int)__float_as_uint(oldv), (int)__float_as_uint(v), CTRL, ROWMASK, 0xf, false)); }
DI float wave_scan_add(float v) {
    v += dpp_f<0x111, 0xf>(0.f, v); v += dpp_f<0x112, 0xf>(0.f, v); v += dpp_f<0x114, 0xf>(0.f, v); v += dpp_f<0x118, 0xf>(0.f, v);
    v += dpp_f<0x142, 0xa>(0.f, v); v += dpp_f<0x143, 0xc>(0.f, v); return v;
}
DI float wave_scan_max(float v) {
    const float ninf = -__builtin_inff();
    v = fmaxf(v, dpp_f<0x111, 0xf>(ninf, v)); v = fmaxf(v, dpp_f<0x112, 0xf>(ninf, v)); v = fmaxf(v, dpp_f<0x114, 0xf>(ninf, v)); v = fmaxf(v, dpp_f<0x118, 0xf>(ninf, v));
    v = fmaxf(v, dpp_f<0x142, 0xa>(ninf, v)); v = fmaxf(v, dpp_f<0x143, 0xc>(ninf, v)); return v;
}
DI float lane_bcast(float v, int l) { return __uint_as_float((unsigned)__builtin_amdgcn_readlane((int)__float_as_uint(v), l)); }
DI float wave_sum(float v) { return lane_bcast(wave_scan_add(v), 63); }
namespace pg8 {
#define PG8_LAS __attribute__((address_space(3)))
typedef unsigned short bf16_t;
typedef short bf16x8 __attribute__((ext_vector_type(8)));
typedef float f32x4 __attribute__((ext_vector_type(4)));
typedef unsigned u32x4 __attribute__((ext_vector_type(4)));
constexpr int BM = 256, BK = 64, HALF = 128, HTB = HALF * BK * 2  , STAGE_BYTES = 8 * HTB, NXCD = 8, WGM = 8;

__host__ __device__ __forceinline__ int lds_byte(int r, int c) { const int st = (r >> 4) * 2 + (c >> 5), rr = r & 15, cc = c & 31, ob = rr * 64 + cc * 2; return st * 1024 + (ob ^ (((ob >> 9) & 1) << 5)); }
__host__ __device__ __forceinline__ void stage_rc(int b, int& R, int& C) { const int st = b / 1024, sb = b % 1024, swz = sb ^ (((sb >> 9) & 1) << 5); R = (st >> 1) * 16 + swz / 64; C = (st & 1) * 32 + (swz % 64) / 2; }
__host__ __device__ __forceinline__ int perm32(int rho) { const int n = rho >> 4, i = rho & 15; return 8 * (i >> 2) + 4 * n + (i & 3); }

struct Unit { int pm, pn; int seg = 0; };
struct Gemm { const bf16_t* A; const bf16_t* Bt; int M, N, K; size_t segA = 0, segB = 0; };

struct StaticOrder {
    int nM, nN, nwg, G, c;
    __host__ __device__ void init(int M, int N, int G_, int c_) { nM = M / BM; nN = N / BM; nwg = nM * nN; G = G_; c = c_; }
    __host__ __device__ bool next(int i, Unit& u) const {
        const long L = (long)i * G + c; if (L >= nwg) return false;
        int wgid = (int)L; { const int q = nwg / NXCD, r = nwg % NXCD, xcd = wgid % NXCD, off = wgid / NXCD; wgid = (xcd < r ? xcd * (q + 1) : r * (q + 1) + (xcd - r) * q) + off; }
        const int nig = WGM * nN, gid = wgid / nig, fm = gid * WGM, gsz = (nM - fm) < WGM ? (nM - fm) : WGM;
        u.pm = fm + ((wgid % nig) % gsz); u.pn = (wgid % nig) / gsz; return true;
    }
    __device__ __forceinline__ void a_ready(const Unit&) const {}
    __device__ __forceinline__ void done(const Unit&) const {}
};

struct CtxOrder {
    int first, pm0;
    __host__ __device__ bool next(int i, Unit& u) const { const int idx = (int)blockIdx.x - first; if (i != 0 || idx < 0 || idx >= 32) return false; u.pm = pm0 + (idx >> 2); u.pn = idx & 3; return true; }
    __device__ __forceinline__ void a_ready(const Unit&) const {}
    __device__ __forceinline__ void done(const Unit&) const {}
};

struct MergeOrder {
    StaticOrder S;
    __host__ __device__ bool next(int i, Unit& u) const { const int j = i / 3; if (!S.next(j, u)) return false; u.seg = i - 3 * j; return true; }
    __device__ __forceinline__ void a_ready(const Unit&) const {}
    __device__ __forceinline__ void done(const Unit&) const {}
};

template <int ACT  > struct EpiBf16 {
    static constexpr bool PERM = true, AFTER_DRAIN = false;
    bf16_t* O; int ldc; size_t tstride; int segcols = 0;
    __device__ __forceinline__ void operator()(const f32x4 (&acc)[2][2][4][2], const Unit& u, int wr, int wc, int fr, int fq) const {
        const int row0 = u.pm * BM + wr * 64 + fr, col0 = (tstride ? 0 : u.pn * BM) + wc * 32 + 8 * fq + u.seg * segcols;
        bf16_t* Ob = O + (size_t)u.pn * tstride;
#pragma unroll
        for (int ai = 0; ai < 2; ++ai)
#pragma unroll
            for (int m = 0; m < 4; ++m) { bf16_t* rowp = Ob + (size_t)(row0 + ai * HALF + m * 16) * ldc + col0;
#pragma unroll
                for (int bj = 0; bj < 2; ++bj) { f32x4 v0 = acc[ai][bj][m][0], v1 = acc[ai][bj][m][1];
                    if (ACT == 1) {
#pragma unroll
                        for (int k = 0; k < 4; ++k) { v0[k] = fsigmoid(v0[k]); v1[k] = fsigmoid(v1[k]); } }
                    u32x4 w; w.x = pk2(v0[0], v0[1]); w.y = pk2(v0[2], v0[3]); w.z = pk2(v1[0], v1[1]); w.w = pk2(v1[2], v1[3]);
                    *(u32x4*)(rowp + bj * HALF) = w; } }
    }
};
struct EpiSwiGLU {
    static constexpr bool PERM = false, AFTER_DRAIN = false;
    bf16_t* O; int ldc;
    __device__ __forceinline__ void operator()(const f32x4 (&acc)[2][2][4][2], const Unit& u, int wr, int wc, int fr, int fq) const {
        const int row0 = u.pm * BM + wr * 64 + fr, f0 = u.pn * 128 + wc * 16 + 4 * fq;
#pragma unroll
        for (int ai = 0; ai < 2; ++ai)
#pragma unroll
            for (int m = 0; m < 4; ++m) { bf16_t* rowp = O + (size_t)(row0 + ai * HALF + m * 16) * ldc + f0;
#pragma unroll
                for (int bj = 0; bj < 2; ++bj) { const f32x4 a = acc[ai][bj][m][0], b = acc[ai][bj][m][1];
                    u32x2 w; w.x = pk2(fsilu(a[0]) * b[0], fsilu(a[1]) * b[1]); w.y = pk2(fsilu(a[2]) * b[2], fsilu(a[3]) * b[3]);
                    *(u32x2*)(rowp + bj * 64) = w; } }
    }
};
struct EpiMerge {
    static constexpr bool PERM = true, AFTER_DRAIN = false;
    bf16_t* O; const bf16_t* G; bf16_t* T1;
    __device__ __forceinline__ void operator()(const f32x4 (&acc)[2][2][4][2], const Unit& u, int wr, int wc, int fr, int fq) const {
        const int row0 = u.pm * BM + wr * 64 + fr, col0 = u.pn * BM + wc * 32 + 8 * fq, gi = u.seg;
        const bf16_t* src = (gi == 2) ? T1 : O; bf16_t* dst = (gi == 1) ? T1 : O;
#pragma unroll
        for (int ai = 0; ai < 2; ++ai) {
            u32x4 g[4][2]; u32x4 pv[4][2];
#pragma unroll
            for (int m = 0; m < 4; ++m)
#pragma unroll
                for (int bj = 0; bj < 2; ++bj) { const size_t r = (size_t)(row0 + ai * HALF + m * 16); const int c = col0 + bj * HALF;
                    g[m][bj] = *(const u32x4*)(G + r * 3072 + gi * 1024 + c);
                    if (gi > 0) pv[m][bj] = *(const u32x4*)(src + r * 1024 + c); }
            asm volatile("" ::: "memory");
#pragma unroll
            for (int m = 0; m < 4; ++m)
#pragma unroll
                for (int bj = 0; bj < 2; ++bj) { const size_t r = (size_t)(row0 + ai * HALF + m * 16); const int c = col0 + bj * HALF;
                    const u32x4 gv = g[m][bj];
                    const f32x4 v0 = acc[ai][bj][m][0], v1 = acc[ai][bj][m][1];
                    float o0 = bflo(gv.x) * v0[0], o1 = bfhi(gv.x) * v0[1], o2 = bflo(gv.y) * v0[2], o3 = bfhi(gv.y) * v0[3];
                    float o4 = bflo(gv.z) * v1[0], o5 = bfhi(gv.z) * v1[1], o6 = bflo(gv.w) * v1[2], o7 = bfhi(gv.w) * v1[3];
                    if (gi > 0) { const u32x4 a = pv[m][bj];
                        o0 += bflo(a.x); o1 += bfhi(a.x); o2 += bflo(a.y); o3 += bfhi(a.y); o4 += bflo(a.z); o5 += bfhi(a.z); o6 += bflo(a.w); o7 += bfhi(a.w); }
                    u32x4 w; w.x = pk2(o0, o1); w.y = pk2(o2, o3); w.z = pk2(o4, o5); w.w = pk2(o6, o7);
                    *(u32x4*)(dst + r * 1024 + c) = w; }
        }
    }
};

struct EpiGin {
    static constexpr bool PERM = true, AFTER_DRAIN = false;
    bf16_t* O; size_t tstride; const float* lb;
    __device__ __forceinline__ void operator()(const f32x4 (&acc)[2][2][4][2], const Unit& u, int wr, int wc, int fr, int fq) const {
        const int row0 = u.pm * BM + wr * 64 + fr, col0 = wc * 32 + 8 * fq;
        bf16_t* Ob = O + (size_t)u.pn * tstride;
        const int mode = (u.pn == 9) ? 1 : ((u.pn == 10 || u.pn == 11) ? 2 : 0);
#pragma unroll
        for (int bj = 0; bj < 2; ++bj) {
            f32x4 l0 = (f32x4){0.f, 0.f, 0.f, 0.f}, l1 = l0;
            if (mode == 2) { l0 = *(const f32x4*)(lb + col0 + bj * HALF); l1 = *(const f32x4*)(lb + col0 + bj * HALF + 4); }
#pragma unroll
            for (int ai = 0; ai < 2; ++ai)
#pragma unroll
                for (int m = 0; m < 4; ++m) { bf16_t* rowp = Ob + (size_t)(row0 + ai * HALF + m * 16) * 256 + col0 + bj * HALF;
                    f32x4 v0 = acc[ai][bj][m][0], v1 = acc[ai][bj][m][1];
                    if (mode == 1) {
#pragma unroll
                        for (int k = 0; k < 4; ++k) { v0[k] = 0.125f * fsilu(v0[k]); v1[k] = 0.125f * fsilu(v1[k]); }
                    } else if (mode == 2) {
#pragma unroll
                        for (int k = 0; k < 4; ++k) {
                            { const float z = v0[k], ez = fexp(-fabsf(z)), sg = (z >= 0.f ? 1.0f : ez) * __builtin_amdgcn_rcpf(1.0f + ez), lbk = l0[k];
                              v0[k] = (lbk > 0.f) ? flog(lbk + (1.0f - lbk) * sg) : (fminf(z, 0.f) - flog(1.0f + ez)); }
                            { const float z = v1[k], ez = fexp(-fabsf(z)), sg = (z >= 0.f ? 1.0f : ez) * __builtin_amdgcn_rcpf(1.0f + ez), lbk = l1[k];
                              v1[k] = (lbk > 0.f) ? flog(lbk + (1.0f - lbk) * sg) : (fminf(z, 0.f) - flog(1.0f + ez)); } }
                    }
                    u32x4 w; w.x = pk2(v0[0], v0[1]); w.y = pk2(v0[2], v0[3]); w.z = pk2(v1[0], v1[1]); w.w = pk2(v1[2], v1[3]);
                    *(u32x4*)rowp = w; }
        }
    }
};

struct EpiBf16Cnt {
    static constexpr bool PERM = true, AFTER_DRAIN = false;
    bf16_t* O; int ldc; unsigned* cnt; int pm0;
    __device__ __forceinline__ void operator()(const f32x4 (&acc)[2][2][4][2], const Unit& u, int wr, int wc, int fr, int fq) const {
        const int row0 = u.pm * BM + wr * 64 + fr, col0 = u.pn * BM + wc * 32 + 8 * fq;
#pragma unroll
        for (int ai = 0; ai < 2; ++ai)
#pragma unroll
            for (int m = 0; m < 4; ++m) { bf16_t* rowp = O + (size_t)(row0 + ai * HALF + m * 16) * ldc + col0;
#pragma unroll
                for (int bj = 0; bj < 2; ++bj) { const f32x4 v0 = acc[ai][bj][m][0], v1 = acc[ai][bj][m][1];
                    const unsigned long long lo = ((unsigned long long)pk2(v0[2], v0[3]) << 32) | pk2(v0[0], v0[1]), hi = ((unsigned long long)pk2(v1[2], v1[3]) << 32) | pk2(v1[0], v1[1]);
                    unsigned long long* q = (unsigned long long*)(rowp + bj * HALF);
                    __hip_atomic_store(q, lo, __ATOMIC_RELAXED, __HIP_MEMORY_SCOPE_AGENT); __hip_atomic_store(q + 1, hi, __ATOMIC_RELAXED, __HIP_MEMORY_SCOPE_AGENT); } }
        asm volatile("s_waitcnt vmcnt(0)" ::: "memory");
        if (fr == 0 && fq == 0) __hip_atomic_fetch_add(cnt + 16 * (u.pm - pm0), 1u, __ATOMIC_RELAXED, __HIP_MEMORY_SCOPE_AGENT);
    }
};
template <class Epi, class Sched, bool ALIGN_EPI = false, bool SP2 = false>
__device__ __forceinline__ void gemm_phase(PG8_LAS unsigned char* lds, const Gemm g, const Sched& S, const Epi& E) {
    int tid_ = threadIdx.x; asm volatile("" : "+v"(tid_));
    const int tid = tid_, wid = __builtin_amdgcn_readfirstlane(tid >> 6), lane = tid & 63, wr = wid >> 2, wc = wid & 3, fr = lane & 15, fq = lane >> 4;
    const int K = g.K, nt = K / BK;
    unsigned voffA[2], voffB[2];
#pragma unroll
    for (int i = 0; i < 2; ++i) { int R, C; stage_rc(tid * 16 + i * 8192, R, C); const int Rb = Epi::PERM ? ((R & ~31) + perm32(R & 31)) : R;
        voffA[i] = (unsigned)(R * K + C) * 2u; voffB[i] = (unsigned)(Rb * K + C) * 2u; }
    const size_t kstep = (size_t)(BK * 2);
    const size_t hstep = (size_t)HALF * K * 2;
    const size_t tstep = 2 * hstep;
    const unsigned ldsw = (unsigned)wid * 1024u;
    const int aoff = lds_byte(wr * 64 + fr, fq * 8), boff = lds_byte(wc * 32 + fr, fq * 8);
#define PG8_SA(b, h) (((b) * 2 + (h)) * HTB)
#define PG8_SB(b, h) ((4 + (b) * 2 + (h)) * HTB)
#define PG8_STAGE(bufoff, gbase, voff) do { _Pragma("unroll") for (int _i = 0; _i < 2; ++_i) \
        __builtin_amdgcn_global_load_lds((const unsigned*)((const char*)(gbase) + (voff)[_i]), (PG8_LAS unsigned*)(lds + (bufoff) + ldsw + _i * 8192), 16, 0, 0); } while (0)
#define PG8_LDA(dst, b, h) do { _Pragma("unroll") for (int m = 0; m < 4; ++m) _Pragma("unroll") for (int k = 0; k < 2; ++k) dst[m][k] = *(const PG8_LAS bf16x8*)(lds + PG8_SA(b, h) + aoff + m * 2048 + k * 1024); } while (0)
#define PG8_LDB(dst, b, h) do { _Pragma("unroll") for (int n = 0; n < 2; ++n) _Pragma("unroll") for (int k = 0; k < 2; ++k) dst[n][k] = *(const PG8_LAS bf16x8*)(lds + PG8_SB(b, h) + boff + n * 2048 + k * 1024); } while (0)
#define PG8_MMA(ai, bj, At, Bt) do { __builtin_amdgcn_s_setprio(1); _Pragma("unroll") for (int m = 0; m < 4; ++m) _Pragma("unroll") for (int n = 0; n < 2; ++n) _Pragma("unroll") for (int k = 0; k < 2; ++k) \
        acc[ai][bj][m][n] = __builtin_amdgcn_mfma_f32_16x16x32_bf16(Bt[n][k], At[m][k], acc[ai][bj][m][n], 0, 0, 0); __builtin_amdgcn_s_setprio(0); } while (0)
#define PG8_WAIT_V(n) asm volatile("s_waitcnt vmcnt(" #n ")" ::: "memory")
#define PG8_WAIT_L(n) asm volatile("s_waitcnt lgkmcnt(" #n ")" ::: "memory")
#define PG8_BAR __builtin_amdgcn_s_barrier()
#define PG8_SCHED __builtin_amdgcn_sched_barrier(0)
    Unit cur, nxt; int ui = 0;
    if (!S.next(0, cur)) return;
    f32x4 acc[2][2][4][2];
#pragma unroll
    for (int a = 0; a < 2; ++a)
#pragma unroll
        for (int b = 0; b < 2; ++b)
#pragma unroll
            for (int m = 0; m < 4; ++m)
#pragma unroll
                for (int n = 0; n < 2; ++n) acc[a][b][m][n] = (f32x4){0.f, 0.f, 0.f, 0.f};
    bf16x8 At[4][2], B0[2][2], B1[2][2];
    const char* cA = (const char*)g.A + (size_t)cur.pm * tstep + (size_t)cur.seg * g.segA; const char* cB = (const char*)g.Bt + (size_t)cur.pn * tstep + (size_t)cur.seg * g.segB;
    S.a_ready(cur);
    if constexpr (SP2) {
        PG8_STAGE(PG8_SB(0, 0), cB, voffB); PG8_STAGE(PG8_SB(0, 1), cB + hstep, voffB); PG8_STAGE(PG8_SA(0, 0), cA, voffA); PG8_STAGE(PG8_SA(0, 1), cA + hstep, voffA);
        if (wr == 1) PG8_BAR;
        PG8_WAIT_V(2); PG8_BAR;
        PG8_STAGE(PG8_SB(1, 0), cB + kstep, voffB); PG8_STAGE(PG8_SA(1, 0), cA + kstep, voffA); PG8_STAGE(PG8_SB(1, 1), cB + hstep + kstep, voffB);
        PG8_WAIT_V(6); PG8_BAR;
    } else {
        PG8_STAGE(PG8_SB(0, 0), cB, voffB); PG8_STAGE(PG8_SA(0, 0), cA, voffA); PG8_STAGE(PG8_SB(0, 1), cB + hstep, voffB); PG8_STAGE(PG8_SA(0, 1), cA + hstep, voffA);
        if (wr == 1) PG8_BAR;
        PG8_WAIT_V(4); PG8_BAR;
        PG8_STAGE(PG8_SB(1, 0), cB + kstep, voffB); PG8_STAGE(PG8_SA(1, 0), cA + kstep, voffA); PG8_STAGE(PG8_SB(1, 1), cB + hstep + kstep, voffB);
        PG8_WAIT_V(6); PG8_BAR;
    }
    for (;;) {
        const bool has_next = S.next(ui + 1, nxt);
        const char* nA = has_next ? (const char*)g.A + (size_t)nxt.pm * tstep + (size_t)nxt.seg * g.segA : cA; const char* nB = has_next ? (const char*)g.Bt + (size_t)nxt.pn * tstep + (size_t)nxt.seg * g.segB : cB;
        for (int t = 0; t < nt; t += 2) {
            const bool last = (t == nt - 2);
            const char* a1 = cA + (size_t)(t + 1) * kstep;
            const char* a2 = last ? nA : cA + (size_t)(t + 2) * kstep; const char* b2 = last ? nB : cB + (size_t)(t + 2) * kstep;
            const char* a3 = a2 + kstep; const char* b3 = b2 + kstep;
            if (last && has_next) S.a_ready(nxt);
            if constexpr (SP2) {
            PG8_LDB(B0, 0, 0); PG8_LDB(B1, 0, 1); PG8_SCHED; PG8_LDA(At, 0, 0); PG8_STAGE(PG8_SA(1, 1), a1 + hstep, voffA);
            PG8_WAIT_V(8); PG8_WAIT_L(0); PG8_BAR; PG8_MMA(0, 0, At, B0); PG8_MMA(0, 1, At, B1); PG8_BAR; PG8_SCHED;
            PG8_LDA(At, 0, 1); PG8_STAGE(PG8_SB(0, 0), b2, voffB); PG8_STAGE(PG8_SB(0, 1), b2 + hstep, voffB); PG8_STAGE(PG8_SA(0, 0), a2, voffA);
            PG8_WAIT_V(8); PG8_WAIT_L(0); PG8_BAR; PG8_MMA(1, 0, At, B0); PG8_MMA(1, 1, At, B1); PG8_BAR; PG8_SCHED;
            PG8_LDB(B0, 1, 0); PG8_LDB(B1, 1, 1); PG8_SCHED; PG8_LDA(At, 1, 0); PG8_STAGE(PG8_SA(0, 1), a2 + hstep, voffA);
            PG8_WAIT_V(8); PG8_WAIT_L(0); PG8_BAR; PG8_MMA(0, 0, At, B0); PG8_MMA(0, 1, At, B1); PG8_BAR; PG8_SCHED;
            PG8_LDA(At, 1, 1); PG8_STAGE(PG8_SB(1, 0), b3, voffB); PG8_STAGE(PG8_SB(1, 1), b3 + hstep, voffB); PG8_STAGE(PG8_SA(1, 0), a3, voffA);
            PG8_WAIT_V(8); PG8_WAIT_L(0); PG8_BAR; PG8_MMA(1, 0, At, B0); PG8_MMA(1, 1, At, B1); PG8_BAR; PG8_SCHED;
            } else {
            PG8_LDB(B0, 0, 0); PG8_SCHED; PG8_LDA(At, 0, 0); PG8_STAGE(PG8_SA(1, 1), a1 + hstep, voffA);
            PG8_WAIT_L(8); PG8_BAR; PG8_WAIT_L(0); PG8_MMA(0, 0, At, B0); PG8_BAR; PG8_SCHED;
            PG8_LDB(B1, 0, 1); PG8_STAGE(PG8_SB(0, 0), b2, voffB);
            PG8_BAR; PG8_WAIT_L(0); PG8_MMA(0, 1, At, B1); PG8_BAR;
            PG8_LDA(At, 0, 1); PG8_STAGE(PG8_SA(0, 0), a2, voffA);
            PG8_BAR; PG8_WAIT_L(0); PG8_MMA(1, 0, At, B0); PG8_BAR; PG8_SCHED;
            PG8_STAGE(PG8_SB(0, 1), b2 + hstep, voffB);
            PG8_WAIT_V(6); PG8_BAR; PG8_MMA(1, 1, At, B1); PG8_BAR;
            PG8_LDB(B0, 1, 0); PG8_SCHED; PG8_LDA(At, 1, 0); PG8_STAGE(PG8_SA(0, 1), a2 + hstep, voffA);
            PG8_WAIT_L(8); PG8_BAR; PG8_WAIT_L(0); PG8_MMA(0, 0, At, B0); PG8_BAR; PG8_SCHED;
            PG8_LDB(B1, 1, 1); PG8_STAGE(PG8_SB(1, 0), b3, voffB);
            PG8_BAR; PG8_WAIT_L(0); PG8_MMA(0, 1, At, B1); PG8_BAR;
            PG8_LDA(At, 1, 1); PG8_STAGE(PG8_SA(1, 0), a3, voffA);
            PG8_BAR; PG8_WAIT_L(0); PG8_MMA(1, 0, At, B0); PG8_BAR; PG8_SCHED;
            PG8_STAGE(PG8_SB(1, 1), b3 + hstep, voffB);
            PG8_WAIT_V(6); PG8_BAR; PG8_MMA(1, 1, At, B1); PG8_BAR;
            }
        }
        if constexpr (ALIGN_EPI) { if (wr == 0) PG8_BAR; }
        if constexpr (!Epi::AFTER_DRAIN) { E(acc, cur, wr, wc, fr, fq); S.done(cur); }
        if (!has_next) break;
#pragma unroll
        for (int a = 0; a < 2; ++a)
#pragma unroll
            for (int b = 0; b < 2; ++b)
#pragma unroll
                for (int m = 0; m < 4; ++m)
#pragma unroll
                    for (int n = 0; n < 2; ++n) acc[a][b][m][n] = (f32x4){0.f, 0.f, 0.f, 0.f};
        cur = nxt; cA = nA; cB = nB; ++ui;
        if constexpr (ALIGN_EPI) { if (wr == 1) PG8_BAR; }
    }
    PG8_WAIT_V(0);
    if constexpr (!ALIGN_EPI) { if (wr == 0) PG8_BAR; }
    PG8_BAR;
    if constexpr (Epi::AFTER_DRAIN) { E.fused(acc, cur, wr, wc, fr, fq, lds, wid, lane); S.done(cur); }
#undef PG8_SA
#undef PG8_SB
#undef PG8_STAGE
#undef PG8_LDA
#undef PG8_LDB
#undef PG8_MMA
#undef PG8_WAIT_V
#undef PG8_WAIT_L
#undef PG8_BAR
#undef PG8_SCHED
}
}

struct Params { const float* in[22]; float* out; unsigned char* ws; };
typedef const __attribute__((address_space(4))) Params* KP;
DI KP kparams() { KP kp = (KP)__builtin_amdgcn_kernarg_segment_ptr(); asm volatile("" : "+s"(kp)); return kp; }
enum { I_X = 0, I_C, I_CTX, I_CCTX, I_WADA, I_BADA, I_NPRE, I_NPOST, I_W1, I_W3, I_W2, I_WIN, I_SINK, I_MLCONV, I_MLFB, I_MLNORM, I_HGLB, I_HGNORM, I_WBA, I_WBM, I_WBH, I_WOUT };

DI void transpose_item(const float* Wa, const float* Wb, int ldw, int K, bf16_t* dst, int k0, LAS float* scr, int lane) {
    const float* src = (((lane & 31) < 16) ? Wa : Wb) + (lane & 15);
#pragma unroll 8
    for (int i = 0; i < 32; ++i) { const int kk = 2 * i + (lane >> 5); scr[kk * 33 + (lane & 31)] = src[(size_t)(k0 + kk) * ldw]; }
    asm volatile("s_waitcnt lgkmcnt(0)" ::: "memory");
    const int c = lane & 7;
#pragma unroll
    for (int j = 0; j < 4; ++j) { const int n = (lane >> 3) + 8 * j; const LAS float* s = scr + (8 * c) * 33 + n;
        u32x4 o; o.x = pk2(s[0 * 33], s[1 * 33]); o.y = pk2(s[2 * 33], s[3 * 33]); o.z = pk2(s[4 * 33], s[5 * 33]); o.w = pk2(s[6 * 33], s[7 * 33]);
        *(u32x4*)(dst + (size_t)n * K + k0 + 8 * c) = o; }
    asm volatile("s_waitcnt lgkmcnt(0)" ::: "memory");
}
struct Seg { const float* Wa; const float* Wb; int ldw, K, ngroups, colA0, colB0, cstep; bf16_t* dst; };
DI bool seg_run(const Seg& s, int& it, LAS float* scr, int lane) {
    const int nk = s.K / 64, n = s.ngroups * nk;
    if (it >= n) { it -= n; return false; }
    const int gi = it / nk, kb = it % nk;
    transpose_item(s.Wa + s.colA0 + gi * s.cstep, s.Wb + s.colB0 + gi * s.cstep, s.ldw, s.K, s.dst + (size_t)gi * 32 * s.K, kb * 64, scr, lane);
    return true;
}
DI void convert_weights(KP p, int l, LAS unsigned char* lds, const unsigned mask, const int vb, const int vg) {
    int tid_ = threadIdx.x; asm volatile("" : "+v"(tid_));
    const int wave = tid_ >> 6, lane = tid_ & 63;
    if (vb < 0) return;
    LAS float* scr = (LAS float*)(lds + wave * 8704);
    bf16_t* W = (bf16_t*)(p->ws + WS_W);
    const int gw = vb * 8 + wave, NGW = vg * 8;
    constexpr int NITEMS = 2 * 176 * 16 + 2 * 32 * 44 + 128 * 16 + 96 * 16 + 3 * 32 * 8 + 32 * 16;
    for (int item = gw; item < NITEMS; item += NGW) {
        int it = item;
        if (it < 2 * 2816) { const int f = it / 2816; if (!((mask >> f) & 1u)) continue; it -= f * 2816;
            const float* w1 = p->in[I_W1] + (size_t)(l * 2 + f) * DM * DFF; const float* w3 = p->in[I_W3] + (size_t)(l * 2 + f) * DM * DFF;
            Seg s{w1, w3, DFF, DM, 176, 0, 0, 16, W + WO_W13 + (size_t)f * 5632 * 1024}; seg_run(s, it, scr, lane); continue; }
        it -= 2 * 2816;
        if (it < 2 * 1408) { const int f = it / 1408; if (!((mask >> (2 + f)) & 1u)) continue; it -= f * 1408;
            const float* w2 = p->in[I_W2] + (size_t)(l * 2 + f) * DFF * DM;
            Seg s{w2, w2, DM, DFF, 32, 0, 16, 32, W + WO_W2 + (size_t)f * 1024 * 2816}; seg_run(s, it, scr, lane); continue; }
        it -= 2 * 1408;
        const float* win = p->in[I_WIN] + (size_t)l * DM * DIN;
        if (it < 72 * 16) { if (!((mask >> 4) & 1u)) continue; Seg s{win, win, DIN, DM, 72, 0, 16, 32, W + WO_WIN}; seg_run(s, it, scr, lane); continue; }
        it -= 72 * 16;
        if (it < 56 * 16) { if (!((mask >> 5) & 1u)) continue; Seg s{win, win, DIN, DM, 56, 2320, 2336, 32, W + WO_WIN + (size_t)2304 * 1024}; seg_run(s, it, scr, lane); continue; }
        it -= 56 * 16;
        if (it < 96 * 16) { if (!((mask >> 6) & 1u)) continue; Seg s{win, win, DIN, DM, 96, 4112, 4128, 32, W + WO_WG}; seg_run(s, it, scr, lane); continue; }
        it -= 96 * 16;
        if (it < 3 * 256) { const int f = it / 256; if (!((mask >> (7 + f)) & 1u)) continue; it -= f * 256;
            const float* wb = p->in[I_WBA + f] + (size_t)l * 512 * DM;
            Seg s{wb, wb, DM, 512, 32, 0, 16, 32, W + WO_WB + (size_t)f * 1024 * 512}; seg_run(s, it, scr, lane); continue; }
        it -= 3 * 256;
        if (!((mask >> 10) & 1u)) continue;
        { const float* wo = p->in[I_WOUT] + (size_t)l * DM * DM; Seg s{wo, wo, DM, DM, 32, 0, 16, 32, W + WO_WOUT}; seg_run(s, it, scr, lane); }
    }
}

DI void mods_phase(KP p, LAS unsigned char* lds, int tid) {
    asm volatile("" : "+v"(tid));
    const int wave = tid >> 6, lane = tid & 63;
    LAS float* sc = (LAS float*)lds;
    LAS float* red = (LAS float*)(lds + 36864);
    for (int i = tid; i < 9 * 1024; i += 512) { const float v = (i < 8192) ? p->in[I_C][i] : p->in[I_CCTX][i - 8192]; sc[i] = v / (1.0f + expf(-v)); }
    __syncthreads();
    float* mod = (float*)(p->ws + WS_MOD);
    for (int it = blockIdx.x; it < 288; it += gridDim.x) {
        const int l = it / 144, cb = it % 144, col = cb * 64 + lane;
        const float* wp = p->in[I_WADA] + ((size_t)l * 1024 + wave * 128) * 9216 + col;
        float acc[9];
#pragma unroll
        for (int i = 0; i < 9; ++i) acc[i] = 0.f;
#pragma unroll 32
        for (int k = 0; k < 128; ++k) { const float wv = wp[(size_t)k * 9216];
#pragma unroll
            for (int i = 0; i < 9; ++i) acc[i] += sc[i * 1024 + wave * 128 + k] * wv; }
#pragma unroll
        for (int i = 0; i < 9; ++i) red[(wave * 9 + i) * 64 + lane] = acc[i];
        __syncthreads();
        for (int o = tid; o < 576; o += 512) { const int i = o >> 6, ln = o & 63; float s = 0.f;
#pragma unroll
            for (int w = 0; w < 8; ++w) s += red[(w * 9 + i) * 64 + ln];
            mod[((size_t)l * 9 + i) * 9216 + cb * 64 + ln] = s + p->in[I_BADA][(size_t)l * 9216 + cb * 64 + ln]; }
        __syncthreads();
    }
    if (blockIdx.x == gridDim.x - 1) {
        f32x2* tab = (f32x2*)(p->ws + WS_ROPE);
        float* lbt = (float*)(p->ws + WS_LB);
        if (tid < 256) { const float a0 = p->in[I_HGLB][tid], a1 = p->in[I_HGLB][256 + tid]; lbt[tid] = 0.f; lbt[256 + tid] = 1.0f / (1.0f + expf(a0 - a1)); }
        for (int e = tid; e < 1024; e += 512) { const int pos = e >> 4, i = e & 15;
            const float inv = exp2f(-(float)i * (13.287712379549449f / 16.0f));
            const float a = (float)pos * inv; float rev = a * 0.15915494309189535f; rev -= floorf(rev);
            f32x2 cs; cs.x = __builtin_amdgcn_cosf(rev); cs.y = __builtin_amdgcn_sinf(rev); tab[e] = cs; }
    }
}

struct RowArgs {
    const float* xs_lat; const float* xs_ctx; float* xd_lat; float* xd_ctx;
    const bf16_t* Y; bf16_t* H; const float* mod; const float* modpre; const float* gpost; const float* gpre; const float* wgates; float* gates;
    int jpost, jpre, row0, row1, vb, vg; float wpost;
};
template <bool POST, bool PRE, bool GATES, bool YSC = false>
DI void row_phase(const RowArgs& a, LAS unsigned char* lds, int tid) {
    asm volatile("" : "+v"(tid));
    const int wave = tid >> 6, lane = tid & 63;
    LAS f32x4* wl = (LAS f32x4*)lds;
    if (GATES) {
        for (int idx = tid; idx < 1024 * 4; idx += 512) { const int k = idx >> 2, c4 = idx & 3; const int ln = (k & 255) >> 2, j = k >> 8, e = k & 3;
            wl[((j * 4 + e) * 4 + c4) * 64 + ln] = *(const f32x4*)(a.wgates + (size_t)k * DIN + 4 * c4); }
        __syncthreads();
    }
    int row = a.row0 + a.vb * 8 + wave;
    const bool any = a.vb >= 0 && row < a.row1;
    f32x4 xn[4]; u32x2 yn[4];
#define ROW_LOAD(r_) do { const float* src_ = (r_) < MLAT ? a.xs_lat + (size_t)(r_) * DM : a.xs_ctx + (size_t)((r_) - MLAT) * DM; \
        _Pragma("unroll") for (int j = 0; j < 4; ++j) { xn[j] = *(const f32x4*)(src_ + 4 * lane + 256 * j); if (POST) { if (YSC) { const unsigned long long yv_ = __hip_atomic_load((const unsigned long long*)(a.Y + (size_t)(r_) * DM + 4 * lane + 256 * j), __ATOMIC_RELAXED, __HIP_MEMORY_SCOPE_AGENT); yn[j] = (u32x2){(unsigned)yv_, (unsigned)(yv_ >> 32)}; } \
            else yn[j] = *(const u32x2*)(a.Y + (size_t)(r_) * DM + 4 * lane + 256 * j); } } } while (0)
    if (any) ROW_LOAD(row);
    for (; any && row < a.row1; row += a.vg * 8) {
        const int mi = row < MLAT ? (row >> 12) : 8;
        const float* md = a.mod + (size_t)mi * 9216;
        const float* mdp = a.modpre + (size_t)mi * 9216;
        f32x4 x[4]; u32x2 yw[4];
#pragma unroll
        for (int j = 0; j < 4; ++j) { x[j] = xn[j]; if (POST) yw[j] = yn[j]; }
        f32x4 gt[4], gp[4], sh[4], scl[4], gg[4];
#pragma unroll
        for (int j = 0; j < 4; ++j) { const int c = 4 * lane + 256 * j;
            if (POST) { gt[j] = *(const f32x4*)(md + (3 * a.jpost + 2) * DM + c); gp[j] = *(const f32x4*)(a.gpost + c); }
            if (PRE) { sh[j] = *(const f32x4*)(mdp + (3 * a.jpre) * DM + c); scl[j] = *(const f32x4*)(mdp + (3 * a.jpre + 1) * DM + c); gg[j] = *(const f32x4*)(a.gpre + c); } }
        const int rnext = row + a.vg * 8;
        if (rnext < a.row1) ROW_LOAD(rnext);
        if (POST) {
            f32x4 y[4]; float s = 0.f;
#pragma unroll
            for (int j = 0; j < 4; ++j) { const u32x2 w = yw[j];
                y[j] = (f32x4){bflo(w.x), bfhi(w.x), bflo(w.y), bfhi(w.y)}; s += (y[j][0] * y[j][0] + y[j][1] * y[j][1]) + (y[j][2] * y[j][2] + y[j][3] * y[j][3]); }
            const float rstd = 1.0f / sqrtf(wave_sum(s) * (1.0f / DM) + EPS);
            float* dst = row < MLAT ? a.xd_lat + (size_t)row * DM : a.xd_ctx + (size_t)(row - MLAT) * DM;
#pragma unroll
            for (int j = 0; j < 4; ++j) { const int c = 4 * lane + 256 * j;
                x[j] = x[j] + a.wpost * gt[j] * (y[j] * rstd * gp[j]);
                *(f32x4*)(dst + c) = x[j]; }
        }
        if (PRE) {
            float s = 0.f;
#pragma unroll
            for (int j = 0; j < 4; ++j) s += (x[j][0] * x[j][0] + x[j][1] * x[j][1]) + (x[j][2] * x[j][2] + x[j][3] * x[j][3]);
            const float rstd = 1.0f / sqrtf(wave_sum(s) * (1.0f / DM) + EPS);
            f32x4 hv[4]; f32x4 g4[4];
#pragma unroll
            for (int c4 = 0; c4 < 4; ++c4) g4[c4] = (f32x4){0.f, 0.f, 0.f, 0.f};
#pragma unroll
            for (int j = 0; j < 4; ++j) { const int c = 4 * lane + 256 * j;
                hv[j] = (x[j] * rstd * gg[j]) * (1.0f + scl[j]) + sh[j];
                u32x2 w; w.x = pk2(hv[j][0], hv[j][1]); w.y = pk2(hv[j][2], hv[j][3]);
                *(u32x2*)(a.H + (size_t)row * DM + c) = w;
                if (GATES) {
#pragma unroll
                    for (int e = 0; e < 4; ++e)
#pragma unroll
                        for (int c4 = 0; c4 < 4; ++c4) g4[c4] += hv[j][e] * wl[((j * 4 + e) * 4 + c4) * 64 + lane];
                    asm volatile("" ::: "memory");
                } }
            if (GATES) {
#pragma unroll
                for (int c4 = 0; c4 < 4; ++c4)
#pragma unroll
                    for (int k = 0; k < 4; ++k) g4[c4][k] = wave_sum(g4[c4][k]);
                if (lane == 0) {
#pragma unroll
                    for (int c4 = 0; c4 < 4; ++c4) *(f32x4*)(a.gates + (size_t)row * 16 + 4 * c4) = g4[c4]; }
            }
        }
    }
#undef ROW_LOAD
    if (GATES) __syncthreads();
}

constexpr int RS = 144;
constexpr int AT_K = 0, AT_V = 9216, AT_TAB = 18432;
struct AttnArgs { const bf16_t* P; bf16_t* ATT; const float* sink; const f32x2* rope; };

DI void attn_item(const AttnArgs& A, int item, LAS unsigned char* lds, int tid) {
    asm volatile("" : "+v"(tid));
    const int w = tid >> 6, lane = tid & 63, r = lane & 31, hh = lane >> 5;
    const LAS f32x2* tab = (const LAS f32x2*)(lds + AT_TAB);
    int b, g, qb = 0, qrow0; bool lat;
    if (item < 512) { b = item >> 6; g = (item >> 5) & 1; qb = item & 31; lat = true; qrow0 = b * SEQ + qb * 128; }
    else { const int it = item - 512; b = it >> 2; g = (it >> 1) & 1; lat = false; qrow0 = MLAT + b * CTXL + (it & 1) * 128; }
    const int head = g * 4 + (w >> 1), qoff = (w & 1) * 64;
    bf16x8 qf[2][4];
#pragma unroll
    for (int qt = 0; qt < 2; ++qt) {
        const int ql = qoff + 32 * qt + r;
        const bf16_t* qp = A.P + pidx(qrow0 + ql, PC_AQ + head * 64 + 8 * hh);
        float x[4][8];
#pragma unroll
        for (int ks = 0; ks < 4; ++ks) { const u32x4 raw = *(const u32x4*)(qp + 16 * ks);
            x[ks][0] = bflo(raw.x); x[ks][1] = bfhi(raw.x); x[ks][2] = bflo(raw.y); x[ks][3] = bfhi(raw.y); x[ks][4] = bflo(raw.z); x[ks][5] = bfhi(raw.z); x[ks][6] = bflo(raw.w); x[ks][7] = bfhi(raw.w); }
        if (lat) {
            const int t = qb * 128 + ql;
#pragma unroll
            for (int pr = 0; pr < 2; ++pr) { const int pos = pr ? (t & 63) : (t >> 6);
#pragma unroll
                for (int j = 0; j < 8; ++j) { const f32x2 cs = tab[pos * 16 + 8 * hh + j]; const float x1 = x[2 * pr][j], x2 = x[2 * pr + 1][j];
                    x[2 * pr][j] = x1 * cs.x - x2 * cs.y; x[2 * pr + 1][j] = x2 * cs.x + x1 * cs.y; } }
        }
#pragma unroll
        for (int ks = 0; ks < 4; ++ks) qf[qt][ks] = pack8(x[ks][0] * 0.125f, x[ks][1] * 0.125f, x[ks][2] * 0.125f, x[ks][3] * 0.125f, x[ks][4] * 0.125f, x[ks][5] * 0.125f, x[ks][6] * 0.125f, x[ks][7] * 0.125f);
    }
    f32x16 O[2][2];
#pragma unroll
    for (int qt = 0; qt < 2; ++qt)
#pragma unroll
        for (int dt = 0; dt < 2; ++dt)
#pragma unroll
            for (int i = 0; i < 16; ++i) O[qt][dt][i] = 0.f;
    const float sk = A.sink[head];
    float m_run[2] = {sk, sk}, l_run[2];
    l_run[0] = l_run[1] = (hh == 0) ? 1.0f : 0.0f;
    const int ti_hi = (lat && qb == 31) ? 4 : 6;
    int ti = lat ? (qb == 0 ? 2 : 0) : 6;
    const int ss = tid >> 3, sc8 = tid & 7, half = sc8 >> 2, i0 = (sc8 & 3) * 4;
    u32x2 k1, k2; u32x4 vr;
#define ATT_LOAD(tix) do { const int krow_ = ((tix) < 6 ? b * SEQ + 128 * (qb - 1) + 64 * (tix) : MLAT + b * CTXL + 64 * ((tix) - 6)) + ss; \
        const bf16_t* kp_ = A.P + pidx(krow_, PC_AK); \
        k1 = *(const u32x2*)(kp_ + g * 64 + 32 * half + i0); k2 = *(const u32x2*)(kp_ + g * 64 + 32 * half + 16 + i0); \
        vr = *(const u32x4*)(kp_ + (PC_AV - PC_AK) + g * 64 + 8 * sc8); } while (0)
    ATT_LOAD(ti);
    for (;;) {
        {
            float a[4] = {bflo(k1.x), bfhi(k1.x), bflo(k1.y), bfhi(k1.y)}, c[4] = {bflo(k2.x), bfhi(k2.x), bflo(k2.y), bfhi(k2.y)};
            if (ti < 6) { const int kpos = 128 * (qb - 1) + 64 * ti + ss; const int pos = half ? (kpos & 63) : (kpos >> 6);
#pragma unroll
                for (int e = 0; e < 4; ++e) { const f32x2 cs = tab[pos * 16 + i0 + e]; const float x1 = a[e], x2 = c[e]; a[e] = x1 * cs.x - x2 * cs.y; c[e] = x2 * cs.x + x1 * cs.y; } }
            u32x2 o1, o2; o1.x = pk2(a[0], a[1]); o1.y = pk2(a[2], a[3]); o2.x = pk2(c[0], c[1]); o2.y = pk2(c[2], c[3]);
            *(LAS u32x2*)(lds + AT_K + ss * RS + (32 * half + i0) * 2) = o1;
            *(LAS u32x2*)(lds + AT_K + ss * RS + (32 * half + 16 + i0) * 2) = o2;
            const unsigned vv[4] = {vr.x, vr.y, vr.z, vr.w};
#pragma unroll
            for (int e = 0; e < 4; ++e) { *(LAS unsigned short*)(lds + AT_V + (8 * sc8 + 2 * e) * RS + ss * 2) = (unsigned short)(vv[e] & 0xffffu);
                *(LAS unsigned short*)(lds + AT_V + (8 * sc8 + 2 * e + 1) * RS + ss * 2) = (unsigned short)(vv[e] >> 16); }
        }
        LDS_BARRIER();
        const int tn = (ti < 6 && ti + 1 == ti_hi) ? 6 : ti + 1;
        if (tn < 10) ATT_LOAD(tn);
        f32x16 S[2][2];
#pragma unroll
        for (int st = 0; st < 2; ++st) {
            bf16x8 kf[4];
#pragma unroll
            for (int ks = 0; ks < 4; ++ks) kf[ks] = *(const LAS bf16x8*)(lds + AT_K + (32 * st + r) * RS + (16 * ks + 8 * hh) * 2);
#pragma unroll
            for (int qt = 0; qt < 2; ++qt) { f32x16 acc;
#pragma unroll
                for (int i = 0; i < 16; ++i) acc[i] = 0.f;
#pragma unroll
                for (int ks = 0; ks < 4; ++ks) acc = MFMA32(kf[ks], qf[qt][ks], acc);
                S[qt][st] = acc; }
        }
        if (ti < 2 || (ti >= 4 && ti < 6)) {
            const int kp0 = 128 * (qb - 1) + 64 * ti;
#pragma unroll
            for (int qt = 0; qt < 2; ++qt) { const int qpos = qb * 128 + qoff + 32 * qt + r;
#pragma unroll
                for (int st = 0; st < 2; ++st)
#pragma unroll
                    for (int i = 0; i < 16; ++i) { const int df = qpos - (kp0 + 32 * st + crow(i, hh)); if (df > 128 || df < -128) S[qt][st][i] = -INFINITY; } }
        }
#pragma unroll
        for (int qt = 0; qt < 2; ++qt) {
            float mx = S[qt][0][0];
#pragma unroll
            for (int st = 0; st < 2; ++st)
#pragma unroll
                for (int i = 0; i < 16; ++i) mx = fmaxf(mx, S[qt][st][i]);
            mx = fmaxf(mx, __shfl_xor(mx, 32));
            const float mn = fmaxf(m_run[qt], mx), scale = fexp(m_run[qt] - mn);
            m_run[qt] = mn; float ls = 0.f;
#pragma unroll
            for (int st = 0; st < 2; ++st)
#pragma unroll
                for (int i = 0; i < 16; ++i) { const float pv = fexp(S[qt][st][i] - mn); S[qt][st][i] = pv; ls += pv; }
            l_run[qt] = l_run[qt] * scale + ls;
#pragma unroll
            for (int dt = 0; dt < 2; ++dt)
#pragma unroll
                for (int i = 0; i < 16; ++i) O[qt][dt][i] *= scale;
        }
#pragma unroll
        for (int kk = 0; kk < 4; ++kk) { const int st = kk >> 1, s2 = kk & 1;
            bf16x8 pb[2];
#pragma unroll
            for (int qt = 0; qt < 2; ++qt) pb[qt] = pack8(S[qt][st][8 * s2 + 0], S[qt][st][8 * s2 + 1], S[qt][st][8 * s2 + 2], S[qt][st][8 * s2 + 3], S[qt][st][8 * s2 + 4], S[qt][st][8 * s2 + 5], S[qt][st][8 * s2 + 6], S[qt][st][8 * s2 + 7]);
#pragma unroll
            for (int dt = 0; dt < 2; ++dt) {
                const LAS unsigned char* vp = lds + AT_V + (32 * dt + r) * RS + (32 * st + 16 * s2 + 4 * hh) * 2;
                const s16x4 lo = *(const LAS s16x4*)vp, hi = *(const LAS s16x4*)(vp + 16);
                const bf16x8 va = __builtin_shufflevector(lo, hi, 0, 1, 2, 3, 4, 5, 6, 7);
#pragma unroll
                for (int qt = 0; qt < 2; ++qt) O[qt][dt] = MFMA32(va, pb[qt], O[qt][dt]);
            }
        }
        LDS_BARRIER();
        if (tn >= 10) break;
        ti = tn;
    }
#undef ATT_LOAD
#pragma unroll
    for (int qt = 0; qt < 2; ++qt) {
        const float l = l_run[qt] + __shfl_xor(l_run[qt], 32), inv = 1.0f / l;
        bf16_t* op = A.ATT + (size_t)(qrow0 + qoff + 32 * qt + r) * 512 + head * 64;
#pragma unroll
        for (int dt = 0; dt < 2; ++dt)
#pragma unroll
            for (int ig = 0; ig < 4; ++ig) { u32x2 wv; wv.x = pk2(O[qt][dt][4 * ig] * inv, O[qt][dt][4 * ig + 1] * inv); wv.y = pk2(O[qt][dt][4 * ig + 2] * inv, O[qt][dt][4 * ig + 3] * inv);
                *(u32x2*)(op + 32 * dt + 8 * ig + 4 * hh) = wv; }
    }
}

constexpr int SC_QS = 0, SC_KS = 9216, SC_QE = 18432, SC_UKT = 27648, SC_VT = 36864, SC_CBT = 55296, SC_F = 73728;
constexpr int SF_EB = 0, SF_QN = 256, SF_SSQ = 2304, SF_N = 3328, SF_DEC = 3840, SF_CONV = 4096, SF_GN = 5632, SF_CACHE = 6144;
struct ScanArgs { const bf16_t* P; bf16_t* OUT; const float* gates; const float* convw; const float* fbias; const float* gnorm; const float* lbl; int layer; unsigned char* wsdbg; };

template <bool IS_ML>
DI void scan_item(const ScanArgs& A, int b, int hd, const int dir, unsigned* prog_mine, unsigned* prog_other, LAS unsigned char* lds, int tid) {
    asm volatile("" : "+v"(tid));
    const int w = tid >> 6, lane = tid & 63, r = lane & 31, hh = lane >> 5;
    const int etile = w & 3, ttile = w >> 2, dtile = w >> 2;
    LAS float* F = (LAS float*)(lds + SC_F);
    LAS float* eb_s = F + SF_EB / 4; LAS float* qn_s = F + SF_QN / 4; LAS float* ssq_s = F + SF_SSQ / 4; LAS float* n_s = F + SF_N / 4; LAS float* dec_s = F + SF_DEC / 4; LAS float* conv_s = F + SF_CONV / 4;
    LAS float* gn_s = F + SF_GN / 4; LAS unsigned* cache_s = (LAS unsigned*)(F + SF_CACHE / 4);
    const int vcol = (IS_ML ? PC_MV : PC_HI) + hd * 128, gcol = (IS_ML ? PC_MO : PC_HG) + hd * 128;
    __syncthreads();
    if (IS_ML) {
        if (tid < 384) { const int j = tid >> 6, d = tid & 63; conv_s[tid] = A.convw[(j % 3) * 512 + (j / 3) * 256 + hd * 64 + d]; }
    }
    if (tid < 128) { n_s[tid] = 0.f; gn_s[tid] = A.gnorm[hd * 128 + tid]; }
    if (tid == 0) cache_s[0] = 0u;
    f32x16 Cst;
#pragma unroll
    for (int i = 0; i < 16; ++i) Cst[i] = 0.f;
    float m_run = 0.f;
#pragma unroll
    for (int ig = 0; ig < 4; ++ig) *(LAS u32x2*)(lds + SC_CBT + (32 * etile + r) * RS + (32 * dtile + 8 * ig + 4 * hh) * 2) = (u32x2){0u, 0u};
    const float fb = IS_ML ? A.fbias[dir * 4 + hd] : 0.f;
    unsigned pend = 0;
    u32x4 rq[3], rk[3], rv[2]; float rgi = 0.f, rgf = 0.f;
#define SC_ROWS(c_) const int cc_ = (c_) < 4 ? (dir ? 3 - (c_) : (c_)) : (dir ? 67 - (c_) : (c_) - 4); \
    const int slo_ = (c_) < 4 ? MLAT + b * CTXL : b * SEQ, slen_ = (c_) < 4 ? CTXL : SEQ; const int rb_ = slo_ + 64 * cc_;
#define SC_LOAD(c_) do { SC_ROWS(c_) const int ti_ = 64 * cc_ + (dir ? 63 - lane : lane); const int prow_ = slo_ + ti_; \
    if (IS_ML) { const u32x4 z4_ = (u32x4){0u, 0u, 0u, 0u}; \
        const bf16_t* pq_ = A.P + pidx(prow_, PC_MQ + hd * 64 + 8 * w); const bf16_t* pk_ = A.P + pidx(prow_, PC_MK + hd * 64 + 8 * w); rq[1] = *(const u32x4*)pq_; rk[1] = *(const u32x4*)pk_; \
        rq[0] = ti_ > 0 ? *(const u32x4*)(pq_ - 256) : z4_; rk[0] = ti_ > 0 ? *(const u32x4*)(pk_ - 256) : z4_; \
        rq[2] = ti_ + 1 < slen_ ? *(const u32x4*)(pq_ + 256) : z4_; rk[2] = ti_ + 1 < slen_ ? *(const u32x4*)(pk_ + 256) : z4_; \
        const float* gp_ = A.gates + (size_t)(slo_ + ti_) * 16; rgi = gp_[dir * 4 + hd]; rgf = gp_[8 + dir * 4 + hd]; \
    } else { rq[1] = *(const u32x4*)(A.P + pidx(prow_, PC_HQ + hd * 64 + 8 * w)); rk[1] = *(const u32x4*)(A.P + pidx(prow_, PC_HF + dir * 256 + hd * 64 + 8 * w)); } \
    { const bf16_t* pv_ = A.P + pidx(prow_, vcol + 16 * w); rv[0] = *(const u32x4*)pv_; rv[1] = *(const u32x4*)(pv_ + 8); } } while (0)
    SC_LOAD(0);
    __syncthreads();
#ifdef DBG_SEL
    unsigned long long wacc_ = 0;
#endif
#pragma unroll 1
    for (int c = 0; c < 68; ++c) {
#ifdef DBG_SEL
        { const unsigned long long ta_ = __builtin_amdgcn_s_memrealtime(); asm volatile("s_waitcnt vmcnt(0)" ::: "memory"); wacc_ += __builtin_amdgcn_s_memrealtime() - ta_; }
#endif
        float ea = 1.f, wprev = 0.f, enm = 0.f, a_prev = 0.f;
        {
            const unsigned vv[8] = {rv[0].x, rv[0].y, rv[0].z, rv[0].w, rv[1].x, rv[1].y, rv[1].z, rv[1].w};
#pragma unroll
            for (int e = 0; e < 8; ++e) { *(LAS unsigned short*)(lds + SC_VT + (16 * w + 2 * e) * RS + lane * 2) = (unsigned short)(vv[e] & 0xffffu);
                *(LAS unsigned short*)(lds + SC_VT + (16 * w + 2 * e + 1) * RS + lane * 2) = (unsigned short)(vv[e] >> 16); }
        }
        if (IS_ML) {
            const float li = rgi, xf = rgf + fb;
            const float lf = fminf(xf, 0.f) - flog1p(fexp(-fabsf(xf)));
            const float bc = wave_scan_add(lf);
            const float beta = li - bc; const float pm = wave_scan_max(beta);
            const float bl = lane_bcast(bc, 63), pmx = lane_bcast(pm, 63);
            const float mm = fmaxf(m_run, pm), mmx = fmaxf(m_run, pmx);
            ea = fexp(-mm); wprev = fexp(m_run - mm); enm = fexp(-(bc + mm));
            a_prev = fexp(m_run - mmx); const float u = fexp(beta - mmx);
            m_run = bl + mmx;
            if (w == 0) eb_s[lane] = fexp(fminf(beta, 80.f));
            float q8[8], k8[8];
            const unsigned q0[4] = {rq[0].x, rq[0].y, rq[0].z, rq[0].w}, q1[4] = {rq[1].x, rq[1].y, rq[1].z, rq[1].w}, q2[4] = {rq[2].x, rq[2].y, rq[2].z, rq[2].w};
            const unsigned k0[4] = {rk[0].x, rk[0].y, rk[0].z, rk[0].w}, k1[4] = {rk[1].x, rk[1].y, rk[1].z, rk[1].w}, k2[4] = {rk[2].x, rk[2].y, rk[2].z, rk[2].w};
            float cw[6][8];
#pragma unroll
            for (int j = 0; j < 6; ++j) { const f32x4 c0 = *(const LAS f32x4*)(conv_s + j * 64 + 8 * w), c1 = *(const LAS f32x4*)(conv_s + j * 64 + 8 * w + 4);
                cw[j][0] = c0[0]; cw[j][1] = c0[1]; cw[j][2] = c0[2]; cw[j][3] = c0[3]; cw[j][4] = c1[0]; cw[j][5] = c1[1]; cw[j][6] = c1[2]; cw[j][7] = c1[3]; }
#pragma unroll
            for (int e = 0; e < 4; ++e) {
                q8[2 * e] = fsilu(bflo(q0[e]) * cw[0][2 * e] + bflo(q1[e]) * cw[1][2 * e] + bflo(q2[e]) * cw[2][2 * e]);
                q8[2 * e + 1] = fsilu(bfhi(q0[e]) * cw[0][2 * e + 1] + bfhi(q1[e]) * cw[1][2 * e + 1] + bfhi(q2[e]) * cw[2][2 * e + 1]);
                k8[2 * e] = 0.125f * fsilu(bflo(k0[e]) * cw[3][2 * e] + bflo(k1[e]) * cw[4][2 * e] + bflo(k2[e]) * cw[5][2 * e]);
                k8[2 * e + 1] = 0.125f * fsilu(bfhi(k0[e]) * cw[3][2 * e + 1] + bfhi(k1[e]) * cw[4][2 * e + 1] + bfhi(k2[e]) * cw[5][2 * e + 1]); }
            *(LAS bf16x8*)(lds + SC_QS + lane * RS + 16 * w) = pack8(q8[0], q8[1], q8[2], q8[3], q8[4], q8[5], q8[6], q8[7]);
            *(LAS bf16x8*)(lds + SC_KS + lane * RS + 16 * w) = pack8(k8[0], k8[1], k8[2], k8[3], k8[4], k8[5], k8[6], k8[7]);
#pragma unroll
            for (int e = 0; e < 4; ++e) { const unsigned pkv = pk2(u * k8[2 * e], u * k8[2 * e + 1]);
                *(LAS unsigned short*)(lds + SC_UKT + (8 * w + 2 * e) * RS + lane * 2) = (unsigned short)(pkv & 0xffffu);
                *(LAS unsigned short*)(lds + SC_UKT + (8 * w + 2 * e + 1) * RS + lane * 2) = (unsigned short)(pkv >> 16); }
            const LAS float* nv = n_s + (c & 1) * 64 + 8 * w; const f32x4 n0 = *(const LAS f32x4*)nv, n1 = *(const LAS f32x4*)(nv + 4);
            qn_s[lane * 8 + w] = (q8[0] * n0[0] + q8[1] * n0[1] + q8[2] * n0[2] + q8[3] * n0[3]) + (q8[4] * n1[0] + q8[5] * n1[1] + q8[6] * n1[2] + q8[7] * n1[3]);
        } else {
            float x[8], kk[8], qs[8];
            const unsigned qr[4] = {rq[1].x, rq[1].y, rq[1].z, rq[1].w}, zr[4] = {rk[1].x, rk[1].y, rk[1].z, rk[1].w};
#pragma unroll
            for (int e = 0; e < 8; ++e) { x[e] = (e & 1) ? bfhi(zr[e >> 1]) : bflo(zr[e >> 1]); qs[e] = (e & 1) ? bfhi(qr[e >> 1]) : bflo(qr[e >> 1]); kk[e] = 1.0f - fexp(x[e]); }
#pragma unroll
            for (int e = 0; e < 8; ++e) x[e] = wave_scan_add(x[e]);
            float qe[8], qt[8], kt[8], ku[8];
#pragma unroll
            for (int e = 0; e < 8; ++e) { const float bb = x[e];
                const float blv = __uint_as_float(__builtin_amdgcn_readlane(__float_as_uint(bb), 63)), ref = __uint_as_float(__builtin_amdgcn_readlane(__float_as_uint(bb), 31));
                qe[e] = qs[e] * fexp(bb); qt[e] = qs[e] * fexp(fminf(bb - ref, 60.f)); kt[e] = kk[e] * fexp(fminf(ref - bb, 60.f)); ku[e] = kk[e] * fexp(blv - bb);
                if (lane == 0) dec_s[8 * w + e] = fexp(blv); }
#pragma unroll
            for (int e = 0; e < 4; ++e) { const unsigned pkv = pk2(ku[2 * e], ku[2 * e + 1]);
                *(LAS unsigned short*)(lds + SC_UKT + (8 * w + 2 * e) * RS + lane * 2) = (unsigned short)(pkv & 0xffffu);
                *(LAS unsigned short*)(lds + SC_UKT + (8 * w + 2 * e + 1) * RS + lane * 2) = (unsigned short)(pkv >> 16); }
            *(LAS bf16x8*)(lds + SC_QE + lane * RS + 16 * w) = pack8(qe[0], qe[1], qe[2], qe[3], qe[4], qe[5], qe[6], qe[7]);
            *(LAS bf16x8*)(lds + SC_QS + lane * RS + 16 * w) = pack8(qt[0], qt[1], qt[2], qt[3], qt[4], qt[5], qt[6], qt[7]);
            *(LAS bf16x8*)(lds + SC_KS + lane * RS + 16 * w) = pack8(kt[0], kt[1], kt[2], kt[3], kt[4], kt[5], kt[6], kt[7]);
        }
        const bool first_role = (c < 2) || (c >= 4 && c < 36);
        if (pend && !first_role) {
            asm volatile("s_waitcnt vmcnt(0)" ::: "memory"); if (lane == 0) __hip_atomic_fetch_add(prog_mine, pend, __ATOMIC_RELAXED, __HIP_MEMORY_SCOPE_AGENT); pend = 0; }
        if (!first_role && tid == 0) {
            const int cp = (c < 4) ? 3 - c : 71 - c; const unsigned need = 8u * (unsigned)((cp < 2 ? cp : cp - 2) + 1);
            if (cache_s[0] < need) {
                unsigned v; unsigned spins = 0;
                for (;;) { v = __hip_atomic_load(prog_other, __ATOMIC_RELAXED, __HIP_MEMORY_SCOPE_AGENT); if (v >= need) break; __builtin_amdgcn_s_sleep(2); if (++spins > (1u << 24)) break; }
                __builtin_amdgcn_fence(__ATOMIC_ACQUIRE, "agent");
                asm volatile("s_waitcnt vmcnt(0)" ::: "memory");
                cache_s[0] = v;
            }
        }
        LDS_BARRIER();
        SC_ROWS(c)
        const int t = 32 * ttile + r;
        const int orow = rb_ + (dir ? 63 - t : t);
        bf16_t* op = A.OUT + (size_t)orow * 512 + hd * 128 + 32 * etile + 4 * hh;
        unsigned long long prevv[4]; u32x2 gwv[4];
        if (!first_role) {
            const bf16_t* gp = A.P + pidx(orow, gcol + 32 * etile + 4 * hh);
#pragma unroll
            for (int ig = 0; ig < 4; ++ig) { prevv[ig] = __hip_atomic_load((const unsigned long long*)(op + 8 * ig), __ATOMIC_RELAXED, __HIP_MEMORY_SCOPE_AGENT); gwv[ig] = *(const u32x2*)(gp + 8 * ig); }
        }
        if (c + 1 < 68) SC_LOAD(c + 1);
        bf16x8 qf[4];
#pragma unroll
        for (int ks = 0; ks < 4; ++ks) qf[ks] = *(const LAS bf16x8*)(lds + SC_QS + t * RS + (16 * ks + 8 * hh) * 2);
        const int tt = __builtin_amdgcn_readfirstlane(ttile);
        f32x16 Sd, Sf;
#pragma unroll
        for (int i = 0; i < 16; ++i) { Sd[i] = 0.f; Sf[i] = 0.f; }
#pragma unroll
        for (int ks = 0; ks < 4; ++ks) { const bf16x8 kf = *(const LAS bf16x8*)(lds + SC_KS + (32 * tt + r) * RS + (16 * ks + 8 * hh) * 2); Sd = MFMA32(kf, qf[ks], Sd); }
        if (tt == 1) {
#pragma unroll
            for (int ks = 0; ks < 4; ++ks) { const bf16x8 kf = *(const LAS bf16x8*)(lds + SC_KS + r * RS + (16 * ks + 8 * hh) * 2); Sf = MFMA32(kf, qf[ks], Sf); }
        }
        float c1 = 1.0f, c2 = 1.0f;
        if (IS_ML) {
            const float ea_t = __shfl(ea, t), en_t = __shfl(enm, t), wprev_t = __shfl(wprev, t);
            float rs = 0.f;
#pragma unroll
            for (int ig = 0; ig < 4; ++ig) { const f32x4 bt = *(const LAS f32x4*)(eb_s + 32 * tt + 8 * ig + 4 * hh);
#pragma unroll
                for (int k = 0; k < 4; ++k) { const float v = (8 * ig + 4 * hh + k <= r) ? Sd[4 * ig + k] * bt[k] : 0.f; Sd[4 * ig + k] = v; rs += v; } }
            if (tt == 1) {
#pragma unroll
                for (int ig = 0; ig < 4; ++ig) { const f32x4 bt = *(const LAS f32x4*)(eb_s + 8 * ig + 4 * hh);
#pragma unroll
                    for (int k = 0; k < 4; ++k) { const float v = Sf[4 * ig + k] * bt[k]; Sf[4 * ig + k] = v; rs += v; } }
            }
            rs += __shfl_xor(rs, 32);
            const f32x4 qa = *(const LAS f32x4*)(qn_s + t * 8), qb4 = *(const LAS f32x4*)(qn_s + t * 8 + 4);
            const float qn = ((qa[0] + qa[1]) + (qa[2] + qa[3])) + ((qb4[0] + qb4[1]) + (qb4[2] + qb4[3]));
            const float den = wprev_t * qn + ea_t * rs;
            const float inv = 1.0f / fmaxf(fabsf(den), en_t);
            c1 = wprev_t * inv; c2 = ea_t * inv;
            {
                const bf16x8 uk = *(const LAS bf16x8*)(lds + SC_UKT + (8 * w + (lane >> 3)) * RS + 16 * (lane & 7));
                float sacc = ((bf1(uk[0]) + bf1(uk[1])) + (bf1(uk[2]) + bf1(uk[3]))) + ((bf1(uk[4]) + bf1(uk[5])) + (bf1(uk[6]) + bf1(uk[7])));
                sacc += __shfl_xor(sacc, 1); sacc += __shfl_xor(sacc, 2); sacc += __shfl_xor(sacc, 4);
                if ((lane & 7) == 0) n_s[((c + 1) & 1) * 64 + 8 * w + (lane >> 3)] = a_prev * n_s[(c & 1) * 64 + 8 * w + (lane >> 3)] + sacc;
            }
        } else {
#pragma unroll
            for (int i = 0; i < 16; ++i) { if (crow(i, hh) > r) Sd[i] = 0.f; }
        }
        f32x16 acc1;
#pragma unroll
        for (int i = 0; i < 16; ++i) acc1[i] = 0.f;
#pragma unroll
        for (int ks = 0; ks < 4; ++ks) { const bf16x8 ca = *(const LAS bf16x8*)(lds + SC_CBT + (32 * etile + r) * RS + (16 * ks + 8 * hh) * 2);
            const bf16x8 qb = IS_ML ? qf[ks] : *(const LAS bf16x8*)(lds + SC_QE + t * RS + (16 * ks + 8 * hh) * 2);
            acc1 = MFMA32(ca, qb, acc1); }
        f32x16 acc2;
        if (IS_ML) {
#pragma unroll
            for (int i = 0; i < 16; ++i) acc2[i] = 0.f;
        } else acc2 = acc1;
#pragma unroll
        for (int s2 = 0; s2 < 2; ++s2) {
            const LAS unsigned char* vp = lds + SC_VT + (32 * etile + r) * RS + (32 * tt + 16 * s2 + 4 * hh) * 2;
            const s16x4 lo = *(const LAS s16x4*)vp, hi = *(const LAS s16x4*)(vp + 16);
            const bf16x8 va = __builtin_shufflevector(lo, hi, 0, 1, 2, 3, 4, 5, 6, 7);
            const bf16x8 pb = pack8(Sd[8 * s2 + 0], Sd[8 * s2 + 1], Sd[8 * s2 + 2], Sd[8 * s2 + 3], Sd[8 * s2 + 4], Sd[8 * s2 + 5], Sd[8 * s2 + 6], Sd[8 * s2 + 7]);
            acc2 = MFMA32(va, pb, acc2); }
        if (tt == 1) {
#pragma unroll
            for (int s2 = 0; s2 < 2; ++s2) {
                const LAS unsigned char* vp = lds + SC_VT + (32 * etile + r) * RS + (16 * s2 + 4 * hh) * 2;
                const s16x4 lo = *(const LAS s16x4*)vp, hi = *(const LAS s16x4*)(vp + 16);
                const bf16x8 va = __builtin_shufflevector(lo, hi, 0, 1, 2, 3, 4, 5, 6, 7);
                const bf16x8 pb = pack8(Sf[8 * s2 + 0], Sf[8 * s2 + 1], Sf[8 * s2 + 2], Sf[8 * s2 + 3], Sf[8 * s2 + 4], Sf[8 * s2 + 5], Sf[8 * s2 + 6], Sf[8 * s2 + 7]);
                acc2 = MFMA32(va, pb, acc2); }
        }
        f32x16 hv;
        if (IS_ML) {
#pragma unroll
            for (int i = 0; i < 16; ++i) hv[i] = c1 * acc1[i] + c2 * acc2[i];
        } else hv = acc2;
        if (first_role) {
#pragma unroll
            for (int ig = 0; ig < 4; ++ig) { const unsigned lo_ = pk2(hv[4 * ig], hv[4 * ig + 1]), hi_ = pk2(hv[4 * ig + 2], hv[4 * ig + 3]);
                __hip_atomic_store((unsigned long long*)(op + 8 * ig), ((unsigned long long)hi_ << 32) | lo_, __ATOMIC_RELAXED, __HIP_MEMORY_SCOPE_AGENT); }
            ++pend;
        } else {
            float sq = 0.f;
#pragma unroll
            for (int ig = 0; ig < 4; ++ig) { const unsigned a0 = (unsigned)prevv[ig], a1 = (unsigned)(prevv[ig] >> 32);
                hv[4 * ig] += bflo(a0); hv[4 * ig + 1] += bfhi(a0); hv[4 * ig + 2] += bflo(a1); hv[4 * ig + 3] += bfhi(a1);
                sq += (hv[4 * ig] * hv[4 * ig] + hv[4 * ig + 1] * hv[4 * ig + 1]) + (hv[4 * ig + 2] * hv[4 * ig + 2] + hv[4 * ig + 3] * hv[4 * ig + 3]); }
            sq += __shfl_xor(sq, 32);
            if (hh == 0) ssq_s[etile * 64 + t] = sq;
            LDS_BARRIER();
            const float tot = (ssq_s[t] + ssq_s[64 + t]) + (ssq_s[128 + t] + ssq_s[192 + t]);
            const float rstd = 1.0f / sqrtf(tot * (1.0f / 128.0f) + EPS);
#pragma unroll
            for (int ig = 0; ig < 4; ++ig) { const f32x4 g4 = *(const LAS f32x4*)(gn_s + 32 * etile + 4 * hh + 8 * ig);
                const float g0 = bflo(gwv[ig].x), g1 = bfhi(gwv[ig].x), g2 = bflo(gwv[ig].y), g3 = bfhi(gwv[ig].y);
                const float o0 = hv[4 * ig] * rstd * g4[0] * (IS_ML ? fsigmoid(g0) : fsilu(g0)), o1 = hv[4 * ig + 1] * rstd * g4[1] * (IS_ML ? fsigmoid(g1) : fsilu(g1));
                const float o2 = hv[4 * ig + 2] * rstd * g4[2] * (IS_ML ? fsigmoid(g2) : fsilu(g2)), o3 = hv[4 * ig + 3] * rstd * g4[3] * (IS_ML ? fsigmoid(g3) : fsilu(g3));
                u32x2 wv; wv.x = pk2(o0, o1); wv.y = pk2(o2, o3); *(u32x2*)(op + 8 * ig) = wv; }
        }
        if (IS_ML) {
#pragma unroll
            for (int i = 0; i < 16; ++i) Cst[i] *= a_prev;
        } else {
#pragma unroll
            for (int ig = 0; ig < 4; ++ig) { const f32x4 dv = *(const LAS f32x4*)(dec_s + 32 * dtile + 8 * ig + 4 * hh);
#pragma unroll
                for (int k = 0; k < 4; ++k) Cst[4 * ig + k] *= dv[k]; }
        }
#pragma unroll
        for (int ks = 0; ks < 4; ++ks) { const bf16x8 ua = *(const LAS bf16x8*)(lds + SC_UKT + (32 * dtile + r) * RS + (16 * ks + 8 * hh) * 2);
            const bf16x8 vb = *(const LAS bf16x8*)(lds + SC_VT + (32 * etile + r) * RS + (16 * ks + 8 * hh) * 2);
            Cst = MFMA32(ua, vb, Cst); }
        LDS_BARRIER();
#pragma unroll
        for (int ig = 0; ig < 4; ++ig) { u32x2 wv; wv.x = pk2(Cst[4 * ig], Cst[4 * ig + 1]); wv.y = pk2(Cst[4 * ig + 2], Cst[4 * ig + 3]);
            *(LAS u32x2*)(lds + SC_CBT + (32 * etile + r) * RS + (32 * dtile + 8 * ig + 4 * hh) * 2) = wv; }
    }
    if (pend) { asm volatile("s_waitcnt vmcnt(0)" ::: "memory"); if (lane == 0) __hip_atomic_fetch_add(prog_mine, pend, __ATOMIC_RELAXED, __HIP_MEMORY_SCOPE_AGENT); }
#undef SC_LOAD
#undef SC_ROWS
#ifdef DBG_SEL
    if (IS_ML && blockIdx.x == 0 && tid == 0 && A.layer == 0) { unsigned long long* d_ = (unsigned long long*)(A.wsdbg + WS_LB + 4096); d_[40] = wacc_; d_[41] = 0; }
#endif
    __syncthreads();
}
#ifndef PH
#define PH 0xffff
#endif

#define XB_TMO      128
#define XB_XCNT(j)  (256  + 64 * (j))
#define XB_XSUB(j)  (1280 + 64 * (j))
#define XB_XGEN(j)  (2304 + 64 * (j))
#define XB_TOP      3328
#define XB_TOPGEN   3392
#define XCD_BAR_WORDS 3456
#define XB_SPIN_CAP (1u << 18)

__device__ __forceinline__ unsigned xb_ld(unsigned* p)              { return __hip_atomic_load(p, __ATOMIC_RELAXED, __HIP_MEMORY_SCOPE_AGENT); }
__device__ __forceinline__ unsigned xb_add(unsigned* p, unsigned v) { return __hip_atomic_fetch_add(p, v, __ATOMIC_RELAXED, __HIP_MEMORY_SCOPE_AGENT); }
__device__ __forceinline__ unsigned xb_xcc_id() { return (unsigned)__builtin_amdgcn_s_getreg((3 << 11) | 20) & 0xFu; }
#define XB_SPIN(cond, bar) do { unsigned _sp = 0; while (cond) { __builtin_amdgcn_s_sleep(1); \
    if ((++_sp & 255u) == 0u) { if (xb_ld(&(bar)[XB_TMO])) break; if (_sp > XB_SPIN_CAP) { atomicAdd(&(bar)[XB_TMO], 1u); break; } } } } while (0)

struct XcdBarrier {
    unsigned* bar; unsigned x;
    volatile LAS unsigned* st;
};

__device__ __forceinline__ XcdBarrier xcd_barrier_post(unsigned* bar, volatile LAS unsigned* st) {
    XcdBarrier b; b.bar = bar; b.x = xb_xcc_id(); b.st = st;
    if (threadIdx.x == 0) (void)xb_add(&bar[XB_XCNT(b.x)], 1u);
    return b;
}
__device__ __forceinline__ void xcd_barrier_complete(unsigned* bar, unsigned x, unsigned& nloc, unsigned& nx) {
    const unsigned G = gridDim.x * gridDim.y * gridDim.z;
    unsigned sum, cnt, mine, sp = 0u;
    for (;;) {
        sum = 0u; cnt = 0u; mine = 0u;
#pragma unroll
        for (unsigned j = 0; j < 16; ++j) { const unsigned c = xb_ld(&bar[XB_XCNT(j)]); sum += c; cnt += (c > 0u) ? 1u : 0u; mine = (j == x) ? c : mine; }
        if (sum == G) break;
        __builtin_amdgcn_s_sleep(1);
        if ((++sp & 255u) == 0u) { if (xb_ld(&bar[XB_TMO])) break; if (sp > XB_SPIN_CAP) { atomicAdd(&bar[XB_TMO], 1u); break; } }
    }
    nloc = mine > 0u ? mine : 1u; nx = cnt > 0u ? cnt : 1u;
}

__device__ __forceinline__ void xcd_barrier(const XcdBarrier& b) {
    asm volatile("s_waitcnt vmcnt(0)" ::: "memory");
    __syncthreads();
    if (threadIdx.x == 0) {
        unsigned* bar = b.bar;
        __builtin_amdgcn_s_waitcnt(0);
        unsigned nloc = b.st[0], nx = b.st[1];
        if (nloc == 0u) { xcd_barrier_complete(bar, b.x, nloc, nx); b.st[0] = nloc; b.st[1] = nx; }
        const unsigned old = xb_add(&bar[XB_XSUB(b.x)], 1u);
        const unsigned gen = old / nloc;
        if (old + 1u == (gen + 1u) * nloc) {
            __builtin_amdgcn_fence(__ATOMIC_RELEASE, "agent");
            asm volatile("s_waitcnt vmcnt(0)" ::: "memory");
            const unsigned og = xb_add(&bar[XB_TOP], 1u);
            const unsigned tg = og / nx;
            if (og + 1u == (tg + 1u) * nx) xb_add(&bar[XB_TOPGEN], 1u);
            else XB_SPIN(xb_ld(&bar[XB_TOPGEN]) == tg, bar);
            __builtin_amdgcn_fence(__ATOMIC_ACQUIRE, "agent");
            xb_add(&bar[XB_XGEN(b.x)], 1u);
            asm volatile("s_waitcnt vmcnt(0)" ::: "memory");
        } else {
            XB_SPIN(xb_ld(&bar[XB_XGEN(b.x)]) == gen, bar);
            __builtin_amdgcn_fence(__ATOMIC_ACQUIRE, "agent");
            asm volatile("s_waitcnt vmcnt(0)" ::: "memory");
        }
    }
    __syncthreads();
}


#ifdef DBG_SEL
#define DBG_BAR() do { DBG_STAMP(ws, 100 + nbar_, 0); ++nbar_; } while (0)
#define DBG_STAMP(ws_, idx, blk) do { if ((int)blockIdx.x == (blk) && threadIdx.x == 0) ((unsigned long long*)((ws_) + WS_LB + 4096))[idx] = __builtin_amdgcn_s_memrealtime(); } while (0)
#else
#define DBG_BAR() do {} while (0)
#define DBG_STAMP(ws_, idx, blk) do {} while (0)
#endif
DI void mix_phase(KP p, int l, LAS unsigned char* lds, int tid) {
    asm volatile("" : "+v"(tid));
    const int G = gridDim.x, bid = blockIdx.x;
    const bf16_t* P = (const bf16_t*)(p->ws + WS_P);
    bf16_t* ATT = (bf16_t*)(p->ws + WS_S); bf16_t* MLB = ATT + (size_t)MTOT * 512; bf16_t* HGB = MLB + (size_t)MTOT * 512;
    const int nattn = 512 + (l == 0 ? 32 : 0);
    DBG_STAMP(p->ws, 10 + 20 * l, 0);
    if (bid < 128) {
        const int it = bid, dir = it & 1, hd = (it >> 1) & 3, b = (it >> 3) & 7, ty = it >> 6;
        unsigned* prog = (unsigned*)p->ws + (l * 128 + (it & ~1)) * 16;
        if (ty == 0) { ScanArgs A{P, MLB, (const float*)(p->ws + WS_GATES), p->in[I_MLCONV] + (size_t)l * 3 * 512, p->in[I_MLFB] + l * 8, p->in[I_MLNORM] + l * 512, p->in[I_HGLB], l, p->ws};
#ifndef NO_SCANML
            scan_item<true>(A, b, hd, dir, prog + dir * 16, prog + (dir ^ 1) * 16, lds, tid);
#endif
        } else { ScanArgs A{P, HGB, (const float*)(p->ws + WS_GATES), p->in[I_MLCONV], p->in[I_MLFB], p->in[I_HGNORM] + l * 512, p->in[I_HGLB], l, p->ws};
#ifndef NO_SCANHG
            scan_item<false>(A, b, hd, dir, prog + dir * 16, prog + (dir ^ 1) * 16, lds, tid);
#endif
        }
    }
    DBG_STAMP(p->ws, 11 + 20 * l, 0); DBG_STAMP(p->ws, 16 + 20 * l, 1); DBG_STAMP(p->ws, 12 + 20 * l, 64);
    if (bid >= 128) {
        __syncthreads();
        const f32x2* rope = (const f32x2*)(p->ws + WS_ROPE);
        for (int i = tid; i < 1024; i += 512) ((LAS f32x2*)(lds + AT_TAB))[i] = rope[i];
        __syncthreads();
        AttnArgs A{P, ATT, p->in[I_SINK] + l * 8, rope};
        for (int it = bid - 128; it < nattn; it += G - 128) {
#ifndef NO_ATTN
 attn_item(A, it, lds, tid);
#endif
 }
        DBG_STAMP(p->ws, 13 + 20 * l, 128);
        __syncthreads();
        convert_weights(p, l, lds, 0x7cau, bid - 128, G - 128);
        if (l == 0) convert_weights(p, 1, lds, 0x35u, bid - 128, G - 128);
        DBG_STAMP(p->ws, 14 + 20 * l, 128);
    }
}

template <class Epi> DI void run_gemm(LAS unsigned char* lds, const bf16_t* A, const bf16_t* Bt, int M, int N, int K, const Epi& E) {
    pg8::Gemm g{A, Bt, M, N, K}; pg8::StaticOrder S; S.init(M, N, (int)gridDim.x, (int)blockIdx.x);
    pg8::gemm_phase<Epi, pg8::StaticOrder, true, true>(lds, g, S, E);
}

template <class Epi> DI void run_gemm_ctx(LAS unsigned char* lds, const bf16_t* A, const bf16_t* Bt, int N, int K, const Epi& E) {
    pg8::Gemm g{A, Bt, MTOT, N, K}; pg8::CtxOrder S{224, MLAT / 256};
    pg8::gemm_phase<Epi, pg8::CtxOrder, true, true>(lds, g, S, E);
}

DI void run_gemm_ctx_cnt(LAS unsigned char* lds, const bf16_t* A, const bf16_t* Bt, int N, int K, bf16_t* O, unsigned* cnt) {
    pg8::Gemm g{A, Bt, MTOT, N, K}; pg8::CtxOrder S{224, MLAT / 256};
    pg8::EpiBf16Cnt E{O, DM, cnt, MLAT / 256};
    pg8::gemm_phase<pg8::EpiBf16Cnt, pg8::CtxOrder, true, true>(lds, g, S, E);
    if (threadIdx.x == 0) {
        unsigned* c = cnt + 16 * (((int)blockIdx.x - 224) >> 2); unsigned spins = 0;
        while (__hip_atomic_load(c, __ATOMIC_RELAXED, __HIP_MEMORY_SCOPE_AGENT) < 32u) { __builtin_amdgcn_s_sleep(2); if (++spins > (1u << 22)) break; }
        __builtin_amdgcn_fence(__ATOMIC_ACQUIRE, "agent");
        asm volatile("s_waitcnt vmcnt(0)" ::: "memory");
    }
    __syncthreads();
}

#define GRID_BAR() do { XcdBarrier xb_; xb_.bar = (unsigned*)(ws) + 8192; xb_.x = xb_xcc_id(); xb_.st = (volatile LAS unsigned*)(lds + 131072); xcd_barrier(xb_); DBG_BAR(); } while (0)
__global__ void __launch_bounds__(512) fwd_kernel(Params p_unused) {
    extern __shared__ __attribute__((aligned(16))) unsigned char lds_raw[];
    LAS unsigned char* lds = (LAS unsigned char*)lds_raw;
    cg::grid_group grid = cg::this_grid();
#define tid ((int)threadIdx.x)
#define ws (kparams()->ws)
#define W ((bf16_t*)(ws + WS_W))
#define H ((bf16_t*)(ws + WS_H))
#define PB ((bf16_t*)(ws + WS_P))
#define SB ((bf16_t*)(ws + WS_S))
#define XC ((float*)(ws + WS_XC))
#define mod ((const float*)(ws + WS_MOD))
#define gates ((float*)(ws + WS_GATES))
    KP p = kparams();
    int nbar_ = 0; (void)nbar_;
    DBG_STAMP(ws, 99, 0);
    if (threadIdx.x < 16) ((LAS unsigned*)(lds + 131072))[threadIdx.x] = 0u;
    __syncthreads();
    (void)xcd_barrier_post((unsigned*)(ws) + 8192, (volatile LAS unsigned*)(lds + 131072));

#if PH & 1
    convert_weights(p, 0, lds, 0x35u, (int)blockIdx.x, (int)gridDim.x);
    __syncthreads();
    mods_phase(p, lds, tid);
#endif
    if (ws == nullptr) grid.sync();
    GRID_BAR();
    {
        RowArgs a{p->in[I_X], p->in[I_CTX], nullptr, nullptr, nullptr, H, mod, mod, nullptr, p->in[I_NPRE], nullptr, nullptr, 0, 0, 0, MTOT, (int)blockIdx.x, (int)gridDim.x, 0.f};
#if PH & 2
        row_phase<false, true, false>(a, lds, tid);
#endif
    }
    GRID_BAR();

#pragma unroll 1
    for (int l = 0; l < 2; ++l) {
#pragma unroll 1
      for (int f = 0; f < 2; ++f) {
        p = kparams();
        const float* modl = mod + (size_t)l * 9 * 9216;
        const float* npre = p->in[I_NPRE] + (size_t)l * 3 * DM; const float* npost = p->in[I_NPOST] + (size_t)l * 3 * DM;
        const bool ctx2 = (l == 0);
        const int bid = (int)blockIdx.x, G = (int)gridDim.x;
        if (f == 1) {
            { pg8::EpiGin E{PB, PTS, (const float*)(ws + WS_LB) + l * 256}; run_gemm(lds, H, W + WO_WIN, MTOT, NPC, DM, E); }
            GRID_BAR();
            mix_phase(p, l, lds, tid);
            GRID_BAR();
            DBG_STAMP(ws, 15 + 20 * l, 0);
            { pg8::EpiBf16<1> E{PB, NGC, 0}; run_gemm(lds, H, W + WO_WG, ctx2 ? MTOT : MLAT, NGC, DM, E); }
            GRID_BAR();
            {
                const int Mm = ctx2 ? MTOT : MLAT;
                pg8::Gemm g{SB, W + WO_WB, Mm, DM, 512, (size_t)MTOT * 512 * 2, (size_t)1024 * 512 * 2};
                pg8::MergeOrder S; S.S.init(Mm, DM, (int)gridDim.x, (int)blockIdx.x);
                pg8::EpiMerge E{H, PB, PB + (size_t)MTOT * NGC};
                pg8::gemm_phase<pg8::EpiMerge, pg8::MergeOrder, true, true>(lds, g, S, E);
            }
            GRID_BAR();
            { pg8::EpiBf16<0> E{SB, DM, 0}; run_gemm(lds, H, W + WO_WOUT, MLAT, DM, DM, E); }
            GRID_BAR();
            {
                const int vg = ctx2 ? 224 : G;
                RowArgs a{p->out, XC, p->out, XC, SB, H, modl, modl, npost + DM, npre + 2 * DM, nullptr, nullptr, 1, 2, 0, MLAT, bid < vg ? bid : -1, vg, 1.0f};
                if (bid < vg) row_phase<true, true, false>(a, lds, tid);
                else {
                    run_gemm_ctx_cnt(lds, H, W + WO_WOUT, DM, DM, SB, (unsigned*)(ws) + 12288 + (l * 4 + 3) * 128);
                    const int r0 = MLAT + ((bid - 224) >> 2) * 256 + ((bid - 224) & 3) * 64;
                    RowArgs c{p->out, XC, p->out, XC, SB, H, modl, modl, npost + DM, npre + 2 * DM, nullptr, nullptr, 1, 2, r0, r0 + 64, 0, 1, 1.0f};
                    row_phase<true, true, false, true>(c, lds, tid);
                }
            }
            GRID_BAR();
        }
        const bool hc = (f == 0) || ctx2;
        { pg8::EpiSwiGLU E{PB, DFF}; run_gemm(lds, H, W + WO_W13 + (size_t)f * 5632 * 1024, hc ? MTOT : MLAT, 5632, DM, E); }
        GRID_BAR();
        { pg8::EpiBf16<0> E{SB, DM, 0}; run_gemm(lds, PB, W + WO_W2 + (size_t)f * 1024 * 2816, MLAT, DM, DFF, E); }
        GRID_BAR();
        {
            const int vg = hc ? 224 : G;
            const bool has_pre = (f == 0) || (l == 0);
            RowArgs a{(l == 0 && f == 0) ? p->in[I_X] : p->out, (l == 0 && f == 0) ? p->in[I_CTX] : XC, p->out, XC, SB, H, modl, f == 0 ? modl : mod + (size_t)9 * 9216,
                      npost + (f == 0 ? 0 : 2 * DM), f == 0 ? npre + DM : p->in[I_NPRE] + 3 * DM, p->in[I_WIN] + (size_t)l * DM * DIN + 2304, gates, f == 0 ? 0 : 2, f == 0 ? 1 : 0, 0, MLAT, bid < vg ? bid : -1, vg, 0.5f};
            if (bid < vg) {
                if (f == 0) row_phase<true, true, true>(a, lds, tid);
                else if (has_pre) row_phase<true, true, false>(a, lds, tid);
                else row_phase<true, false, false>(a, lds, tid);
            } else {
                run_gemm_ctx_cnt(lds, PB, W + WO_W2 + (size_t)f * 1024 * 2816, DM, DFF, SB, (unsigned*)(ws) + 12288 + (l * 4 + f) * 128);
                const int r0 = MLAT + ((bid - 224) >> 2) * 256 + ((bid - 224) & 3) * 64;
                RowArgs c = a; c.row0 = r0; c.row1 = r0 + 64; c.vb = 0; c.vg = 1;
                if (f == 0) row_phase<true, true, true, true>(c, lds, tid);
                else row_phase<true, true, false, true>(c, lds, tid);
            }
        }
        if (!(l == 1 && f == 1)) GRID_BAR();
      }
    }
#ifdef DBG_SEL
    GRID_BAR();
    if (blockIdx.x == 0) {
        const unsigned long long* dbg = (const unsigned long long*)(ws + WS_LB + 4096);
        long long K = DBG_FIXED ? DBG_FIXED : (long long)(dbg[DBG_SEL] - dbg[DBG_REF]) / DBG_DIV;
        if (K < 0) K = 0; if (K > 18000) K = 18000;
        float* o = kparams()->out;
        for (int i = threadIdx.x; i < (int)K; i += 512) o[i] += 0.5f;
    }
#endif
#undef tid
#undef ws
#undef W
#undef H
#undef PB
#undef SB
#undef XC
#undef mod
#undef gates
}

extern "C" void kernel_launch(void* const* d_in, const int* in_sizes, int n_in, void* d_out, int out_size, void* d_ws, size_t ws_size, hipStream_t stream) {
    static int grid = 0;
    if (grid == 0) {
        if (n_in != 22 || out_size != MLAT * DM || ws_size < WS_END) { fprintf(stderr, "kernel_launch: unexpected shapes (n_in %d out %d ws %zu)\n", n_in, out_size, ws_size); grid = -1; return; }
        int dev = 0, cus = 0, per_cu = 0;
        (void)hipGetDevice(&dev);
        (void)hipDeviceGetAttribute(&cus, hipDeviceAttributeMultiprocessorCount, dev);
        (void)hipFuncSetAttribute((const void*)fwd_kernel, hipFuncAttributeMaxDynamicSharedMemorySize, LDS_BYTES);
        (void)hipOccupancyMaxActiveBlocksPerMultiprocessor(&per_cu, (const void*)fwd_kernel, 512, LDS_BYTES);
        if (per_cu < 1) per_cu = 1;
        if (per_cu > 1) per_cu = 1;
        grid = cus * per_cu;
        if (grid <= 0) grid = 256;
    }
    if (grid < 0) return;
    if (grid < 192) { fprintf(stderr, "kernel_launch: grid %d too small for the paired scans\n", grid); return; }
    (void)hipMemsetAsync(d_ws, 0, 65536, stream);
    Params p{};
    for (int i = 0; i < 22; ++i) p.in[i] = (const float*)d_in[i];
    p.out = (float*)d_out; p.ws = (unsigned char*)d_ws;
    void* args[] = {&p};
    hipError_t e = hipLaunchCooperativeKernel((const void*)fwd_kernel, dim3(grid), dim3(512), args, LDS_BYTES, stream);
    if (e != hipSuccess) fprintf(stderr, "cooperative launch failed: %s (grid %d)\n", hipGetErrorString(e), grid);
}
```

```cpp
#include <hip/hip_runtime.h>
#include <hip/hip_cooperative_groups.h>
#include <cstdio>
#include <cstdint>
namespace cg = cooperative_groups;

#define DI __device__ __forceinline__
#define LAS __attribute__((address_space(3)))
typedef unsigned short bf16_t;
typedef short bf16x8 __attribute__((ext_vector_type(8)));
typedef short s16x4 __attribute__((ext_vector_type(4)));
typedef float f32x2 __attribute__((ext_vector_type(2)));
typedef float f32x4 __attribute__((ext_vector_type(4)));
typedef float f32x16 __attribute__((ext_vector_type(16)));
typedef unsigned u32x2 __attribute__((ext_vector_type(2)));
typedef unsigned u32x4 __attribute__((ext_vector_type(4)));

constexpr int DM = 1024, NB = 8, SEQ = 4096, CTXL = 256, DFF = 2816, DIN = 7184, NMOD = 9;
constexpr int MLAT = NB * SEQ, MCTX = NB * CTXL, MTOT = MLAT + MCTX;
constexpr int NPC = 4096;
constexpr int NGC = 3072;
constexpr float EPS = 1e-6f;
constexpr int PC_AQ = 0, PC_AK = 512, PC_AV = 640, PC_MQ = 768, PC_MK = 1024, PC_MV = 1280, PC_MO = 1792, PC_HQ = 2304, PC_HF = 2560, PC_HI = 3072, PC_HG = 3584;

constexpr size_t MiB = 1u << 20;
constexpr size_t WS_MOD = 1 * MiB;
constexpr size_t WS_ROPE = 2 * MiB;
constexpr size_t WS_LB = 2 * MiB + 65536;
constexpr size_t WS_GATES = 3 * MiB;
constexpr size_t WS_XC = 6 * MiB;
constexpr size_t WS_W = 14 * MiB;
constexpr size_t WS_H = 66 * MiB;
constexpr size_t WS_P = 134 * MiB;
constexpr size_t WS_S = 406 * MiB;
constexpr size_t WS_END = 508 * MiB;
constexpr size_t WO_W13 = 0;
constexpr size_t WO_W2 = WO_W13 + (size_t)2 * 5632 * 1024;
constexpr size_t WO_WIN = WO_W2 + (size_t)2 * 1024 * 2816;
constexpr size_t WO_WG = WO_WIN + (size_t)4096 * 1024;
constexpr size_t WO_WB = WO_WG + (size_t)3072 * 1024;
constexpr size_t WO_WOUT = WO_WB + (size_t)3 * 1024 * 512;
constexpr size_t WO_END = WO_WOUT + (size_t)1024 * 1024;
static_assert(WO_END * 2 <= 52 * MiB, "weights fit");
static_assert((size_t)MTOT * 1024 * 2 <= 68 * MiB && (size_t)MTOT * 4096 * 2 <= 272 * MiB && (size_t)MTOT * 512 * 2 * 3 <= 102 * MiB, "ws map");

constexpr int LDS_BYTES = 131072 + 64;
constexpr size_t PTS = (size_t)MTOT * 256;
__device__ __forceinline__ size_t pidx(int row, int col) { return (size_t)(col >> 8) * PTS + (size_t)row * 256 + (col & 255); }

DI unsigned f2bf(float f) { unsigned u = __float_as_uint(f); return (u + 0x7fffu + ((u >> 16) & 1u)) >> 16; }
typedef __bf16 bf16v2 __attribute__((ext_vector_type(2)));
DI unsigned pk2(float lo, float hi) { f32x2 v = {lo, hi}; bf16v2 b = __builtin_convertvector(v, bf16v2); return __builtin_bit_cast(unsigned, b); }
DI float bflo(unsigned w) { return __uint_as_float(w << 16); }
DI float bfhi(unsigned w) { return __uint_as_float(w & 0xffff0000u); }
DI float bf1(short s) { return __uint_as_float(((unsigned)(unsigned short)s) << 16); }
DI float fexp(float x) { return __builtin_amdgcn_exp2f(x * 1.4426950408889634f); }
DI float flog(float x) { return __builtin_amdgcn_logf(x) * 0.6931471805599453f; }
DI float flog1p(float e) { const float u = 1.0f + e, d = u - 1.0f; return d == 0.f ? e : flog(u) * e * __builtin_amdgcn_rcpf(d); }
DI float fsigmoid(float x) { return __builtin_amdgcn_rcpf(1.0f + fexp(-x)); }
DI float fsilu(float x) { return x * fsigmoid(x); }
DI bf16x8 pack8(float a0, float a1, float a2, float a3, float a4, float a5, float a6, float a7) {
    u32x4 p; p.x = pk2(a0, a1); p.y = pk2(a2, a3); p.z = pk2(a4, a5); p.w = pk2(a6, a7); return __builtin_bit_cast(bf16x8, p);
}
#define MFMA32(a, b, c) __builtin_amdgcn_mfma_f32_32x32x16_bf16((a), (b), (c), 0, 0, 0)
DI int crow(int i, int h) { return (i & 3) + 8 * (i >> 2) + 4 * h; }

#define LDS_BARRIER() do { asm volatile("s_waitcnt lgkmcnt(0)" ::: "memory"); __builtin_amdgcn_s_barrier(); asm volatile("" ::: "memory"); } while (0)
template <int CTRL, int ROWMASK> DI float dpp_f(float oldv, float v) { return __uint_as_float((unsigned)__builtin_amdgcn_update_dpp((int)__float_as_uint(oldv), (int)__float_as_uint(v), CTRL, ROWMASK, 0xf, false)); }
DI float wave_scan_add(float v) {
    v += dpp_f<0x111, 0xf>(0.f, v); v += dpp_f<0x112, 0xf>(0.f, v); v += dpp_f<0x114, 0xf>(0.f, v); v += dpp_f<0x118, 0xf>(0.f, v);
    v += dpp_f<0x142, 0xa>(0.f, v); v += dpp_f<0x143, 0xc>(0.f, v); return v;
}
DI float wave_scan_max(float v) {
    const float ninf = -__builtin_inff();
    v = fmaxf(v, dpp_f<0x111, 0xf>(ninf, v)); v = fmaxf(v, dpp_f<0x112, 0xf>(ninf, v)); v = fmaxf(v, dpp_f<0x114, 0xf>(ninf, v)); v = fmaxf(v, dpp_f<0x118, 0xf>(ninf, v));
    v = fmaxf(v, dpp_f<0x142, 0xa>(ninf, v)); v = fmaxf(v, dpp_f<0x143, 0xc>(ninf, v)); return v;
}
DI float lane_bcast(float v, int l) { return __uint_as_float((unsigned)__builtin_amdgcn_readlane((int)__float_as_uint(v), l)); }
DI float wave_sum(float v) { return lane_bcast(wave_scan_add(v), 63); }
namespace pg8 {
#define PG8_LAS __attribute__((address_space(3)))
typedef unsigned short bf16_t;
typedef short bf16x8 __attribute__((ext_vector_type(8)));
typedef float f32x4 __attribute__((ext_vector_type(4)));
typedef unsigned u32x4 __attribute__((ext_vector_type(4)));
constexpr int BM = 256, BK = 64, HALF = 128, HTB = HALF * BK * 2  , STAGE_BYTES = 8 * HTB, NXCD = 8, WGM = 8;

__host__ __device__ __forceinline__ int lds_byte(int r, int c) { const int st = (r >> 4) * 2 + (c >> 5), rr = r & 15, cc = c & 31, ob = rr * 64 + cc * 2; return st * 1024 + (ob ^ (((ob >> 9) & 1) << 5)); }
__host__ __device__ __forceinline__ void stage_rc(int b, int& R, int& C) { const int st = b / 1024, sb = b % 1024, swz = sb ^ (((sb >> 9) & 1) << 5); R = (st >> 1) * 16 + swz / 64; C = (st & 1) * 32 + (swz % 64) / 2; }
__host__ __device__ __forceinline__ int perm32(int rho) { const int n = rho >> 4, i = rho & 15; return 8 * (i >> 2) + 4 * n + (i & 3); }

struct Unit { int pm, pn; int seg = 0; };
struct Gemm { const bf16_t* A; const bf16_t* Bt; int M, N, K; size_t segA = 0, segB = 0; };

struct StaticOrder {
    int nM, nN, nwg, G, c;
    __host__ __device__ void init(int M, int N, int G_, int c_) { nM = M / BM; nN = N / BM; nwg = nM * nN; G = G_; c = c_; }
    __host__ __device__ bool next(int i, Unit& u) const {
        const long L = (long)i * G + c; if (L >= nwg) return false;
        int wgid = (int)L; { const int q = nwg / NXCD, r = nwg % NXCD, xcd = wgid % NXCD, off = wgid / NXCD; wgid = (xcd < r ? xcd * (q + 1) : r * (q + 1) + (xcd - r) * q) + off; }
        const int nig = WGM * nN, gid = wgid / nig, fm = gid * WGM, gsz = (nM - fm) < WGM ? (nM - fm) : WGM;
        u.pm = fm + ((wgid % nig) % gsz); u.pn = (wgid % nig) / gsz; return true;
    }
    __device__ __forceinline__ void a_ready(const Unit&) const {}
    __device__ __forceinline__ void done(const Unit&) const {}
};

struct CtxOrder {
    int first, pm0;
    __host__ __device__ bool next(int i, Unit& u) const { const int idx = (int)blockIdx.x - first; if (i != 0 || idx < 0 || idx >= 32) return false; u.pm = pm0 + (idx >> 2); u.pn = idx & 3; return true; }
    __device__ __forceinline__ void a_ready(const Unit&) const {}
    __device__ __forceinline__ void done(const Unit&) const {}
};

struct MergeOrder {
    StaticOrder S;
    __host__ __device__ bool next(int i, Unit& u) const { const int j = i / 3; if (!S.next(j, u)) return false; u.seg = i - 3 * j; return true; }
    __device__ __forceinline__ void a_ready(const Unit&) const {}
    __device__ __forceinline__ void done(const Unit&) const {}
};

template <int ACT  > struct EpiBf16 {
    static constexpr bool PERM = true, AFTER_DRAIN = false;
    bf16_t* O; int ldc; size_t tstride; int segcols = 0;
    __device__ __forceinline__ void operator()(const f32x4 (&acc)[2][2][4][2], const Unit& u, int wr, int wc, int fr, int fq) const {
        const int row0 = u.pm * BM + wr * 64 + fr, col0 = (tstride ? 0 : u.pn * BM) + wc * 32 + 8 * fq + u.seg * segcols;
        bf16_t* Ob = O + (size_t)u.pn * tstride;
#pragma unroll
        for (int ai = 0; ai < 2; ++ai)
#pragma unroll
            for (int m = 0; m < 4; ++m) { bf16_t* rowp = Ob + (size_t)(row0 + ai * HALF + m * 16) * ldc + col0;
#pragma unroll
                for (int bj = 0; bj < 2; ++bj) { f32x4 v0 = acc[ai][bj][m][0], v1 = acc[ai][bj][m][1];
                    if (ACT == 1) {
#pragma unroll
                        for (int k = 0; k < 4; ++k) { v0[k] = fsigmoid(v0[k]); v1[k] = fsigmoid(v1[k]); } }
                    u32x4 w; w.x = pk2(v0[0], v0[1]); w.y = pk2(v0[2], v0[3]); w.z = pk2(v1[0], v1[1]); w.w = pk2(v1[2], v1[3]);
                    *(u32x4*)(rowp + bj * HALF) = w; } }
    }
};
struct EpiSwiGLU {
    static constexpr bool PERM = false, AFTER_DRAIN = false;
    bf16_t* O; int ldc;
    __device__ __forceinline__ void operator()(const f32x4 (&acc)[2][2][4][2], const Unit& u, int wr, int wc, int fr, int fq) const {
        const int row0 = u.pm * BM + wr * 64 + fr, f0 = u.pn * 128 + wc * 16 + 4 * fq;
#pragma unroll
        for (int ai = 0; ai < 2; ++ai)
#pragma unroll
            for (int m = 0; m < 4; ++m) { bf16_t* rowp = O + (size_t)(row0 + ai * HALF + m * 16) * ldc + f0;
#pragma unroll
                for (int bj = 0; bj < 2; ++bj) { const f32x4 a = acc[ai][bj][m][0], b = acc[ai][bj][m][1];
                    u32x2 w; w.x = pk2(fsilu(a[0]) * b[0], fsilu(a[1]) * b[1]); w.y = pk2(fsilu(a[2]) * b[2], fsilu(a[3]) * b[3]);
                    *(u32x2*)(rowp + bj * 64) = w; } }
    }
};
struct EpiMerge {
    static constexpr bool PERM = true, AFTER_DRAIN = false;
    bf16_t* O; const bf16_t* G; bf16_t* T1;
    __device__ __forceinline__ void operator()(const f32x4 (&acc)[2][2][4][2], const Unit& u, int wr, int wc, int fr, int fq) const {
        const int row0 = u.pm * BM + wr * 64 + fr, col0 = u.pn * BM + wc * 32 + 8 * fq, gi = u.seg;
        const bf16_t* src = (gi == 2) ? T1 : O; bf16_t* dst = (gi == 1) ? T1 : O;
#pragma unroll
        for (int ai = 0; ai < 2; ++ai) {
            u32x4 g[4][2]; u32x4 pv[4][2];
#pragma unroll
            for (int m = 0; m < 4; ++m)
#pragma unroll
                for (int bj = 0; bj < 2; ++bj) { const size_t r = (size_t)(row0 + ai * HALF + m * 16); const int c = col0 + bj * HALF;
                    g[m][bj] = *(const u32x4*)(G + r * 3072 + gi * 1024 + c);
                    if (gi > 0) pv[m][bj] = *(const u32x4*)(src + r * 1024 + c); }
            asm volatile("" ::: "memory");
#pragma unroll
            for (int m = 0; m < 4; ++m)
#pragma unroll
                for (int bj = 0; bj < 2; ++bj) { const size_t r = (size_t)(row0 + ai * HALF + m * 16); const int c = col0 + bj * HALF;
                    const u32x4 gv = g[m][bj];
                    const f32x4 v0 = acc[ai][bj][m][0], v1 = acc[ai][bj][m][1];
                    float o0 = bflo(gv.x) * v0[0], o1 = bfhi(gv.x) * v0[1], o2 = bflo(gv.y) * v0[2], o3 = bfhi(gv.y) * v0[3];
                    float o4 = bflo(gv.z) * v1[0], o5 = bfhi(gv.z) * v1[1], o6 = bflo(gv.w) * v1[2], o7 = bfhi(gv.w) * v1[3];
                    if (gi > 0) { const u32x4 a = pv[m][bj];
                        o0 += bflo(a.x); o1 += bfhi(a.x); o2 += bflo(a.y); o3 += bfhi(a.y); o4 += bflo(a.z); o5 += bfhi(a.z); o6 += bflo(a.w); o7 += bfhi(a.w); }
                    u32x4 w; w.x = pk2(o0, o1); w.y = pk2(o2, o3); w.z = pk2(o4, o5); w.w = pk2(o6, o7);
                    *(u32x4*)(dst + r * 1024 + c) = w; }
        }
    }
};

struct EpiGin {
    static constexpr bool PERM = true, AFTER_DRAIN = false;
    bf16_t* O; size_t tstride; const float* lb;
    __device__ __forceinline__ void operator()(const f32x4 (&acc)[2][2][4][2], const Unit& u, int wr, int wc, int fr, int fq) const {
        const int row0 = u.pm * BM + wr * 64 + fr, col0 = wc * 32 + 8 * fq;
        bf16_t* Ob = O + (size_t)u.pn * tstride;
        const int mode = (u.pn == 9) ? 1 : ((u.pn == 10 || u.pn == 11) ? 2 : 0);
#pragma unroll
        for (int bj = 0; bj < 2; ++bj) {
            f32x4 l0 = (f32x4){0.f, 0.f, 0.f, 0.f}, l1 = l0;
            if (mode == 2) { l0 = *(const f32x4*)(lb + col0 + bj * HALF); l1 = *(const f32x4*)(lb + col0 + bj * HALF + 4); }
#pragma unroll
            for (int ai = 0; ai < 2; ++ai)
#pragma unroll
                for (int m = 0; m < 4; ++m) { bf16_t* rowp = Ob + (size_t)(row0 + ai * HALF + m * 16) * 256 + col0 + bj * HALF;
                    f32x4 v0 = acc[ai][bj][m][0], v1 = acc[ai][bj][m][1];
                    if (mode == 1) {
#pragma unroll
                        for (int k = 0; k < 4; ++k) { v0[k] = 0.125f * fsilu(v0[k]); v1[k] = 0.125f * fsilu(v1[k]); }
                    } else if (mode == 2) {
#pragma unroll
                        for (int k = 0; k < 4; ++k) {
                            { const float z = v0[k], ez = fexp(-fabsf(z)), sg = (z >= 0.f ? 1.0f : ez) * __builtin_amdgcn_rcpf(1.0f + ez), lbk = l0[k];
                              v0[k] = (lbk > 0.f) ? flog(lbk + (1.0f - lbk) * sg) : (fminf(z, 0.f) - flog(1.0f + ez)); }
                            { const float z = v1[k], ez = fexp(-fabsf(z)), sg = (z >= 0.f ? 1.0f : ez) * __builtin_amdgcn_rcpf(1.0f + ez), lbk = l1[k];
                              v1[k] = (lbk > 0.f) ? flog(lbk + (1.0f - lbk) * sg) : (fminf(z, 0.f) - flog(1.0f + ez)); } }
                    }
                    u32x4 w; w.x = pk2(v0[0], v0[1]); w.y = pk2(v0[2], v0[3]); w.z = pk2(v1[0], v1[1]); w.w = pk2(v1[2], v1[3]);
                    *(u32x4*)rowp = w; }
        }
    }
};

struct EpiBf16Cnt {
    static constexpr bool PERM = true, AFTER_DRAIN = false;
    bf16_t* O; int ldc; unsigned* cnt; int pm0;
    __device__ __forceinline__ void operator()(const f32x4 (&acc)[2][2][4][2], const Unit& u, int wr, int wc, int fr, int fq) const {
        const int row0 = u.pm * BM + wr * 64 + fr, col0 = u.pn * BM + wc * 32 + 8 * fq;
#pragma unroll
        for (int ai = 0; ai < 2; ++ai)
#pragma unroll
            for (int m = 0; m < 4; ++m) { bf16_t* rowp = O + (size_t)(row0 + ai * HALF + m * 16) * ldc + col0;
#pragma unroll
                for (int bj = 0; bj < 2; ++bj) { const f32x4 v0 = acc[ai][bj][m][0], v1 = acc[ai][bj][m][1];
                    const unsigned long long lo = ((unsigned long long)pk2(v0[2], v0[3]) << 32) | pk2(v0[0], v0[1]), hi = ((unsigned long long)pk2(v1[2], v1[3]) << 32) | pk2(v1[0], v1[1]);
                    unsigned long long* q = (unsigned long long*)(rowp + bj * HALF);
                    __hip_atomic_store(q, lo, __ATOMIC_RELAXED, __HIP_MEMORY_SCOPE_AGENT); __hip_atomic_store(q + 1, hi, __ATOMIC_RELAXED, __HIP_MEMORY_SCOPE_AGENT); } }
        asm volatile("s_waitcnt vmcnt(0)" ::: "memory");
        if (fr == 0 && fq == 0) __hip_atomic_fetch_add(cnt + 16 * (u.pm - pm0), 1u, __ATOMIC_RELAXED, __HIP_MEMORY_SCOPE_AGENT);
    }
};
template <class Epi, class Sched, bool ALIGN_EPI = false, bool SP2 = false>
__device__ __forceinline__ void gemm_phase(PG8_LAS unsigned char* lds, const Gemm g, const Sched& S, const Epi& E) {
    int tid_ = threadIdx.x; asm volatile("" : "+v"(tid_));
    const int tid = tid_, wid = __builtin_amdgcn_readfirstlane(tid >> 6), lane = tid & 63, wr = wid >> 2, wc = wid & 3, fr = lane & 15, fq = lane >> 4;
    const int K = g.K, nt = K / BK;
    unsigned voffA[2], voffB[2];
#pragma unroll
    for (int i = 0; i < 2; ++i) { int R, C; stage_rc(tid * 16 + i * 8192, R, C); const int Rb = Epi::PERM ? ((R & ~31) + perm32(R & 31)) : R;
        voffA[i] = (unsigned)(R * K + C) * 2u; voffB[i] = (unsigned)(Rb * K + C) * 2u; }
    const size_t kstep = (size_t)(BK * 2);
    const size_t hstep = (size_t)HALF * K * 2;
    const size_t tstep = 2 * hstep;
    const unsigned ldsw = (unsigned)wid * 1024u;
    const int aoff = lds_byte(wr * 64 + fr, fq * 8), boff = lds_byte(wc * 32 + fr, fq * 8);
#define PG8_SA(b, h) (((b) * 2 + (h)) * HTB)
#define PG8_SB(b, h) ((4 + (b) * 2 + (h)) * HTB)
#define PG8_STAGE(bufoff, gbase, voff) do { _Pragma("unroll") for (int _i = 0; _i < 2; ++_i) \
        __builtin_amdgcn_global_load_lds((const unsigned*)((const char*)(gbase) + (voff)[_i]), (PG8_LAS unsigned*)(lds + (bufoff) + ldsw + _i * 8192), 16, 0, 0); } while (0)
#define PG8_LDA(dst, b, h) do { _Pragma("unroll") for (int m = 0; m < 4; ++m) _Pragma("unroll") for (int k = 0; k < 2; ++k) dst[m][k] = *(const PG8_LAS bf16x8*)(lds + PG8_SA(b, h) + aoff + m * 2048 + k * 1024); } while (0)
#define PG8_LDB(dst, b, h) do { _Pragma("unroll") for (int n = 0; n < 2; ++n) _Pragma("unroll") for (int k = 0; k < 2; ++k) dst[n][k] = *(const PG8_LAS bf16x8*)(lds + PG8_SB(b, h) + boff + n * 2048 + k * 1024); } while (0)
#define PG8_MMA(ai, bj, At, Bt) do { __builtin_amdgcn_s_setprio(1); _Pragma("unroll") for (int m = 0; m < 4; ++m) _Pragma("unroll") for (int n = 0; n < 2; ++n) _Pragma("unroll") for (int k = 0; k < 2; ++k) \
        acc[ai][bj][m][n] = __builtin_amdgcn_mfma_f32_16x16x32_bf16(Bt[n][k], At[m][k], acc[ai][bj][m][n], 0, 0, 0); __builtin_amdgcn_s_setprio(0); } while (0)
#define PG8_WAIT_V(n) asm volatile("s_waitcnt vmcnt(" #n ")" ::: "memory")
#define PG8_WAIT_L(n) asm volatile("s_waitcnt lgkmcnt(" #n ")" ::: "memory")
#define PG8_BAR __builtin_amdgcn_s_barrier()
#define PG8_SCHED __builtin_amdgcn_sched_barrier(0)
    Unit cur, nxt; int ui = 0;
    if (!S.next(0, cur)) return;
    f32x4 acc[2][2][4][2];
#pragma unroll
    for (int a = 0; a < 2; ++a)
#pragma unroll
        for (int b = 0; b < 2; ++b)
#pragma unroll
            for (int m = 0; m < 4; ++m)
#pragma unroll
                for (int n = 0; n < 2; ++n) acc[a][b][m][n] = (f32x4){0.f, 0.f, 0.f, 0.f};
    bf16x8 At[4][2], B0[2][2], B1[2][2];
    const char* cA = (const char*)g.A + (size_t)cur.pm * tstep + (size_t)cur.seg * g.segA; const char* cB = (const char*)g.Bt + (size_t)cur.pn * tstep + (size_t)cur.seg * g.segB;
    S.a_ready(cur);
    if constexpr (SP2) {
        PG8_STAGE(PG8_SB(0, 0), cB, voffB); PG8_STAGE(PG8_SB(0, 1), cB + hstep, voffB); PG8_STAGE(PG8_SA(0, 0), cA, voffA); PG8_STAGE(PG8_SA(0, 1), cA + hstep, voffA);
        if (wr == 1) PG8_BAR;
        PG8_WAIT_V(2); PG8_BAR;
        PG8_STAGE(PG8_SB(1, 0), cB + kstep, voffB); PG8_STAGE(PG8_SA(1, 0), cA + kstep, voffA); PG8_STAGE(PG8_SB(1, 1), cB + hstep + kstep, voffB);
        PG8_WAIT_V(6); PG8_BAR;
    } else {
        PG8_STAGE(PG8_SB(0, 0), cB, voffB); PG8_STAGE(PG8_SA(0, 0), cA, voffA); PG8_STAGE(PG8_SB(0, 1), cB + hstep, voffB); PG8_STAGE(PG8_SA(0, 1), cA + hstep, voffA);
        if (wr == 1) PG8_BAR;
        PG8_WAIT_V(4); PG8_BAR;
        PG8_STAGE(PG8_SB(1, 0), cB + kstep, voffB); PG8_STAGE(PG8_SA(1, 0), cA + kstep, voffA); PG8_STAGE(PG8_SB(1, 1), cB + hstep + kstep, voffB);
        PG8_WAIT_V(6); PG8_BAR;
    }
    for (;;) {
        const bool has_next = S.next(ui + 1, nxt);
        const char* nA = has_next ? (const char*)g.A + (size_t)nxt.pm * tstep + (size_t)nxt.seg * g.segA : cA; const char* nB = has_next ? (const char*)g.Bt + (size_t)nxt.pn * tstep + (size_t)nxt.seg * g.segB : cB;
        for (int t = 0; t < nt; t += 2) {
            const bool last = (t == nt - 2);
            const char* a1 = cA + (size_t)(t + 1) * kstep;
            const char* a2 = last ? nA : cA + (size_t)(t + 2) * kstep; const char* b2 = last ? nB : cB + (size_t)(t + 2) * kstep;
            const char* a3 = a2 + kstep; const char* b3 = b2 + kstep;
            if (last && has_next) S.a_ready(nxt);
            if constexpr (SP2) {
            PG8_LDB(B0, 0, 0); PG8_LDB(B1, 0, 1); PG8_SCHED; PG8_LDA(At, 0, 0); PG8_STAGE(PG8_SA(1, 1), a1 + hstep, voffA);
            PG8_WAIT_V(8); PG8_WAIT_L(0); PG8_BAR; PG8_MMA(0, 0, At, B0); PG8_MMA(0, 1, At, B1); PG8_BAR; PG8_SCHED;
            PG8_LDA(At, 0, 1); PG8_STAGE(PG8_SB(0, 0), b2, voffB); PG8_STAGE(PG8_SB(0, 1), b2 + hstep, voffB); PG8_STAGE(PG8_SA(0, 0), a2, voffA);
            PG8_WAIT_V(8); PG8_WAIT_L(0); PG8_BAR; PG8_MMA(1, 0, At, B0); PG8_MMA(1, 1, At, B1); PG8_BAR; PG8_SCHED;
            PG8_LDB(B0, 1, 0); PG8_LDB(B1, 1, 1); PG8_SCHED; PG8_LDA(At, 1, 0); PG8_STAGE(PG8_SA(0, 1), a2 + hstep, voffA);
            PG8_WAIT_V(8); PG8_WAIT_L(0); PG8_BAR; PG8_MMA(0, 0, At, B0); PG8_MMA(0, 1, At, B1); PG8_BAR; PG8_SCHED;
            PG8_LDA(At, 1, 1); PG8_STAGE(PG8_SB(1, 0), b3, voffB); PG8_STAGE(PG8_SB(1, 1), b3 + hstep, voffB); PG8_STAGE(PG8_SA(1, 0), a3, voffA);
            PG8_WAIT_V(8); PG8_WAIT_L(0); PG8_BAR; PG8_MMA(1, 0, At, B0); PG8_MMA(1, 1, At, B1); PG8_BAR; PG8_SCHED;
            } else {
            PG8_LDB(B0, 0, 0); PG8_SCHED; PG8_LDA(At, 0, 0); PG8_STAGE(PG8_SA(1, 1), a1 + hstep, voffA);
            PG8_WAIT_L(8); PG8_BAR; PG8_WAIT_L(0); PG8_MMA(0, 0, At, B0); PG8_BAR; PG8_SCHED;
            PG8_LDB(B1, 0, 1); PG8_STAGE(PG8_SB(0, 0), b2, voffB);
            PG8_BAR; PG8_WAIT_L(0); PG8_MMA(0, 1, At, B1); PG8_BAR;
            PG8_LDA(At, 0, 1); PG8_STAGE(PG8_SA(0, 0), a2, voffA);
            PG8_BAR; PG8_WAIT_L(0); PG8_MMA(1, 0, At, B0); PG8_BAR; PG8_SCHED;
            PG8_STAGE(PG8_SB(0, 1), b2 + hstep, voffB);
            PG8_WAIT_V(6); PG8_BAR; PG8_MMA(1, 1, At, B1); PG8_BAR;
            PG8_LDB(B0, 1, 0); PG8_SCHED; PG8_LDA(At, 1, 0); PG8_STAGE(PG8_SA(0, 1), a2 + hstep, voffA);
            PG8_WAIT_L(8); PG8_BAR; PG8_WAIT_L(0); PG8_MMA(0, 0, At, B0); PG8_BAR; PG8_SCHED;
            PG8_LDB(B1, 1, 1); PG8_STAGE(PG8_SB(1, 0), b3, voffB);
            PG8_BAR; PG8_WAIT_L(0); PG8_MMA(0, 1, At, B1); PG8_BAR;
            PG8_LDA(At, 1, 1); PG8_STAGE(PG8_SA(1, 0), a3, voffA);
            PG8_BAR; PG8_WAIT_L(0); PG8_MMA(1, 0, At, B0); PG8_BAR; PG8_SCHED;
            PG8_STAGE(PG8_SB(1, 1), b3 + hstep, voffB);
            PG8_WAIT_V(6); PG8_BAR; PG8_MMA(1, 1, At, B1); PG8_BAR;
            }
        }
        if constexpr (ALIGN_EPI) { if (wr == 0) PG8_BAR; }
        if constexpr (!Epi::AFTER_DRAIN) { E(acc, cur, wr, wc, fr, fq); S.done(cur); }
        if (!has_next) break;
#pragma unroll
        for (int a = 0; a < 2; ++a)
#pragma unroll
            for (int b = 0; b < 2; ++b)
#pragma unroll
                for (int m = 0; m < 4; ++m)
#pragma unroll
                    for (int n = 0; n < 2; ++n) acc[a][b][m][n] = (f32x4){0.f, 0.f, 0.f, 0.f};
        cur = nxt; cA = nA; cB = nB; ++ui;
        if constexpr (ALIGN_EPI) { if (wr == 1) PG8_BAR; }
    }
    PG8_WAIT_V(0);
    if constexpr (!ALIGN_EPI) { if (wr == 0) PG8_BAR; }
    PG8_BAR;
    if constexpr (Epi::AFTER_DRAIN) { E.fused(acc, cur, wr, wc, fr, fq, lds, wid, lane); S.done(cur); }
#undef PG8_SA
#undef PG8_SB
#undef PG8_STAGE
#undef PG8_LDA
#undef PG8_LDB
#undef PG8_MMA
#undef PG8_WAIT_V
#undef PG8_WAIT_L
#undef PG8_BAR
#undef PG8_SCHED
}
}

struct Params { const float* in[22]; float* out; unsigned char* ws; };
typedef const __attribute__((address_space(4))) Params* KP;
DI KP kparams() { KP kp = (KP)__builtin_amdgcn_kernarg_segment_ptr(); asm volatile("" : "+s"(kp)); return kp; }
enum { I_X = 0, I_C, I_CTX, I_CCTX, I_WADA, I_BADA, I_NPRE, I_NPOST, I_W1, I_W3, I_W2, I_WIN, I_SINK, I_MLCONV, I_MLFB, I_MLNORM, I_HGLB, I_HGNORM, I_WBA, I_WBM, I_WBH, I_WOUT };

DI void transpose_item(const float* Wa, const float* Wb, int ldw, int K, bf16_t* dst, int k0, LAS float* scr, int lane) {
    const float* src = (((lane & 31) < 16) ? Wa : Wb) + (lane & 15);
#pragma unroll 8
    for (int i = 0; i < 32; ++i) { const int kk = 2 * i + (lane >> 5); scr[kk * 33 + (lane & 31)] = src[(size_t)(k0 + kk) * ldw]; }
    asm volatile("s_waitcnt lgkmcnt(0)" ::: "memory");
    const int c = lane & 7;
#pragma unroll
    for (int j = 0; j < 4; ++j) { const int n = (lane >> 3) + 8 * j; const LAS float* s = scr + (8 * c) * 33 + n;
        u32x4 o; o.x = pk2(s[0 * 33], s[1 * 33]); o.y = pk2(s[2 * 33], s[3 * 33]); o.z = pk2(s[4 * 33], s[5 * 33]); o.w = pk2(s[6 * 33], s[7 * 33]);
        *(u32x4*)(dst + (size_t)n * K + k0 + 8 * c) = o; }
    asm volatile("s_waitcnt lgkmcnt(0)" ::: "memory");
}
struct Seg { const float* Wa; const float* Wb; int ldw, K, ngroups, colA0, colB0, cstep; bf16_t* dst; };
DI bool seg_run(const Seg& s, int& it, LAS float* scr, int lane) {
    const int nk = s.K / 64, n = s.ngroups * nk;
    if (it >= n) { it -= n; return false; }
    const int gi = it / nk, kb = it % nk;
    transpose_item(s.Wa + s.colA0 + gi * s.cstep, s.Wb + s.colB0 + gi * s.cstep, s.ldw, s.K, s.dst + (size_t)gi * 32 * s.K, kb * 64, scr, lane);
    return true;
}
DI void convert_weights(KP p, int l, LAS unsigned char* lds, const unsigned mask, const int vb, const int vg) {
    int tid_ = threadIdx.x; asm volatile("" : "+v"(tid_));
    const int wave = tid_ >> 6, lane = tid_ & 63;
    if (vb < 0) return;
    LAS float* scr = (LAS float*)(lds + wave * 8704);
    bf16_t* W = (bf16_t*)(p->ws + WS_W);
    const int gw = vb * 8 + wave, NGW = vg * 8;
    constexpr int NITEMS = 2 * 176 * 16 + 2 * 32 * 44 + 128 * 16 + 96 * 16 + 3 * 32 * 8 + 32 * 16;
    for (int item = gw; item < NITEMS; item += NGW) {
        int it = item;
        if (it < 2 * 2816) { const int f = it / 2816; if (!((mask >> f) & 1u)) continue; it -= f * 2816;
            const float* w1 = p->in[I_W1] + (size_t)(l * 2 + f) * DM * DFF; const float* w3 = p->in[I_W3] + (size_t)(l * 2 + f) * DM * DFF;
            Seg s{w1, w3, DFF, DM, 176, 0, 0, 16, W + WO_W13 + (size_t)f * 5632 * 1024}; seg_run(s, it, scr, lane); continue; }
        it -= 2 * 2816;
        if (it < 2 * 1408) { const int f = it / 1408; if (!((mask >> (2 + f)) & 1u)) continue; it -= f * 1408;
            const float* w2 = p->in[I_W2] + (size_t)(l * 2 + f) * DFF * DM;
            Seg s{w2, w2, DM, DFF, 32, 0, 16, 32, W + WO_W2 + (size_t)f * 1024 * 2816}; seg_run(s, it, scr, lane); continue; }
        it -= 2 * 1408;
        const float* win = p->in[I_WIN] + (size_t)l * DM * DIN;
        if (it < 72 * 16) { if (!((mask >> 4) & 1u)) continue; Seg s{win, win, DIN, DM, 72, 0, 16, 32, W + WO_WIN}; seg_run(s, it, scr, lane); continue; }
        it -= 72 * 16;
        if (it < 56 * 16) { if (!((mask >> 5) & 1u)) continue; Seg s{win, win, DIN, DM, 56, 2320, 2336, 32, W + WO_WIN + (size_t)2304 * 1024}; seg_run(s, it, scr, lane); continue; }
        it -= 56 * 16;
        if (it < 96 * 16) { if (!((mask >> 6) & 1u)) continue; Seg s{win, win, DIN, DM, 96, 4112, 4128, 32, W + WO_WG}; seg_run(s, it, scr, lane); continue; }
        it -= 96 * 16;
        if (it < 3 * 256) { const int f = it / 256; if (!((mask >> (7 + f)) & 1u)) continue; it -= f * 256;
            const float* wb = p->in[I_WBA + f] + (size_t)l * 512 * DM;
            Seg s{wb, wb, DM, 512, 32, 0, 16, 32, W + WO_WB + (size_t)f * 1024 * 512}; seg_run(s, it, scr, lane); continue; }
        it -= 3 * 256;
        if (!((mask >> 10) & 1u)) continue;
        { const float* wo = p->in[I_WOUT] + (size_t)l * DM * DM; Seg s{wo, wo, DM, DM, 32, 0, 16, 32, W + WO_WOUT}; seg_run(s, it, scr, lane); }
    }
}

DI void mods_phase(KP p, LAS unsigned char* lds, int tid) {
    asm volatile("" : "+v"(tid));
    const int wave = tid >> 6, lane = tid & 63;
    LAS float* sc = (LAS float*)lds;
    LAS float* red = (LAS float*)(lds + 36864);
    for (int i = tid; i < 9 * 1024; i += 512) { const float v = (i < 8192) ? p->in[I_C][i] : p->in[I_CCTX][i - 8192]; sc[i] = v / (1.0f + expf(-v)); }
    __syncthreads();
    float* mod = (float*)(p->ws + WS_MOD);
    for (int it = blockIdx.x; it < 288; it += gridDim.x) {
        const int l = it / 144, cb = it % 144, col = cb * 64 + lane;
        const float* wp = p->in[I_WADA] + ((size_t)l * 1024 + wave * 128) * 9216 + col;
        float acc[9];
#pragma unroll
        for (int i = 0; i < 9; ++i) acc[i] = 0.f;
#pragma unroll 32
        for (int k = 0; k < 128; ++k) { const float wv = wp[(size_t)k * 9216];
#pragma unroll
            for (int i = 0; i < 9; ++i) acc[i] += sc[i * 1024 + wave * 128 + k] * wv; }
#pragma unroll
        for (int i = 0; i < 9; ++i) red[(wave * 9 + i) * 64 + lane] = acc[i];
        __syncthreads();
        for (int o = tid; o < 576; o += 512) { const int i = o >> 6, ln = o & 63; float s = 0.f;
#pragma unroll
            for (int w = 0; w < 8; ++w) s += red[(w * 9 + i) * 64 + ln];
            mod[((size_t)l * 9 + i) * 9216 + cb * 64 + ln] = s + p->in[I_BADA][(size_t)l * 9216 + cb * 64 + ln]; }
        __syncthreads();
    }
    if (blockIdx.x == gridDim.x - 1) {
        f32x2* tab = (f32x2*)(p->ws + WS_ROPE);
        float* lbt = (float*)(p->ws + WS_LB);
        if (tid < 256) { const float a0 = p->in[I_HGLB][tid], a1 = p->in[I_HGLB][256 + tid]; lbt[tid] = 0.f; lbt[256 + tid] = 1.0f / (1.0f + expf(a0 - a1)); }
        for (int e = tid; e < 1024; e += 512) { const int pos = e >> 4, i = e & 15;
            const float inv = exp2f(-(float)i * (13.287712379549449f / 16.0f));
            const float a = (float)pos * inv; float rev = a * 0.15915494309189535f; rev -= floorf(rev);
            f32x2 cs; cs.x = __builtin_amdgcn_cosf(rev); cs.y = __builtin_amdgcn_sinf(rev); tab[e] = cs; }
    }
}

struct RowArgs {
    const float* xs_lat; const float* xs_ctx; float* xd_lat; float* xd_ctx;
    const bf16_t* Y; bf16_t* H; const float* mod; const float* modpre; const float* gpost; const float* gpre; const float* wgates; float* gates;
    int jpost, jpre, row0, row1, vb, vg; float wpost;
};
template <bool POST, bool PRE, bool GATES, bool YSC = false>
DI void row_phase(const RowArgs& a, LAS unsigned char* lds, int tid) {
    asm volatile("" : "+v"(tid));
    const int wave = tid >> 6, lane = tid & 63;
    LAS f32x4* wl = (LAS f32x4*)lds;
    if (GATES) {
        for (int idx = tid; idx < 1024 * 4; idx += 512) { const int k = idx >> 2, c4 = idx & 3; const int ln = (k & 255) >> 2, j = k >> 8, e = k & 3;
            wl[((j * 4 + e) * 4 + c4) * 64 + ln] = *(const f32x4*)(a.wgates + (size_t)k * DIN + 4 * c4); }
        __syncthreads();
    }
    int row = a.row0 + a.vb * 8 + wave;
    const bool any = a.vb >= 0 && row < a.row1;
    f32x4 xn[4]; u32x2 yn[4];
#define ROW_LOAD(r_) do { const float* src_ = (r_) < MLAT ? a.xs_lat + (size_t)(r_) * DM : a.xs_ctx + (size_t)((r_) - MLAT) * DM; \
        _Pragma("unroll") for (int j = 0; j < 4; ++j) { xn[j] = __builtin_nontemporal_load((const f32x4*)(src_ + 4 * lane + 256 * j)); if (POST) { if (YSC) { const unsigned long long yv_ = __hip_atomic_load((const unsigned long long*)(a.Y + (size_t)(r_) * DM + 4 * lane + 256 * j), __ATOMIC_RELAXED, __HIP_MEMORY_SCOPE_AGENT); yn[j] = (u32x2){(unsigned)yv_, (unsigned)(yv_ >> 32)}; } \
            else yn[j] = __builtin_nontemporal_load((const u32x2*)(a.Y + (size_t)(r_) * DM + 4 * lane + 256 * j)); } } } while (0)
    if (any) ROW_LOAD(row);
    for (; any && row < a.row1; row += a.vg * 8) {
        const int mi = row < MLAT ? (row >> 12) : 8;
        const float* md = a.mod + (size_t)mi * 9216;
        const float* mdp = a.modpre + (size_t)mi * 9216;
        f32x4 x[4]; u32x2 yw[4];
#pragma unroll
        for (int j = 0; j < 4; ++j) { x[j] = xn[j]; if (POST) yw[j] = yn[j]; }
        f32x4 gt[4], gp[4], sh[4], scl[4], gg[4];
#pragma unroll
        for (int j = 0; j < 4; ++j) { const int c = 4 * lane + 256 * j;
            if (POST) { gt[j] = *(const f32x4*)(md + (3 * a.jpost + 2) * DM + c); gp[j] = *(const f32x4*)(a.gpost + c); }
            if (PRE) { sh[j] = *(const f32x4*)(mdp + (3 * a.jpre) * DM + c); scl[j] = *(const f32x4*)(mdp + (3 * a.jpre + 1) * DM + c); gg[j] = *(const f32x4*)(a.gpre + c); } }
        const int rnext = row + a.vg * 8;
        if (rnext < a.row1) ROW_LOAD(rnext);
        if (POST) {
            f32x4 y[4]; float s = 0.f;
#pragma unroll
            for (int j = 0; j < 4; ++j) { const u32x2 w = yw[j];
                y[j] = (f32x4){bflo(w.x), bfhi(w.x), bflo(w.y), bfhi(w.y)}; s += (y[j][0] * y[j][0] + y[j][1] * y[j][1]) + (y[j][2] * y[j][2] + y[j][3] * y[j][3]); }
            const float rstd = 1.0f / sqrtf(wave_sum(s) * (1.0f / DM) + EPS);
            float* dst = row < MLAT ? a.xd_lat + (size_t)row * DM : a.xd_ctx + (size_t)(row - MLAT) * DM;
#pragma unroll
            for (int j = 0; j < 4; ++j) { const int c = 4 * lane + 256 * j;
                x[j] = x[j] + a.wpost * gt[j] * (y[j] * rstd * gp[j]);
                __builtin_nontemporal_store(x[j], (f32x4*)(dst + c)); }
        }
        if (PRE) {
            float s = 0.f;
#pragma unroll
            for (int j = 0; j < 4; ++j) s += (x[j][0] * x[j][0] + x[j][1] * x[j][1]) + (x[j][2] * x[j][2] + x[j][3] * x[j][3]);
            const float rstd = 1.0f / sqrtf(wave_sum(s) * (1.0f / DM) + EPS);
            f32x4 hv[4]; f32x4 g4[4];
#pragma unroll
            for (int c4 = 0; c4 < 4; ++c4) g4[c4] = (f32x4){0.f, 0.f, 0.f, 0.f};
#pragma unroll
            for (int j = 0; j < 4; ++j) { const int c = 4 * lane + 256 * j;
                hv[j] = (x[j] * rstd * gg[j]) * (1.0f + scl[j]) + sh[j];
                u32x2 w; w.x = pk2(hv[j][0], hv[j][1]); w.y = pk2(hv[j][2], hv[j][3]);
                *(u32x2*)(a.H + (size_t)row * DM + c) = w;
                if (GATES) {
#pragma unroll
                    for (int e = 0; e < 4; ++e)
#pragma unroll
                        for (int c4 = 0; c4 < 4; ++c4) g4[c4] += hv[j][e] * wl[((j * 4 + e) * 4 + c4) * 64 + lane];
                    asm volatile("" ::: "memory");
                } }
            if (GATES) {
#pragma unroll
                for (int c4 = 0; c4 < 4; ++c4)
#pragma unroll
                    for (int k = 0; k < 4; ++k) g4[c4][k] = wave_sum(g4[c4][k]);
                if (lane == 0) {
#pragma unroll
                    for (int c4 = 0; c4 < 4; ++c4) *(f32x4*)(a.gates + (size_t)row * 16 + 4 * c4) = g4[c4]; }
            }
        }
    }
#undef ROW_LOAD
    if (GATES) __syncthreads();
}

constexpr int RS = 144;
constexpr int AT_K = 0, AT_V = 9216, AT_TAB = 18432;
struct AttnArgs { const bf16_t* P; bf16_t* ATT; const float* sink; const f32x2* rope; };

DI void attn_item(const AttnArgs& A, int item, LAS unsigned char* lds, int tid) {
    asm volatile("" : "+v"(tid));
    const int w = tid >> 6, lane = tid & 63, r = lane & 31, hh = lane >> 5;
    const LAS f32x2* tab = (const LAS f32x2*)(lds + AT_TAB);
    int b, g, qb = 0, qrow0; bool lat;
    if (item < 512) { b = item >> 6; g = (item >> 5) & 1; qb = item & 31; lat = true; qrow0 = b * SEQ + qb * 128; }
    else { const int it = item - 512; b = it >> 2; g = (it >> 1) & 1; lat = false; qrow0 = MLAT + b * CTXL + (it & 1) * 128; }
    const int head = g * 4 + (w >> 1), qoff = (w & 1) * 64;
    bf16x8 qf[2][4];
#pragma unroll
    for (int qt = 0; qt < 2; ++qt) {
        const int ql = qoff + 32 * qt + r;
        const bf16_t* qp = A.P + pidx(qrow0 + ql, PC_AQ + head * 64 + 8 * hh);
        float x[4][8];
#pragma unroll
        for (int ks = 0; ks < 4; ++ks) { const u32x4 raw = *(const u32x4*)(qp + 16 * ks);
            x[ks][0] = bflo(raw.x); x[ks][1] = bfhi(raw.x); x[ks][2] = bflo(raw.y); x[ks][3] = bfhi(raw.y); x[ks][4] = bflo(raw.z); x[ks][5] = bfhi(raw.z); x[ks][6] = bflo(raw.w); x[ks][7] = bfhi(raw.w); }
        if (lat) {
            const int t = qb * 128 + ql;
#pragma unroll
            for (int pr = 0; pr < 2; ++pr) { const int pos = pr ? (t & 63) : (t >> 6);
#pragma unroll
                for (int j = 0; j < 8; ++j) { const f32x2 cs = tab[pos * 16 + 8 * hh + j]; const float x1 = x[2 * pr][j], x2 = x[2 * pr + 1][j];
                    x[2 * pr][j] = x1 * cs.x - x2 * cs.y; x[2 * pr + 1][j] = x2 * cs.x + x1 * cs.y; } }
        }
#pragma unroll
        for (int ks = 0; ks < 4; ++ks) qf[qt][ks] = pack8(x[ks][0] * 0.125f, x[ks][1] * 0.125f, x[ks][2] * 0.125f, x[ks][3] * 0.125f, x[ks][4] * 0.125f, x[ks][5] * 0.125f, x[ks][6] * 0.125f, x[ks][7] * 0.125f);
    }
    f32x16 O[2][2];
#pragma unroll
    for (int qt = 0; qt < 2; ++qt)
#pragma unroll
        for (int dt = 0; dt < 2; ++dt)
#pragma unroll
            for (int i = 0; i < 16; ++i) O[qt][dt][i] = 0.f;
    const float sk = A.sink[head];
    float m_run[2] = {sk, sk}, l_run[2];
    l_run[0] = l_run[1] = (hh == 0) ? 1.0f : 0.0f;
    const int ti_hi = (lat && qb == 31) ? 4 : 6;
    int ti = lat ? (qb == 0 ? 2 : 0) : 6;
    const int ss = tid >> 3, sc8 = tid & 7, half = sc8 >> 2, i0 = (sc8 & 3) * 4;
    u32x2 k1, k2; u32x4 vr;
#define ATT_LOAD(tix) do { const int krow_ = ((tix) < 6 ? b * SEQ + 128 * (qb - 1) + 64 * (tix) : MLAT + b * CTXL + 64 * ((tix) - 6)) + ss; \
        const bf16_t* kp_ = A.P + pidx(krow_, PC_AK); \
        k1 = *(const u32x2*)(kp_ + g * 64 + 32 * half + i0); k2 = *(const u32x2*)(kp_ + g * 64 + 32 * half + 16 + i0); \
        vr = *(const u32x4*)(kp_ + (PC_AV - PC_AK) + g * 64 + 8 * sc8); } while (0)
    ATT_LOAD(ti);
    for (;;) {
        {
            float a[4] = {bflo(k1.x), bfhi(k1.x), bflo(k1.y), bfhi(k1.y)}, c[4] = {bflo(k2.x), bfhi(k2.x), bflo(k2.y), bfhi(k2.y)};
            if (ti < 6) { const int kpos = 128 * (qb - 1) + 64 * ti + ss; const int pos = half ? (kpos & 63) : (kpos >> 6);
#pragma unroll
                for (int e = 0; e < 4; ++e) { const f32x2 cs = tab[pos * 16 + i0 + e]; const float x1 = a[e], x2 = c[e]; a[e] = x1 * cs.x - x2 * cs.y; c[e] = x2 * cs.x + x1 * cs.y; } }
            u32x2 o1, o2; o1.x = pk2(a[0], a[1]); o1.y = pk2(a[2], a[3]); o2.x = pk2(c[0], c[1]); o2.y = pk2(c[2], c[3]);
            *(LAS u32x2*)(lds + AT_K + ss * RS + (32 * half + i0) * 2) = o1;
            *(LAS u32x2*)(lds + AT_K + ss * RS + (32 * half + 16 + i0) * 2) = o2;
            const unsigned vv[4] = {vr.x, vr.y, vr.z, vr.w};
#pragma unroll
            for (int e = 0; e < 4; ++e) { *(LAS unsigned short*)(lds + AT_V + (8 * sc8 + 2 * e) * RS + ss * 2) = (unsigned short)(vv[e] & 0xffffu);
                *(LAS unsigned short*)(lds + AT_V + (8 * sc8 + 2 * e + 1) * RS + ss * 2) = (unsigned short)(vv[e] >> 16); }
        }
        LDS_BARRIER();
        const int tn = (ti < 6 && ti + 1 == ti_hi) ? 6 : ti + 1;
        if (tn < 10) ATT_LOAD(tn);
        f32x16 S[2][2];
#pragma unroll
        for (int st = 0; st < 2; ++st) {
            bf16x8 kf[4];
#pragma unroll
            for (int ks = 0; ks < 4; ++ks) kf[ks] = *(const LAS bf16x8*)(lds + AT_K + (32 * st + r) * RS + (16 * ks + 8 * hh) * 2);
#pragma unroll
            for (int qt = 0; qt < 2; ++qt) { f32x16 acc;
#pragma unroll
                for (int i = 0; i < 16; ++i) acc[i] = 0.f;
#pragma unroll
                for (int ks = 0; ks < 4; ++ks) acc = MFMA32(kf[ks], qf[qt][ks], acc);
                S[qt][st] = acc; }
        }
        if (ti < 2 || (ti >= 4 && ti < 6)) {
            const int kp0 = 128 * (qb - 1) + 64 * ti;
#pragma unroll
            for (int qt = 0; qt < 2; ++qt) { const int qpos = qb * 128 + qoff + 32 * qt + r;
#pragma unroll
                for (int st = 0; st < 2; ++st)
#pragma unroll
                    for (int i = 0; i < 16; ++i) { const int df = qpos - (kp0 + 32 * st + crow(i, hh)); if (df > 128 || df < -128) S[qt][st][i] = -INFINITY; } }
        }
#pragma unroll
        for (int qt = 0; qt < 2; ++qt) {
            float mx = S[qt][0][0];
#pragma unroll
            for (int st = 0; st < 2; ++st)
#pragma unroll
                for (int i = 0; i < 16; ++i) mx = fmaxf(mx, S[qt][st][i]);
            mx = fmaxf(mx, __shfl_xor(mx, 32));
            const float mn = fmaxf(m_run[qt], mx), scale = fexp(m_run[qt] - mn);
            m_run[qt] = mn; float ls = 0.f;
#pragma unroll
            for (int st = 0; st < 2; ++st)
#pragma unroll
                for (int i = 0; i < 16; ++i) { const float pv = fexp(S[qt][st][i] - mn); S[qt][st][i] = pv; ls += pv; }
            l_run[qt] = l_run[qt] * scale + ls;
#pragma unroll
            for (int dt = 0; dt < 2; ++dt)
#pragma unroll
                for (int i = 0; i < 16; ++i) O[qt][dt][i] *= scale;
        }
#pragma unroll
        for (int kk = 0; kk < 4; ++kk) { const int st = kk >> 1, s2 = kk & 1;
            bf16x8 pb[2];
#pragma unroll
            for (int qt = 0; qt < 2; ++qt) pb[qt] = pack8(S[qt][st][8 * s2 + 0], S[qt][st][8 * s2 + 1], S[qt][st][8 * s2 + 2], S[qt][st][8 * s2 + 3], S[qt][st][8 * s2 + 4], S[qt][st][8 * s2 + 5], S[qt][st][8 * s2 + 6], S[qt][st][8 * s2 + 7]);
#pragma unroll
            for (int dt = 0; dt < 2; ++dt) {
                const LAS unsigned char* vp = lds + AT_V + (32 * dt + r) * RS + (32 * st + 16 * s2 + 4 * hh) * 2;
                const s16x4 lo = *(const LAS s16x4*)vp, hi = *(const LAS s16x4*)(vp + 16);
                const bf16x8 va = __builtin_shufflevector(lo, hi, 0, 1, 2, 3, 4, 5, 6, 7);
#pragma unroll
                for (int qt = 0; qt < 2; ++qt) O[qt][dt] = MFMA32(va, pb[qt], O[qt][dt]);
            }
        }
        LDS_BARRIER();
        if (tn >= 10) break;
        ti = tn;
    }
#undef ATT_LOAD
#pragma unroll
    for (int qt = 0; qt < 2; ++qt) {
        const float l = l_run[qt] + __shfl_xor(l_run[qt], 32), inv = 1.0f / l;
        bf16_t* op = A.ATT + (size_t)(qrow0 + qoff + 32 * qt + r) * 512 + head * 64;
#pragma unroll
        for (int dt = 0; dt < 2; ++dt)
#pragma unroll
            for (int ig = 0; ig < 4; ++ig) { u32x2 wv; wv.x = pk2(O[qt][dt][4 * ig] * inv, O[qt][dt][4 * ig + 1] * inv); wv.y = pk2(O[qt][dt][4 * ig + 2] * inv, O[qt][dt][4 * ig + 3] * inv);
                *(u32x2*)(op + 32 * dt + 8 * ig + 4 * hh) = wv; }
    }
}

constexpr int SC_QS = 0, SC_KS = 9216, SC_QE = 18432, SC_UKT = 27648, SC_VT = 36864, SC_CBT = 55296, SC_F = 73728;
constexpr int SF_EB = 0, SF_QN = 256, SF_SSQ = 2304, SF_N = 3328, SF_DEC = 3840, SF_CONV = 4096, SF_GN = 5632, SF_CACHE = 6144;
struct ScanArgs { const bf16_t* P; bf16_t* OUT; const float* gates; const float* convw; const float* fbias; const float* gnorm; const float* lbl; int layer; unsigned char* wsdbg; };

template <bool IS_ML>
DI void scan_item(const ScanArgs& A, int b, int hd, const int dir, unsigned* prog_mine, unsigned* prog_other, LAS unsigned char* lds, int tid) {
    asm volatile("" : "+v"(tid));
    const int w = tid >> 6, lane = tid & 63, r = lane & 31, hh = lane >> 5;
    const int etile = w & 3, ttile = w >> 2, dtile = w >> 2;
    LAS float* F = (LAS float*)(lds + SC_F);
    LAS float* eb_s = F + SF_EB / 4; LAS float* qn_s = F + SF_QN / 4; LAS float* ssq_s = F + SF_SSQ / 4; LAS float* n_s = F + SF_N / 4; LAS float* dec_s = F + SF_DEC / 4; LAS float* conv_s = F + SF_CONV / 4;
    LAS float* gn_s = F + SF_GN / 4; LAS unsigned* cache_s = (LAS unsigned*)(F + SF_CACHE / 4);
    const int vcol = (IS_ML ? PC_MV : PC_HI) + hd * 128, gcol = (IS_ML ? PC_MO : PC_HG) + hd * 128;
    __syncthreads();
    if (IS_ML) {
        if (tid < 384) { const int j = tid >> 6, d = tid & 63; conv_s[tid] = A.convw[(j % 3) * 512 + (j / 3) * 256 + hd * 64 + d]; }
    }
    if (tid < 128) { n_s[tid] = 0.f; gn_s[tid] = A.gnorm[hd * 128 + tid]; }
    if (tid == 0) cache_s[0] = 0u;
    f32x16 Cst;
#pragma unroll
    for (int i = 0; i < 16; ++i) Cst[i] = 0.f;
    float m_run = 0.f;
#pragma unroll
    for (int ig = 0; ig < 4; ++ig) *(LAS u32x2*)(lds + SC_CBT + (32 * etile + r) * RS + (32 * dtile + 8 * ig + 4 * hh) * 2) = (u32x2){0u, 0u};
    const float fb = IS_ML ? A.fbias[dir * 4 + hd] : 0.f;
    bool pending = false;
    u32x4 rq[3], rk[3], rv[2]; float rgi = 0.f, rgf = 0.f;
#define SC_ROWS(c_) const int cc_ = (c_) < 4 ? (dir ? 3 - (c_) : (c_)) : (dir ? 67 - (c_) : (c_) - 4); \
    const int slo_ = (c_) < 4 ? MLAT + b * CTXL : b * SEQ, slen_ = (c_) < 4 ? CTXL : SEQ; const int rb_ = slo_ + 64 * cc_;
#define SC_LOAD(c_) do { SC_ROWS(c_) const int ti_ = 64 * cc_ + (dir ? 63 - lane : lane); const int prow_ = slo_ + ti_; \
    if (IS_ML) { const u32x4 z4_ = (u32x4){0u, 0u, 0u, 0u}; \
        const bf16_t* pq_ = A.P + pidx(prow_, PC_MQ + hd * 64 + 8 * w); const bf16_t* pk_ = A.P + pidx(prow_, PC_MK + hd * 64 + 8 * w); rq[1] = *(const u32x4*)pq_; rk[1] = *(const u32x4*)pk_; \
        rq[0] = ti_ > 0 ? *(const u32x4*)(pq_ - 256) : z4_; rk[0] = ti_ > 0 ? *(const u32x4*)(pk_ - 256) : z4_; \
        rq[2] = ti_ + 1 < slen_ ? *(const u32x4*)(pq_ + 256) : z4_; rk[2] = ti_ + 1 < slen_ ? *(const u32x4*)(pk_ + 256) : z4_; \
        const float* gp_ = A.gates + (size_t)(slo_ + ti_) * 16; rgi = gp_[dir * 4 + hd]; rgf = gp_[8 + dir * 4 + hd]; \
    } else { rq[1] = *(const u32x4*)(A.P + pidx(prow_, PC_HQ + hd * 64 + 8 * w)); rk[1] = *(const u32x4*)(A.P + pidx(prow_, PC_HF + dir * 256 + hd * 64 + 8 * w)); } \
    { const bf16_t* pv_ = A.P + pidx(prow_, vcol + 16 * w); rv[0] = *(const u32x4*)pv_; rv[1] = *(const u32x4*)(pv_ + 8); } } while (0)
    SC_LOAD(0);
    __syncthreads();
#ifdef DBG_SEL
    unsigned long long wacc_ = 0;
#endif
#pragma unroll 1
    for (int c = 0; c < 68; ++c) {
#ifdef DBG_SEL
        { const unsigned long long ta_ = __builtin_amdgcn_s_memrealtime(); asm volatile("s_waitcnt vmcnt(0)" ::: "memory"); wacc_ += __builtin_amdgcn_s_memrealtime() - ta_; }
#endif
        float ea = 1.f, wprev = 0.f, enm = 0.f, a_prev = 0.f;
        {
            const unsigned vv[8] = {rv[0].x, rv[0].y, rv[0].z, rv[0].w, rv[1].x, rv[1].y, rv[1].z, rv[1].w};
#pragma unroll
            for (int e = 0; e < 8; ++e) { *(LAS unsigned short*)(lds + SC_VT + (16 * w + 2 * e) * RS + lane * 2) = (unsigned short)(vv[e] & 0xffffu);
                *(LAS unsigned short*)(lds + SC_VT + (16 * w + 2 * e + 1) * RS + lane * 2) = (unsigned short)(vv[e] >> 16); }
        }
        if (IS_ML) {
            const float li = rgi, xf = rgf + fb;
            const float lf = fminf(xf, 0.f) - flog1p(fexp(-fabsf(xf)));
            const float bc = wave_scan_add(lf);
            const float beta = li - bc; const float pm = wave_scan_max(beta);
            const float bl = lane_bcast(bc, 63), pmx = lane_bcast(pm, 63);
            const float mm = fmaxf(m_run, pm), mmx = fmaxf(m_run, pmx);
            ea = fexp(-mm); wprev = fexp(m_run - mm); enm = fexp(-(bc + mm));
            a_prev = fexp(m_run - mmx); const float u = fexp(beta - mmx);
            m_run = bl + mmx;
            if (w == 0) eb_s[lane] = fexp(fminf(beta, 80.f));
            float q8[8], k8[8];
            const unsigned q0[4] = {rq[0].x, rq[0].y, rq[0].z, rq[0].w}, q1[4] = {rq[1].x, rq[1].y, rq[1].z, rq[1].w}, q2[4] = {rq[2].x, rq[2].y, rq[2].z, rq[2].w};
            const unsigned k0[4] = {rk[0].x, rk[0].y, rk[0].z, rk[0].w}, k1[4] = {rk[1].x, rk[1].y, rk[1].z, rk[1].w}, k2[4] = {rk[2].x, rk[2].y, rk[2].z, rk[2].w};
            float cw[6][8];
#pragma unroll
            for (int j = 0; j < 6; ++j) { const f32x4 c0 = *(const LAS f32x4*)(conv_s + j * 64 + 8 * w), c1 = *(const LAS f32x4*)(conv_s + j * 64 + 8 * w + 4);
                cw[j][0] = c0[0]; cw[j][1] = c0[1]; cw[j][2] = c0[2]; cw[j][3] = c0[3]; cw[j][4] = c1[0]; cw[j][5] = c1[1]; cw[j][6] = c1[2]; cw[j][7] = c1[3]; }
#pragma unroll
            for (int e = 0; e < 4; ++e) {
                q8[2 * e] = fsilu(bflo(q0[e]) * cw[0][2 * e] + bflo(q1[e]) * cw[1][2 * e] + bflo(q2[e]) * cw[2][2 * e]);
                q8[2 * e + 1] = fsilu(bfhi(q0[e]) * cw[0][2 * e + 1] + bfhi(q1[e]) * cw[1][2 * e + 1] + bfhi(q2[e]) * cw[2][2 * e + 1]);
                k8[2 * e] = 0.125f * fsilu(bflo(k0[e]) * cw[3][2 * e] + bflo(k1[e]) * cw[4][2 * e] + bflo(k2[e]) * cw[5][2 * e]);
                k8[2 * e + 1] = 0.125f * fsilu(bfhi(k0[e]) * cw[3][2 * e + 1] + bfhi(k1[e]) * cw[4][2 * e + 1] + bfhi(k2[e]) * cw[5][2 * e + 1]); }
            *(LAS bf16x8*)(lds + SC_QS + lane * RS + 16 * w) = pack8(q8[0], q8[1], q8[2], q8[3], q8[4], q8[5], q8[6], q8[7]);
            *(LAS bf16x8*)(lds + SC_KS + lane * RS + 16 * w) = pack8(k8[0], k8[1], k8[2], k8[3], k8[4], k8[5], k8[6], k8[7]);
#pragma unroll
            for (int e = 0; e < 4; ++e) { const unsigned pkv = pk2(u * k8[2 * e], u * k8[2 * e + 1]);
                *(LAS unsigned short*)(lds + SC_UKT + (8 * w + 2 * e) * RS + lane * 2) = (unsigned short)(pkv & 0xffffu);
                *(LAS unsigned short*)(lds + SC_UKT + (8 * w + 2 * e + 1) * RS + lane * 2) = (unsigned short)(pkv >> 16); }
            const LAS float* nv = n_s + (c & 1) * 64 + 8 * w; const f32x4 n0 = *(const LAS f32x4*)nv, n1 = *(const LAS f32x4*)(nv + 4);
            qn_s[lane * 8 + w] = (q8[0] * n0[0] + q8[1] * n0[1] + q8[2] * n0[2] + q8[3] * n0[3]) + (q8[4] * n1[0] + q8[5] * n1[1] + q8[6] * n1[2] + q8[7] * n1[3]);
        } else {
            float x[8], kk[8], qs[8];
            const unsigned qr[4] = {rq[1].x, rq[1].y, rq[1].z, rq[1].w}, zr[4] = {rk[1].x, rk[1].y, rk[1].z, rk[1].w};
#pragma unroll
            for (int e = 0; e < 8; ++e) { x[e] = (e & 1) ? bfhi(zr[e >> 1]) : bflo(zr[e >> 1]); qs[e] = (e & 1) ? bfhi(qr[e >> 1]) : bflo(qr[e >> 1]); kk[e] = 1.0f - fexp(x[e]); }
#pragma unroll
            for (int e = 0; e < 8; ++e) x[e] = wave_scan_add(x[e]);
            float qe[8], qt[8], kt[8], ku[8];
#pragma unroll
            for (int e = 0; e < 8; ++e) { const float bb = x[e];
                const float blv = __uint_as_float(__builtin_amdgcn_readlane(__float_as_uint(bb), 63)), ref = __uint_as_float(__builtin_amdgcn_readlane(__float_as_uint(bb), 31));
                qe[e] = qs[e] * fexp(bb); qt[e] = qs[e] * fexp(fminf(bb - ref, 60.f)); kt[e] = kk[e] * fexp(fminf(ref - bb, 60.f)); ku[e] = kk[e] * fexp(blv - bb);
                if (lane == 0) dec_s[8 * w + e] = fexp(blv); }
#pragma unroll
            for (int e = 0; e < 4; ++e) { const unsigned pkv = pk2(ku[2 * e], ku[2 * e + 1]);
                *(LAS unsigned short*)(lds + SC_UKT + (8 * w + 2 * e) * RS + lane * 2) = (unsigned short)(pkv & 0xffffu);
                *(LAS unsigned short*)(lds + SC_UKT + (8 * w + 2 * e + 1) * RS + lane * 2) = (unsigned short)(pkv >> 16); }
            *(LAS bf16x8*)(lds + SC_QE + lane * RS + 16 * w) = pack8(qe[0], qe[1], qe[2], qe[3], qe[4], qe[5], qe[6], qe[7]);
            *(LAS bf16x8*)(lds + SC_QS + lane * RS + 16 * w) = pack8(qt[0], qt[1], qt[2], qt[3], qt[4], qt[5], qt[6], qt[7]);
            *(LAS bf16x8*)(lds + SC_KS + lane * RS + 16 * w) = pack8(kt[0], kt[1], kt[2], kt[3], kt[4], kt[5], kt[6], kt[7]);
        }
        const bool first_role = (c < 2) || (c >= 4 && c < 36);
        if (pending && !first_role) {
            asm volatile("s_waitcnt vmcnt(0)" ::: "memory"); if (lane == 0) __hip_atomic_fetch_add(prog_mine, 1u, __ATOMIC_RELAXED, __HIP_MEMORY_SCOPE_AGENT); pending = false; }
        if (!first_role && tid == 0) {
            const int cp = (c < 4) ? 3 - c : 71 - c; const unsigned need = 8u * (unsigned)((cp < 2 ? cp : cp - 2) + 1);
            if (cache_s[0] < need) {
                unsigned v; unsigned spins = 0;
                for (;;) { v = __hip_atomic_load(prog_other, __ATOMIC_RELAXED, __HIP_MEMORY_SCOPE_AGENT); if (v >= need) break; __builtin_amdgcn_s_sleep(2); if (++spins > (1u << 24)) break; }
                __builtin_amdgcn_fence(__ATOMIC_ACQUIRE, "agent");
                asm volatile("s_waitcnt vmcnt(0)" ::: "memory");
                cache_s[0] = v;
            }
        }
        LDS_BARRIER();
        SC_ROWS(c)
        const int t = 32 * ttile + r;
        const int orow = rb_ + (dir ? 63 - t : t);
        bf16_t* op = A.OUT + (size_t)orow * 512 + hd * 128 + 32 * etile + 4 * hh;
        unsigned long long prevv[4]; u32x2 gwv[4];
        if (!first_role) {
            const bf16_t* gp = A.P + pidx(orow, gcol + 32 * etile + 4 * hh);
#pragma unroll
            for (int ig = 0; ig < 4; ++ig) { prevv[ig] = __hip_atomic_load((const unsigned long long*)(op + 8 * ig), __ATOMIC_RELAXED, __HIP_MEMORY_SCOPE_AGENT); gwv[ig] = *(const u32x2*)(gp + 8 * ig); }
        }
        if (c + 1 < 68) SC_LOAD(c + 1);
        bf16x8 qf[4];
#pragma unroll
        for (int ks = 0; ks < 4; ++ks) qf[ks] = *(const LAS bf16x8*)(lds + SC_QS + t * RS + (16 * ks + 8 * hh) * 2);
        f32x16 S[2];
#pragma unroll
        for (int st = 0; st < 2; ++st) { f32x16 acc;
#pragma unroll
            for (int i = 0; i < 16; ++i) acc[i] = 0.f;
#pragma unroll
            for (int ks = 0; ks < 4; ++ks) { const bf16x8 kf = *(const LAS bf16x8*)(lds + SC_KS + (32 * st + r) * RS + (16 * ks + 8 * hh) * 2); acc = MFMA32(kf, qf[ks], acc); }
            S[st] = acc; }
        float c1 = 1.0f, c2 = 1.0f;
        if (IS_ML) {
            const float ea_t = __shfl(ea, t), en_t = __shfl(enm, t), wprev_t = __shfl(wprev, t);
            float rs = 0.f;
#pragma unroll
            for (int st = 0; st < 2; ++st)
#pragma unroll
                for (int ig = 0; ig < 4; ++ig) { const f32x4 bt = *(const LAS f32x4*)(eb_s + 32 * st + 8 * ig + 4 * hh);
#pragma unroll
                    for (int k = 0; k < 4; ++k) { const int s = 32 * st + 8 * ig + 4 * hh + k; const float v = (s <= t) ? S[st][4 * ig + k] * bt[k] : 0.f; S[st][4 * ig + k] = v; rs += v; } }
            rs += __shfl_xor(rs, 32);
            const f32x4 qa = *(const LAS f32x4*)(qn_s + t * 8), qb4 = *(const LAS f32x4*)(qn_s + t * 8 + 4);
            const float qn = ((qa[0] + qa[1]) + (qa[2] + qa[3])) + ((qb4[0] + qb4[1]) + (qb4[2] + qb4[3]));
            const float den = wprev_t * qn + ea_t * rs;
            const float inv = 1.0f / fmaxf(fabsf(den), en_t);
            c1 = wprev_t * inv; c2 = ea_t * inv;
            {
                const bf16x8 uk = *(const LAS bf16x8*)(lds + SC_UKT + (8 * w + (lane >> 3)) * RS + 16 * (lane & 7));
                float sacc = ((bf1(uk[0]) + bf1(uk[1])) + (bf1(uk[2]) + bf1(uk[3]))) + ((bf1(uk[4]) + bf1(uk[5])) + (bf1(uk[6]) + bf1(uk[7])));
                sacc += __shfl_xor(sacc, 1); sacc += __shfl_xor(sacc, 2); sacc += __shfl_xor(sacc, 4);
                if ((lane & 7) == 0) n_s[((c + 1) & 1) * 64 + 8 * w + (lane >> 3)] = a_prev * n_s[(c & 1) * 64 + 8 * w + (lane >> 3)] + sacc;
            }
        } else {
#pragma unroll
            for (int st = 0; st < 2; ++st)
#pragma unroll
                for (int i = 0; i < 16; ++i) { const int s = 32 * st + crow(i, hh); if (s > t) S[st][i] = 0.f; }
        }
        f32x16 acc1;
#pragma unroll
        for (int i = 0; i < 16; ++i) acc1[i] = 0.f;
#pragma unroll
        for (int ks = 0; ks < 4; ++ks) { const bf16x8 ca = *(const LAS bf16x8*)(lds + SC_CBT + (32 * etile + r) * RS + (16 * ks + 8 * hh) * 2);
            const bf16x8 qb = IS_ML ? qf[ks] : *(const LAS bf16x8*)(lds + SC_QE + t * RS + (16 * ks + 8 * hh) * 2);
            acc1 = MFMA32(ca, qb, acc1); }
        f32x16 acc2;
        if (IS_ML) {
#pragma unroll
            for (int i = 0; i < 16; ++i) acc2[i] = 0.f;
        } else acc2 = acc1;
#pragma unroll
        for (int kk2 = 0; kk2 < 4; ++kk2) { const int st = kk2 >> 1, s2 = kk2 & 1;
            const LAS unsigned char* vp = lds + SC_VT + (32 * etile + r) * RS + (32 * st + 16 * s2 + 4 * hh) * 2;
            const s16x4 lo = *(const LAS s16x4*)vp, hi = *(const LAS s16x4*)(vp + 16);
            const bf16x8 va = __builtin_shufflevector(lo, hi, 0, 1, 2, 3, 4, 5, 6, 7);
            const bf16x8 pb = pack8(S[st][8 * s2 + 0], S[st][8 * s2 + 1], S[st][8 * s2 + 2], S[st][8 * s2 + 3], S[st][8 * s2 + 4], S[st][8 * s2 + 5], S[st][8 * s2 + 6], S[st][8 * s2 + 7]);
            acc2 = MFMA32(va, pb, acc2); }
        f32x16 hv;
        if (IS_ML) {
#pragma unroll
            for (int i = 0; i < 16; ++i) hv[i] = c1 * acc1[i] + c2 * acc2[i];
        } else hv = acc2;
        if (pending) {
            asm volatile("s_waitcnt vmcnt(0)" ::: "memory"); if (lane == 0) __hip_atomic_fetch_add(prog_mine, 1u, __ATOMIC_RELAXED, __HIP_MEMORY_SCOPE_AGENT); pending = false; }
        if (first_role) {
#pragma unroll
            for (int ig = 0; ig < 4; ++ig) { const unsigned lo_ = pk2(hv[4 * ig], hv[4 * ig + 1]), hi_ = pk2(hv[4 * ig + 2], hv[4 * ig + 3]);
                __hip_atomic_store((unsigned long long*)(op + 8 * ig), ((unsigned long long)hi_ << 32) | lo_, __ATOMIC_RELAXED, __HIP_MEMORY_SCOPE_AGENT); }
            pending = true;
        } else {
            float sq = 0.f;
#pragma unroll
            for (int ig = 0; ig < 4; ++ig) { const unsigned a0 = (unsigned)prevv[ig], a1 = (unsigned)(prevv[ig] >> 32);
                hv[4 * ig] += bflo(a0); hv[4 * ig + 1] += bfhi(a0); hv[4 * ig + 2] += bflo(a1); hv[4 * ig + 3] += bfhi(a1);
                sq += (hv[4 * ig] * hv[4 * ig] + hv[4 * ig + 1] * hv[4 * ig + 1]) + (hv[4 * ig + 2] * hv[4 * ig + 2] + hv[4 * ig + 3] * hv[4 * ig + 3]); }
            sq += __shfl_xor(sq, 32);
            if (hh == 0) ssq_s[etile * 64 + t] = sq;
            LDS_BARRIER();
            const float tot = (ssq_s[t] + ssq_s[64 + t]) + (ssq_s[128 + t] + ssq_s[192 + t]);
            const float rstd = 1.0f / sqrtf(tot * (1.0f / 128.0f) + EPS);
#pragma unroll
            for (int ig = 0; ig < 4; ++ig) { const f32x4 g4 = *(const LAS f32x4*)(gn_s + 32 * etile + 4 * hh + 8 * ig);
                const float g0 = bflo(gwv[ig].x), g1 = bfhi(gwv[ig].x), g2 = bflo(gwv[ig].y), g3 = bfhi(gwv[ig].y);
                const float o0 = hv[4 * ig] * rstd * g4[0] * (IS_ML ? fsigmoid(g0) : fsilu(g0)), o1 = hv[4 * ig + 1] * rstd * g4[1] * (IS_ML ? fsigmoid(g1) : fsilu(g1));
                const float o2 = hv[4 * ig + 2] * rstd * g4[2] * (IS_ML ? fsigmoid(g2) : fsilu(g2)), o3 = hv[4 * ig + 3] * rstd * g4[3] * (IS_ML ? fsigmoid(g3) : fsilu(g3));
                u32x2 wv; wv.x = pk2(o0, o1); wv.y = pk2(o2, o3); *(u32x2*)(op + 8 * ig) = wv; }
        }
        if (IS_ML) {
#pragma unroll
            for (int i = 0; i < 16; ++i) Cst[i] *= a_prev;
        } else {
#pragma unroll
            for (int ig = 0; ig < 4; ++ig) { const f32x4 dv = *(const LAS f32x4*)(dec_s + 32 * dtile + 8 * ig + 4 * hh);
#pragma unroll
                for (int k = 0; k < 4; ++k) Cst[4 * ig + k] *= dv[k]; }
        }
#pragma unroll
        for (int ks = 0; ks < 4; ++ks) { const bf16x8 ua = *(const LAS bf16x8*)(lds + SC_UKT + (32 * dtile + r) * RS + (16 * ks + 8 * hh) * 2);
            const bf16x8 vb = *(const LAS bf16x8*)(lds + SC_VT + (32 * etile + r) * RS + (16 * ks + 8 * hh) * 2);
            Cst = MFMA32(ua, vb, Cst); }
        LDS_BARRIER();
#pragma unroll
        for (int ig = 0; ig < 4; ++ig) { u32x2 wv; wv.x = pk2(Cst[4 * ig], Cst[4 * ig + 1]); wv.y = pk2(Cst[4 * ig + 2], Cst[4 * ig + 3]);
            *(LAS u32x2*)(lds + SC_CBT + (32 * etile + r) * RS + (32 * dtile + 8 * ig + 4 * hh) * 2) = wv; }
    }
    if (pending) { asm volatile("s_waitcnt vmcnt(0)" ::: "memory"); if (lane == 0) __hip_atomic_fetch_add(prog_mine, 1u, __ATOMIC_RELAXED, __HIP_MEMORY_SCOPE_AGENT); }
#undef SC_LOAD
#undef SC_ROWS
#ifdef DBG_SEL
    if (IS_ML && blockIdx.x == 0 && tid == 0 && A.layer == 0) { unsigned long long* d_ = (unsigned long long*)(A.wsdbg + WS_LB + 4096); d_[40] = wacc_; d_[41] = 0; }
#endif
    __syncthreads();
}
#ifndef PH
#define PH 0xffff
#endif

#define XB_TMO      128
#define XB_XCNT(j)  (256  + 64 * (j))
#define XB_XSUB(j)  (1280 + 64 * (j))
#define XB_XGEN(j)  (2304 + 64 * (j))
#define XB_TOP      3328
#define XB_TOPGEN   3392
#define XCD_BAR_WORDS 3456
#define XB_SPIN_CAP (1u << 18)

__device__ __forceinline__ unsigned xb_ld(unsigned* p)              { return __hip_atomic_load(p, __ATOMIC_RELAXED, __HIP_MEMORY_SCOPE_AGENT); }
__device__ __forceinline__ unsigned xb_add(unsigned* p, unsigned v) { return __hip_atomic_fetch_add(p, v, __ATOMIC_RELAXED, __HIP_MEMORY_SCOPE_AGENT); }
__device__ __forceinline__ unsigned xb_xcc_id() { return (unsigned)__builtin_amdgcn_s_getreg((3 << 11) | 20) & 0xFu; }
#define XB_SPIN(cond, bar) do { unsigned _sp = 0; while (cond) { __builtin_amdgcn_s_sleep(1); \
    if ((++_sp & 255u) == 0u) { if (xb_ld(&(bar)[XB_TMO])) break; if (_sp > XB_SPIN_CAP) { atomicAdd(&(bar)[XB_TMO], 1u); break; } } } } while (0)

struct XcdBarrier {
    unsigned* bar; unsigned x;
    volatile LAS unsigned* st;
};

__device__ __forceinline__ XcdBarrier xcd_barrier_post(unsigned* bar, volatile LAS unsigned* st) {
    XcdBarrier b; b.bar = bar; b.x = xb_xcc_id(); b.st = st;
    if (threadIdx.x == 0) (void)xb_add(&bar[XB_XCNT(b.x)], 1u);
    return b;
}
__device__ __forceinline__ void xcd_barrier_complete(unsigned* bar, unsigned x, unsigned& nloc, unsigned& nx) {
    const unsigned G = gridDim.x * gridDim.y * gridDim.z;
    unsigned sum, cnt, mine, sp = 0u;
    for (;;) {
        sum = 0u; cnt = 0u; mine = 0u;
#pragma unroll
        for (unsigned j = 0; j < 16; ++j) { const unsigned c = xb_ld(&bar[XB_XCNT(j)]); sum += c; cnt += (c > 0u) ? 1u : 0u; mine = (j == x) ? c : mine; }
        if (sum == G) break;
        __builtin_amdgcn_s_sleep(1);
        if ((++sp & 255u) == 0u) { if (xb_ld(&bar[XB_TMO])) break; if (sp > XB_SPIN_CAP) { atomicAdd(&bar[XB_TMO], 1u); break; } }
    }
    nloc = mine > 0u ? mine : 1u; nx = cnt > 0u ? cnt : 1u;
}

__device__ __forceinline__ void xcd_barrier(const XcdBarrier& b) {
    asm volatile("s_waitcnt vmcnt(0)" ::: "memory");
    __syncthreads();
    if (threadIdx.x == 0) {
        unsigned* bar = b.bar;
        __builtin_amdgcn_s_waitcnt(0);
        unsigned nloc = b.st[0], nx = b.st[1];
        if (nloc == 0u) { xcd_barrier_complete(bar, b.x, nloc, nx); b.st[0] = nloc; b.st[1] = nx; }
        const unsigned old = xb_add(&bar[XB_XSUB(b.x)], 1u);
        const unsigned gen = old / nloc;
        if (old + 1u == (gen + 1u) * nloc) {
            __builtin_amdgcn_fence(__ATOMIC_RELEASE, "agent");
            asm volatile("s_waitcnt vmcnt(0)" ::: "memory");
            const unsigned og = xb_add(&bar[XB_TOP], 1u);
            const unsigned tg = og / nx;
            if (og + 1u == (tg + 1u) * nx) xb_add(&bar[XB_TOPGEN], 1u);
            else XB_SPIN(xb_ld(&bar[XB_TOPGEN]) == tg, bar);
            __builtin_amdgcn_fence(__ATOMIC_ACQUIRE, "agent");
            xb_add(&bar[XB_XGEN(b.x)], 1u);
            asm volatile("s_waitcnt vmcnt(0)" ::: "memory");
        } else {
            XB_SPIN(xb_ld(&bar[XB_XGEN(b.x)]) == gen, bar);
            __builtin_amdgcn_fence(__ATOMIC_ACQUIRE, "agent");
            asm volatile("s_waitcnt vmcnt(0)" ::: "memory");
        }
    }
    __syncthreads();
}


#ifdef DBG_SEL
#define DBG_BAR() do { DBG_STAMP(ws, 100 + nbar_, 0); ++nbar_; } while (0)
#define DBG_STAMP(ws_, idx, blk) do { if ((int)blockIdx.x == (blk) && threadIdx.x == 0) ((unsigned long long*)((ws_) + WS_LB + 4096))[idx] = __builtin_amdgcn_s_memrealtime(); } while (0)
#else
#define DBG_BAR() do {} while (0)
#define DBG_STAMP(ws_, idx, blk) do {} while (0)
#endif
DI void mix_phase(KP p, int l, LAS unsigned char* lds, int tid) {
    asm volatile("" : "+v"(tid));
    const int G = gridDim.x, bid = blockIdx.x;
    const bf16_t* P = (const bf16_t*)(p->ws + WS_P);
    bf16_t* ATT = (bf16_t*)(p->ws + WS_S); bf16_t* MLB = ATT + (size_t)MTOT * 512; bf16_t* HGB = MLB + (size_t)MTOT * 512;
    const int nattn = 512 + (l == 0 ? 32 : 0);
    DBG_STAMP(p->ws, 10 + 20 * l, 0);
    if (bid < 128) {
        const int it = bid, dir = it & 1, hd = (it >> 1) & 3, b = (it >> 3) & 7, ty = it >> 6;
        unsigned* prog = (unsigned*)p->ws + (l * 128 + (it & ~1)) * 16;
        if (ty == 0) { ScanArgs A{P, MLB, (const float*)(p->ws + WS_GATES), p->in[I_MLCONV] + (size_t)l * 3 * 512, p->in[I_MLFB] + l * 8, p->in[I_MLNORM] + l * 512, p->in[I_HGLB], l, p->ws};
#ifndef NO_SCANML
            scan_item<true>(A, b, hd, dir, prog + dir * 16, prog + (dir ^ 1) * 16, lds, tid);
#endif
        } else { ScanArgs A{P, HGB, (const float*)(p->ws + WS_GATES), p->in[I_MLCONV], p->in[I_MLFB], p->in[I_HGNORM] + l * 512, p->in[I_HGLB], l, p->ws};
#ifndef NO_SCANHG
            scan_item<false>(A, b, hd, dir, prog + dir * 16, prog + (dir ^ 1) * 16, lds, tid);
#endif
        }
    }
    DBG_STAMP(p->ws, 11 + 20 * l, 0); DBG_STAMP(p->ws, 16 + 20 * l, 1); DBG_STAMP(p->ws, 12 + 20 * l, 64);
    if (bid >= 128) {
        __syncthreads();
        const f32x2* rope = (const f32x2*)(p->ws + WS_ROPE);
        for (int i = tid; i < 1024; i += 512) ((LAS f32x2*)(lds + AT_TAB))[i] = rope[i];
        __syncthreads();
        AttnArgs A{P, ATT, p->in[I_SINK] + l * 8, rope};
        for (int it = bid - 128; it < nattn; it += G - 128) {
#ifndef NO_ATTN
 attn_item(A, it, lds, tid);
#endif
 }
        DBG_STAMP(p->ws, 13 + 20 * l, 128);
        __syncthreads();
        convert_weights(p, l, lds, 0x7cau, bid - 128, G - 128);
        if (l == 0) convert_weights(p, 1, lds, 0x35u, bid - 128, G - 128);
        DBG_STAMP(p->ws, 14 + 20 * l, 128);
    }
}

template <class Epi> DI void run_gemm(LAS unsigned char* lds, const bf16_t* A, const bf16_t* Bt, int M, int N, int K, const Epi& E) {
    pg8::Gemm g{A, Bt, M, N, K}; pg8::StaticOrder S; S.init(M, N, (int)gridDim.x, (int)blockIdx.x);
    pg8::gemm_phase<Epi, pg8::StaticOrder, true, true>(lds, g, S, E);
}

template <class Epi> DI void run_gemm_ctx(LAS unsigned char* lds, const bf16_t* A, const bf16_t* Bt, int N, int K, const Epi& E) {
    pg8::Gemm g{A, Bt, MTOT, N, K}; pg8::CtxOrder S{224, MLAT / 256};
    pg8::gemm_phase<Epi, pg8::CtxOrder, true, true>(lds, g, S, E);
}

DI void run_gemm_ctx_cnt(LAS unsigned char* lds, const bf16_t* A, const bf16_t* Bt, int N, int K, bf16_t* O, unsigned* cnt) {
    pg8::Gemm g{A, Bt, MTOT, N, K}; pg8::CtxOrder S{224, MLAT / 256};
    pg8::EpiBf16Cnt E{O, DM, cnt, MLAT / 256};
    pg8::gemm_phase<pg8::EpiBf16Cnt, pg8::CtxOrder, true, true>(lds, g, S, E);
    if (threadIdx.x == 0) {
        unsigned* c = cnt + 16 * (((int)blockIdx.x - 224) >> 2); unsigned spins = 0;
        while (__hip_atomic_load(c, __ATOMIC_RELAXED, __HIP_MEMORY_SCOPE_AGENT) < 32u) { __builtin_amdgcn_s_sleep(2); if (++spins > (1u << 22)) break; }
        __builtin_amdgcn_fence(__ATOMIC_ACQUIRE, "agent");
        asm volatile("s_waitcnt vmcnt(0)" ::: "memory");
    }
    __syncthreads();
}

#define GRID_BAR() do { XcdBarrier xb_; xb_.bar = (unsigned*)(ws) + 8192; xb_.x = xb_xcc_id(); xb_.st = (volatile LAS unsigned*)(lds + 131072); xcd_barrier(xb_); DBG_BAR(); } while (0)
__global__ void __launch_bounds__(512) fwd_kernel(Params p_unused) {
    extern __shared__ __attribute__((aligned(16))) unsigned char lds_raw[];
    LAS unsigned char* lds = (LAS unsigned char*)lds_raw;
    cg::grid_group grid = cg::this_grid();
#define tid ((int)threadIdx.x)
#define ws (kparams()->ws)
#define W ((bf16_t*)(ws + WS_W))
#define H ((bf16_t*)(ws + WS_H))
#define PB ((bf16_t*)(ws + WS_P))
#define SB ((bf16_t*)(ws + WS_S))
#define XC ((float*)(ws + WS_XC))
#define mod ((const float*)(ws + WS_MOD))
#define gates ((float*)(ws + WS_GATES))
    KP p = kparams();
    int nbar_ = 0; (void)nbar_;
    DBG_STAMP(ws, 99, 0);
    if (threadIdx.x < 16) ((LAS unsigned*)(lds + 131072))[threadIdx.x] = 0u;
    __syncthreads();
    (void)xcd_barrier_post((unsigned*)(ws) + 8192, (volatile LAS unsigned*)(lds + 131072));

#if PH & 1
    convert_weights(p, 0, lds, 0x35u, (int)blockIdx.x, (int)gridDim.x);
    __syncthreads();
    mods_phase(p, lds, tid);
#endif
    if (ws == nullptr) grid.sync();
    GRID_BAR();
    {
        RowArgs a{p->in[I_X], p->in[I_CTX], nullptr, nullptr, nullptr, H, mod, mod, nullptr, p->in[I_NPRE], nullptr, nullptr, 0, 0, 0, MTOT, (int)blockIdx.x, (int)gridDim.x, 0.f};
#if PH & 2
        row_phase<false, true, false>(a, lds, tid);
#endif
    }
    GRID_BAR();

#pragma unroll 1
    for (int l = 0; l < 2; ++l) {
#pragma unroll 1
      for (int f = 0; f < 2; ++f) {
        p = kparams();
        const float* modl = mod + (size_t)l * 9 * 9216;
        const float* npre = p->in[I_NPRE] + (size_t)l * 3 * DM; const float* npost = p->in[I_NPOST] + (size_t)l * 3 * DM;
        const bool ctx2 = (l == 0);
        const int bid = (int)blockIdx.x, G = (int)gridDim.x;
        if (f == 1) {
            { pg8::EpiGin E{PB, PTS, (const float*)(ws + WS_LB) + l * 256}; run_gemm(lds, H, W + WO_WIN, MTOT, NPC, DM, E); }
            GRID_BAR();
            mix_phase(p, l, lds, tid);
            GRID_BAR();
            DBG_STAMP(ws, 15 + 20 * l, 0);
            { pg8::EpiBf16<1> E{PB, NGC, 0}; run_gemm(lds, H, W + WO_WG, ctx2 ? MTOT : MLAT, NGC, DM, E); }
            GRID_BAR();
            {
                const int Mm = ctx2 ? MTOT : MLAT;
                pg8::Gemm g{SB, W + WO_WB, Mm, DM, 512, (size_t)MTOT * 512 * 2, (size_t)1024 * 512 * 2};
                pg8::MergeOrder S; S.S.init(Mm, DM, (int)gridDim.x, (int)blockIdx.x);
                pg8::EpiMerge E{H, PB, PB + (size_t)MTOT * NGC};
                pg8::gemm_phase<pg8::EpiMerge, pg8::MergeOrder, true, true>(lds, g, S, E);
            }
            GRID_BAR();
            { pg8::EpiBf16<0> E{SB, DM, 0}; run_gemm(lds, H, W + WO_WOUT, MLAT, DM, DM, E); }
            GRID_BAR();
            {
                const int vg = ctx2 ? 224 : G;
                RowArgs a{p->out, XC, p->out, XC, SB, H, modl, modl, npost + DM, npre + 2 * DM, nullptr, nullptr, 1, 2, 0, MLAT, bid < vg ? bid : -1, vg, 1.0f};
                if (bid < vg) row_phase<true, true, false>(a, lds, tid);
                else {
                    run_gemm_ctx_cnt(lds, H, W + WO_WOUT, DM, DM, SB, (unsigned*)(ws) + 12288 + (l * 4 + 3) * 128);
                    const int r0 = MLAT + ((bid - 224) >> 2) * 256 + ((bid - 224) & 3) * 64;
                    RowArgs c{p->out, XC, p->out, XC, SB, H, modl, modl, npost + DM, npre + 2 * DM, nullptr, nullptr, 1, 2, r0, r0 + 64, 0, 1, 1.0f};
                    row_phase<true, true, false, true>(c, lds, tid);
                }
            }
            GRID_BAR();
        }
        const bool hc = (f == 0) || ctx2;
        { pg8::EpiSwiGLU E{PB, DFF}; run_gemm(lds, H, W + WO_W13 + (size_t)f * 5632 * 1024, hc ? MTOT : MLAT, 5632, DM, E); }
        GRID_BAR();
        { pg8::EpiBf16<0> E{SB, DM, 0}; run_gemm(lds, PB, W + WO_W2 + (size_t)f * 1024 * 2816, MLAT, DM, DFF, E); }
        GRID_BAR();
        {
            const int vg = hc ? 224 : G;
            const bool has_pre = (f == 0) || (l == 0);
            RowArgs a{(l == 0 && f == 0) ? p->in[I_X] : p->out, (l == 0 && f == 0) ? p->in[I_CTX] : XC, p->out, XC, SB, H, modl, f == 0 ? modl : mod + (size_t)9 * 9216,
                      npost + (f == 0 ? 0 : 2 * DM), f == 0 ? npre + DM : p->in[I_NPRE] + 3 * DM, p->in[I_WIN] + (size_t)l * DM * DIN + 2304, gates, f == 0 ? 0 : 2, f == 0 ? 1 : 0, 0, MLAT, bid < vg ? bid : -1, vg, 0.5f};
            if (bid < vg) {
                if (f == 0) row_phase<true, true, true>(a, lds, tid);
                else if (has_pre) row_phase<true, true, false>(a, lds, tid);
                else row_phase<true, false, false>(a, lds, tid);
            } else {
                run_gemm_ctx_cnt(lds, PB, W + WO_W2 + (size_t)f * 1024 * 2816, DM, DFF, SB, (unsigned*)(ws) + 12288 + (l * 4 + f) * 128);
                const int r0 = MLAT + ((bid - 224) >> 2) * 256 + ((bid - 224) & 3) * 64;
                RowArgs c = a; c.row0 = r0; c.row1 = r0 + 64; c.vb = 0; c.vg = 1;
                if (f == 0) row_phase<true, true, true, true>(c, lds, tid);
                else row_phase<true, true, false, true>(c, lds, tid);
            }
        }
        if (!(l == 1 && f == 1)) GRID_BAR();
      }
    }
#ifdef DBG_SEL
    GRID_BAR();
    if (blockIdx.x == 0) {
        const unsigned long long* dbg = (const unsigned long long*)(ws + WS_LB + 4096);
        long long K = DBG_FIXED ? DBG_FIXED : (long long)(dbg[DBG_SEL] - dbg[DBG_REF]) / DBG_DIV;
        if (K < 0) K = 0; if (K > 18000) K = 18000;
        float* o = kparams()->out;
        for (int i = threadIdx.x; i < (int)K; i += 512) o[i] += 0.5f;
    }
#endif
#undef tid
#undef ws
#undef W
#undef H
#undef PB
#undef SB
#undef XC
#undef mod
#undef gates
}

extern "C" void kernel_launch(void* const* d_in, const int* in_sizes, int n_in, void* d_out, int out_size, void* d_ws, size_t ws_size, hipStream_t stream) {
    static int grid = 0;
    if (grid == 0) {
        if (n_in != 22 || out_size != MLAT * DM || ws_size < WS_END) { fprintf(stderr, "kernel_launch: unexpected shapes (n_in %d out %d ws %zu)\n", n_in, out_size, ws_size); grid = -1; return; }
        int dev = 0, cus = 0, per_cu = 0;
        (void)hipGetDevice(&dev);
        (void)hipDeviceGetAttribute(&cus, hipDeviceAttributeMultiprocessorCount, dev);
        (void)hipFuncSetAttribute((const void*)fwd_kernel, hipFuncAttributeMaxDynamicSharedMemorySize, LDS_BYTES);
        (void)hipOccupancyMaxActiveBlocksPerMultiprocessor(&per_cu, (const void*)fwd_kernel, 512, LDS_BYTES);
        if (per_cu < 1) per_cu = 1;
        if (per_cu > 1) per_cu = 1;
        grid = cus * per_cu;
        if (grid <= 0) grid = 256;
    }
    if (grid < 0) return;
    if (grid < 192) { fprintf(stderr, "kernel_launch: grid %d too small for the paired scans\n", grid); return; }
    (void)hipMemsetAsync(d_ws, 0, 65536, stream);
    Params p{};
    for (int i = 0; i < 22; ++i) p.in[i] = (const float*)d_in[i];
    p.out = (float*)d_out; p.ws = (unsigned char*)d_ws;
    void* args[] = {&p};
    hipError_t e = hipLaunchCooperativeKernel((const void*)fwd_kernel, dim3(grid), dim3(512), args, LDS_BYTES, stream);
    if (e != hipSuccess) fprintf(stderr, "cooperative launch failed: %s (grid %d)\n", hipGetErrorString(e), grid);
}
```

```cpp
#include <hip/hip_runtime.h>
#include <hip/hip_cooperative_groups.h>
#include <cstdio>
#include <cstdint>
namespace cg = cooperative_groups;

#define DI __device__ __forceinline__
#define LAS __attribute__((address_space(3)))
typedef unsigned short bf16_t;
typedef short bf16x8 __attribute__((ext_vector_type(8)));
typedef short s16x4 __attribute__((ext_vector_type(4)));
typedef float f32x2 __attribute__((ext_vector_type(2)));
typedef float f32x4 __attribute__((ext_vector_type(4)));
typedef float f32x16 __attribute__((ext_vector_type(16)));
typedef unsigned u32x2 __attribute__((ext_vector_type(2)));
typedef unsigned u32x4 __attribute__((ext_vector_type(4)));

constexpr int DM = 1024, NB = 8, SEQ = 4096, CTXL = 256, DFF = 2816, DIN = 7184, NMOD = 9;
constexpr int MLAT = NB * SEQ, MCTX = NB * CTXL, MTOT = MLAT + MCTX;
constexpr int NPC = 4096;
constexpr int NGC = 3072;
constexpr float EPS = 1e-6f;
constexpr int PC_AQ = 0, PC_AK = 512, PC_AV = 640, PC_MQ = 768, PC_MK = 1024, PC_MV = 1280, PC_MO = 1792, PC_HQ = 2304, PC_HF = 2560, PC_HI = 3072, PC_HG = 3584;

constexpr size_t MiB = 1u << 20;
constexpr size_t WS_MOD = 1 * MiB;
constexpr size_t WS_ROPE = 2 * MiB;
constexpr size_t WS_LB = 2 * MiB + 65536;
constexpr size_t WS_GATES = 3 * MiB;
constexpr size_t WS_XC = 6 * MiB;
constexpr size_t WS_W = 14 * MiB;
constexpr size_t WS_H = 66 * MiB;
constexpr size_t WS_P = 134 * MiB;
constexpr size_t WS_S = 406 * MiB;
constexpr size_t WS_END = 508 * MiB;
constexpr size_t WO_W13 = 0;
constexpr size_t WO_W2 = WO_W13 + (size_t)2 * 5632 * 1024;
constexpr size_t WO_WIN = WO_W2 + (size_t)2 * 1024 * 2816;
constexpr size_t WO_WG = WO_WIN + (size_t)4096 * 1024;
constexpr size_t WO_WB = WO_WG + (size_t)3072 * 1024;
constexpr size_t WO_WOUT = WO_WB + (size_t)3 * 1024 * 512;
constexpr size_t WO_END = WO_WOUT + (size_t)1024 * 1024;
static_assert(WO_END * 2 <= 52 * MiB, "weights fit");
static_assert((size_t)MTOT * 1024 * 2 <= 68 * MiB && (size_t)MTOT * 4096 * 2 <= 272 * MiB && (size_t)MTOT * 512 * 2 * 3 <= 102 * MiB, "ws map");

constexpr int LDS_BYTES = 131072 + 64;
constexpr size_t PTS = (size_t)MTOT * 256;
__device__ __forceinline__ size_t pidx(int row, int col) { return (size_t)(col >> 8) * PTS + (size_t)row * 256 + (col & 255); }

DI unsigned f2bf(float f) { unsigned u = __float_as_uint(f); return (u + 0x7fffu + ((u >> 16) & 1u)) >> 16; }
typedef __bf16 bf16v2 __attribute__((ext_vector_type(2)));
DI unsigned pk2(float lo, float hi) { f32x2 v = {lo, hi}; bf16v2 b = __builtin_convertvector(v, bf16v2); return __builtin_bit_cast(unsigned, b); }
DI float bflo(unsigned w) { return __uint_as_float(w << 16); }
DI float bfhi(unsigned w) { return __uint_as_float(w & 0xffff0000u); }
DI float bf1(short s) { return __uint_as_float(((unsigned)(unsigned short)s) << 16); }
DI float fexp(float x) { return __builtin_amdgcn_exp2f(x * 1.4426950408889634f); }
DI float flog(float x) { return __builtin_amdgcn_logf(x) * 0.6931471805599453f; }
DI float flog1p(float e) { const float u = 1.0f + e, d = u - 1.0f; return d == 0.f ? e : flog(u) * e * __builtin_amdgcn_rcpf(d); }
DI float fsigmoid(float x) { return __builtin_amdgcn_rcpf(1.0f + fexp(-x)); }
DI float fsilu(float x) { return x * fsigmoid(x); }
DI bf16x8 pack8(float a0, float a1, float a2, float a3, float a4, float a5, float a6, float a7) {
    u32x4 p; p.x = pk2(a0, a1); p.y = pk2(a2, a3); p.z = pk2(a4, a5); p.w = pk2(a6, a7); return __builtin_bit_cast(bf16x8, p);
}
#define MFMA32(a, b, c) __builtin_amdgcn_mfma_f32_32x32x16_bf16((a), (b), (c), 0, 0, 0)
DI int crow(int i, int h) { return (i & 3) + 8 * (i >> 2) + 4 * h; }

#define LDS_BARRIER() do { asm volatile("s_waitcnt lgkmcnt(0)" ::: "memory"); __builtin_amdgcn_s_barrier(); asm volatile("" ::: "memory"); } while (0)
template <int CTRL, int ROWMASK> DI float dpp_f(float oldv, float v) { return __uint_as_float((unsigned)__builtin_amdgcn_update_dpp((int)__float_as_uint(oldv), (int)__float_as_uint(v), CTRL, ROWMASK, 0xf, false)); }
DI float wave_scan_add(float v) {
    v += dpp_f<0x111, 0xf>(0.f, v); v += dpp_f<0x112, 0xf>(0.f, v); v += dpp_f<0x114, 0xf>(0.f, v); v += dpp_f<0x118, 0xf>(0.f, v);
    v += dpp_f<0x142, 0xa>(0.f, v); v += dpp_f<0x143, 0xc>(0.f, v); return v;
}
DI float wave_scan_max(float v) {
    const float ninf = -__builtin_inff();
    v = fmaxf(v, dpp_f<0x111, 0xf>(ninf, v)); v = fmaxf(v, dpp_f<0x112, 0xf>(ninf, v)); v = fmaxf(v, dpp_f<0x114, 0xf>(ninf, v)); v = fmaxf(v, dpp_f<0x118, 0xf>(ninf, v));
    v = fmaxf(v, dpp_f<0x142, 0xa>(ninf, v)); v = fmaxf(v, dpp_f<0x143, 0xc>(ninf, v)); return v;
}
DI float lane_bcast(float v, int l) { return __uint_as_float((unsigned)__builtin_amdgcn_readlane((int)__float_as_uint(v), l)); }
DI float wave_sum(float v) { return lane_bcast(wave_scan_add(v), 63); }
namespace pg8 {
#define PG8_LAS __attribute__((address_space(3)))
typedef unsigned short bf16_t;
typedef short bf16x8 __attribute__((ext_vector_type(8)));
typedef float f32x4 __attribute__((ext_vector_type(4)));
typedef unsigned u32x4 __attribute__((ext_vector_type(4)));
constexpr int BM = 256, BK = 64, HALF = 128, HTB = HALF * BK * 2  , STAGE_BYTES = 8 * HTB, NXCD = 8, WGM = 8;

__host__ __device__ __forceinline__ int lds_byte(int r, int c) { const int st = (r >> 4) * 2 + (c >> 5), rr = r & 15, cc = c & 31, ob = rr * 64 + cc * 2; return st * 1024 + (ob ^ (((ob >> 9) & 1) << 5)); }
__host__ __device__ __forceinline__ void stage_rc(int b, int& R, int& C) { const int st = b / 1024, sb = b % 1024, swz = sb ^ (((sb >> 9) & 1) << 5); R = (st >> 1) * 16 + swz / 64; C = (st & 1) * 32 + (swz % 64) / 2; }
__host__ __device__ __forceinline__ int perm32(int rho) { const int n = rho >> 4, i = rho & 15; return 8 * (i >> 2) + 4 * n + (i & 3); }

struct Unit { int pm, pn; int seg = 0; };
struct Gemm { const bf16_t* A; const bf16_t* Bt; int M, N, K; size_t segA = 0, segB = 0; };

struct StaticOrder {
    int nM, nN, nwg, G, c;
    __host__ __device__ void init(int M, int N, int G_, int c_) { nM = M / BM; nN = N / BM; nwg = nM * nN; G = G_; c = c_; }
    __host__ __device__ bool next(int i, Unit& u) const {
        const long L = (long)i * G + c; if (L >= nwg) return false;
        int wgid = (int)L; { const int q = nwg / NXCD, r = nwg % NXCD, xcd = wgid % NXCD, off = wgid / NXCD; wgid = (xcd < r ? xcd * (q + 1) : r * (q + 1) + (xcd - r) * q) + off; }
        const int nig = WGM * nN, gid = wgid / nig, fm = gid * WGM, gsz = (nM - fm) < WGM ? (nM - fm) : WGM;
        u.pm = fm + ((wgid % nig) % gsz); u.pn = (wgid % nig) / gsz; return true;
    }
    __device__ __forceinline__ void a_ready(const Unit&) const {}
    __device__ __forceinline__ void done(const Unit&) const {}
};

struct CtxOrder {
    int first, pm0;
    __host__ __device__ bool next(int i, Unit& u) const { const int idx = (int)blockIdx.x - first; if (i != 0 || idx < 0 || idx >= 32) return false; u.pm = pm0 + (idx >> 2); u.pn = idx & 3; return true; }
    __device__ __forceinline__ void a_ready(const Unit&) const {}
    __device__ __forceinline__ void done(const Unit&) const {}
};

struct MergeOrder {
    StaticOrder S;
    __host__ __device__ bool next(int i, Unit& u) const { const int j = i / 3; if (!S.next(j, u)) return false; u.seg = i - 3 * j; return true; }
    __device__ __forceinline__ void a_ready(const Unit&) const {}
    __device__ __forceinline__ void done(const Unit&) const {}
};

template <int ACT  > struct EpiBf16 {
    static constexpr bool PERM = true, AFTER_DRAIN = false;
    bf16_t* O; int ldc; size_t tstride; int segcols = 0;
    __device__ __forceinline__ void operator()(const f32x4 (&acc)[2][2][4][2], const Unit& u, int wr, int wc, int fr, int fq) const {
        const int row0 = u.pm * BM + wr * 64 + fr, col0 = (tstride ? 0 : u.pn * BM) + wc * 32 + 8 * fq + u.seg * segcols;
        bf16_t* Ob = O + (size_t)u.pn * tstride;
#pragma unroll
        for (int ai = 0; ai < 2; ++ai)
#pragma unroll
            for (int m = 0; m < 4; ++m) { bf16_t* rowp = Ob + (size_t)(row0 + ai * HALF + m * 16) * ldc + col0;
#pragma unroll
                for (int bj = 0; bj < 2; ++bj) { f32x4 v0 = acc[ai][bj][m][0], v1 = acc[ai][bj][m][1];
                    if (ACT == 1) {
#pragma unroll
                        for (int k = 0; k < 4; ++k) { v0[k] = fsigmoid(v0[k]); v1[k] = fsigmoid(v1[k]); } }
                    u32x4 w; w.x = pk2(v0[0], v0[1]); w.y = pk2(v0[2], v0[3]); w.z = pk2(v1[0], v1[1]); w.w = pk2(v1[2], v1[3]);
                    *(u32x4*)(rowp + bj * HALF) = w; } }
    }
};
struct EpiSwiGLU {
    static constexpr bool PERM = false, AFTER_DRAIN = false;
    bf16_t* O; int ldc;
    __device__ __forceinline__ void operator()(const f32x4 (&acc)[2][2][4][2], const Unit& u, int wr, int wc, int fr, int fq) const {
        const int row0 = u.pm * BM + wr * 64 + fr, f0 = u.pn * 128 + wc * 16 + 4 * fq;
#pragma unroll
        for (int ai = 0; ai < 2; ++ai)
#pragma unroll
            for (int m = 0; m < 4; ++m) { bf16_t* rowp = O + (size_t)(row0 + ai * HALF + m * 16) * ldc + f0;
#pragma unroll
                for (int bj = 0; bj < 2; ++bj) { const f32x4 a = acc[ai][bj][m][0], b = acc[ai][bj][m][1];
                    u32x2 w; w.x = pk2(fsilu(a[0]) * b[0], fsilu(a[1]) * b[1]); w.y = pk2(fsilu(a[2]) * b[2], fsilu(a[3]) * b[3]);
                    *(u32x2*)(rowp + bj * 64) = w; } }
    }
};
struct EpiMerge {
    static constexpr bool PERM = true, AFTER_DRAIN = false;
    bf16_t* O; const bf16_t* G; bf16_t* T1;
    __device__ __forceinline__ void operator()(const f32x4 (&acc)[2][2][4][2], const Unit& u, int wr, int wc, int fr, int fq) const {
        const int row0 = u.pm * BM + wr * 64 + fr, col0 = u.pn * BM + wc * 32 + 8 * fq, gi = u.seg;
        const bf16_t* src = (gi == 2) ? T1 : O; bf16_t* dst = (gi == 1) ? T1 : O;
#pragma unroll
        for (int ai = 0; ai < 2; ++ai) {
            u32x4 g[4][2]; u32x4 pv[4][2];
#pragma unroll
            for (int m = 0; m < 4; ++m)
#pragma unroll
                for (int bj = 0; bj < 2; ++bj) { const size_t r = (size_t)(row0 + ai * HALF + m * 16); const int c = col0 + bj * HALF;
                    g[m][bj] = __builtin_nontemporal_load((const u32x4*)(G + r * 3072 + gi * 1024 + c));
                    if (gi > 0) pv[m][bj] = *(const u32x4*)(src + r * 1024 + c); }
            asm volatile("" ::: "memory");
#pragma unroll
            for (int m = 0; m < 4; ++m)
#pragma unroll
                for (int bj = 0; bj < 2; ++bj) { const size_t r = (size_t)(row0 + ai * HALF + m * 16); const int c = col0 + bj * HALF;
                    const u32x4 gv = g[m][bj];
                    const f32x4 v0 = acc[ai][bj][m][0], v1 = acc[ai][bj][m][1];
                    float o0 = bflo(gv.x) * v0[0], o1 = bfhi(gv.x) * v0[1], o2 = bflo(gv.y) * v0[2], o3 = bfhi(gv.y) * v0[3];
                    float o4 = bflo(gv.z) * v1[0], o5 = bfhi(gv.z) * v1[1], o6 = bflo(gv.w) * v1[2], o7 = bfhi(gv.w) * v1[3];
                    if (gi > 0) { const u32x4 a = pv[m][bj];
                        o0 += bflo(a.x); o1 += bfhi(a.x); o2 += bflo(a.y); o3 += bfhi(a.y); o4 += bflo(a.z); o5 += bfhi(a.z); o6 += bflo(a.w); o7 += bfhi(a.w); }
                    u32x4 w; w.x = pk2(o0, o1); w.y = pk2(o2, o3); w.z = pk2(o4, o5); w.w = pk2(o6, o7);
                    *(u32x4*)(dst + r * 1024 + c) = w; }
        }
    }
};

struct EpiGin {
    static constexpr bool PERM = true, AFTER_DRAIN = false;
    bf16_t* O; size_t tstride; const float* lb;
    __device__ __forceinline__ void operator()(const f32x4 (&acc)[2][2][4][2], const Unit& u, int wr, int wc, int fr, int fq) const {
        const int row0 = u.pm * BM + wr * 64 + fr, col0 = wc * 32 + 8 * fq;
        bf16_t* Ob = O + (size_t)u.pn * tstride;
        const int mode = (u.pn == 9) ? 1 : ((u.pn == 10 || u.pn == 11) ? 2 : 0);
#pragma unroll
        for (int bj = 0; bj < 2; ++bj) {
            f32x4 l0 = (f32x4){0.f, 0.f, 0.f, 0.f}, l1 = l0;
            if (mode == 2) { l0 = *(const f32x4*)(lb + col0 + bj * HALF); l1 = *(const f32x4*)(lb + col0 + bj * HALF + 4); }
#pragma unroll
            for (int ai = 0; ai < 2; ++ai)
#pragma unroll
                for (int m = 0; m < 4; ++m) { bf16_t* rowp = Ob + (size_t)(row0 + ai * HALF + m * 16) * 256 + col0 + bj * HALF;
                    f32x4 v0 = acc[ai][bj][m][0], v1 = acc[ai][bj][m][1];
                    if (mode == 1) {
#pragma unroll
                        for (int k = 0; k < 4; ++k) { v0[k] = 0.125f * fsilu(v0[k]); v1[k] = 0.125f * fsilu(v1[k]); }
                    } else if (mode == 2) {
#pragma unroll
                        for (int k = 0; k < 4; ++k) {
                            { const float z = v0[k], ez = fexp(-fabsf(z)), sg = (z >= 0.f ? 1.0f : ez) * __builtin_amdgcn_rcpf(1.0f + ez), lbk = l0[k];
                              v0[k] = (lbk > 0.f) ? flog(lbk + (1.0f - lbk) * sg) : (fminf(z, 0.f) - flog(1.0f + ez)); }
                            { const float z = v1[k], ez = fexp(-fabsf(z)), sg = (z >= 0.f ? 1.0f : ez) * __builtin_amdgcn_rcpf(1.0f + ez), lbk = l1[k];
                              v1[k] = (lbk > 0.f) ? flog(lbk + (1.0f - lbk) * sg) : (fminf(z, 0.f) - flog(1.0f + ez)); } }
                    }
                    u32x4 w; w.x = pk2(v0[0], v0[1]); w.y = pk2(v0[2], v0[3]); w.z = pk2(v1[0], v1[1]); w.w = pk2(v1[2], v1[3]);
                    *(u32x4*)rowp = w; }
        }
    }
};

struct EpiBf16Cnt {
    static constexpr bool PERM = true, AFTER_DRAIN = false;
    bf16_t* O; int ldc; unsigned* cnt; int pm0;
    __device__ __forceinline__ void operator()(const f32x4 (&acc)[2][2][4][2], const Unit& u, int wr, int wc, int fr, int fq) const {
        const int row0 = u.pm * BM + wr * 64 + fr, col0 = u.pn * BM + wc * 32 + 8 * fq;
#pragma unroll
        for (int ai = 0; ai < 2; ++ai)
#pragma unroll
            for (int m = 0; m < 4; ++m) { bf16_t* rowp = O + (size_t)(row0 + ai * HALF + m * 16) * ldc + col0;
#pragma unroll
                for (int bj = 0; bj < 2; ++bj) { const f32x4 v0 = acc[ai][bj][m][0], v1 = acc[ai][bj][m][1];
                    const unsigned long long lo = ((unsigned long long)pk2(v0[2], v0[3]) << 32) | pk2(v0[0], v0[1]), hi = ((unsigned long long)pk2(v1[2], v1[3]) << 32) | pk2(v1[0], v1[1]);
                    unsigned long long* q = (unsigned long long*)(rowp + bj * HALF);
                    __hip_atomic_store(q, lo, __ATOMIC_RELAXED, __HIP_MEMORY_SCOPE_AGENT); __hip_atomic_store(q + 1, hi, __ATOMIC_RELAXED, __HIP_MEMORY_SCOPE_AGENT); } }
        asm volatile("s_waitcnt vmcnt(0)" ::: "memory");
        if (fr == 0 && fq == 0) __hip_atomic_fetch_add(cnt + 16 * (u.pm - pm0), 1u, __ATOMIC_RELAXED, __HIP_MEMORY_SCOPE_AGENT);
    }
};
template <class Epi, class Sched, bool ALIGN_EPI = false, bool SP2 = false>
__device__ __forceinline__ void gemm_phase(PG8_LAS unsigned char* lds, const Gemm g, const Sched& S, const Epi& E) {
    int tid_ = threadIdx.x; asm volatile("" : "+v"(tid_));
    const int tid = tid_, wid = __builtin_amdgcn_readfirstlane(tid >> 6), lane = tid & 63, wr = wid >> 2, wc = wid & 3, fr = lane & 15, fq = lane >> 4;
    const int K = g.K, nt = K / BK;
    unsigned voffA[2], voffB[2];
#pragma unroll
    for (int i = 0; i < 2; ++i) { int R, C; stage_rc(tid * 16 + i * 8192, R, C); const int Rb = Epi::PERM ? ((R & ~31) + perm32(R & 31)) : R;
        voffA[i] = (unsigned)(R * K + C) * 2u; voffB[i] = (unsigned)(Rb * K + C) * 2u; }
    const size_t kstep = (size_t)(BK * 2);
    const size_t hstep = (size_t)HALF * K * 2;
    const size_t tstep = 2 * hstep;
    const unsigned ldsw = (unsigned)wid * 1024u;
    const int aoff = lds_byte(wr * 64 + fr, fq * 8), boff = lds_byte(wc * 32 + fr, fq * 8);
#define PG8_SA(b, h) (((b) * 2 + (h)) * HTB)
#define PG8_SB(b, h) ((4 + (b) * 2 + (h)) * HTB)
#define PG8_STAGE(bufoff, gbase, voff) do { _Pragma("unroll") for (int _i = 0; _i < 2; ++_i) \
        __builtin_amdgcn_global_load_lds((const unsigned*)((const char*)(gbase) + (voff)[_i]), (PG8_LAS unsigned*)(lds + (bufoff) + ldsw + _i * 8192), 16, 0, 0); } while (0)
#define PG8_LDA(dst, b, h) do { _Pragma("unroll") for (int m = 0; m < 4; ++m) _Pragma("unroll") for (int k = 0; k < 2; ++k) dst[m][k] = *(const PG8_LAS bf16x8*)(lds + PG8_SA(b, h) + aoff + m * 2048 + k * 1024); } while (0)
#define PG8_LDB(dst, b, h) do { _Pragma("unroll") for (int n = 0; n < 2; ++n) _Pragma("unroll") for (int k = 0; k < 2; ++k) dst[n][k] = *(const PG8_LAS bf16x8*)(lds + PG8_SB(b, h) + boff + n * 2048 + k * 1024); } while (0)
#define PG8_MMA(ai, bj, At, Bt) do { __builtin_amdgcn_s_setprio(1); _Pragma("unroll") for (int m = 0; m < 4; ++m) _Pragma("unroll") for (int n = 0; n < 2; ++n) _Pragma("unroll") for (int k = 0; k < 2; ++k) \
        acc[ai][bj][m][n] = __builtin_amdgcn_mfma_f32_16x16x32_bf16(Bt[n][k], At[m][k], acc[ai][bj][m][n], 0, 0, 0); __builtin_amdgcn_s_setprio(0); } while (0)
#define PG8_WAIT_V(n) asm volatile("s_waitcnt vmcnt(" #n ")" ::: "memory")
#define PG8_WAIT_L(n) asm volatile("s_waitcnt lgkmcnt(" #n ")" ::: "memory")
#define PG8_BAR __builtin_amdgcn_s_barrier()
#define PG8_SCHED __builtin_amdgcn_sched_barrier(0)
    Unit cur, nxt; int ui = 0;
    if (!S.next(0, cur)) return;
    f32x4 acc[2][2][4][2];
#pragma unroll
    for (int a = 0; a < 2; ++a)
#pragma unroll
        for (int b = 0; b < 2; ++b)
#pragma unroll
            for (int m = 0; m < 4; ++m)
#pragma unroll
                for (int n = 0; n < 2; ++n) acc[a][b][m][n] = (f32x4){0.f, 0.f, 0.f, 0.f};
    bf16x8 At[4][2], B0[2][2], B1[2][2];
    const char* cA = (const char*)g.A + (size_t)cur.pm * tstep + (size_t)cur.seg * g.segA; const char* cB = (const char*)g.Bt + (size_t)cur.pn * tstep + (size_t)cur.seg * g.segB;
    S.a_ready(cur);
    if constexpr (SP2) {
        PG8_STAGE(PG8_SB(0, 0), cB, voffB); PG8_STAGE(PG8_SB(0, 1), cB + hstep, voffB); PG8_STAGE(PG8_SA(0, 0), cA, voffA); PG8_STAGE(PG8_SA(0, 1), cA + hstep, voffA);
        if (wr == 1) PG8_BAR;
        PG8_WAIT_V(2); PG8_BAR;
        PG8_STAGE(PG8_SB(1, 0), cB + kstep, voffB); PG8_STAGE(PG8_SA(1, 0), cA + kstep, voffA); PG8_STAGE(PG8_SB(1, 1), cB + hstep + kstep, voffB);
        PG8_WAIT_V(6); PG8_BAR;
    } else {
        PG8_STAGE(PG8_SB(0, 0), cB, voffB); PG8_STAGE(PG8_SA(0, 0), cA, voffA); PG8_STAGE(PG8_SB(0, 1), cB + hstep, voffB); PG8_STAGE(PG8_SA(0, 1), cA + hstep, voffA);
        if (wr == 1) PG8_BAR;
        PG8_WAIT_V(4); PG8_BAR;
        PG8_STAGE(PG8_SB(1, 0), cB + kstep, voffB); PG8_STAGE(PG8_SA(1, 0), cA + kstep, voffA); PG8_STAGE(PG8_SB(1, 1), cB + hstep + kstep, voffB);
        PG8_WAIT_V(6); PG8_BAR;
    }
    for (;;) {
        const bool has_next = S.next(ui + 1, nxt);
        const char* nA = has_next ? (const char*)g.A + (size_t)nxt.pm * tstep + (size_t)nxt.seg * g.segA : cA; const char* nB = has_next ? (const char*)g.Bt + (size_t)nxt.pn * tstep + (size_t)nxt.seg * g.segB : cB;
        for (int t = 0; t < nt; t += 2) {
            const bool last = (t == nt - 2);
            const char* a1 = cA + (size_t)(t + 1) * kstep;
            const char* a2 = last ? nA : cA + (size_t)(t + 2) * kstep; const char* b2 = last ? nB : cB + (size_t)(t + 2) * kstep;
            const char* a3 = a2 + kstep; const char* b3 = b2 + kstep;
            if (last && has_next) S.a_ready(nxt);
            if constexpr (SP2) {
            PG8_LDB(B0, 0, 0); PG8_LDB(B1, 0, 1); PG8_SCHED; PG8_LDA(At, 0, 0); PG8_STAGE(PG8_SA(1, 1), a1 + hstep, voffA);
            PG8_WAIT_V(8); PG8_WAIT_L(0); PG8_BAR; PG8_MMA(0, 0, At, B0); PG8_MMA(0, 1, At, B1); PG8_BAR; PG8_SCHED;
            PG8_LDA(At, 0, 1); PG8_STAGE(PG8_SB(0, 0), b2, voffB); PG8_STAGE(PG8_SB(0, 1), b2 + hstep, voffB); PG8_STAGE(PG8_SA(0, 0), a2, voffA);
            PG8_WAIT_V(8); PG8_WAIT_L(0); PG8_BAR; PG8_MMA(1, 0, At, B0); PG8_MMA(1, 1, At, B1); PG8_BAR; PG8_SCHED;
            PG8_LDB(B0, 1, 0); PG8_LDB(B1, 1, 1); PG8_SCHED; PG8_LDA(At, 1, 0); PG8_STAGE(PG8_SA(0, 1), a2 + hstep, voffA);
            PG8_WAIT_V(8); PG8_WAIT_L(0); PG8_BAR; PG8_MMA(0, 0, At, B0); PG8_MMA(0, 1, At, B1); PG8_BAR; PG8_SCHED;
            PG8_LDA(At, 1, 1); PG8_STAGE(PG8_SB(1, 0), b3, voffB); PG8_STAGE(PG8_SB(1, 1), b3 + hstep, voffB); PG8_STAGE(PG8_SA(1, 0), a3, voffA);
            PG8_WAIT_V(8); PG8_WAIT_L(0); PG8_BAR; PG8_MMA(1, 0, At, B0); PG8_MMA(1, 1, At, B1); PG8_BAR; PG8_SCHED;
            } else {
            PG8_LDB(B0, 0, 0); PG8_SCHED; PG8_LDA(At, 0, 0); PG8_STAGE(PG8_SA(1, 1), a1 + hstep, voffA);
            PG8_WAIT_L(8); PG8_BAR; PG8_WAIT_L(0); PG8_MMA(0, 0, At, B0); PG8_BAR; PG8_SCHED;
            PG8_LDB(B1, 0, 1); PG8_STAGE(PG8_SB(0, 0), b2, voffB);
            PG8_BAR; PG8_WAIT_L(0); PG8_MMA(0, 1, At, B1); PG8_BAR;
            PG8_LDA(At, 0, 1); PG8_STAGE(PG8_SA(0, 0), a2, voffA);
            PG8_BAR; PG8_WAIT_L(0); PG8_MMA(1, 0, At, B0); PG8_BAR; PG8_SCHED;
            PG8_STAGE(PG8_SB(0, 1), b2 + hstep, voffB);
            PG8_WAIT_V(6); PG8_BAR; PG8_MMA(1, 1, At, B1); PG8_BAR;
            PG8_LDB(B0, 1, 0); PG8_SCHED; PG8_LDA(At, 1, 0); PG8_STAGE(PG8_SA(0, 1), a2 + hstep, voffA);
            PG8_WAIT_L(8); PG8_BAR; PG8_WAIT_L(0); PG8_MMA(0, 0, At, B0); PG8_BAR; PG8_SCHED;
            PG8_LDB(B1, 1, 1); PG8_STAGE(PG8_SB(1, 0), b3, voffB);
            PG8_BAR; PG8_WAIT_L(0); PG8_MMA(0, 1, At, B1); PG8_BAR;
            PG8_LDA(At, 1, 1); PG8_STAGE(PG8_SA(1, 0), a3, voffA);
            PG8_BAR; PG8_WAIT_L(0); PG8_MMA(1, 0, At, B0); PG8_BAR; PG8_SCHED;
            PG8_STAGE(PG8_SB(1, 1), b3 + hstep, voffB);
            PG8_WAIT_V(6); PG8_BAR; PG8_MMA(1, 1, At, B1); PG8_BAR;
            }
        }
        if constexpr (ALIGN_EPI) { if (wr == 0) PG8_BAR; }
        if constexpr (!Epi::AFTER_DRAIN) { E(acc, cur, wr, wc, fr, fq); S.done(cur); }
        if (!has_next) break;
#pragma unroll
        for (int a = 0; a < 2; ++a)
#pragma unroll
            for (int b = 0; b < 2; ++b)
#pragma unroll
                for (int m = 0; m < 4; ++m)
#pragma unroll
                    for (int n = 0; n < 2; ++n) acc[a][b][m][n] = (f32x4){0.f, 0.f, 0.f, 0.f};
        cur = nxt; cA = nA; cB = nB; ++ui;
        if constexpr (ALIGN_EPI) { if (wr == 1) PG8_BAR; }
    }
    PG8_WAIT_V(0);
    if constexpr (!ALIGN_EPI) { if (wr == 0) PG8_BAR; }
    PG8_BAR;
    if constexpr (Epi::AFTER_DRAIN) { E.fused(acc, cur, wr, wc, fr, fq, lds, wid, lane); S.done(cur); }
#undef PG8_SA
#undef PG8_SB
#undef PG8_STAGE
#undef PG8_LDA
#undef PG8_LDB
#undef PG8_MMA
#undef PG8_WAIT_V
#undef PG8_WAIT_L
#undef PG8_BAR
#undef PG8_SCHED
}
}

struct Params { const float* in[22]; float* out; unsigned char* ws; };
typedef const __attribute__((address_space(4))) Params* KP;
DI KP kparams() { KP kp = (KP)__builtin_amdgcn_kernarg_segment_ptr(); asm volatile("" : "+s"(kp)); return kp; }
enum { I_X = 0, I_C, I_CTX, I_CCTX, I_WADA, I_BADA, I_NPRE, I_NPOST, I_W1, I_W3, I_W2, I_WIN, I_SINK, I_MLCONV, I_MLFB, I_MLNORM, I_HGLB, I_HGNORM, I_WBA, I_WBM, I_WBH, I_WOUT };

DI void transpose_item(const float* Wa, const float* Wb, int ldw, int K, bf16_t* dst, int k0, LAS float* scr, int lane) {
    const float* src = (((lane & 31) < 16) ? Wa : Wb) + (lane & 15);
#pragma unroll 8
    for (int i = 0; i < 32; ++i) { const int kk = 2 * i + (lane >> 5); scr[kk * 33 + (lane & 31)] = __builtin_nontemporal_load(src + (size_t)(k0 + kk) * ldw); }
    asm volatile("s_waitcnt lgkmcnt(0)" ::: "memory");
    const int c = lane & 7;
#pragma unroll
    for (int j = 0; j < 4; ++j) { const int n = (lane >> 3) + 8 * j; const LAS float* s = scr + (8 * c) * 33 + n;
        u32x4 o; o.x = pk2(s[0 * 33], s[1 * 33]); o.y = pk2(s[2 * 33], s[3 * 33]); o.z = pk2(s[4 * 33], s[5 * 33]); o.w = pk2(s[6 * 33], s[7 * 33]);
        *(u32x4*)(dst + (size_t)n * K + k0 + 8 * c) = o; }
    asm volatile("s_waitcnt lgkmcnt(0)" ::: "memory");
}
struct Seg { const float* Wa; const float* Wb; int ldw, K, ngroups, colA0, colB0, cstep; bf16_t* dst; };
DI bool seg_run(const Seg& s, int& it, LAS float* scr, int lane) {
    const int nk = s.K / 64, n = s.ngroups * nk;
    if (it >= n) { it -= n; return false; }
    const int gi = it / nk, kb = it % nk;
    transpose_item(s.Wa + s.colA0 + gi * s.cstep, s.Wb + s.colB0 + gi * s.cstep, s.ldw, s.K, s.dst + (size_t)gi * 32 * s.K, kb * 64, scr, lane);
    return true;
}
DI void convert_weights(KP p, int l, LAS unsigned char* lds, const unsigned mask, const int vb, const int vg) {
    int tid_ = threadIdx.x; asm volatile("" : "+v"(tid_));
    const int wave = tid_ >> 6, lane = tid_ & 63;
    if (vb < 0) return;
    LAS float* scr = (LAS float*)(lds + wave * 8704);
    bf16_t* W = (bf16_t*)(p->ws + WS_W);
    const int gw = vb * 8 + wave, NGW = vg * 8;
    constexpr int NITEMS = 2 * 176 * 16 + 2 * 32 * 44 + 128 * 16 + 96 * 16 + 3 * 32 * 8 + 32 * 16;
    for (int item = gw; item < NITEMS; item += NGW) {
        int it = item;
        if (it < 2 * 2816) { const int f = it / 2816; if (!((mask >> f) & 1u)) continue; it -= f * 2816;
            const float* w1 = p->in[I_W1] + (size_t)(l * 2 + f) * DM * DFF; const float* w3 = p->in[I_W3] + (size_t)(l * 2 + f) * DM * DFF;
            Seg s{w1, w3, DFF, DM, 176, 0, 0, 16, W + WO_W13 + (size_t)f * 5632 * 1024}; seg_run(s, it, scr, lane); continue; }
        it -= 2 * 2816;
        if (it < 2 * 1408) { const int f = it / 1408; if (!((mask >> (2 + f)) & 1u)) continue; it -= f * 1408;
            const float* w2 = p->in[I_W2] + (size_t)(l * 2 + f) * DFF * DM;
            Seg s{w2, w2, DM, DFF, 32, 0, 16, 32, W + WO_W2 + (size_t)f * 1024 * 2816}; seg_run(s, it, scr, lane); continue; }
        it -= 2 * 1408;
        const float* win = p->in[I_WIN] + (size_t)l * DM * DIN;
        if (it < 72 * 16) { if (!((mask >> 4) & 1u)) continue; Seg s{win, win, DIN, DM, 72, 0, 16, 32, W + WO_WIN}; seg_run(s, it, scr, lane); continue; }
        it -= 72 * 16;
        if (it < 56 * 16) { if (!((mask >> 5) & 1u)) continue; Seg s{win, win, DIN, DM, 56, 2320, 2336, 32, W + WO_WIN + (size_t)2304 * 1024}; seg_run(s, it, scr, lane); continue; }
        it -= 56 * 16;
        if (it < 96 * 16) { if (!((mask >> 6) & 1u)) continue; Seg s{win, win, DIN, DM, 96, 4112, 4128, 32, W + WO_WG}; seg_run(s, it, scr, lane); continue; }
        it -= 96 * 16;
        if (it < 3 * 256) { const int f = it / 256; if (!((mask >> (7 + f)) & 1u)) continue; it -= f * 256;
            const float* wb = p->in[I_WBA + f] + (size_t)l * 512 * DM;
            Seg s{wb, wb, DM, 512, 32, 0, 16, 32, W + WO_WB + (size_t)f * 1024 * 512}; seg_run(s, it, scr, lane); continue; }
        it -= 3 * 256;
        if (!((mask >> 10) & 1u)) continue;
        { const float* wo = p->in[I_WOUT] + (size_t)l * DM * DM; Seg s{wo, wo, DM, DM, 32, 0, 16, 32, W + WO_WOUT}; seg_run(s, it, scr, lane); }
    }
}

DI void mods_phase(KP p, LAS unsigned char* lds, int tid) {
    asm volatile("" : "+v"(tid));
    const int wave = tid >> 6, lane = tid & 63;
    LAS float* sc = (LAS float*)lds;
    LAS float* red = (LAS float*)(lds + 36864);
    for (int i = tid; i < 9 * 1024; i += 512) { const float v = (i < 8192) ? p->in[I_C][i] : p->in[I_CCTX][i - 8192]; sc[i] = v / (1.0f + expf(-v)); }
    __syncthreads();
    float* mod = (float*)(p->ws + WS_MOD);
    for (int it = blockIdx.x; it < 288; it += gridDim.x) {
        const int l = it / 144, cb = it % 144, col = cb * 64 + lane;
        const float* wp = p->in[I_WADA] + ((size_t)l * 1024 + wave * 128) * 9216 + col;
        float acc[9];
#pragma unroll
        for (int i = 0; i < 9; ++i) acc[i] = 0.f;
#pragma unroll 32
        for (int k = 0; k < 128; ++k) { const float wv = __builtin_nontemporal_load(wp + (size_t)k * 9216);
#pragma unroll
            for (int i = 0; i < 9; ++i) acc[i] += sc[i * 1024 + wave * 128 + k] * wv; }
#pragma unroll
        for (int i = 0; i < 9; ++i) red[(wave * 9 + i) * 64 + lane] = acc[i];
        __syncthreads();
        for (int o = tid; o < 576; o += 512) { const int i = o >> 6, ln = o & 63; float s = 0.f;
#pragma unroll
            for (int w = 0; w < 8; ++w) s += red[(w * 9 + i) * 64 + ln];
            mod[((size_t)l * 9 + i) * 9216 + cb * 64 + ln] = s + p->in[I_BADA][(size_t)l * 9216 + cb * 64 + ln]; }
        __syncthreads();
    }
    if (blockIdx.x == gridDim.x - 1) {
        f32x2* tab = (f32x2*)(p->ws + WS_ROPE);
        float* lbt = (float*)(p->ws + WS_LB);
        if (tid < 256) { const float a0 = p->in[I_HGLB][tid], a1 = p->in[I_HGLB][256 + tid]; lbt[tid] = 0.f; lbt[256 + tid] = 1.0f / (1.0f + expf(a0 - a1)); }
        for (int e = tid; e < 1024; e += 512) { const int pos = e >> 4, i = e & 15;
            const float inv = exp2f(-(float)i * (13.287712379549449f / 16.0f));
            const float a = (float)pos * inv; float rev = a * 0.15915494309189535f; rev -= floorf(rev);
            f32x2 cs; cs.x = __builtin_amdgcn_cosf(rev); cs.y = __builtin_amdgcn_sinf(rev); tab[e] = cs; }
    }
}

struct RowArgs {
    const float* xs_lat; const float* xs_ctx; float* xd_lat; float* xd_ctx;
    const bf16_t* Y; bf16_t* H; const float* mod; const float* modpre; const float* gpost; const float* gpre; const float* wgates; float* gates;
    int jpost, jpre, row0, row1, vb, vg; float wpost;
};
template <bool POST, bool PRE, bool GATES, bool YSC = false>
DI void row_phase(const RowArgs& a, LAS unsigned char* lds, int tid) {
    asm volatile("" : "+v"(tid));
    const int wave = tid >> 6, lane = tid & 63;
    LAS f32x4* wl = (LAS f32x4*)lds;
    if (GATES) {
        for (int idx = tid; idx < 1024 * 4; idx += 512) { const int k = idx >> 2, c4 = idx & 3; const int ln = (k & 255) >> 2, j = k >> 8, e = k & 3;
            wl[((j * 4 + e) * 4 + c4) * 64 + ln] = *(const f32x4*)(a.wgates + (size_t)k * DIN + 4 * c4); }
        __syncthreads();
    }
    int row = a.row0 + a.vb * 8 + wave;
    const bool any = a.vb >= 0 && row < a.row1;
    f32x4 xn[4]; u32x2 yn[4];
#define ROW_LOAD(r_) do { const float* src_ = (r_) < MLAT ? a.xs_lat + (size_t)(r_) * DM : a.xs_ctx + (size_t)((r_) - MLAT) * DM; \
        _Pragma("unroll") for (int j = 0; j < 4; ++j) { xn[j] = __builtin_nontemporal_load((const f32x4*)(src_ + 4 * lane + 256 * j)); if (POST) { if (YSC) { const unsigned long long yv_ = __hip_atomic_load((const unsigned long long*)(a.Y + (size_t)(r_) * DM + 4 * lane + 256 * j), __ATOMIC_RELAXED, __HIP_MEMORY_SCOPE_AGENT); yn[j] = (u32x2){(unsigned)yv_, (unsigned)(yv_ >> 32)}; } \
            else yn[j] = __builtin_nontemporal_load((const u32x2*)(a.Y + (size_t)(r_) * DM + 4 * lane + 256 * j)); } } } while (0)
    if (any) ROW_LOAD(row);
    for (; any && row < a.row1; row += a.vg * 8) {
        const int mi = row < MLAT ? (row >> 12) : 8;
        const float* md = a.mod + (size_t)mi * 9216;
        const float* mdp = a.modpre + (size_t)mi * 9216;
        f32x4 x[4]; u32x2 yw[4];
#pragma unroll
        for (int j = 0; j < 4; ++j) { x[j] = xn[j]; if (POST) yw[j] = yn[j]; }
        f32x4 gt[4], gp[4], sh[4], scl[4], gg[4];
#pragma unroll
        for (int j = 0; j < 4; ++j) { const int c = 4 * lane + 256 * j;
            if (POST) { gt[j] = *(const f32x4*)(md + (3 * a.jpost + 2) * DM + c); gp[j] = *(const f32x4*)(a.gpost + c); }
            if (PRE) { sh[j] = *(const f32x4*)(mdp + (3 * a.jpre) * DM + c); scl[j] = *(const f32x4*)(mdp + (3 * a.jpre + 1) * DM + c); gg[j] = *(const f32x4*)(a.gpre + c); } }
        const int rnext = row + a.vg * 8;
        if (rnext < a.row1) ROW_LOAD(rnext);
        if (POST) {
            f32x4 y[4]; float s = 0.f;
#pragma unroll
            for (int j = 0; j < 4; ++j) { const u32x2 w = yw[j];
                y[j] = (f32x4){bflo(w.x), bfhi(w.x), bflo(w.y), bfhi(w.y)}; s += (y[j][0] * y[j][0] + y[j][1] * y[j][1]) + (y[j][2] * y[j][2] + y[j][3] * y[j][3]); }
            const float rstd = 1.0f / sqrtf(wave_sum(s) * (1.0f / DM) + EPS);
            float* dst = row < MLAT ? a.xd_lat + (size_t)row * DM : a.xd_ctx + (size_t)(row - MLAT) * DM;
#pragma unroll
            for (int j = 0; j < 4; ++j) { const int c = 4 * lane + 256 * j;
                x[j] = x[j] + a.wpost * gt[j] * (y[j] * rstd * gp[j]);
                __builtin_nontemporal_store(x[j], (f32x4*)(dst + c)); }
        }
        if (PRE) {
            float s = 0.f;
#pragma unroll
            for (int j = 0; j < 4; ++j) s += (x[j][0] * x[j][0] + x[j][1] * x[j][1]) + (x[j][2] * x[j][2] + x[j][3] * x[j][3]);
            const float rstd = 1.0f / sqrtf(wave_sum(s) * (1.0f / DM) + EPS);
            f32x4 hv[4]; f32x4 g4[4];
#pragma unroll
            for (int c4 = 0; c4 < 4; ++c4) g4[c4] = (f32x4){0.f, 0.f, 0.f, 0.f};
#pragma unroll
            for (int j = 0; j < 4; ++j) { const int c = 4 * lane + 256 * j;
                hv[j] = (x[j] * rstd * gg[j]) * (1.0f + scl[j]) + sh[j];
                u32x2 w; w.x = pk2(hv[j][0], hv[j][1]); w.y = pk2(hv[j][2], hv[j][3]);
                *(u32x2*)(a.H + (size_t)row * DM + c) = w;
                if (GATES) {
#pragma unroll
                    for (int e = 0; e < 4; ++e)
#pragma unroll
                        for (int c4 = 0; c4 < 4; ++c4) g4[c4] += hv[j][e] * wl[((j * 4 + e) * 4 + c4) * 64 + lane];
                    asm volatile("" ::: "memory");
                } }
            if (GATES) {
#pragma unroll
                for (int c4 = 0; c4 < 4; ++c4)
#pragma unroll
                    for (int k = 0; k < 4; ++k) g4[c4][k] = wave_sum(g4[c4][k]);
                if (lane == 0) {
#pragma unroll
                    for (int c4 = 0; c4 < 4; ++c4) *(f32x4*)(a.gates + (size_t)row * 16 + 4 * c4) = g4[c4]; }
            }
        }
    }
#undef ROW_LOAD
    if (GATES) __syncthreads();
}

constexpr int RS = 144;
constexpr int AT_K = 0, AT_V = 9216, AT_TAB = 18432;
struct AttnArgs { const bf16_t* P; bf16_t* ATT; const float* sink; const f32x2* rope; };

DI void attn_item(const AttnArgs& A, int item, LAS unsigned char* lds, int tid) {
    asm volatile("" : "+v"(tid));
    const int w = tid >> 6, lane = tid & 63, r = lane & 31, hh = lane >> 5;
    const LAS f32x2* tab = (const LAS f32x2*)(lds + AT_TAB);
    int b, g, qb = 0, qrow0; bool lat;
    if (item < 512) { b = item >> 6; g = (item >> 5) & 1; qb = item & 31; lat = true; qrow0 = b * SEQ + qb * 128; }
    else { const int it = item - 512; b = it >> 2; g = (it >> 1) & 1; lat = false; qrow0 = MLAT + b * CTXL + (it & 1) * 128; }
    const int head = g * 4 + (w >> 1), qoff = (w & 1) * 64;
    bf16x8 qf[2][4];
#pragma unroll
    for (int qt = 0; qt < 2; ++qt) {
        const int ql = qoff + 32 * qt + r;
        const bf16_t* qp = A.P + pidx(qrow0 + ql, PC_AQ + head * 64 + 8 * hh);
        float x[4][8];
#pragma unroll
        for (int ks = 0; ks < 4; ++ks) { const u32x4 raw = *(const u32x4*)(qp + 16 * ks);
            x[ks][0] = bflo(raw.x); x[ks][1] = bfhi(raw.x); x[ks][2] = bflo(raw.y); x[ks][3] = bfhi(raw.y); x[ks][4] = bflo(raw.z); x[ks][5] = bfhi(raw.z); x[ks][6] = bflo(raw.w); x[ks][7] = bfhi(raw.w); }
        if (lat) {
            const int t = qb * 128 + ql;
#pragma unroll
            for (int pr = 0; pr < 2; ++pr) { const int pos = pr ? (t & 63) : (t >> 6);
#pragma unroll
                for (int j = 0; j < 8; ++j) { const f32x2 cs = tab[pos * 16 + 8 * hh + j]; const float x1 = x[2 * pr][j], x2 = x[2 * pr + 1][j];
                    x[2 * pr][j] = x1 * cs.x - x2 * cs.y; x[2 * pr + 1][j] = x2 * cs.x + x1 * cs.y; } }
        }
#pragma unroll
        for (int ks = 0; ks < 4; ++ks) qf[qt][ks] = pack8(x[ks][0] * 0.125f, x[ks][1] * 0.125f, x[ks][2] * 0.125f, x[ks][3] * 0.125f, x[ks][4] * 0.125f, x[ks][5] * 0.125f, x[ks][6] * 0.125f, x[ks][7] * 0.125f);
    }
    f32x16 O[2][2];
#pragma unroll
    for (int qt = 0; qt < 2; ++qt)
#pragma unroll
        for (int dt = 0; dt < 2; ++dt)
#pragma unroll
            for (int i = 0; i < 16; ++i) O[qt][dt][i] = 0.f;
    const float sk = A.sink[head];
    float m_run[2] = {sk, sk}, l_run[2];
    l_run[0] = l_run[1] = (hh == 0) ? 1.0f : 0.0f;
    const int ti_hi = (lat && qb == 31) ? 4 : 6;
    int ti = lat ? (qb == 0 ? 2 : 0) : 6;
    const int ss = tid >> 3, sc8 = tid & 7, half = sc8 >> 2, i0 = (sc8 & 3) * 4;
    u32x2 k1, k2; u32x4 vr;
#define ATT_LOAD(tix) do { const int krow_ = ((tix) < 6 ? b * SEQ + 128 * (qb - 1) + 64 * (tix) : MLAT + b * CTXL + 64 * ((tix) - 6)) + ss; \
        const bf16_t* kp_ = A.P + pidx(krow_, PC_AK); \
        k1 = *(const u32x2*)(kp_ + g * 64 + 32 * half + i0); k2 = *(const u32x2*)(kp_ + g * 64 + 32 * half + 16 + i0); \
        vr = *(const u32x4*)(kp_ + (PC_AV - PC_AK) + g * 64 + 8 * sc8); } while (0)
    ATT_LOAD(ti);
    for (;;) {
        {
            float a[4] = {bflo(k1.x), bfhi(k1.x), bflo(k1.y), bfhi(k1.y)}, c[4] = {bflo(k2.x), bfhi(k2.x), bflo(k2.y), bfhi(k2.y)};
            if (ti < 6) { const int kpos = 128 * (qb - 1) + 64 * ti + ss; const int pos = half ? (kpos & 63) : (kpos >> 6);
#pragma unroll
                for (int e = 0; e < 4; ++e) { const f32x2 cs = tab[pos * 16 + i0 + e]; const float x1 = a[e], x2 = c[e]; a[e] = x1 * cs.x - x2 * cs.y; c[e] = x2 * cs.x + x1 * cs.y; } }
            u32x2 o1, o2; o1.x = pk2(a[0], a[1]); o1.y = pk2(a[2], a[3]); o2.x = pk2(c[0], c[1]); o2.y = pk2(c[2], c[3]);
            *(LAS u32x2*)(lds + AT_K + ss * RS + (32 * half + i0) * 2) = o1;
            *(LAS u32x2*)(lds + AT_K + ss * RS + (32 * half + 16 + i0) * 2) = o2;
            const unsigned vv[4] = {vr.x, vr.y, vr.z, vr.w};
#pragma unroll
            for (int e = 0; e < 4; ++e) { *(LAS unsigned short*)(lds + AT_V + (8 * sc8 + 2 * e) * RS + ss * 2) = (unsigned short)(vv[e] & 0xffffu);
                *(LAS unsigned short*)(lds + AT_V + (8 * sc8 + 2 * e + 1) * RS + ss * 2) = (unsigned short)(vv[e] >> 16); }
        }
        LDS_BARRIER();
        const int tn = (ti < 6 && ti + 1 == ti_hi) ? 6 : ti + 1;
        if (tn < 10) ATT_LOAD(tn);
        f32x16 S[2][2];
#pragma unroll
        for (int st = 0; st < 2; ++st) {
            bf16x8 kf[4];
#pragma unroll
            for (int ks = 0; ks < 4; ++ks) kf[ks] = *(const LAS bf16x8*)(lds + AT_K + (32 * st + r) * RS + (16 * ks + 8 * hh) * 2);
#pragma unroll
            for (int qt = 0; qt < 2; ++qt) { f32x16 acc;
#pragma unroll
                for (int i = 0; i < 16; ++i) acc[i] = 0.f;
#pragma unroll
                for (int ks = 0; ks < 4; ++ks) acc = MFMA32(kf[ks], qf[qt][ks], acc);
                S[qt][st] = acc; }
        }
        if (ti < 2 || (ti >= 4 && ti < 6)) {
            const int kp0 = 128 * (qb - 1) + 64 * ti;
#pragma unroll
            for (int qt = 0; qt < 2; ++qt) { const int qpos = qb * 128 + qoff + 32 * qt + r;
#pragma unroll
                for (int st = 0; st < 2; ++st)
#pragma unroll
                    for (int i = 0; i < 16; ++i) { const int df = qpos - (kp0 + 32 * st + crow(i, hh)); if (df > 128 || df < -128) S[qt][st][i] = -INFINITY; } }
        }
#pragma unroll
        for (int qt = 0; qt < 2; ++qt) {
            float mx = S[qt][0][0];
#pragma unroll
            for (int st = 0; st < 2; ++st)
#pragma unroll
                for (int i = 0; i < 16; ++i) mx = fmaxf(mx, S[qt][st][i]);
            mx = fmaxf(mx, __shfl_xor(mx, 32));
            const float mn = fmaxf(m_run[qt], mx), scale = fexp(m_run[qt] - mn);
            m_run[qt] = mn; float ls = 0.f;
#pragma unroll
            for (int st = 0; st < 2; ++st)
#pragma unroll
                for (int i = 0; i < 16; ++i) { const float pv = fexp(S[qt][st][i] - mn); S[qt][st][i] = pv; ls += pv; }
            l_run[qt] = l_run[qt] * scale + ls;
#pragma unroll
            for (int dt = 0; dt < 2; ++dt)
#pragma unroll
                for (int i = 0; i < 16; ++i) O[qt][dt][i] *= scale;
        }
#pragma unroll
        for (int kk = 0; kk < 4; ++kk) { const int st = kk >> 1, s2 = kk & 1;
            bf16x8 pb[2];
#pragma unroll
            for (int qt = 0; qt < 2; ++qt) pb[qt] = pack8(S[qt][st][8 * s2 + 0], S[qt][st][8 * s2 + 1], S[qt][st][8 * s2 + 2], S[qt][st][8 * s2 + 3], S[qt][st][8 * s2 + 4], S[qt][st][8 * s2 + 5], S[qt][st][8 * s2 + 6], S[qt][st][8 * s2 + 7]);
#pragma unroll
            for (int dt = 0; dt < 2; ++dt) {
                const LAS unsigned char* vp = lds + AT_V + (32 * dt + r) * RS + (32 * st + 16 * s2 + 4 * hh) * 2;
                const s16x4 lo = *(const LAS s16x4*)vp, hi = *(const LAS s16x4*)(vp + 16);
                const bf16x8 va = __builtin_shufflevector(lo, hi, 0, 1, 2, 3, 4, 5, 6, 7);
#pragma unroll
                for (int qt = 0; qt < 2; ++qt) O[qt][dt] = MFMA32(va, pb[qt], O[qt][dt]);
            }
        }
        LDS_BARRIER();
        if (tn >= 10) break;
        ti = tn;
    }
#undef ATT_LOAD
#pragma unroll
    for (int qt = 0; qt < 2; ++qt) {
        const float l = l_run[qt] + __shfl_xor(l_run[qt], 32), inv = 1.0f / l;
        bf16_t* op = A.ATT + (size_t)(qrow0 + qoff + 32 * qt + r) * 512 + head * 64;
#pragma unroll
        for (int dt = 0; dt < 2; ++dt)
#pragma unroll
            for (int ig = 0; ig < 4; ++ig) { u32x2 wv; wv.x = pk2(O[qt][dt][4 * ig] * inv, O[qt][dt][4 * ig + 1] * inv); wv.y = pk2(O[qt][dt][4 * ig + 2] * inv, O[qt][dt][4 * ig + 3] * inv);
                *(u32x2*)(op + 32 * dt + 8 * ig + 4 * hh) = wv; }
    }
}

constexpr int SC_QS = 0, SC_KS = 9216, SC_QE = 18432, SC_UKT = 27648, SC_VT = 36864, SC_CBT = 55296, SC_F = 73728;
constexpr int SF_EB = 0, SF_QN = 256, SF_SSQ = 2304, SF_N = 3328, SF_DEC = 3840, SF_CONV = 4096, SF_GN = 5632, SF_CACHE = 6144;
struct ScanArgs { const bf16_t* P; bf16_t* OUT; const float* gates; const float* convw; const float* fbias; const float* gnorm; const float* lbl; int layer; unsigned char* wsdbg; };

template <bool IS_ML>
DI void scan_item(const ScanArgs& A, int b, int hd, const int dir, unsigned* prog_mine, unsigned* prog_other, LAS unsigned char* lds, int tid) {
    asm volatile("" : "+v"(tid));
    const int w = tid >> 6, lane = tid & 63, r = lane & 31, hh = lane >> 5;
    const int etile = w & 3, ttile = w >> 2, dtile = w >> 2;
    LAS float* F = (LAS float*)(lds + SC_F);
    LAS float* eb_s = F + SF_EB / 4; LAS float* qn_s = F + SF_QN / 4; LAS float* ssq_s = F + SF_SSQ / 4; LAS float* n_s = F + SF_N / 4; LAS float* dec_s = F + SF_DEC / 4; LAS float* conv_s = F + SF_CONV / 4;
    LAS float* gn_s = F + SF_GN / 4; LAS unsigned* cache_s = (LAS unsigned*)(F + SF_CACHE / 4);
    const int vcol = (IS_ML ? PC_MV : PC_HI) + hd * 128, gcol = (IS_ML ? PC_MO : PC_HG) + hd * 128;
    __syncthreads();
    if (IS_ML) {
        if (tid < 384) { const int j = tid >> 6, d = tid & 63; conv_s[tid] = A.convw[(j % 3) * 512 + (j / 3) * 256 + hd * 64 + d]; }
    }
    if (tid < 128) { n_s[tid] = 0.f; gn_s[tid] = A.gnorm[hd * 128 + tid]; }
    if (tid == 0) cache_s[0] = 0u;
    f32x16 Cst;
#pragma unroll
    for (int i = 0; i < 16; ++i) Cst[i] = 0.f;
    float m_run = 0.f;
#pragma unroll
    for (int ig = 0; ig < 4; ++ig) *(LAS u32x2*)(lds + SC_CBT + (32 * etile + r) * RS + (32 * dtile + 8 * ig + 4 * hh) * 2) = (u32x2){0u, 0u};
    const float fb = IS_ML ? A.fbias[dir * 4 + hd] : 0.f;
    bool pending = false;
    u32x4 rq[3], rk[3], rv[2]; float rgi = 0.f, rgf = 0.f;
#define SC_ROWS(c_) const int cc_ = (c_) < 4 ? (dir ? 3 - (c_) : (c_)) : (dir ? 67 - (c_) : (c_) - 4); \
    const int slo_ = (c_) < 4 ? MLAT + b * CTXL : b * SEQ, slen_ = (c_) < 4 ? CTXL : SEQ; const int rb_ = slo_ + 64 * cc_;
#define SC_LOAD(c_) do { SC_ROWS(c_) const int ti_ = 64 * cc_ + (dir ? 63 - lane : lane); const int prow_ = slo_ + ti_; \
    if (IS_ML) { const u32x4 z4_ = (u32x4){0u, 0u, 0u, 0u}; \
        const bf16_t* pq_ = A.P + pidx(prow_, PC_MQ + hd * 64 + 8 * w); const bf16_t* pk_ = A.P + pidx(prow_, PC_MK + hd * 64 + 8 * w); rq[1] = *(const u32x4*)pq_; rk[1] = *(const u32x4*)pk_; \
        rq[0] = ti_ > 0 ? *(const u32x4*)(pq_ - 256) : z4_; rk[0] = ti_ > 0 ? *(const u32x4*)(pk_ - 256) : z4_; \
        rq[2] = ti_ + 1 < slen_ ? *(const u32x4*)(pq_ + 256) : z4_; rk[2] = ti_ + 1 < slen_ ? *(const u32x4*)(pk_ + 256) : z4_; \
        const float* gp_ = A.gates + (size_t)(slo_ + ti_) * 16; rgi = gp_[dir * 4 + hd]; rgf = gp_[8 + dir * 4 + hd]; \
    } else { rq[1] = *(const u32x4*)(A.P + pidx(prow_, PC_HQ + hd * 64 + 8 * w)); rk[1] = *(const u32x4*)(A.P + pidx(prow_, PC_HF + dir * 256 + hd * 64 + 8 * w)); } \
    { const bf16_t* pv_ = A.P + pidx(prow_, vcol + 16 * w); rv[0] = *(const u32x4*)pv_; rv[1] = *(const u32x4*)(pv_ + 8); } } while (0)
    SC_LOAD(0);
    __syncthreads();
#ifdef DBG_SEL
    unsigned long long wacc_ = 0;
#endif
#pragma unroll 1
    for (int c = 0; c < 68; ++c) {
#ifdef DBG_SEL
        { const unsigned long long ta_ = __builtin_amdgcn_s_memrealtime(); asm volatile("s_waitcnt vmcnt(0)" ::: "memory"); wacc_ += __builtin_amdgcn_s_memrealtime() - ta_; }
#endif
        float ea = 1.f, wprev = 0.f, enm = 0.f, a_prev = 0.f;
        {
            const unsigned vv[8] = {rv[0].x, rv[0].y, rv[0].z, rv[0].w, rv[1].x, rv[1].y, rv[1].z, rv[1].w};
#pragma unroll
            for (int e = 0; e < 8; ++e) { *(LAS unsigned short*)(lds + SC_VT + (16 * w + 2 * e) * RS + lane * 2) = (unsigned short)(vv[e] & 0xffffu);
                *(LAS unsigned short*)(lds + SC_VT + (16 * w + 2 * e + 1) * RS + lane * 2) = (unsigned short)(vv[e] >> 16); }
        }
        if (IS_ML) {
            const float li = rgi, xf = rgf + fb;
            const float lf = fminf(xf, 0.f) - flog1p(fexp(-fabsf(xf)));
            const float bc = wave_scan_add(lf);
            const float beta = li - bc; const float pm = wave_scan_max(beta);
            const float bl = lane_bcast(bc, 63), pmx = lane_bcast(pm, 63);
            const float mm = fmaxf(m_run, pm), mmx = fmaxf(m_run, pmx);
            ea = fexp(-mm); wprev = fexp(m_run - mm); enm = fexp(-(bc + mm));
            a_prev = fexp(m_run - mmx); const float u = fexp(beta - mmx);
            m_run = bl + mmx;
            if (w == 0) eb_s[lane] = fexp(fminf(beta, 80.f));
            float q8[8], k8[8];
            const unsigned q0[4] = {rq[0].x, rq[0].y, rq[0].z, rq[0].w}, q1[4] = {rq[1].x, rq[1].y, rq[1].z, rq[1].w}, q2[4] = {rq[2].x, rq[2].y, rq[2].z, rq[2].w};
            const unsigned k0[4] = {rk[0].x, rk[0].y, rk[0].z, rk[0].w}, k1[4] = {rk[1].x, rk[1].y, rk[1].z, rk[1].w}, k2[4] = {rk[2].x, rk[2].y, rk[2].z, rk[2].w};
            float cw[6][8];
#pragma unroll
            for (int j = 0; j < 6; ++j) { const f32x4 c0 = *(const LAS f32x4*)(conv_s + j * 64 + 8 * w), c1 = *(const LAS f32x4*)(conv_s + j * 64 + 8 * w + 4);
                cw[j][0] = c0[0]; cw[j][1] = c0[1]; cw[j][2] = c0[2]; cw[j][3] = c0[3]; cw[j][4] = c1[0]; cw[j][5] = c1[1]; cw[j][6] = c1[2]; cw[j][7] = c1[3]; }
#pragma unroll
            for (int e = 0; e < 4; ++e) {
                q8[2 * e] = fsilu(bflo(q0[e]) * cw[0][2 * e] + bflo(q1[e]) * cw[1][2 * e] + bflo(q2[e]) * cw[2][2 * e]);
                q8[2 * e + 1] = fsilu(bfhi(q0[e]) * cw[0][2 * e + 1] + bfhi(q1[e]) * cw[1][2 * e + 1] + bfhi(q2[e]) * cw[2][2 * e + 1]);
                k8[2 * e] = 0.125f * fsilu(bflo(k0[e]) * cw[3][2 * e] + bflo(k1[e]) * cw[4][2 * e] + bflo(k2[e]) * cw[5][2 * e]);
                k8[2 * e + 1] = 0.125f * fsilu(bfhi(k0[e]) * cw[3][2 * e + 1] + bfhi(k1[e]) * cw[4][2 * e + 1] + bfhi(k2[e]) * cw[5][2 * e + 1]); }
            *(LAS bf16x8*)(lds + SC_QS + lane * RS + 16 * w) = pack8(q8[0], q8[1], q8[2], q8[3], q8[4], q8[5], q8[6], q8[7]);
            *(LAS bf16x8*)(lds + SC_KS + lane * RS + 16 * w) = pack8(k8[0], k8[1], k8[2], k8[3], k8[4], k8[5], k8[6], k8[7]);
#pragma unroll
            for (int e = 0; e < 4; ++e) { const unsigned pkv = pk2(u * k8[2 * e], u * k8[2 * e + 1]);
                *(LAS unsigned short*)(lds + SC_UKT + (8 * w + 2 * e) * RS + lane * 2) = (unsigned short)(pkv & 0xffffu);
                *(LAS unsigned short*)(lds + SC_UKT + (8 * w + 2 * e + 1) * RS + lane * 2) = (unsigned short)(pkv >> 16); }
            const LAS float* nv = n_s + (c & 1) * 64 + 8 * w; const f32x4 n0 = *(const LAS f32x4*)nv, n1 = *(const LAS f32x4*)(nv + 4);
            qn_s[lane * 8 + w] = (q8[0] * n0[0] + q8[1] * n0[1] + q8[2] * n0[2] + q8[3] * n0[3]) + (q8[4] * n1[0] + q8[5] * n1[1] + q8[6] * n1[2] + q8[7] * n1[3]);
        } else {
            float x[8], kk[8], qs[8];
            const unsigned qr[4] = {rq[1].x, rq[1].y, rq[1].z, rq[1].w}, zr[4] = {rk[1].x, rk[1].y, rk[1].z, rk[1].w};
#pragma unroll
            for (int e = 0; e < 8; ++e) { x[e] = (e & 1) ? bfhi(zr[e >> 1]) : bflo(zr[e >> 1]); qs[e] = (e & 1) ? bfhi(qr[e >> 1]) : bflo(qr[e >> 1]); kk[e] = 1.0f - fexp(x[e]); }
#pragma unroll
            for (int e = 0; e < 8; ++e) x[e] = wave_scan_add(x[e]);
            float qe[8], qt[8], kt[8], ku[8];
#pragma unroll
            for (int e = 0; e < 8; ++e) { const float bb = x[e];
                const float blv = __uint_as_float(__builtin_amdgcn_readlane(__float_as_uint(bb), 63)), ref = __uint_as_float(__builtin_amdgcn_readlane(__float_as_uint(bb), 31));
                qe[e] = qs[e] * fexp(bb); qt[e] = qs[e] * fexp(fminf(bb - ref, 60.f)); kt[e] = kk[e] * fexp(fminf(ref - bb, 60.f)); ku[e] = kk[e] * fexp(blv - bb);
                if (lane == 0) dec_s[8 * w + e] = fexp(blv); }
#pragma unroll
            for (int e = 0; e < 4; ++e) { const unsigned pkv = pk2(ku[2 * e], ku[2 * e + 1]);
                *(LAS unsigned short*)(lds + SC_UKT + (8 * w + 2 * e) * RS + lane * 2) = (unsigned short)(pkv & 0xffffu);
                *(LAS unsigned short*)(lds + SC_UKT + (8 * w + 2 * e + 1) * RS + lane * 2) = (unsigned short)(pkv >> 16); }
            *(LAS bf16x8*)(lds + SC_QE + lane * RS + 16 * w) = pack8(qe[0], qe[1], qe[2], qe[3], qe[4], qe[5], qe[6], qe[7]);
            *(LAS bf16x8*)(lds + SC_QS + lane * RS + 16 * w) = pack8(qt[0], qt[1], qt[2], qt[3], qt[4], qt[5], qt[6], qt[7]);
            *(LAS bf16x8*)(lds + SC_KS + lane * RS + 16 * w) = pack8(kt[0], kt[1], kt[2], kt[3], kt[4], kt[5], kt[6], kt[7]);
        }
        const bool first_role = (c < 2) || (c >= 4 && c < 36);
        if (pending && !first_role) {
            asm volatile("s_waitcnt vmcnt(0)" ::: "memory"); if (lane == 0) __hip_atomic_fetch_add(prog_mine, 1u, __ATOMIC_RELAXED, __HIP_MEMORY_SCOPE_AGENT); pending = false; }
        if (!first_role && tid == 0) {
            const int cp = (c < 4) ? 3 - c : 71 - c; const unsigned need = 8u * (unsigned)((cp < 2 ? cp : cp - 2) + 1);
            if (cache_s[0] < need) {
                unsigned v; unsigned spins = 0;
                for (;;) { v = __hip_atomic_load(prog_other, __ATOMIC_RELAXED, __HIP_MEMORY_SCOPE_AGENT); if (v >= need) break; __builtin_amdgcn_s_sleep(2); if (++spins > (1u << 24)) break; }
                __builtin_amdgcn_fence(__ATOMIC_ACQUIRE, "agent");
                asm volatile("s_waitcnt vmcnt(0)" ::: "memory");
                cache_s[0] = v;
            }
        }
        LDS_BARRIER();
        SC_ROWS(c)
        const int t = 32 * ttile + r;
        const int orow = rb_ + (dir ? 63 - t : t);
        bf16_t* op = A.OUT + (size_t)orow * 512 + hd * 128 + 32 * etile + 4 * hh;
        unsigned long long prevv[4]; u32x2 gwv[4];
        if (!first_role) {
            const bf16_t* gp = A.P + pidx(orow, gcol + 32 * etile + 4 * hh);
#pragma unroll
            for (int ig = 0; ig < 4; ++ig) { prevv[ig] = __hip_atomic_load((const unsigned long long*)(op + 8 * ig), __ATOMIC_RELAXED, __HIP_MEMORY_SCOPE_AGENT); gwv[ig] = *(const u32x2*)(gp + 8 * ig); }
        }
        if (c + 1 < 68) SC_LOAD(c + 1);
        bf16x8 qf[4];
#pragma unroll
        for (int ks = 0; ks < 4; ++ks) qf[ks] = *(const LAS bf16x8*)(lds + SC_QS + t * RS + (16 * ks + 8 * hh) * 2);
        f32x16 S[2];
#pragma unroll
        for (int st = 0; st < 2; ++st) { f32x16 acc;
#pragma unroll
            for (int i = 0; i < 16; ++i) acc[i] = 0.f;
#pragma unroll
            for (int ks = 0; ks < 4; ++ks) { const bf16x8 kf = *(const LAS bf16x8*)(lds + SC_KS + (32 * st + r) * RS + (16 * ks + 8 * hh) * 2); acc = MFMA32(kf, qf[ks], acc); }
            S[st] = acc; }
        float c1 = 1.0f, c2 = 1.0f;
        if (IS_ML) {
            const float ea_t = __shfl(ea, t), en_t = __shfl(enm, t), wprev_t = __shfl(wprev, t);
            float rs = 0.f;
#pragma unroll
            for (int st = 0; st < 2; ++st)
#pragma unroll
                for (int ig = 0; ig < 4; ++ig) { const f32x4 bt = *(const LAS f32x4*)(eb_s + 32 * st + 8 * ig + 4 * hh);
#pragma unroll
                    for (int k = 0; k < 4; ++k) { const int s = 32 * st + 8 * ig + 4 * hh + k; const float v = (s <= t) ? S[st][4 * ig + k] * bt[k] : 0.f; S[st][4 * ig + k] = v; rs += v; } }
            rs += __shfl_xor(rs, 32);
            const f32x4 qa = *(const LAS f32x4*)(qn_s + t * 8), qb4 = *(const LAS f32x4*)(qn_s + t * 8 + 4);
            const float qn = ((qa[0] + qa[1]) + (qa[2] + qa[3])) + ((qb4[0] + qb4[1]) + (qb4[2] + qb4[3]));
            const float den = wprev_t * qn + ea_t * rs;
            const float inv = 1.0f / fmaxf(fabsf(den), en_t);
            c1 = wprev_t * inv; c2 = ea_t * inv;
            {
                const bf16x8 uk = *(const LAS bf16x8*)(lds + SC_UKT + (8 * w + (lane >> 3)) * RS + 16 * (lane & 7));
                float sacc = ((bf1(uk[0]) + bf1(uk[1])) + (bf1(uk[2]) + bf1(uk[3]))) + ((bf1(uk[4]) + bf1(uk[5])) + (bf1(uk[6]) + bf1(uk[7])));
                sacc += __shfl_xor(sacc, 1); sacc += __shfl_xor(sacc, 2); sacc += __shfl_xor(sacc, 4);
                if ((lane & 7) == 0) n_s[((c + 1) & 1) * 64 + 8 * w + (lane >> 3)] = a_prev * n_s[(c & 1) * 64 + 8 * w + (lane >> 3)] + sacc;
            }
        } else {
#pragma unroll
            for (int st = 0; st < 2; ++st)
#pragma unroll
                for (int i = 0; i < 16; ++i) { const int s = 32 * st + crow(i, hh); if (s > t) S[st][i] = 0.f; }
        }
        f32x16 acc1;
#pragma unroll
        for (int i = 0; i < 16; ++i) acc1[i] = 0.f;
#pragma unroll
        for (int ks = 0; ks < 4; ++ks) { const bf16x8 ca = *(const LAS bf16x8*)(lds + SC_CBT + (32 * etile + r) * RS + (16 * ks + 8 * hh) * 2);
            const bf16x8 qb = IS_ML ? qf[ks] : *(const LAS bf16x8*)(lds + SC_QE + t * RS + (16 * ks + 8 * hh) * 2);
            acc1 = MFMA32(ca, qb, acc1); }
        f32x16 acc2;
        if (IS_ML) {
#pragma unroll
            for (int i = 0; i < 16; ++i) acc2[i] = 0.f;
        } else acc2 = acc1;
#pragma unroll
        for (int kk2 = 0; kk2 < 4; ++kk2) { const int st = kk2 >> 1, s2 = kk2 & 1;
            const LAS unsigned char* vp = lds + SC_VT + (32 * etile + r) * RS + (32 * st + 16 * s2 + 4 * hh) * 2;
            const s16x4 lo = *(const LAS s16x4*)vp, hi = *(const LAS s16x4*)(vp + 16);
            const bf16x8 va = __builtin_shufflevector(lo, hi, 0, 1, 2, 3, 4, 5, 6, 7);
            const bf16x8 pb = pack8(S[st][8 * s2 + 0], S[st][8 * s2 + 1], S[st][8 * s2 + 2], S[st][8 * s2 + 3], S[st][8 * s2 + 4], S[st][8 * s2 + 5], S[st][8 * s2 + 6], S[st][8 * s2 + 7]);
            acc2 = MFMA32(va, pb, acc2); }
        f32x16 hv;
        if (IS_ML) {
#pragma unroll
            for (int i = 0; i < 16; ++i) hv[i] = c1 * acc1[i] + c2 * acc2[i];
        } else hv = acc2;
        if (pending) {
            asm volatile("s_waitcnt vmcnt(0)" ::: "memory"); if (lane == 0) __hip_atomic_fetch_add(prog_mine, 1u, __ATOMIC_RELAXED, __HIP_MEMORY_SCOPE_AGENT); pending = false; }
        if (first_role) {
#pragma unroll
            for (int ig = 0; ig < 4; ++ig) { const unsigned lo_ = pk2(hv[4 * ig], hv[4 * ig + 1]), hi_ = pk2(hv[4 * ig + 2], hv[4 * ig + 3]);
                __hip_atomic_store((unsigned long long*)(op + 8 * ig), ((unsigned long long)hi_ << 32) | lo_, __ATOMIC_RELAXED, __HIP_MEMORY_SCOPE_AGENT); }
            pending = true;
        } else {
            float sq = 0.f;
#pragma unroll
            for (int ig = 0; ig < 4; ++ig) { const unsigned a0 = (unsigned)prevv[ig], a1 = (unsigned)(prevv[ig] >> 32);
                hv[4 * ig] += bflo(a0); hv[4 * ig + 1] += bfhi(a0); hv[4 * ig + 2] += bflo(a1); hv[4 * ig + 3] += bfhi(a1);
                sq += (hv[4 * ig] * hv[4 * ig] + hv[4 * ig + 1] * hv[4 * ig + 1]) + (hv[4 * ig + 2] * hv[4 * ig + 2] + hv[4 * ig + 3] * hv[4 * ig + 3]); }
            sq += __shfl_xor(sq, 32);
            if (hh == 0) ssq_s[etile * 64 + t] = sq;
            LDS_BARRIER();
            const float tot = (ssq_s[t] + ssq_s[64 + t]) + (ssq_s[128 + t] + ssq_s[192 + t]);
            const float rstd = 1.0f / sqrtf(tot * (1.0f / 128.0f) + EPS);
#pragma unroll
            for (int ig = 0; ig < 4; ++ig) { const f32x4 g4 = *(const LAS f32x4*)(gn_s + 32 * etile + 4 * hh + 8 * ig);
                const float g0 = bflo(gwv[ig].x), g1 = bfhi(gwv[ig].x), g2 = bflo(gwv[ig].y), g3 = bfhi(gwv[ig].y);
                const float o0 = hv[4 * ig] * rstd * g4[0] * (IS_ML ? fsigmoid(g0) : fsilu(g0)), o1 = hv[4 * ig + 1] * rstd * g4[1] * (IS_ML ? fsigmoid(g1) : fsilu(g1));
                const float o2 = hv[4 * ig + 2] * rstd * g4[2] * (IS_ML ? fsigmoid(g2) : fsilu(g2)), o3 = hv[4 * ig + 3] * rstd * g4[3] * (IS_ML ? fsigmoid(g3) : fsilu(g3));
                u32x2 wv; wv.x = pk2(o0, o1); wv.y = pk2(o2, o3); *(u32x2*)(op + 8 * ig) = wv; }
        }
        if (IS_ML) {
#pragma unroll
            for (int i = 0; i < 16; ++i) Cst[i] *= a_prev;
        } else {
#pragma unroll
            for (int ig = 0; ig < 4; ++ig) { const f32x4 dv = *(const LAS f32x4*)(dec_s + 32 * dtile + 8 * ig + 4 * hh);
#pragma unroll
                for (int k = 0; k < 4; ++k) Cst[4 * ig + k] *= dv[k]; }
        }
#pragma unroll
        for (int ks = 0; ks < 4; ++ks) { const bf16x8 ua = *(const LAS bf16x8*)(lds + SC_UKT + (32 * dtile + r) * RS + (16 * ks + 8 * hh) * 2);
            const bf16x8 vb = *(const LAS bf16x8*)(lds + SC_VT + (32 * etile + r) * RS + (16 * ks + 8 * hh) * 2);
            Cst = MFMA32(ua, vb, Cst); }
        LDS_BARRIER();
#pragma unroll
        for (int ig = 0; ig < 4; ++ig) { u32x2 wv; wv.x = pk2(Cst[4 * ig], Cst[4 * ig + 1]); wv.y = pk2(Cst[4 * ig + 2], Cst[4 * ig + 3]);
            *(LAS u32x2*)(lds + SC_CBT + (32 * etile + r) * RS + (32 * dtile + 8 * ig + 4 * hh) * 2) = wv; }
    }
    if (pending) { asm volatile("s_waitcnt vmcnt(0)" ::: "memory"); if (lane == 0) __hip_atomic_fetch_add(prog_mine, 1u, __ATOMIC_RELAXED, __HIP_MEMORY_SCOPE_AGENT); }
#undef SC_LOAD
#undef SC_ROWS
#ifdef DBG_SEL
    if (IS_ML && blockIdx.x == 0 && tid == 0 && A.layer == 0) { unsigned long long* d_ = (unsigned long long*)(A.wsdbg + WS_LB + 4096); d_[40] = wacc_; d_[41] = 0; }
#endif
    __syncthreads();
}
#ifndef PH
#define PH 0xffff
#endif

#define XB_TMO      128
#define XB_XCNT(j)  (256  + 64 * (j))
#define XB_XSUB(j)  (1280 + 64 * (j))
#define XB_XGEN(j)  (2304 + 64 * (j))
#define XB_TOP      3328
#define XB_TOPGEN   3392
#define XCD_BAR_WORDS 3456
#define XB_SPIN_CAP (1u << 18)

__device__ __forceinline__ unsigned xb_ld(unsigned* p)              { return __hip_atomic_load(p, __ATOMIC_RELAXED, __HIP_MEMORY_SCOPE_AGENT); }
__device__ __forceinline__ unsigned xb_add(unsigned* p, unsigned v) { return __hip_atomic_fetch_add(p, v, __ATOMIC_RELAXED, __HIP_MEMORY_SCOPE_AGENT); }
__device__ __forceinline__ unsigned xb_xcc_id() { return (unsigned)__builtin_amdgcn_s_getreg((3 << 11) | 20) & 0xFu; }
#define XB_SPIN(cond, bar) do { unsigned _sp = 0; while (cond) { __builtin_amdgcn_s_sleep(1); \
    if ((++_sp & 255u) == 0u) { if (xb_ld(&(bar)[XB_TMO])) break; if (_sp > XB_SPIN_CAP) { atomicAdd(&(bar)[XB_TMO], 1u); break; } } } } while (0)

struct XcdBarrier {
    unsigned* bar; unsigned x;
    volatile LAS unsigned* st;
};

__device__ __forceinline__ XcdBarrier xcd_barrier_post(unsigned* bar, volatile LAS unsigned* st) {
    XcdBarrier b; b.bar = bar; b.x = xb_xcc_id(); b.st = st;
    if (threadIdx.x == 0) (void)xb_add(&bar[XB_XCNT(b.x)], 1u);
    return b;
}
__device__ __forceinline__ void xcd_barrier_complete(unsigned* bar, unsigned x, unsigned& nloc, unsigned& nx) {
    const unsigned G = gridDim.x * gridDim.y * gridDim.z;
    unsigned sum, cnt, mine, sp = 0u;
    for (;;) {
        sum = 0u; cnt = 0u; mine = 0u;
#pragma unroll
        for (unsigned j = 0; j < 16; ++j) { const unsigned c = xb_ld(&bar[XB_XCNT(j)]); sum += c; cnt += (c > 0u) ? 1u : 0u; mine = (j == x) ? c : mine; }
        if (sum == G) break;
        __builtin_amdgcn_s_sleep(1);
        if ((++sp & 255u) == 0u) { if (xb_ld(&bar[XB_TMO])) break; if (sp > XB_SPIN_CAP) { atomicAdd(&bar[XB_TMO], 1u); break; } }
    }
    nloc = mine > 0u ? mine : 1u; nx = cnt > 0u ? cnt : 1u;
}

__device__ __forceinline__ void xcd_barrier(const XcdBarrier& b) {
    asm volatile("s_waitcnt vmcnt(0)" ::: "memory");
    __syncthreads();
    if (threadIdx.x == 0) {
        unsigned* bar = b.bar;
        __builtin_amdgcn_s_waitcnt(0);
        unsigned nloc = b.st[0], nx = b.st[1];
        if (nloc == 0u) { xcd_barrier_complete(bar, b.x, nloc, nx); b.st[0] = nloc; b.st[1] = nx; }
        const unsigned old = xb_add(&bar[XB_XSUB(b.x)], 1u);
        const unsigned gen = old / nloc;
        if (old + 1u == (gen + 1u) * nloc) {
            __builtin_amdgcn_fence(__ATOMIC_RELEASE, "agent");
            asm volatile("s_waitcnt vmcnt(0)" ::: "memory");
            const unsigned og = xb_add(&bar[XB_TOP], 1u);
            const unsigned tg = og / nx;
            if (og + 1u == (tg + 1u) * nx) xb_add(&bar[XB_TOPGEN], 1u);
            else XB_SPIN(xb_ld(&bar[XB_TOPGEN]) == tg, bar);
            __builtin_amdgcn_fence(__ATOMIC_ACQUIRE, "agent");
            xb_add(&bar[XB_XGEN(b.x)], 1u);
            asm volatile("s_waitcnt vmcnt(0)" ::: "memory");
        } else {
            XB_SPIN(xb_ld(&bar[XB_XGEN(b.x)]) == gen, bar);
            __builtin_amdgcn_fence(__ATOMIC_ACQUIRE, "agent");
            asm volatile("s_waitcnt vmcnt(0)" ::: "memory");
        }
    }
    __syncthreads();
}


#ifdef DBG_SEL
#define DBG_BAR() do { DBG_STAMP(ws, 100 + nbar_, 0); ++nbar_; } while (0)
#define DBG_STAMP(ws_, idx, blk) do { if ((int)blockIdx.x == (blk) && threadIdx.x == 0) ((unsigned long long*)((ws_) + WS_LB + 4096))[idx] = __builtin_amdgcn_s_memrealtime(); } while (0)
#else
#define DBG_BAR() do {} while (0)
#define DBG_STAMP(ws_, idx, blk) do {} while (0)
#endif
DI void mix_phase(KP p, int l, LAS unsigned char* lds, int tid) {
    asm volatile("" : "+v"(tid));
    const int G = gridDim.x, bid = blockIdx.x;
    const bf16_t* P = (const bf16_t*)(p->ws + WS_P);
    bf16_t* ATT = (bf16_t*)(p->ws + WS_S); bf16_t* MLB = ATT + (size_t)MTOT * 512; bf16_t* HGB = MLB + (size_t)MTOT * 512;
    const int nattn = 512 + (l == 0 ? 32 : 0);
    DBG_STAMP(p->ws, 10 + 20 * l, 0);
    if (bid < 128) {
        const int it = bid, dir = it & 1, hd = (it >> 1) & 3, b = (it >> 3) & 7, ty = it >> 6;
        unsigned* prog = (unsigned*)p->ws + (l * 128 + (it & ~1)) * 16;
        if (ty == 0) { ScanArgs A{P, MLB, (const float*)(p->ws + WS_GATES), p->in[I_MLCONV] + (size_t)l * 3 * 512, p->in[I_MLFB] + l * 8, p->in[I_MLNORM] + l * 512, p->in[I_HGLB], l, p->ws};
#ifndef NO_SCANML
            scan_item<true>(A, b, hd, dir, prog + dir * 16, prog + (dir ^ 1) * 16, lds, tid);
#endif
        } else { ScanArgs A{P, HGB, (const float*)(p->ws + WS_GATES), p->in[I_MLCONV], p->in[I_MLFB], p->in[I_HGNORM] + l * 512, p->in[I_HGLB], l, p->ws};
#ifndef NO_SCANHG
            scan_item<false>(A, b, hd, dir, prog + dir * 16, prog + (dir ^ 1) * 16, lds, tid);
#endif
        }
    }
    DBG_STAMP(p->ws, 11 + 20 * l, 0); DBG_STAMP(p->ws, 16 + 20 * l, 1); DBG_STAMP(p->ws, 12 + 20 * l, 64);
    if (bid >= 128) {
        __syncthreads();
        const f32x2* rope = (const f32x2*)(p->ws + WS_ROPE);
        for (int i = tid; i < 1024; i += 512) ((LAS f32x2*)(lds + AT_TAB))[i] = rope[i];
        __syncthreads();
        AttnArgs A{P, ATT, p->in[I_SINK] + l * 8, rope};
        for (int it = bid - 128; it < nattn; it += G - 128) {
#ifndef NO_ATTN
 attn_item(A, it, lds, tid);
#endif
 }
        DBG_STAMP(p->ws, 13 + 20 * l, 128);
        __syncthreads();
        convert_weights(p, l, lds, 0x7cau, bid - 128, G - 128);
        if (l == 0) convert_weights(p, 1, lds, 0x35u, bid - 128, G - 128);
        DBG_STAMP(p->ws, 14 + 20 * l, 128);
    }
}

template <class Epi> DI void run_gemm(LAS unsigned char* lds, const bf16_t* A, const bf16_t* Bt, int M, int N, int K, const Epi& E) {
    pg8::Gemm g{A, Bt, M, N, K}; pg8::StaticOrder S; S.init(M, N, (int)gridDim.x, (int)blockIdx.x);
    pg8::gemm_phase<Epi, pg8::StaticOrder, true, true>(lds, g, S, E);
}

template <class Epi> DI void run_gemm_ctx(LAS unsigned char* lds, const bf16_t* A, const bf16_t* Bt, int N, int K, const Epi& E) {
    pg8::Gemm g{A, Bt, MTOT, N, K}; pg8::CtxOrder S{224, MLAT / 256};
    pg8::gemm_phase<Epi, pg8::CtxOrder, true, true>(lds, g, S, E);
}

DI void run_gemm_ctx_cnt(LAS unsigned char* lds, const bf16_t* A, const bf16_t* Bt, int N, int K, bf16_t* O, unsigned* cnt) {
    pg8::Gemm g{A, Bt, MTOT, N, K}; pg8::CtxOrder S{224, MLAT / 256};
    pg8::EpiBf16Cnt E{O, DM, cnt, MLAT / 256};
    pg8::gemm_phase<pg8::EpiBf16Cnt, pg8::CtxOrder, true, true>(lds, g, S, E);
    if (threadIdx.x == 0) {
        unsigned* c = cnt + 16 * (((int)blockIdx.x - 224) >> 2); unsigned spins = 0;
        while (__hip_atomic_load(c, __ATOMIC_RELAXED, __HIP_MEMORY_SCOPE_AGENT) < 32u) { __builtin_amdgcn_s_sleep(2); if (++spins > (1u << 22)) break; }
        __builtin_amdgcn_fence(__ATOMIC_ACQUIRE, "agent");
        asm volatile("s_waitcnt vmcnt(0)" ::: "memory");
    }
    __syncthreads();
}

#define GRID_BAR() do { XcdBarrier xb_; xb_.bar = (unsigned*)(ws) + 8192; xb_.x = xb_xcc_id(); xb_.st = (volatile LAS unsigned*)(lds + 131072); xcd_barrier(xb_); DBG_BAR(); } while (0)
__global__ void __launch_bounds__(512) fwd_kernel(Params p_unused) {
    extern __shared__ __attribute__((aligned(16))) unsigned char lds_raw[];
    LAS unsigned char* lds = (LAS unsigned char*)lds_raw;
    cg::grid_group grid = cg::this_grid();
#define tid ((int)threadIdx.x)
#define ws (kparams()->ws)
#define W ((bf16_t*)(ws + WS_W))
#define H ((bf16_t*)(ws + WS_H))
#define PB ((bf16_t*)(ws + WS_P))
#define SB ((bf16_t*)(ws + WS_S))
#define XC ((float*)(ws + WS_XC))
#define mod ((const float*)(ws + WS_MOD))
#define gates ((float*)(ws + WS_GATES))
    KP p = kparams();
    int nbar_ = 0; (void)nbar_;
    DBG_STAMP(ws, 99, 0);
    if (threadIdx.x < 16) ((LAS unsigned*)(lds + 131072))[threadIdx.x] = 0u;
    __syncthreads();
    (void)xcd_barrier_post((unsigned*)(ws) + 8192, (volatile LAS unsigned*)(lds + 131072));

#if PH & 1
    convert_weights(p, 0, lds, 0x35u, (int)blockIdx.x, (int)gridDim.x);
    __syncthreads();
    mods_phase(p, lds, tid);
#endif
    if (ws == nullptr) grid.sync();
    GRID_BAR();
    {
        RowArgs a{p->in[I_X], p->in[I_CTX], nullptr, nullptr, nullptr, H, mod, mod, nullptr, p->in[I_NPRE], nullptr, nullptr, 0, 0, 0, MTOT, (int)blockIdx.x, (int)gridDim.x, 0.f};
#if PH & 2
        row_phase<false, true, false>(a, lds, tid);
#endif
    }
    GRID_BAR();

#pragma unroll 1
    for (int l = 0; l < 2; ++l) {
#pragma unroll 1
      for (int f = 0; f < 2; ++f) {
        p = kparams();
        const float* modl = mod + (size_t)l * 9 * 9216;
        const float* npre = p->in[I_NPRE] + (size_t)l * 3 * DM; const float* npost = p->in[I_NPOST] + (size_t)l * 3 * DM;
        const bool ctx2 = (l == 0);
        const int bid = (int)blockIdx.x, G = (int)gridDim.x;
        if (f == 1) {
            { pg8::EpiGin E{PB, PTS, (const float*)(ws + WS_LB) + l * 256}; run_gemm(lds, H, W + WO_WIN, MTOT, NPC, DM, E); }
            GRID_BAR();
            mix_phase(p, l, lds, tid);
            GRID_BAR();
            DBG_STAMP(ws, 15 + 20 * l, 0);
            { pg8::EpiBf16<1> E{PB, NGC, 0}; run_gemm(lds, H, W + WO_WG, ctx2 ? MTOT : MLAT, NGC, DM, E); }
            GRID_BAR();
            {
                const int Mm = ctx2 ? MTOT : MLAT;
                pg8::Gemm g{SB, W + WO_WB, Mm, DM, 512, (size_t)MTOT * 512 * 2, (size_t)1024 * 512 * 2};
                pg8::MergeOrder S; S.S.init(Mm, DM, (int)gridDim.x, (int)blockIdx.x);
                pg8::EpiMerge E{H, PB, PB + (size_t)MTOT * NGC};
                pg8::gemm_phase<pg8::EpiMerge, pg8::MergeOrder, true, true>(lds, g, S, E);
            }
            GRID_BAR();
            { pg8::EpiBf16<0> E{SB, DM, 0}; run_gemm(lds, H, W + WO_WOUT, MLAT, DM, DM, E); }
            GRID_BAR();
            {
                const int vg = ctx2 ? 224 : G;
                RowArgs a{p->out, XC, p->out, XC, SB, H, modl, modl, npost + DM, npre + 2 * DM, nullptr, nullptr, 1, 2, 0, MLAT, bid < vg ? bid : -1, vg, 1.0f};
                if (bid < vg) row_phase<true, true, false>(a, lds, tid);
                else {
                    run_gemm_ctx_cnt(lds, H, W + WO_WOUT, DM, DM, SB, (unsigned*)(ws) + 12288 + (l * 4 + 3) * 128);
                    const int r0 = MLAT + ((bid - 224) >> 2) * 256 + ((bid - 224) & 3) * 64;
                    RowArgs c{p->out, XC, p->out, XC, SB, H, modl, modl, npost + DM, npre + 2 * DM, nullptr, nullptr, 1, 2, r0, r0 + 64, 0, 1, 1.0f};
                    row_phase<true, true, false, true>(c, lds, tid);
                }
            }
            GRID_BAR();
        }
        const bool hc = (f == 0) || ctx2;
        { pg8::EpiSwiGLU E{PB, DFF}; run_gemm(lds, H, W + WO_W13 + (size_t)f * 5632 * 1024, hc ? MTOT : MLAT, 5632, DM, E); }
        GRID_BAR();
        { pg8::EpiBf16<0> E{SB, DM, 0}; run_gemm(lds, PB, W + WO_W2 + (size_t)f * 1024 * 2816, MLAT, DM, DFF, E); }
        GRID_BAR();
        {
            const int vg = hc ? 224 : G;
            const bool has_pre = (f == 0) || (l == 0);
            RowArgs a{(l == 0 && f == 0) ? p->in[I_X] : p->out, (l == 0 && f == 0) ? p->in[I_CTX] : XC, p->out, XC, SB, H, modl, f == 0 ? modl : mod + (size_t)9 * 9216,
                      npost + (f == 0 ? 0 : 2 * DM), f == 0 ? npre + DM : p->in[I_NPRE] + 3 * DM, p->in[I_WIN] + (size_t)l * DM * DIN + 2304, gates, f == 0 ? 0 : 2, f == 0 ? 1 : 0, 0, MLAT, bid < vg ? bid : -1, vg, 0.5f};
            if (bid < vg) {
                if (f == 0) row_phase<true, true, true>(a, lds, tid);
                else if (has_pre) row_phase<true, true, false>(a, lds, tid);
                else row_phase<true, false, false>(a, lds, tid);
            } else {
                run_gemm_ctx_cnt(lds, PB, W + WO_W2 + (size_t)f * 1024 * 2816, DM, DFF, SB, (unsigned*)(ws) + 12288 + (l * 4 + f) * 128);
                const int r0 = MLAT + ((bid - 224) >> 2) * 256 + ((bid - 224) & 3) * 64;
                RowArgs c = a; c.row0 = r0; c.row1 = r0 + 64; c.vb = 0; c.vg = 1;
                if (f == 0) row_phase<true, true, true, true>(c, lds, tid);
                else row_phase<true, true, false, true>(c, lds, tid);
            }
        }
        if (!(l == 1 && f == 1)) GRID_BAR();
      }
    }
#ifdef DBG_SEL
    GRID_BAR();
    if (blockIdx.x == 0) {
        const unsigned long long* dbg = (const unsigned long long*)(ws + WS_LB + 4096);
        long long K = DBG_FIXED ? DBG_FIXED : (long long)(dbg[DBG_SEL] - dbg[DBG_REF]) / DBG_DIV;
        if (K < 0) K = 0; if (K > 18000) K = 18000;
        float* o = kparams()->out;
        for (int i = threadIdx.x; i < (int)K; i += 512) o[i] += 0.5f;
    }
#endif
#undef tid
#undef ws
#undef W
#undef H
#undef PB
#undef SB
#undef XC
#undef mod
#undef gates
}

extern "C" void kernel_launch(void* const* d_in, const int* in_sizes, int n_in, void* d_out, int out_size, void* d_ws, size_t ws_size, hipStream_t stream) {
    static int grid = 0;
    if (grid == 0) {
        if (n_in != 22 || out_size != MLAT * DM || ws_size < WS_END) { fprintf(stderr, "kernel_launch: unexpected shapes (n_in %d out %d ws %zu)\n", n_in, out_size, ws_size); grid = -1; return; }
        int dev = 0, cus = 0, per_cu = 0;
        (void)hipGetDevice(&dev);
        (void)hipDeviceGetAttribute(&cus, hipDeviceAttributeMultiprocessorCount, dev);
        (void)hipFuncSetAttribute((const void*)fwd_kernel, hipFuncAttributeMaxDynamicSharedMemorySize, LDS_BYTES);
        (void)hipOccupancyMaxActiveBlocksPerMultiprocessor(&per_cu, (const void*)fwd_kernel, 512, LDS_BYTES);
        if (per_cu < 1) per_cu = 1;
        if (per_cu > 1) per_cu = 1;
        grid = cus * per_cu;
        if (grid <= 0) grid = 256;
    }
    if (grid < 0) return;
    if (grid < 192) { fprintf(stderr, "kernel_launch: grid %d too small for the paired scans\n", grid); return; }
    (void)hipMemsetAsync(d_ws, 0, 65536, stream);
    Params p{};
    for (int i = 0; i < 22; ++i) p.in[i] = (const float*)d_in[i];
    p.out = (float*)d_out; p.ws = (unsigned char*)d_ws;
    void* args[] = {&p};
    hipError_t e = hipLaunchCooperativeKernel((const void*)fwd_kernel, dim3(grid), dim3(512), args, LDS_BYTES, stream);
    if (e != hipSuccess) fprintf(stderr, "cooperative launch failed: %s (grid %d)\n", hipGetErrorString(e), grid);
}
```
